# Optimizing an MI355X kernel written in HIP

```python
import jax
import jax.numpy as jnp
from jax import lax
import numpy as np

D_MODEL = 2048
BATCH = 4
SEQ = 2048
DEPTH = 1

N_META = 16
POOL_GROUPS = 4
POOL_WINDOWS = (2, 4, 8, 16)
POOL_WIDTH = D_MODEL // 2
POOL_GROUP_DIM = POOL_WIDTH // POOL_GROUPS
DN_HEADS = 16
DN_HEAD_DIM = 128
DN_WIDTH = DN_HEADS * DN_HEAD_DIM
CONV_WIDTH = 4
CHUNK = 64
NORM_EPS = 1e-6
IN_SPLIT_SIZES = (POOL_WIDTH, POOL_WIDTH, DN_WIDTH, DN_WIDTH, DN_WIDTH, DN_WIDTH, DN_HEADS, DN_HEADS, D_MODEL, D_MODEL)
IN_COLS = 2 * POOL_WIDTH + 4 * DN_WIDTH + 2 * DN_HEADS + 2 * D_MODEL

kernel_name = "hybrid_pool_gated_deltanet_block"


def rmsnorm(x, w):
    xf = x.astype(jnp.float32)
    y = xf * lax.rsqrt(jnp.mean(xf * xf, axis=-1, keepdims=True) + NORM_EPS)
    return (y * w.astype(jnp.float32)).astype(x.dtype)


def l2norm(x):
    return x * lax.rsqrt(jnp.sum(x * x, axis=-1, keepdims=True) + NORM_EPS)


def causal_multiscale_pool(u, mix_w, scale):
    Bsz, L, _ = u.shape
    uf = u.astype(jnp.float32)
    csum = jnp.concatenate([jnp.zeros((Bsz, 1, POOL_WIDTH), jnp.float32), jnp.cumsum(uf, axis=1)], axis=1)
    t = jnp.arange(1, L + 1)
    pooled = []
    for gi, w in enumerate(POOL_WINDOWS):
        c = csum[..., gi * POOL_GROUP_DIM:(gi + 1) * POOL_GROUP_DIM]
        lag = jnp.pad(c, ((0, 0), (w, 0), (0, 0)))[:, :L + 1]
        cnt = jnp.minimum(t, w).astype(jnp.float32)[None, :, None]
        pooled.append((c[:, 1:] - lag[:, 1:]) / cnt)
    pooled = jnp.concatenate(pooled, axis=-1) - uf
    pooled = pooled.reshape(Bsz, L, POOL_GROUPS, POOL_GROUP_DIM)
    mixed = jnp.einsum('blgc,gcd->blgd', pooled, mix_w.astype(jnp.float32)).reshape(Bsz, L, POOL_WIDTH)
    return mixed * scale.astype(jnp.float32)


def causal_depthwise_conv_silu(x, w):
    K = w.shape[0]
    L = x.shape[1]
    xp = jnp.pad(x, ((0, 0), (K - 1, 0), (0, 0)))
    y = xp[:, K - 1:K - 1 + L] * w[K - 1]
    for kk in range(K - 1):
        y = y + xp[:, kk:kk + L] * w[kk]
    return jax.nn.silu(y)


def chunk_gated_delta_rule(q, k, v, beta, g):
    Bsz, Lp, H, Dk = q.shape
    Dv = v.shape[-1]
    N = Lp // CHUNK

    def to_chunks(t):
        return jnp.moveaxis(t.reshape((Bsz, N, CHUNK) + t.shape[2:]), 3, 1)

    q, k, v, beta, g = to_chunks(q), to_chunks(k), to_chunks(v), to_chunks(beta), to_chunks(g)
    gcum = jnp.cumsum(g, axis=-1)
    causal = jnp.tril(jnp.ones((CHUNK, CHUNK), bool))
    strict = jnp.tril(jnp.ones((CHUNK, CHUNK), bool), -1)
    diff = gcum[..., :, None] - gcum[..., None, :]
    decay = jnp.where(causal, jnp.exp(jnp.where(causal, diff, 0.0)), 0.0)
    k_beta = k * beta[..., None]
    v_beta = v * beta[..., None]
    lmat = jnp.where(strict, jnp.einsum('bhncd,bhnsd->bhncs', k_beta, k) * decay, 0.0)
    eye = jnp.eye(CHUNK, dtype=jnp.float32)
    tmat = lax.linalg.triangular_solve(eye + lmat, jnp.broadcast_to(eye, lmat.shape), left_side=True, lower=True)
    u_c = jnp.einsum('bhncs,bhnsd->bhncd', tmat, v_beta)
    w_c = jnp.einsum('bhncs,bhnsd->bhncd', tmat, k_beta * jnp.exp(gcum)[..., None])
    qk = jnp.where(causal, jnp.einsum('bhncd,bhnsd->bhncs', q, k) * decay, 0.0)
    q_dec = q * jnp.exp(gcum)[..., None]
    k_dec = k * jnp.exp(gcum[..., -1:] - gcum)[..., None]
    g_last = jnp.exp(gcum[..., -1])

    def step(S, xs):
        u_i, w_i, q_i, k_i, qk_i, gl_i = xs
        v_new = u_i - jnp.einsum('bhcd,bhde->bhce', w_i, S)
        o_i = jnp.einsum('bhcd,bhde->bhce', q_i, S) + jnp.einsum('bhcs,bhse->bhce', qk_i, v_new)
        S = S * gl_i[..., None, None] + jnp.einsum('bhcd,bhce->bhde', k_i, v_new)
        return S, o_i

    xs = tuple(jnp.moveaxis(t, 2, 0) for t in (u_c, w_c, q_dec, k_dec, qk, g_last))
    S0 = jnp.zeros((Bsz, H, Dk, Dv), jnp.float32)
    _, o = lax.scan(step, S0, xs)
    o = jnp.transpose(o, (1, 0, 3, 2, 4))
    return o.reshape(Bsz, Lp, H, Dv)


def gated_deltanet_branch(q, k, v, z, b, a, conv_w, A_log, dt_bias, norm_w):
    Bsz, L, _ = q.shape
    qkv = causal_depthwise_conv_silu(jnp.concatenate([q, k, v], axis=-1), conv_w)
    q, k, v = jnp.split(qkv.astype(jnp.float32), 3, axis=-1)
    heads = lambda t: t.reshape(Bsz, L, DN_HEADS, DN_HEAD_DIM)
    q = l2norm(heads(q)) * (DN_HEAD_DIM ** -0.5)
    k = l2norm(heads(k))
    v = heads(v)
    beta = jax.nn.sigmoid(b.astype(jnp.float32))
    g = -jnp.exp(A_log.astype(jnp.float32)) * jax.nn.softplus(a.astype(jnp.float32) + dt_bias.astype(jnp.float32))
    pad = (-N_META) % CHUNK
    front = lambda t: jnp.pad(t, ((0, 0), (pad, 0)) + ((0, 0),) * (t.ndim - 2))
    o = chunk_gated_delta_rule(front(q), front(k), front(v), front(beta), front(g))[:, pad:]
    o = rmsnorm(o, norm_w) * jax.nn.silu(heads(z.astype(jnp.float32)))
    return o.reshape(Bsz, L, DN_WIDTH)


def hybrid_layer(h, norm_w, w_in, conv_w, A_log, dt_bias, pool_mix, pool_scale, dn_norm_w, w_pool_out, w_dn_out, w_o):
    xn = rmsnorm(h, norm_w)
    proj = xn @ w_in
    splits = np.cumsum(IN_SPLIT_SIZES[:-1]).tolist()
    u_pool, z_pool, q, k, v, z_dn, b, a, gate_pool, gate_dn = jnp.split(proj, splits, axis=-1)
    y_pool = (causal_multiscale_pool(u_pool, pool_mix, pool_scale) * jax.nn.silu(z_pool.astype(jnp.float32))).astype(h.dtype)
    y_dn = gated_deltanet_branch(q, k, v, z_dn, b, a, conv_w, A_log, dt_bias, dn_norm_w).astype(h.dtype)
    merged = jax.nn.sigmoid(gate_pool) * (y_pool @ w_pool_out) + jax.nn.sigmoid(gate_dn) * (y_dn @ w_dn_out)
    return h + merged @ w_o


def setup_inputs(seed: int = 0) -> dict:
    key = jax.random.key(seed)
    ks = jax.random.split(key, 14)
    nrm = jax.random.normal
    x = nrm(ks[0], (BATCH, SEQ, D_MODEL), jnp.float32)
    meta_tokens = nrm(ks[1], (N_META, D_MODEL), jnp.float32)
    norm_w = 1.0 + 0.02 * nrm(ks[2], (DEPTH, D_MODEL), jnp.float32)
    w_in = nrm(ks[3], (DEPTH, D_MODEL, IN_COLS), jnp.float32) * D_MODEL ** -0.5
    conv_w = nrm(ks[4], (DEPTH, CONV_WIDTH, 3 * DN_WIDTH), jnp.float32) * CONV_WIDTH ** -0.5
    A_log = jnp.log(jax.random.uniform(ks[5], (DEPTH, DN_HEADS), jnp.float32, minval=1.0, maxval=16.0))
    dt = jnp.exp(jax.random.uniform(ks[6], (DEPTH, DN_HEADS), jnp.float32, minval=float(np.log(1e-3)), maxval=float(np.log(1e-1))))
    dt_bias = dt + jnp.log(-jnp.expm1(-dt))
    pool_mix = nrm(ks[7], (DEPTH, POOL_GROUPS, POOL_GROUP_DIM, POOL_GROUP_DIM), jnp.float32) * POOL_GROUP_DIM ** -0.5
    pool_scale = 1.0 + 0.02 * nrm(ks[8], (DEPTH, POOL_WIDTH), jnp.float32)
    dn_norm_w = 1.0 + 0.02 * nrm(ks[9], (DEPTH, DN_HEAD_DIM), jnp.float32)
    w_pool_out = nrm(ks[10], (DEPTH, POOL_WIDTH, D_MODEL), jnp.float32) * POOL_WIDTH ** -0.5
    w_dn_out = nrm(ks[11], (DEPTH, DN_WIDTH, D_MODEL), jnp.float32) * DN_WIDTH ** -0.5
    w_o = nrm(ks[12], (DEPTH, D_MODEL, D_MODEL), jnp.float32) * D_MODEL ** -0.5
    final_norm_w = 1.0 + 0.02 * nrm(ks[13], (D_MODEL,), jnp.float32)
    return {"x": x, "meta_tokens": meta_tokens, "norm_w": norm_w, "w_in": w_in, "conv_w": conv_w,
            "A_log": A_log, "dt_bias": dt_bias, "pool_mix": pool_mix, "pool_scale": pool_scale,
            "dn_norm_w": dn_norm_w, "w_pool_out": w_pool_out, "w_dn_out": w_dn_out, "w_o": w_o,
            "final_norm_w": final_norm_w}


def reference(x, meta_tokens, norm_w, w_in, conv_w, A_log, dt_bias, pool_mix, pool_scale, dn_norm_w, w_pool_out, w_dn_out, w_o, final_norm_w):
    Bsz = x.shape[0]
    meta = jnp.broadcast_to(meta_tokens.astype(x.dtype)[None], (Bsz, N_META, D_MODEL))
    h = jnp.concatenate([meta, x], axis=1)
    for i in range(DEPTH):
        h = hybrid_layer(h, norm_w[i], w_in[i], conv_w[i], A_log[i], dt_bias[i], pool_mix[i], pool_scale[i],
                         dn_norm_w[i], w_pool_out[i], w_dn_out[i], w_o[i])
    return rmsnorm(h[:, N_META:], final_norm_w)
```

```cpp
#define MIX 0
#include <hip/hip_runtime.h>
#include <cstdint>
#include <cstdio>

typedef unsigned short bf16_t;
__device__ __forceinline__ float bf2f(bf16_t v) { return __uint_as_float(((unsigned)v) << 16); }
__device__ __forceinline__ bf16_t f2bf(float f) { unsigned u = __float_as_uint(f); return (bf16_t)((u + 0x7fffu + ((u >> 16) & 1u)) >> 16); }
__device__ __forceinline__ float sigmoidf_(float x) { return 1.f / (1.f + __expf(-x)); }
__device__ __forceinline__ float siluf_(float x) { return x / (1.f + __expf(-x)); }
__device__ __forceinline__ float softplusf_(float x) { return x > 20.f ? x : log1pf(__expf(x)); }

constexpr int DM = 2048, NB = 4, SEQ = 2048, NMETA = 16, LEXT = SEQ + NMETA;
constexpr int PW = 1024, PGD = 256, NH = 16, HD = 128, DNW = 2048, CHUNK = 64, NCH = 33, PADF = 48;
constexpr int INC = 14368;
constexpr int C_U = 0, C_ZP = 1024, C_Q = 2048, C_ZD = 8192, C_B = 10240, C_GP = 10272;
constexpr int MTOK = NB * SEQ;
constexpr int MROWS = MTOK + NMETA;
constexpr int MPAD = 8448;
constexpr int NPAD1 = 14592;
constexpr int YLD = 3072;
constexpr float EPS = 1e-6f;
constexpr int NUNITS = NB * NH * NCH;

constexpr size_t MiB = 1u << 20;
constexpr size_t WS_CTL = 0, CTL_ZERO_BYTES = 1 * MiB;
constexpr size_t WS_CH = 1 * MiB;
constexpr size_t CH_ARR = (size_t)NUNITS * 8192 * 2;
constexpr size_t WS_CH_NW = WS_CH, WS_CH_U = WS_CH + CH_ARR, WS_CH_QD = WS_CH + 2 * CH_ARR, WS_CH_KDT = WS_CH + 3 * CH_ARR, WS_CH_QK = WS_CH + 4 * CH_ARR;
constexpr size_t WS_CH_GL = WS_CH_QK + (size_t)NUNITS * 4096 * 2;
constexpr size_t WS_WINT = WS_CH;
constexpr size_t WS_XN = WS_CH + 57 * MiB;
constexpr size_t WS_W2T = 150 * MiB;
constexpr size_t WS_WOT = 162 * MiB;
constexpr size_t WS_MIXT = 170 * MiB;
constexpr size_t WS_U = 171 * MiB;
constexpr size_t WS_SZP = WS_U + (size_t)MPAD * 1024 * 2;
constexpr size_t WS_QKV = WS_SZP + (size_t)MPAD * 1024 * 2;
constexpr size_t WS_BA = 303 * MiB;
constexpr size_t WS_O = 204 * MiB, WS_Y = 236 * MiB, WS_MERGED = 204 * MiB;
constexpr size_t WS_SZD = 304 * MiB + 512 * 1024;
constexpr size_t WS_GATES = WS_SZD + (size_t)MPAD * 2048 * 2;
constexpr size_t WS_POOLED = WS_GATES + (size_t)MPAD * 4096 * 2;
constexpr size_t WS_END = WS_POOLED + (size_t)MTOK * 1024 * 2;
static_assert(WS_CH_GL + NUNITS * 4 <= WS_W2T, "chunk arrays");
static_assert(WS_XN + (size_t)MPAD * 2048 * 2 <= WS_W2T, "xn");
static_assert(WS_QKV == 204 * MiB && WS_QKV + (size_t)MPAD * 6144 * 2 <= WS_BA, "qkv");
static_assert(WS_Y + (size_t)MTOK * YLD * 2 <= WS_BA, "y");
static_assert(WS_BA + (size_t)MPAD * 32 * 4 <= WS_SZD, "ba");
static_assert(WS_END <= 449 * MiB, "ws");

__device__ __forceinline__ int ext_row(int b, int p) { return p < NMETA ? MTOK + p : b * SEQ + (p - NMETA); }

__device__ __forceinline__ float wave_sum(float v) {
#pragma unroll
    for (int o = 1; o < 64; o <<= 1) v += __shfl_xor(v, o);
    return v;
}
#if MIX
__global__ void __launch_bounds__(256) nv_prep(const float* __restrict__ x, const float* __restrict__ meta, const float* __restrict__ nw, bf16_t* __restrict__ XN) {
    const int lane = threadIdx.x & 63, gw = (blockIdx.x * 256 + threadIdx.x) >> 6, ngw = gridDim.x * 4;
    for (int r = gw; r < MPAD; r += ngw) {
        bf16_t* o = XN + (size_t)r * DM;
        if (r >= MROWS) { for (int j = lane; j < DM; j += 64) o[j] = 0; continue; }
        const float* src = r < MTOK ? x + (size_t)r * DM : meta + (size_t)(r - MTOK) * DM;
        float v[32]; float s = 0.f;
#pragma unroll
        for (int j = 0; j < 32; ++j) { v[j] = src[lane + 64 * j]; s += v[j] * v[j]; }
        const float rs = rsqrtf(wave_sum(s) * (1.f / DM) + EPS);
#pragma unroll
        for (int j = 0; j < 32; ++j) o[lane + 64 * j] = f2bf(v[j] * rs * nw[lane + 64 * j]);
    }
}

template <class Epi>
__global__ void __launch_bounds__(256) nv_gemm(const bf16_t* __restrict__ A, int lda, const float* __restrict__ W, int ldw, int M, int N, int K, Epi epi) {
    __shared__ __attribute__((aligned(16))) float As[16][132];
    __shared__ __attribute__((aligned(16))) float Bs[16][132];
    const int tid = threadIdx.x, tx = tid & 15, ty = tid >> 4;
    const int m0 = blockIdx.y * 128, n0 = blockIdx.x * 128;
    float acc[8][8];
#pragma unroll
    for (int i = 0; i < 8; ++i)
#pragma unroll
        for (int j = 0; j < 8; ++j) acc[i][j] = 0.f;
    for (int k0 = 0; k0 < K; k0 += 16) {
        {
            const int r = tid >> 1, kc = (tid & 1) * 8, gm = m0 + r;
            uint4 v = make_uint4(0, 0, 0, 0);
            if (gm < M) v = *(const uint4*)(A + (size_t)gm * lda + k0 + kc);
            const unsigned w[4] = {v.x, v.y, v.z, v.w};
#pragma unroll
            for (int j = 0; j < 4; ++j) { As[kc + 2 * j][r] = __uint_as_float(w[j] << 16); As[kc + 2 * j + 1][r] = __uint_as_float(w[j] & 0xffff0000u); }
        }
        {
            const int kk = tid >> 4, nc = (tid & 15) * 8, gn = n0 + nc;
            float4 v0 = make_float4(0, 0, 0, 0), v1 = v0;
            if (gn < N) { const float* p = W + (size_t)(k0 + kk) * ldw + gn; v0 = *(const float4*)p; v1 = *(const float4*)(p + 4); }
            *(float4*)&Bs[kk][nc] = v0; *(float4*)&Bs[kk][nc + 4] = v1;
        }
        __syncthreads();
#pragma unroll
        for (int kk = 0; kk < 16; ++kk) {
            float a[8], b[8];
            *(float4*)&a[0] = *(const float4*)&As[kk][ty * 8]; *(float4*)&a[4] = *(const float4*)&As[kk][ty * 8 + 4];
            *(float4*)&b[0] = *(const float4*)&Bs[kk][tx * 8]; *(float4*)&b[4] = *(const float4*)&Bs[kk][tx * 8 + 4];
#pragma unroll
            for (int i = 0; i < 8; ++i)
#pragma unroll
                for (int j = 0; j < 8; ++j) acc[i][j] += a[i] * b[j];
        }
        __syncthreads();
    }
#pragma unroll
    for (int i = 0; i < 8; ++i)
#pragma unroll
        for (int j = 0; j < 8; ++j) { const int gm = m0 + ty * 8 + i, gn = n0 + tx * 8 + j; if (gm < M && gn < N) epi(gm, gn, acc[i][j]); }
}

struct EpiProj {
    bf16_t *U, *SZP, *QKV, *SZD, *GATES; float* BA;
    __device__ __forceinline__ void operator()(int m, int n, float v) const {
        if (n < C_ZP) U[(size_t)m * 1024 + n] = f2bf(v);
        else if (n < C_Q) SZP[(size_t)m * 1024 + (n - C_ZP)] = f2bf(siluf_(v));
        else if (n < C_ZD) QKV[(size_t)m * 6144 + (n - C_Q)] = f2bf(v);
        else if (n < C_B) SZD[(size_t)m * 2048 + (n - C_ZD)] = f2bf(siluf_(v));
        else if (n < C_GP) BA[(size_t)m * 32 + (n - C_B)] = v;
        else GATES[(size_t)m * 4096 + (n - C_GP)] = f2bf(sigmoidf_(v));
    }
};
struct EpiPool {
    bf16_t* Y; const bf16_t* SZP; const float* scale; int g, pad;
    __device__ __forceinline__ void operator()(int m, int n, float v) const {
        const int c = g * PGD + n; Y[(size_t)m * YLD + c] = f2bf(v * scale[c] * bf2f(SZP[(size_t)m * 1024 + c]));
    }
};
struct EpiG2a { float* T; const bf16_t* GATES; __device__ __forceinline__ void operator()(int m, int n, float v) const { T[(size_t)m * DM + n] = v * bf2f(GATES[(size_t)m * 4096 + n]); } };
struct EpiG2b { const float* T; const bf16_t* GATES; bf16_t* MG; __device__ __forceinline__ void operator()(int m, int n, float v) const { MG[(size_t)m * DM + n] = f2bf(T[(size_t)m * DM + n] + v * bf2f(GATES[(size_t)m * 4096 + 2048 + n])); } };
struct EpiG3 { const float* x; float* out; __device__ __forceinline__ void operator()(int m, int n, float v) const { out[(size_t)m * DM + n] = x[(size_t)m * DM + n] + v; } };

__global__ void __launch_bounds__(256) nv_pool(const bf16_t* __restrict__ U, bf16_t* __restrict__ PO) {
    const int idx = blockIdx.x * 256 + threadIdx.x; if (idx >= MTOK * PW) return;
    const int m = idx >> 10, c = idx & 1023, b = m >> 11, t = m & 2047, p = t + NMETA, win = 2 << (c >> 8);
    float s = 0.f;
    for (int j = 0; j < win; ++j) { const int pp = p - j; if (pp >= 0) s += bf2f(U[(size_t)ext_row(b, pp) * 1024 + c]); }
    const int cnt = (p + 1) < win ? (p + 1) : win;
    PO[idx] = f2bf(s / (float)cnt - bf2f(U[(size_t)m * 1024 + c]));
}

__global__ void __launch_bounds__(256) nv_chunk_prep(const bf16_t* __restrict__ QKV, const float* __restrict__ BA, const float* __restrict__ conv_w, const float* __restrict__ A_log,
                                                     const float* __restrict__ dt_bias, bf16_t* __restrict__ NW, bf16_t* __restrict__ UU, bf16_t* __restrict__ QD, bf16_t* __restrict__ KDT,
                                                     bf16_t* __restrict__ QK, float* __restrict__ GL) {
    extern __shared__ __attribute__((aligned(16))) float sm[];
    float *q = sm, *k = q + 8192, *v = k + 8192, *Am = v + 8192, *Tm = Am + 4096, *beta = Tm + 4096, *gc = beta + 64;
    const int cu = blockIdx.x, n = cu % NCH, bh = cu / NCH, h = bh % NH, b = bh / NH, tid = threadIdx.x, lane = tid & 63, wv = tid >> 6;
    const int p0 = CHUNK * n - PADF;
    for (int idx = tid; idx < 64 * 384; idx += 256) {
        const int i = idx / 384, c3 = idx % 384, which = c3 >> 7, d = c3 & 127, col = which * 2048 + h * HD + d, p = p0 + i;
        float val = 0.f;
        if (p >= 0) { float a = 0.f;
            for (int kk = 0; kk < 4; ++kk) { const int pp = p - 3 + kk; if (pp >= 0) a += conv_w[kk * 6144 + col] * bf2f(QKV[(size_t)ext_row(b, pp) * 6144 + col]); }
            val = siluf_(a); }
        (which == 0 ? q : which == 1 ? k : v)[i * 128 + d] = val;
    }
    if (tid < 64) { const int p = p0 + tid; float be = 0.f, g = 0.f;
        if (p >= 0) { const int r = ext_row(b, p); be = sigmoidf_(BA[(size_t)r * 32 + h]); g = -__expf(A_log[h]) * softplusf_(BA[(size_t)r * 32 + 16 + h] + dt_bias[h]); }
        beta[tid] = be; gc[tid] = g; }
    __syncthreads();
    if (tid == 0) { float s = 0.f; for (int i = 0; i < 64; ++i) { s += gc[i]; gc[i] = s; } }
    for (int r = wv; r < 128; r += 4) {
        float* row = (r < 64 ? q + r * 128 : k + (r - 64) * 128);
        const float a0 = row[lane], a1 = row[lane + 64];
        const float rs = rsqrtf(wave_sum(a0 * a0 + a1 * a1) + EPS) * (r < 64 ? 0.08838834764831845f : 1.f);
        row[lane] = a0 * rs; row[lane + 64] = a1 * rs;
    }
    __syncthreads();
    bf16_t* oQK = QK + (size_t)cu * 4096;
    for (int idx = tid; idx < 4096; idx += 256) {
        const int i = idx >> 6, j = idx & 63; float akk = 0.f, aqk = 0.f;
        if (j <= i) { for (int d = 0; d < 128; ++d) { const float kj = k[j * 128 + d]; akk += k[i * 128 + d] * kj; aqk += q[i * 128 + d] * kj; }
            const float dec = __expf(gc[i] - gc[j]); akk *= beta[i] * dec; aqk *= dec; }
        Am[idx] = j < i ? akk : 0.f; oQK[idx] = f2bf(j <= i ? aqk : 0.f);
    }
    __syncthreads();
    if (tid < 64) { const int c = tid;
        for (int i = 0; i < 64; ++i) { float s = (i == c) ? 1.f : 0.f; for (int j = c; j < i; ++j) s -= Am[i * 64 + j] * Tm[j * 64 + c]; Tm[i * 64 + c] = (i >= c) ? s : 0.f; } }
    __syncthreads();
    bf16_t *oNW = NW + (size_t)cu * 8192, *oU = UU + (size_t)cu * 8192, *oQD = QD + (size_t)cu * 8192, *oKDT = KDT + (size_t)cu * 8192;
    const float gl = gc[63];
    for (int idx = tid; idx < 8192; idx += 256) {
        const int i = idx >> 7, d = idx & 127; float su = 0.f, sw = 0.f;
        for (int j = 0; j <= i; ++j) { const float t = Tm[i * 64 + j] * beta[j]; su += t * v[j * 128 + d]; sw += t * __expf(gc[j]) * k[j * 128 + d]; }
        oU[idx] = f2bf(su); oNW[idx] = f2bf(-sw);
        oQD[idx] = f2bf(q[idx] * __expf(gc[i]));
        oKDT[d * 64 + i] = f2bf(k[idx] * __expf(gl - gc[i]));
    }
    if (tid == 0) GL[cu] = __expf(gl);
}

__global__ void __launch_bounds__(128) nv_chunk_scan(const bf16_t* __restrict__ NW, const bf16_t* __restrict__ UU, const bf16_t* __restrict__ QD, const bf16_t* __restrict__ KDT,
                                                     const bf16_t* __restrict__ QK, const float* __restrict__ GL, bf16_t* __restrict__ O) {
    __shared__ float vn[64][128];
    const int bh = blockIdx.x, h = bh % NH, b = bh / NH, e = threadIdx.x;
    float S[128];
#pragma unroll
    for (int d = 0; d < 128; ++d) S[d] = 0.f;
    for (int n = 0; n < NCH; ++n) {
        const int cu = bh * NCH + n;
        const bf16_t *nw = NW + (size_t)cu * 8192, *uu = UU + (size_t)cu * 8192, *qd = QD + (size_t)cu * 8192, *kdt = KDT + (size_t)cu * 8192, *qk = QK + (size_t)cu * 4096;
        const float gl = GL[cu];
        for (int i = 0; i < 64; ++i) { float a = bf2f(uu[i * 128 + e]);
#pragma unroll
            for (int d = 0; d < 128; ++d) a += bf2f(nw[i * 128 + d]) * S[d];
            vn[i][e] = a; }
        __syncthreads();
        if (n > 0) for (int i = 0; i < 64; ++i) { float a = 0.f;
#pragma unroll
            for (int d = 0; d < 128; ++d) a += bf2f(qd[i * 128 + d]) * S[d];
            for (int j = 0; j <= i; ++j) a += bf2f(qk[i * 64 + j]) * vn[j][e];
            O[(size_t)(b * SEQ + 64 * (n - 1) + i) * DNW + h * HD + e] = f2bf(a); }
#pragma unroll
        for (int d = 0; d < 128; ++d) { float s = S[d] * gl; for (int i = 0; i < 64; ++i) s += bf2f(kdt[d * 64 + i]) * vn[i][e]; S[d] = s; }
        __syncthreads();
    }
}

__global__ void __launch_bounds__(256) nv_gnorm(const bf16_t* __restrict__ O, const bf16_t* __restrict__ SZD, const float* __restrict__ w, bf16_t* __restrict__ Y) {
    const int lane = threadIdx.x & 63, gw = (blockIdx.x * 256 + threadIdx.x) >> 6; if (gw >= MTOK * NH) return;
    const size_t base = (size_t)(gw >> 4) * DNW + (gw & 15) * HD, yb = (size_t)(gw >> 4) * YLD + 1024 + (gw & 15) * HD;
    const float a0 = bf2f(O[base + lane]), a1 = bf2f(O[base + lane + 64]);
    const float rs = rsqrtf(wave_sum(a0 * a0 + a1 * a1) * (1.f / HD) + EPS);
    Y[yb + lane] = f2bf(a0 * rs * w[lane] * bf2f(SZD[base + lane]));
    Y[yb + lane + 64] = f2bf(a1 * rs * w[lane + 64] * bf2f(SZD[base + lane + 64]));
}

__global__ void __launch_bounds__(256) nv_final(float* __restrict__ out, const float* __restrict__ w) {
    __shared__ float red[4];
    float* row = out + (size_t)blockIdx.x * DM; const int tid = threadIdx.x;
    float v[8]; float s = 0.f;
#pragma unroll
    for (int j = 0; j < 8; ++j) { v[j] = row[tid + 256 * j]; s += v[j] * v[j]; }
    s = wave_sum(s); if ((tid & 63) == 0) red[tid >> 6] = s; __syncthreads();
    const float rs = rsqrtf((red[0] + red[1] + red[2] + red[3]) * (1.f / DM) + EPS);
#pragma unroll
    for (int j = 0; j < 8; ++j) row[tid + 256 * j] = v[j] * rs * w[tid + 256 * j];
}

#endif
namespace pg8 {
#define PG8_LAS __attribute__((address_space(3)))
typedef short bf16x8 __attribute__((ext_vector_type(8)));
typedef float f32x4 __attribute__((ext_vector_type(4)));
typedef unsigned u32x4 __attribute__((ext_vector_type(4)));
constexpr int BM = 256, BK = 64, HALF = 128, HTB = HALF * BK * 2  , STAGE_BYTES = 8 * HTB, NXCD = 8, WGM = 8;

__host__ __device__ __forceinline__ int lds_byte(int r, int c) { const int st = (r >> 4) * 2 + (c >> 5), rr = r & 15, cc = c & 31, ob = rr * 64 + cc * 2; return st * 1024 + (ob ^ (((ob >> 9) & 1) << 5)); }
__host__ __device__ __forceinline__ void stage_rc(int b, int& R, int& C) { const int st = b / 1024, sb = b % 1024, swz = sb ^ (((sb >> 9) & 1) << 5); R = (st >> 1) * 16 + swz / 64; C = (st & 1) * 32 + (swz % 64) / 2; }
__host__ __device__ __forceinline__ int perm32(int rho) { const int n = rho >> 4, i = rho & 15; return 8 * (i >> 2) + 4 * n + (i & 3); }

struct Unit { int pm, pn, aoff, boff, nt, mode; };
struct Gemm { const bf16_t* A; const bf16_t* Bt; int lda, ldb; };

struct StaticOrder {
    int nM, nN, nwg, G, c, nt;
    __device__ void init(int nM_, int nN_, int nt_, int G_, int c_) { nM = nM_; nN = nN_; nwg = nM * nN; G = G_; c = c_; nt = nt_; }
    __device__ bool next(int i, Unit& u) const {
        const long L = (long)i * G + c; if (L >= nwg) return false;
        int wgid = (int)L; { const int q = nwg / NXCD, r = nwg % NXCD, xcd = wgid % NXCD, off = wgid / NXCD; wgid = (xcd < r ? xcd * (q + 1) : r * (q + 1) + (xcd - r) * q) + off; }
        const int nig = WGM * nN, gid = wgid / nig, fm = gid * WGM, gsz = (nM - fm) < WGM ? (nM - fm) : WGM;
        u.pm = fm + ((wgid % nig) % gsz); u.pn = (wgid % nig) / gsz; u.aoff = 0; u.boff = 0; u.nt = nt; u.mode = 0; return true;
    }
};

typedef float f32x2_t __attribute__((ext_vector_type(2))); typedef __bf16 bf16x2_t __attribute__((ext_vector_type(2)));
__device__ __forceinline__ unsigned cvt_pk_bf16(float lo, float hi) { f32x2_t v = {lo, hi}; bf16x2_t b = __builtin_convertvector(v, bf16x2_t); return __builtin_bit_cast(unsigned, b); }
__device__ __forceinline__ u32x4 pack8(f32x4 v0, f32x4 v1) { u32x4 w; w.x = cvt_pk_bf16(v0[0], v0[1]); w.y = cvt_pk_bf16(v0[2], v0[3]); w.z = cvt_pk_bf16(v1[0], v1[1]); w.w = cvt_pk_bf16(v1[2], v1[3]); return w; }
__device__ __forceinline__ void unpack8(u32x4 w, f32x4& v0, f32x4& v1) {
    v0 = (f32x4){__uint_as_float(w.x << 16), __uint_as_float(w.x & 0xffff0000u), __uint_as_float(w.y << 16), __uint_as_float(w.y & 0xffff0000u)};
    v1 = (f32x4){__uint_as_float(w.z << 16), __uint_as_float(w.z & 0xffff0000u), __uint_as_float(w.w << 16), __uint_as_float(w.w & 0xffff0000u)};
}
__device__ __forceinline__ float fast_sigmoid(float x) { return __builtin_amdgcn_rcpf(1.f + __builtin_amdgcn_exp2f(-1.4426950408889634f * x)); }

struct EpiProj {
    static constexpr bool PERM = true;
    bf16_t *U, *SZP, *QKV, *SZD, *GATES; float* BA;
    __device__ __forceinline__ bool reset_after(const Unit&) const { return true; }
    __device__ __forceinline__ void operator()(f32x4 (&acc)[2][2][4][2], const Unit& u, int wr, int wc, int fr, int fq) const {
        const int row0 = u.pm * BM + wr * 64 + fr, pn = u.pn;
        if (pn == 56) {
            if (wc == 0) {
#pragma unroll
                for (int ai = 0; ai < 2; ++ai)
#pragma unroll
                    for (int m = 0; m < 4; ++m) { float* rowp = BA + (size_t)(row0 + ai * HALF + m * 16) * 32 + 8 * fq;
                        *(f32x4*)rowp = acc[ai][0][m][0]; *(f32x4*)(rowp + 4) = acc[ai][0][m][1]; }
            }
            return;
        }
        bf16_t* base; int ld, colt, act;
        if (pn < 4) { base = U; ld = 1024; colt = pn * 256; act = 0; }
        else if (pn < 8) { base = SZP; ld = 1024; colt = (pn - 4) * 256; act = 1; }
        else if (pn < 32) { base = QKV; ld = 6144; colt = (pn - 8) * 256; act = 0; }
        else if (pn < 40) { base = SZD; ld = 2048; colt = (pn - 32) * 256; act = 1; }
        else { base = GATES; ld = 4096; colt = (pn - 40) * 256; act = 2; }
        const int col0 = colt + wc * 32 + 8 * fq;
#pragma unroll
        for (int ai = 0; ai < 2; ++ai)
#pragma unroll
            for (int m = 0; m < 4; ++m) { bf16_t* rowp = base + (size_t)(row0 + ai * HALF + m * 16) * ld + col0;
#pragma unroll
                for (int bj = 0; bj < 2; ++bj) { f32x4 v0 = acc[ai][bj][m][0], v1 = acc[ai][bj][m][1];
                    if (act != 0) {
#pragma unroll
                        for (int j = 0; j < 4; ++j) { const float s0 = fast_sigmoid(v0[j]), s1 = fast_sigmoid(v1[j]); v0[j] = act == 1 ? v0[j] * s0 : s0; v1[j] = act == 1 ? v1[j] * s1 : s1; }
                    }
                    *(u32x4*)(rowp + bj * HALF) = pack8(v0, v1); } }
    }
};
struct EpiPoolMix {
    static constexpr bool PERM = true;
    bf16_t* Y; const bf16_t* SZP; const float* scale;
    __device__ __forceinline__ bool reset_after(const Unit&) const { return true; }
    __device__ __forceinline__ void operator()(f32x4 (&acc)[2][2][4][2], const Unit& u, int wr, int wc, int fr, int fq) const {
        const int row0 = u.pm * BM + wr * 64 + fr, col0 = u.pn * BM + wc * 32 + 8 * fq;
#pragma unroll
        for (int bj = 0; bj < 2; ++bj) { const f32x4 s0 = *(const f32x4*)(scale + col0 + bj * HALF), s1 = *(const f32x4*)(scale + col0 + bj * HALF + 4);
#pragma unroll
            for (int ai = 0; ai < 2; ++ai)
#pragma unroll
                for (int m = 0; m < 4; ++m) { const size_t r = (size_t)(row0 + ai * HALF + m * 16);
                    f32x4 z0, z1; unpack8(*(const u32x4*)(SZP + r * 1024 + col0 + bj * HALF), z0, z1);
                    *(u32x4*)(Y + r * YLD + col0 + bj * HALF) = pack8(acc[ai][bj][m][0] * s0 * z0, acc[ai][bj][m][1] * s1 * z1); } }
    }
};
struct EpiMerge {
    static constexpr bool PERM = true;
    const bf16_t* GATES; bf16_t* MG;
    __device__ __forceinline__ bool reset_after(const Unit& u) const { return u.mode != 0; }
    __device__ __forceinline__ void operator()(f32x4 (&acc)[2][2][4][2], const Unit& u, int wr, int wc, int fr, int fq) const {
        const int row0 = u.pm * BM + wr * 64 + fr, col0 = u.pn * BM + wc * 32 + 8 * fq;
#pragma unroll
        for (int ai = 0; ai < 2; ++ai)
#pragma unroll
            for (int m = 0; m < 4; ++m) { const size_t r = (size_t)(row0 + ai * HALF + m * 16);
#pragma unroll
                for (int bj = 0; bj < 2; ++bj) {
                    f32x4 d0, d1; unpack8(*(const u32x4*)(GATES + r * 4096 + 2048 + col0 + bj * HALF), d0, d1);
                    if (u.mode == 0) {
                        f32x4 p0, p1; unpack8(*(const u32x4*)(GATES + r * 4096 + col0 + bj * HALF), p0, p1);
#pragma unroll
                        for (int j = 0; j < 4; ++j) { acc[ai][bj][m][0][j] *= p0[j] / fmaxf(d0[j], 1e-30f); acc[ai][bj][m][1][j] *= p1[j] / fmaxf(d1[j], 1e-30f); }
                    } else {
                        *(u32x4*)(MG + r * DM + col0 + bj * HALF) = pack8(acc[ai][bj][m][0] * d0, acc[ai][bj][m][1] * d1);
                    } } }
    }
};
struct EpiResid {
    static constexpr bool PERM = false;
    const float* x; float* out;
    __device__ __forceinline__ bool reset_after(const Unit&) const { return true; }
    __device__ __forceinline__ void operator()(f32x4 (&acc)[2][2][4][2], const Unit& u, int wr, int wc, int fr, int fq) const {
        const int row0 = u.pm * BM + wr * 64 + fr, col0 = u.pn * BM + wc * 32 + 4 * fq;
#pragma unroll
        for (int ai = 0; ai < 2; ++ai)
#pragma unroll
            for (int m = 0; m < 4; ++m) { const size_t off = (size_t)(row0 + ai * HALF + m * 16) * DM + col0;
#pragma unroll
                for (int bj = 0; bj < 2; ++bj)
#pragma unroll
                    for (int n = 0; n < 2; ++n) *(f32x4*)(out + off + bj * HALF + n * 16) = *(const f32x4*)(x + off + bj * HALF + n * 16) + acc[ai][bj][m][n]; }
    }
};

template <class Epi, class Sched, bool ALIGN_EPI>
__device__ __forceinline__ void gemm_phase(PG8_LAS unsigned char* lds, const Gemm g, const Sched& S, const Epi& E) {
    const int tid = threadIdx.x, wid = __builtin_amdgcn_readfirstlane(tid >> 6), lane = tid & 63, wr = wid >> 2, wc = wid & 3, fr = lane & 15, fq = lane >> 4;
    const int lda = g.lda, ldb = g.ldb;
    unsigned voffA[2], voffB[2];
#pragma unroll
    for (int i = 0; i < 2; ++i) { int R, C; stage_rc(tid * 16 + i * 8192, R, C); const int Rb = Epi::PERM ? ((R & ~31) + perm32(R & 31)) : R;
        voffA[i] = (unsigned)(R * lda + C) * 2u; voffB[i] = (unsigned)(Rb * ldb + C) * 2u; }
    const size_t kstep = (size_t)(BK * 2);
    const size_t hstepA = (size_t)HALF * lda * 2, hstepB = (size_t)HALF * ldb * 2;
    const unsigned ldsw = (unsigned)wid * 1024u;
    const int aoff = lds_byte(wr * 64 + fr, fq * 8), boff = lds_byte(wc * 32 + fr, fq * 8);
#define PG8_SA(b, h) (((b) * 2 + (h)) * HTB)
#define PG8_SB(b, h) ((4 + (b) * 2 + (h)) * HTB)
#define PG8_STAGE(bufoff, gbase, voff) do { _Pragma("unroll") for (int _i = 0; _i < 2; ++_i) \
        __builtin_amdgcn_global_load_lds((const unsigned*)((const char*)(gbase) + (voff)[_i]), (PG8_LAS unsigned*)(lds + (bufoff) + ldsw + _i * 8192), 16, 0, 0); } while (0)
#define PG8_LDA(dst, b, h) do { _Pragma("unroll") for (int m = 0; m < 4; ++m) _Pragma("unroll") for (int k = 0; k < 2; ++k) dst[m][k] = *(const PG8_LAS bf16x8*)(lds + PG8_SA(b, h) + aoff + m * 2048 + k * 1024); } while (0)
#define PG8_LDB(dst, b, h) do { _Pragma("unroll") for (int n = 0; n < 2; ++n) _Pragma("unroll") for (int k = 0; k < 2; ++k) dst[n][k] = *(const PG8_LAS bf16x8*)(lds + PG8_SB(b, h) + boff + n * 2048 + k * 1024); } while (0)
#define PG8_MMA(ai, bj, At, Bt) do { __builtin_amdgcn_s_setprio(1); _Pragma("unroll") for (int m = 0; m < 4; ++m) _Pragma("unroll") for (int n = 0; n < 2; ++n) _Pragma("unroll") for (int k = 0; k < 2; ++k) \
        acc[ai][bj][m][n] = __builtin_amdgcn_mfma_f32_16x16x32_bf16(Bt[n][k], At[m][k], acc[ai][bj][m][n], 0, 0, 0); __builtin_amdgcn_s_setprio(0); } while (0)
#define PG8_WAIT_V(n) asm volatile("s_waitcnt vmcnt(" #n ")" ::: "memory")
#define PG8_WAIT_L(n) asm volatile("s_waitcnt lgkmcnt(" #n ")" ::: "memory")
#define PG8_BAR __builtin_amdgcn_s_barrier()
#define PG8_SCHED __builtin_amdgcn_sched_barrier(0)
#define PG8_UA(u) ((const char*)g.A + ((size_t)(u).pm * BM * lda + (u).aoff) * 2)
#define PG8_UB(u) ((const char*)g.Bt + ((size_t)(u).pn * BM * ldb + (u).boff) * 2)
    Unit cur, nxt; int ui = 0;
    if (!S.next(0, cur)) return;
    f32x4 acc[2][2][4][2];
#pragma unroll
    for (int a = 0; a < 2; ++a)
#pragma unroll
        for (int b = 0; b < 2; ++b)
#pragma unroll
            for (int m = 0; m < 4; ++m)
#pragma unroll
                for (int n = 0; n < 2; ++n) acc[a][b][m][n] = (f32x4){0.f, 0.f, 0.f, 0.f};
    bf16x8 At[4][2], B0[2][2], B1[2][2];
    const char* cA = PG8_UA(cur); const char* cB = PG8_UB(cur);
    PG8_STAGE(PG8_SB(0, 0), cB, voffB); PG8_STAGE(PG8_SB(0, 1), cB + hstepB, voffB); PG8_STAGE(PG8_SA(0, 0), cA, voffA); PG8_STAGE(PG8_SA(0, 1), cA + hstepA, voffA);
    if (wr == 1) PG8_BAR;
    PG8_WAIT_V(2); PG8_BAR;
    PG8_STAGE(PG8_SB(1, 0), cB + kstep, voffB); PG8_STAGE(PG8_SA(1, 0), cA + kstep, voffA); PG8_STAGE(PG8_SB(1, 1), cB + hstepB + kstep, voffB);
    PG8_WAIT_V(6); PG8_BAR;
    for (;;) {
        const bool has_next = S.next(ui + 1, nxt);
        const char* nA = has_next ? PG8_UA(nxt) : cA; const char* nB = has_next ? PG8_UB(nxt) : cB;
        const int nt = cur.nt;
        for (int t = 0; t < nt; t += 2) {
            const bool last = (t == nt - 2);
            const char* a1 = cA + (size_t)(t + 1) * kstep;
            const char* a2 = last ? nA : cA + (size_t)(t + 2) * kstep; const char* b2 = last ? nB : cB + (size_t)(t + 2) * kstep;
            const char* a3 = a2 + kstep; const char* b3 = b2 + kstep;
            PG8_LDB(B0, 0, 0); PG8_LDB(B1, 0, 1); PG8_SCHED; PG8_LDA(At, 0, 0); PG8_STAGE(PG8_SA(1, 1), a1 + hstepA, voffA);
            PG8_WAIT_V(8); PG8_WAIT_L(0); PG8_BAR; PG8_MMA(0, 0, At, B0); PG8_MMA(0, 1, At, B1); PG8_BAR; PG8_SCHED;
            PG8_LDA(At, 0, 1); PG8_STAGE(PG8_SB(0, 0), b2, voffB); PG8_STAGE(PG8_SB(0, 1), b2 + hstepB, voffB); PG8_STAGE(PG8_SA(0, 0), a2, voffA);
            PG8_WAIT_V(8); PG8_WAIT_L(0); PG8_BAR; PG8_MMA(1, 0, At, B0); PG8_MMA(1, 1, At, B1); PG8_BAR; PG8_SCHED;
            PG8_LDB(B0, 1, 0); PG8_LDB(B1, 1, 1); PG8_SCHED; PG8_LDA(At, 1, 0); PG8_STAGE(PG8_SA(0, 1), a2 + hstepA, voffA);
            PG8_WAIT_V(8); PG8_WAIT_L(0); PG8_BAR; PG8_MMA(0, 0, At, B0); PG8_MMA(0, 1, At, B1); PG8_BAR; PG8_SCHED;
            PG8_LDA(At, 1, 1); PG8_STAGE(PG8_SB(1, 0), b3, voffB); PG8_STAGE(PG8_SB(1, 1), b3 + hstepB, voffB); PG8_STAGE(PG8_SA(1, 0), a3, voffA);
            PG8_WAIT_V(8); PG8_WAIT_L(0); PG8_BAR; PG8_MMA(1, 0, At, B0); PG8_MMA(1, 1, At, B1); PG8_BAR; PG8_SCHED;
        }
        if constexpr (ALIGN_EPI) { if (wr == 0) PG8_BAR; }
        E(acc, cur, wr, wc, fr, fq);
        if (!has_next) break;
        if (E.reset_after(cur)) {
#pragma unroll
            for (int a = 0; a < 2; ++a)
#pragma unroll
                for (int b = 0; b < 2; ++b)
#pragma unroll
                    for (int m = 0; m < 4; ++m)
#pragma unroll
                        for (int n = 0; n < 2; ++n) acc[a][b][m][n] = (f32x4){0.f, 0.f, 0.f, 0.f};
        }
        cur = nxt; cA = nA; cB = nB; ++ui;
        if constexpr (ALIGN_EPI) { if (wr == 1) PG8_BAR; }
    }
    PG8_WAIT_V(0);
    if constexpr (!ALIGN_EPI) { if (wr == 0) PG8_BAR; }
    PG8_BAR;
#undef PG8_SA
#undef PG8_SB
#undef PG8_STAGE
#undef PG8_LDA
#undef PG8_LDB
#undef PG8_MMA
#undef PG8_WAIT_V
#undef PG8_WAIT_L
#undef PG8_BAR
#undef PG8_SCHED
#undef PG8_UA
#undef PG8_UB
}
}
#ifndef DUP_MASK
#define DUP_MASK 0
#endif
#ifndef SIMPLE_PREP
#define SIMPLE_PREP 0
#endif
#ifndef SIMPLE_SCAN
#define SIMPLE_SCAN 0
#endif
constexpr int NWAVES = 8;
constexpr int RING_OFF = 0, RING_BYTES = 131072;
constexpr int LDSCTL_OFF = RING_BYTES, MISC_OFF = LDSCTL_OFF + 320;
constexpr int XTRA_OFF = RING_BYTES + 1024;
constexpr int LDS_BYTES = 147456;
constexpr int CW_BAR = 4096;

#define GAS __attribute__((address_space(1)))
#define LAS __attribute__((address_space(3)))
typedef unsigned v4u __attribute__((ext_vector_type(4)));
typedef float f32x4 __attribute__((ext_vector_type(4)));
typedef GAS unsigned gu32;
#define LDS_WAIT() asm volatile("s_waitcnt lgkmcnt(0)" ::: "memory")
#define VM_WAIT() asm volatile("s_waitcnt vmcnt(0)" ::: "memory")
__device__ __forceinline__ unsigned pk2(float lo, float hi) { return (unsigned)f2bf(lo) | ((unsigned)f2bf(hi) << 16); }

#define XB_TMO      128
#define XB_XCNT(j)  (256  + 64 * (j))
#define XB_XSUB(j)  (1280 + 64 * (j))
#define XB_XGEN(j)  (2304 + 64 * (j))
#define XB_TOP      3328
#define XB_TOPGEN   3392
#define XCD_BAR_WORDS 3456
#define XB_SPIN_CAP (1u << 18)
__device__ __forceinline__ unsigned xb_ld(unsigned* p)              { return __hip_atomic_load(p, __ATOMIC_RELAXED, __HIP_MEMORY_SCOPE_AGENT); }
__device__ __forceinline__ unsigned xb_add(unsigned* p, unsigned v) { return __hip_atomic_fetch_add(p, v, __ATOMIC_RELAXED, __HIP_MEMORY_SCOPE_AGENT); }
__device__ __forceinline__ unsigned xb_xcc_id() { return (unsigned)__builtin_amdgcn_s_getreg((3 << 11) | 20) & 0xFu; }
#define XB_SPIN(cond, bar) do { unsigned _sp = 0; while (cond) { __builtin_amdgcn_s_sleep(1); \
    if ((++_sp & 255u) == 0u) { if (xb_ld(&(bar)[XB_TMO])) break; if (_sp > XB_SPIN_CAP) { atomicAdd(&(bar)[XB_TMO], 1u); break; } } } } while (0)
struct XcdBarrier { unsigned* bar; unsigned x; volatile LAS unsigned* st; };
__device__ __forceinline__ XcdBarrier xcd_barrier_post(unsigned* bar, volatile LAS unsigned* st) {
    XcdBarrier b; b.bar = bar; b.x = xb_xcc_id(); b.st = st;
    if (threadIdx.x == 0) (void)xb_add(&bar[XB_XCNT(b.x)], 1u);
    return b;
}
__device__ __forceinline__ void xcd_barrier_complete(unsigned* bar, unsigned x, unsigned& nloc, unsigned& nx) {
    const unsigned G = gridDim.x * gridDim.y * gridDim.z;
    unsigned sum, cnt, mine, sp = 0u;
    for (;;) {
        sum = 0u; cnt = 0u; mine = 0u;
#pragma unroll
        for (unsigned j = 0; j < 16; ++j) { const unsigned c = xb_ld(&bar[XB_XCNT(j)]); sum += c; cnt += (c > 0u) ? 1u : 0u; mine = (j == x) ? c : mine; }
        if (sum == G) break;
        __builtin_amdgcn_s_sleep(1);
        if ((++sp & 255u) == 0u) { if (xb_ld(&bar[XB_TMO])) break; if (sp > XB_SPIN_CAP) { atomicAdd(&bar[XB_TMO], 1u); break; } }
    }
    nloc = mine > 0u ? mine : 1u; nx = cnt > 0u ? cnt : 1u;
}
__device__ __forceinline__ void xcd_barrier(const XcdBarrier& b) {
    asm volatile("s_waitcnt vmcnt(0)" ::: "memory");
    __syncthreads();
    if (threadIdx.x == 0) {
        unsigned* bar = b.bar;
        __builtin_amdgcn_s_waitcnt(0);
        unsigned nloc = b.st[0], nx = b.st[1];
        if (nloc == 0u) { xcd_barrier_complete(bar, b.x, nloc, nx); b.st[0] = nloc; b.st[1] = nx; }
        const unsigned old = xb_add(&bar[XB_XSUB(b.x)], 1u);
        const unsigned gen = old / nloc;
        if (old + 1u == (gen + 1u) * nloc) {
            __builtin_amdgcn_fence(__ATOMIC_RELEASE, "agent");
            asm volatile("s_waitcnt vmcnt(0)" ::: "memory");
            const unsigned og = xb_add(&bar[XB_TOP], 1u);
            const unsigned tg = og / nx;
            if (og + 1u == (tg + 1u) * nx) xb_add(&bar[XB_TOPGEN], 1u);
            else XB_SPIN(xb_ld(&bar[XB_TOPGEN]) == tg, bar);
            __builtin_amdgcn_fence(__ATOMIC_ACQUIRE, "agent");
            xb_add(&bar[XB_XGEN(b.x)], 1u);
            asm volatile("s_waitcnt vmcnt(0)" ::: "memory");
        } else {
            XB_SPIN(xb_ld(&bar[XB_XGEN(b.x)]) == gen, bar);
            __builtin_amdgcn_fence(__ATOMIC_ACQUIRE, "agent");
            asm volatile("s_waitcnt vmcnt(0)" ::: "memory");
        }
    }
    __syncthreads();
}

struct Args { const float* in[14]; float* out; unsigned char* ws; int ph_lo, ph_hi; };

struct Frame {
    LAS unsigned char* lds; int tid, lane, wave, vcu, G;
};

__device__ __forceinline__ void p0_transpose_item(const float* __restrict__ W, int N, int k0, int n0, bf16_t* __restrict__ WT, int ldt, int dn0, int koff, LAS float* scr, int lane) {
#pragma unroll 8
    for (int i = 0; i < 32; ++i) { const int kk = 2 * i + (lane >> 5); scr[kk * 33 + (lane & 31)] = W[(size_t)(k0 + kk) * N + n0 + (lane & 31)]; }
    LDS_WAIT(); asm volatile("" ::: "memory");
    const int c = lane & 7;
#pragma unroll
    for (int j = 0; j < 4; ++j) { const int n = (lane >> 3) + 8 * j; const LAS float* s = scr + (8 * c) * 33 + n;
        v4u o; o.x = pk2(s[0 * 33], s[1 * 33]); o.y = pk2(s[2 * 33], s[3 * 33]); o.z = pk2(s[4 * 33], s[5 * 33]); o.w = pk2(s[6 * 33], s[7 * 33]);
        *(v4u*)(WT + (size_t)(dn0 + n) * ldt + koff + k0 + 8 * c) = o; }
    LDS_WAIT(); asm volatile("" ::: "memory");
}
__device__ __forceinline__ void p0_prologue(Frame& F, const Args& a) {
    unsigned char* ws = a.ws;
    bf16_t *WinT = (bf16_t*)(ws + WS_WINT), *W2T = (bf16_t*)(ws + WS_W2T), *WoT = (bf16_t*)(ws + WS_WOT), *MixT = (bf16_t*)(ws + WS_MIXT), *XN = (bf16_t*)(ws + WS_XN);
    LAS float* scr = (LAS float*)(F.lds + RING_OFF + F.wave * 16384);
    const int gw = F.vcu * NWAVES + F.wave, NGW = F.G * NWAVES;
    constexpr int I_IN = (DM / 64) * (INC / 32), I_PO = (PW / 64) * (DM / 32), I_DN = (DNW / 64) * (DM / 32), I_WO = (DM / 64) * (DM / 32), I_MX = 4 * (PGD / 64) * (PGD / 32);
    constexpr int NITEMS = I_IN + I_PO + I_DN + I_WO + I_MX;
    for (int it = gw; it < NITEMS; it += NGW) {
        int r = it;
        if (r < I_IN) { const int nblk = INC / 32, kb = r / nblk, nb = r % nblk, n0 = 32 * nb;
            const int dn0 = n0 < C_B ? n0 : (n0 < C_GP ? 14336 + (n0 - C_B) : n0 - 32);
            p0_transpose_item(a.in[3], INC, 64 * kb, n0, WinT, DM, dn0, 0, scr, F.lane); continue; } r -= I_IN;
        if (r < I_PO) { const int nblk = DM / 32, kb = r / nblk, nb = r % nblk; p0_transpose_item(a.in[10], DM, 64 * kb, 32 * nb, W2T, YLD, 32 * nb, 0, scr, F.lane); continue; } r -= I_PO;
        if (r < I_DN) { const int nblk = DM / 32, kb = r / nblk, nb = r % nblk; p0_transpose_item(a.in[11], DM, 64 * kb, 32 * nb, W2T, YLD, 32 * nb, 1024, scr, F.lane); continue; } r -= I_DN;
        if (r < I_WO) { const int nblk = DM / 32, kb = r / nblk, nb = r % nblk; p0_transpose_item(a.in[12], DM, 64 * kb, 32 * nb, WoT, DM, 32 * nb, 0, scr, F.lane); continue; } r -= I_WO;
        { const int g = r / 32, rr = r % 32, kb = rr / 8, nb = rr % 8;
          p0_transpose_item(a.in[7] + (size_t)g * PGD * PGD, PGD, 64 * kb, 32 * nb, MixT + (size_t)g * PGD * PGD, PGD, 32 * nb, 0, scr, F.lane); }
    }
    const float* nw = a.in[2];
    for (int r = gw; r < MPAD + (NPAD1 - INC); r += NGW) {
        if (r >= MROWS) { bf16_t* o = r < MPAD ? XN + (size_t)r * DM : WinT + (size_t)(INC + (r - MPAD)) * DM;
#pragma unroll
            for (int j = 0; j < 4; ++j) *(v4u*)(o + 8 * F.lane + 512 * j) = (v4u){0u, 0u, 0u, 0u};
            continue; }
        const float* src = r < MTOK ? a.in[0] + (size_t)r * DM : a.in[1] + (size_t)(r - MTOK) * DM;
        f32x4 v[8]; float s = 0.f;
#pragma unroll
        for (int j = 0; j < 8; ++j) { v[j] = *(const f32x4*)(src + 4 * F.lane + 256 * j); s += (v[j].x * v[j].x + v[j].y * v[j].y) + (v[j].z * v[j].z + v[j].w * v[j].w); }
        const float rs = rsqrtf(wave_sum(s) * (1.f / DM) + EPS);
        unsigned long long* o8 = (unsigned long long*)(XN + (size_t)r * DM) + F.lane;
#pragma unroll
        for (int j = 0; j < 8; ++j) { const f32x4 w = *(const f32x4*)(nw + 4 * F.lane + 256 * j);
            o8[64 * j] = (unsigned long long)pk2(v[j].x * rs * w.x, v[j].y * rs * w.y) | ((unsigned long long)pk2(v[j].z * rs * w.z, v[j].w * rs * w.w) << 32); }
    }
}

__device__ __forceinline__ void p2_pool(Frame& F, const Args& a) {
    const bf16_t* U = (const bf16_t*)(a.ws + WS_U); bf16_t* PO = (bf16_t*)(a.ws + WS_POOLED);
    const int gt = F.vcu * 512 + F.tid, NT = F.G * 512;
    for (int idx = gt; idx < MTOK * (PW / 8); idx += NT) {
        const int m = idx >> 7, c8 = (idx & 127) * 8, b = m >> 11, t = m & 2047, p = t + NMETA, win = 2 << (c8 >> 8);
        float s[8];
#pragma unroll
        for (int j = 0; j < 8; ++j) s[j] = 0.f;
        for (int w = 0; w < win; ++w) { const int pp = p - w;
            pg8::f32x4 x0, x1; pg8::unpack8(*(const pg8::u32x4*)(U + (size_t)ext_row(b, pp) * 1024 + c8), x0, x1);
#pragma unroll
            for (int j = 0; j < 4; ++j) { s[j] += x0[j]; s[4 + j] += x1[j]; } }
        pg8::f32x4 u0, u1; pg8::unpack8(*(const pg8::u32x4*)(U + (size_t)m * 1024 + c8), u0, u1);
        const float inv = 1.f / (float)win;
        pg8::f32x4 r0, r1;
#pragma unroll
        for (int j = 0; j < 4; ++j) { r0[j] = s[j] * inv - u0[j]; r1[j] = s[4 + j] * inv - u1[j]; }
        *(pg8::u32x4*)(PO + (size_t)m * 1024 + c8) = pg8::pack8(r0, r1);
    }
}
__device__ __forceinline__ void p2_chunk_prep_simple(Frame& F, const Args& a) {
    const bf16_t* QKV = (const bf16_t*)(a.ws + WS_QKV); const float* BA = (const float*)(a.ws + WS_BA);
    const float *conv_w = a.in[4], *A_log = a.in[5], *dt_bias = a.in[6];
    bf16_t *NW = (bf16_t*)(a.ws + WS_CH_NW), *UU = (bf16_t*)(a.ws + WS_CH_U), *QD = (bf16_t*)(a.ws + WS_CH_QD), *KDT = (bf16_t*)(a.ws + WS_CH_KDT), *QK = (bf16_t*)(a.ws + WS_CH_QK);
    float* GL = (float*)(a.ws + WS_CH_GL);
    LAS float* sm = (LAS float*)(F.lds + RING_OFF);
    LAS float *q = sm, *k = q + 8192, *v = k + 8192, *Am = v + 8192, *Tm = Am + 4096;
    LAS float *beta = (LAS float*)(F.lds + XTRA_OFF), *gc = beta + 64;
    const int tid = F.tid, lane = F.lane, wv = F.wave;
    for (int cu = F.vcu; cu < NUNITS; cu += F.G) {
        const int n = cu % NCH, bh = cu / NCH, h = bh % NH, b = bh / NH, p0 = CHUNK * n - PADF;
        for (int idx = tid; idx < 64 * 384; idx += 512) {
            const int i = idx / 384, c3 = idx % 384, which = c3 >> 7, d = c3 & 127, col = which * 2048 + h * HD + d, p = p0 + i;
            float val = 0.f;
            if (p >= 0) { float s = 0.f;
                for (int kk = 0; kk < 4; ++kk) { const int pp = p - 3 + kk; if (pp >= 0) s += conv_w[kk * 6144 + col] * bf2f(QKV[(size_t)ext_row(b, pp) * 6144 + col]); }
                val = siluf_(s); }
            (which == 0 ? q : which == 1 ? k : v)[i * 128 + d] = val;
        }
        if (tid < 64) { const int p = p0 + tid; float be = 0.f, g = 0.f;
            if (p >= 0) { const int r = ext_row(b, p); be = sigmoidf_(BA[(size_t)r * 32 + h]); g = -__expf(A_log[h]) * softplusf_(BA[(size_t)r * 32 + 16 + h] + dt_bias[h]); }
            beta[tid] = be; gc[tid] = g; }
        __syncthreads();
        if (tid == 0) { float s = 0.f; for (int i = 0; i < 64; ++i) { s += gc[i]; gc[i] = s; } }
        for (int r = wv; r < 128; r += 8) {
            LAS float* row = (r < 64 ? q + r * 128 : k + (r - 64) * 128);
            const float a0 = row[lane], a1 = row[lane + 64];
            const float rs = rsqrtf(wave_sum(a0 * a0 + a1 * a1) + EPS) * (r < 64 ? 0.08838834764831845f : 1.f);
            row[lane] = a0 * rs; row[lane + 64] = a1 * rs;
        }
        __syncthreads();
        bf16_t* oQK = QK + (size_t)cu * 4096;
        for (int idx = tid; idx < 4096; idx += 512) {
            const int i = idx >> 6, j = idx & 63; float akk = 0.f, aqk = 0.f;
            if (j <= i) { for (int d = 0; d < 128; ++d) { const float kj = k[j * 128 + d]; akk += k[i * 128 + d] * kj; aqk += q[i * 128 + d] * kj; }
                const float dec = __expf(gc[i] - gc[j]); akk *= beta[i] * dec; aqk *= dec; }
            Am[idx] = j < i ? akk : 0.f; oQK[idx] = f2bf(j <= i ? aqk : 0.f);
        }
        __syncthreads();
        if (tid < 64) { const int c = tid;
            for (int i = 0; i < 64; ++i) { float s = (i == c) ? 1.f : 0.f; for (int j = c; j < i; ++j) s -= Am[i * 64 + j] * Tm[j * 64 + c]; Tm[i * 64 + c] = (i >= c) ? s : 0.f; } }
        __syncthreads();
        bf16_t *oNW = NW + (size_t)cu * 8192, *oU = UU + (size_t)cu * 8192, *oQD = QD + (size_t)cu * 8192, *oKDT = KDT + (size_t)cu * 8192;
        const float gl = gc[63];
        for (int idx = tid; idx < 8192; idx += 512) {
            const int i = idx >> 7, d = idx & 127; float su = 0.f, sw = 0.f;
            for (int j = 0; j <= i; ++j) { const float t = Tm[i * 64 + j] * beta[j]; su += t * v[j * 128 + d]; sw += t * __expf(gc[j]) * k[j * 128 + d]; }
            oU[d * 64 + i] = f2bf(su); oNW[idx] = f2bf(-sw);
            oQD[idx] = f2bf(q[idx] * __expf(gc[i]));
            oKDT[d * 64 + i] = f2bf(k[idx] * __expf(gl - gc[i]));
        }
        if (tid == 0) GL[cu] = __expf(gl);
        __syncthreads();
    }
}

typedef short bf16x8_t __attribute__((ext_vector_type(8)));
typedef unsigned u32x2_t __attribute__((ext_vector_type(2)));
__device__ __forceinline__ u32x2_t pack4bf(f32x4 v) { u32x2_t r; r.x = pg8::cvt_pk_bf16(v[0], v[1]); r.y = pg8::cvt_pk_bf16(v[2], v[3]); return r; }

constexpr int QS_LD = 272, KT_LD = 144, AM_LD = 68;
constexpr int L_QS = 0, L_KS = 17408, L_KT = 34816, L_VT = 53248, L_AM = 71680, L_TM = 89088, L_TB = 106496, L_TW = 115712, L_XS = 124928;
static_assert(L_XS + 3 * 1152 <= RING_BYTES, "chunk-prep LDS map");
__device__ __forceinline__ void p2_chunk_prep_fast(Frame& F, const Args& a) {
    const bf16_t* QKV = (const bf16_t*)(a.ws + WS_QKV); const float* BA = (const float*)(a.ws + WS_BA);
    const float *conv_w = a.in[4], *A_log = a.in[5], *dt_bias = a.in[6];
    bf16_t *NW = (bf16_t*)(a.ws + WS_CH_NW), *UT = (bf16_t*)(a.ws + WS_CH_U), *QD = (bf16_t*)(a.ws + WS_CH_QD), *KDT = (bf16_t*)(a.ws + WS_CH_KDT), *QK = (bf16_t*)(a.ws + WS_CH_QK);
    float* GL = (float*)(a.ws + WS_CH_GL);
    LAS unsigned char* L = F.lds + RING_OFF;
    LAS float *Am = (LAS float*)(L + L_AM), *Tm = (LAS float*)(L + L_TM);
    LAS float *beta = (LAS float*)(F.lds + XTRA_OFF), *gc = beta + 64;
    const int tid = F.tid, lane = F.lane, w = F.wave, fr = lane & 15, fq = lane >> 4;
    for (int cu = F.vcu; cu < NUNITS; cu += F.G) {
        const int n = cu % NCH, bh = cu / NCH, h = bh % NH, b = bh / NH, p0 = CHUNK * n - PADF;
#pragma unroll 1
        for (int it = 0; it < 6; ++it) {
            const int item = tid + 512 * it, which = it >> 1, i = (item >> 4) & 63, d8 = (item & 15) * 8, col = which * 2048 + h * HD + d8, p = p0 + i;
            float v[8];
#pragma unroll
            for (int j = 0; j < 8; ++j) v[j] = 0.f;
            if (p >= 0) {
#pragma unroll
                for (int kk = 0; kk < 4; ++kk) { const int pp = p - 3 + kk;
                    if (pp >= 0) { pg8::f32x4 x0, x1; pg8::unpack8(*(const pg8::u32x4*)(QKV + (size_t)ext_row(b, pp) * 6144 + col), x0, x1);
                        const f32x4 w0 = *(const f32x4*)(conv_w + kk * 6144 + col), w1 = *(const f32x4*)(conv_w + kk * 6144 + col + 4);
#pragma unroll
                        for (int j = 0; j < 4; ++j) { v[j] += w0[j] * x0[j]; v[4 + j] += w1[j] * x1[j]; } } }
#pragma unroll
                for (int j = 0; j < 8; ++j) v[j] = siluf_(v[j]);
            }
            if (which < 2) { float ss = 0.f;
#pragma unroll
                for (int j = 0; j < 8; ++j) ss += v[j] * v[j];
                ss += __shfl_xor(ss, 1); ss += __shfl_xor(ss, 2); ss += __shfl_xor(ss, 4); ss += __shfl_xor(ss, 8);
                const float rs = rsqrtf(ss + EPS) * (which == 0 ? 0.08838834764831845f : 1.f);
#pragma unroll
                for (int j = 0; j < 8; ++j) v[j] *= rs; }
            const pg8::u32x4 pk = pg8::pack8((f32x4){v[0], v[1], v[2], v[3]}, (f32x4){v[4], v[5], v[6], v[7]});
            if (which < 2) *(LAS pg8::u32x4*)(L + (which == 0 ? L_QS : L_KS) + i * QS_LD + d8 * 2) = pk;
            if (which >= 1) { LAS unsigned char* T = L + (which == 1 ? L_KT : L_VT) + i * 2;
                const unsigned pw[4] = {pk.x, pk.y, pk.z, pk.w};
#pragma unroll
                for (int j = 0; j < 4; ++j) { *(LAS bf16_t*)(T + (d8 + 2 * j) * KT_LD) = (bf16_t)(pw[j] & 0xffffu); *(LAS bf16_t*)(T + (d8 + 2 * j + 1) * KT_LD) = (bf16_t)(pw[j] >> 16); } }
        }
        if (w == 7) {
            const int p = p0 + lane; float be = 0.f, g = 0.f;
            if (p >= 0) { const int r = ext_row(b, p); be = sigmoidf_(BA[(size_t)r * 32 + h]); g = -__expf(A_log[h]) * softplusf_(BA[(size_t)r * 32 + 16 + h] + dt_bias[h]); }
#pragma unroll
            for (int o = 1; o < 64; o <<= 1) { const float t = __shfl_up(g, o); if (lane >= o) g += t; }
            beta[lane] = be; gc[lane] = g;
        }
        __syncthreads();
        const float gl = gc[63];
        {
            const int kind = w >> 2, ti = w & 3;
            bf16x8_t af[4];
#pragma unroll
            for (int ks = 0; ks < 4; ++ks) af[ks] = *(const LAS bf16x8_t*)(L + L_KS + (16 * ti + fr) * QS_LD + (32 * ks + 8 * fq) * 2);
            bf16_t* oQK = QK + (size_t)cu * 4096;
#pragma unroll
            for (int tj = 0; tj < 4; ++tj) {
                if (kind == 0) {
                    if (tj > ti) continue;
                    f32x4 acc = (f32x4){0.f, 0.f, 0.f, 0.f};
#pragma unroll
                    for (int ks = 0; ks < 4; ++ks) acc = __builtin_amdgcn_mfma_f32_16x16x32_bf16(af[ks], *(const LAS bf16x8_t*)(L + L_KS + (16 * tj + fr) * QS_LD + (32 * ks + 8 * fq) * 2), acc, 0, 0, 0);
                    const int j = 16 * tj + fr; const float gj = gc[j];
#pragma unroll
                    for (int r = 0; r < 4; ++r) { const int i = 16 * ti + 4 * fq + r; Am[i * AM_LD + j] = j < i ? acc[r] * beta[i] * __expf(gc[i] - gj) : 0.f; }
                } else {
                    const int i = 16 * tj + fr; u32x2_t o = (u32x2_t){0u, 0u};
                    if (tj >= ti) {
                        f32x4 acc = (f32x4){0.f, 0.f, 0.f, 0.f};
#pragma unroll
                        for (int ks = 0; ks < 4; ++ks) acc = __builtin_amdgcn_mfma_f32_16x16x32_bf16(af[ks], *(const LAS bf16x8_t*)(L + L_QS + (16 * tj + fr) * QS_LD + (32 * ks + 8 * fq) * 2), acc, 0, 0, 0);
                        const float gi = gc[i];
#pragma unroll
                        for (int r = 0; r < 4; ++r) { const int j = 16 * ti + 4 * fq + r; acc[r] = j <= i ? acc[r] * __expf(gi - gc[j]) : 0.f; }
                        o = pack4bf(acc);
                    }
                    *(u32x2_t*)(oQK + i * 64 + 16 * ti + 4 * fq) = o;
                }
            }
        }
        __syncthreads();
        if (w == 0) {
            const int ab = fq, c = fr; float t[16];
#pragma unroll
            for (int r = 0; r < 16; ++r) { float s = (r == c) ? 1.f : 0.f;
#pragma unroll
                for (int m4 = 0; m4 < (r + 3) / 4; ++m4) { const f32x4 av = *(const LAS f32x4*)(Am + (16 * ab + r) * AM_LD + 16 * ab + 4 * m4);
#pragma unroll
                    for (int j = 0; j < 4; ++j) if (4 * m4 + j < r) s -= av[j] * t[4 * m4 + j]; }
                t[r] = s; Tm[(16 * ab + r) * AM_LD + 16 * ab + c] = s; }
        } else {
            bf16_t *oQD = QD + (size_t)cu * 8192, *oKDT = KDT + (size_t)cu * 8192;
            for (int idx = tid - 64; idx < 2048; idx += 448) {
                if (idx < 1024) { const int i = idx >> 4, d8 = (idx & 15) * 8; pg8::f32x4 x0, x1; pg8::unpack8(*(const LAS pg8::u32x4*)(L + L_QS + i * QS_LD + d8 * 2), x0, x1);
                    const float e = __expf(gc[i]); *(pg8::u32x4*)(oQD + i * 128 + d8) = pg8::pack8(x0 * e, x1 * e); }
                else { const int id = idx - 1024, d = id >> 3, i8 = (id & 7) * 8; pg8::f32x4 x0, x1; pg8::unpack8(*(const LAS pg8::u32x4*)(L + L_KT + d * KT_LD + i8 * 2), x0, x1);
#pragma unroll
                    for (int j = 0; j < 4; ++j) { x0[j] *= __expf(gl - gc[i8 + j]); x1[j] *= __expf(gl - gc[i8 + 4 + j]); }
                    *(pg8::u32x4*)(oKDT + d * 64 + i8) = pg8::pack8(x0, x1); }
            }
            if (tid == 64) GL[cu] = __expf(gl);
        }
        __syncthreads();
#pragma unroll
        for (int dd = 1; dd < 4; ++dd) {
            if (w < 4 - dd) {
                const int bb = w, ab = w + dd;
                f32x4 acc = (f32x4){0.f, 0.f, 0.f, 0.f};
                for (int c = bb; c < ab; ++c)
#pragma unroll
                    for (int ks = 0; ks < 4; ++ks) acc = __builtin_amdgcn_mfma_f32_16x16x4f32(Am[(16 * ab + fr) * AM_LD + 16 * c + 4 * ks + fq], Tm[(16 * c + 4 * ks + fq) * AM_LD + 16 * bb + fr], acc, 0, 0, 0);
                LAS float* Xs = (LAS float*)(L + L_XS + w * 1152);
#pragma unroll
                for (int r = 0; r < 4; ++r) Xs[(4 * fq + r) * 17 + fr] = acc[r];
                f32x4 acc2 = (f32x4){0.f, 0.f, 0.f, 0.f};
#pragma unroll
                for (int ks = 0; ks < 4; ++ks) acc2 = __builtin_amdgcn_mfma_f32_16x16x4f32(Tm[(16 * ab + fr) * AM_LD + 16 * ab + 4 * ks + fq], Xs[(4 * ks + fq) * 17 + fr], acc2, 0, 0, 0);
#pragma unroll
                for (int r = 0; r < 4; ++r) Tm[(16 * ab + 4 * fq + r) * AM_LD + 16 * bb + fr] = -acc2[r];
            }
            __syncthreads();
        }
        { const int i = tid >> 3, j8 = (tid & 7) * 8; f32x4 t0 = *(const LAS f32x4*)(Tm + i * AM_LD + j8), t1 = *(const LAS f32x4*)(Tm + i * AM_LD + j8 + 4); f32x4 b0, b1, w0, w1;
#pragma unroll
            for (int j = 0; j < 4; ++j) { const int ja = j8 + j, jb = j8 + 4 + j; const float ba = beta[ja], bb = beta[jb];
                b0[j] = ja <= i ? t0[j] * ba : 0.f; b1[j] = jb <= i ? t1[j] * bb : 0.f; w0[j] = b0[j] * __expf(gc[ja]); w1[j] = b1[j] * __expf(gc[jb]); }
            *(LAS pg8::u32x4*)(L + L_TB + i * KT_LD + j8 * 2) = pg8::pack8(b0, b1); *(LAS pg8::u32x4*)(L + L_TW + i * KT_LD + j8 * 2) = pg8::pack8(w0, w1); }
        __syncthreads();
        {
            bf16_t *oU = UT + (size_t)cu * 8192, *oNW = NW + (size_t)cu * 8192;
            bf16x8_t vf[2], kf[2];
#pragma unroll
            for (int ks = 0; ks < 2; ++ks) { vf[ks] = *(const LAS bf16x8_t*)(L + L_VT + (16 * w + fr) * KT_LD + (32 * ks + 8 * fq) * 2); kf[ks] = *(const LAS bf16x8_t*)(L + L_KT + (16 * w + fr) * KT_LD + (32 * ks + 8 * fq) * 2); }
#pragma unroll
            for (int mi = 0; mi < 4; ++mi) {
                f32x4 au = (f32x4){0.f, 0.f, 0.f, 0.f}, aw = (f32x4){0.f, 0.f, 0.f, 0.f};
#pragma unroll
                for (int ks = 0; ks < 2; ++ks) {
                    au = __builtin_amdgcn_mfma_f32_16x16x32_bf16(*(const LAS bf16x8_t*)(L + L_TB + (16 * mi + fr) * KT_LD + (32 * ks + 8 * fq) * 2), vf[ks], au, 0, 0, 0);
                    aw = __builtin_amdgcn_mfma_f32_16x16x32_bf16(kf[ks], *(const LAS bf16x8_t*)(L + L_TW + (16 * mi + fr) * KT_LD + (32 * ks + 8 * fq) * 2), aw, 0, 0, 0);
                }
                *(u32x2_t*)(oU + (16 * w + fr) * 64 + 16 * mi + 4 * fq) = pack4bf(au);
                *(u32x2_t*)(oNW + (16 * mi + fr) * 128 + 16 * w + 4 * fq) = pack4bf(-aw);
            }
        }
        __syncthreads();
    }
}

__device__ __forceinline__ void p3_scan_simple(Frame& F, const Args& a) {
    const bf16_t *NW = (const bf16_t*)(a.ws + WS_CH_NW), *UU = (const bf16_t*)(a.ws + WS_CH_U), *QD = (const bf16_t*)(a.ws + WS_CH_QD), *KDT = (const bf16_t*)(a.ws + WS_CH_KDT), *QK = (const bf16_t*)(a.ws + WS_CH_QK);
    const float* GL = (const float*)(a.ws + WS_CH_GL); bf16_t* O = (bf16_t*)(a.ws + WS_O);
    LAS float* sm = (LAS float*)(F.lds + RING_OFF);
    LAS float *nw = sm, *qd = sm + 8192, *kd = sm + 16384, *vn = sm + 24576;
    const int tid = F.tid, e = (tid >> 6) * 32 + (tid & 31), half = (tid >> 5) & 1, db = 64 * half; const bool act = tid < 256;
    for (int bh = F.vcu; bh < NB * NH; bh += F.G) {
        const int h = bh % NH, b = bh / NH;
        float S[64];
#pragma unroll
        for (int d = 0; d < 64; ++d) S[d] = 0.f;
        for (int n = 0; n < NCH; ++n) {
            const int cu = bh * NCH + n;
            for (int idx = tid; idx < 8192; idx += 512) { nw[idx] = bf2f(NW[(size_t)cu * 8192 + idx]); qd[idx] = bf2f(QD[(size_t)cu * 8192 + idx]);
                const int d = idx >> 6, i = idx & 63; kd[i * 128 + d] = bf2f(KDT[(size_t)cu * 8192 + idx]); }
            __syncthreads();
            const float gl = GL[cu];
            if (act) for (int i = 0; i < 64; ++i) { float s = 0.f;
#pragma unroll
                for (int d = 0; d < 64; ++d) s += nw[i * 128 + db + d] * S[d];
                s += __shfl_xor(s, 32); s += bf2f(UU[(size_t)cu * 8192 + e * 64 + i]);
                if (half == 0) vn[i * 128 + e] = s; }
            __syncthreads();
            if (act) {
                if (n > 0) for (int i = 0; i < 64; ++i) { float s = 0.f;
#pragma unroll
                    for (int d = 0; d < 64; ++d) s += qd[i * 128 + db + d] * S[d];
                    s += __shfl_xor(s, 32);
                    for (int j = 0; j <= i; ++j) s += bf2f(QK[(size_t)cu * 4096 + i * 64 + j]) * vn[j * 128 + e];
                    if (half == 0) O[(size_t)(b * SEQ + 64 * (n - 1) + i) * DNW + h * HD + e] = f2bf(s); }
#pragma unroll
                for (int d = 0; d < 64; ++d) S[d] *= gl;
                for (int i = 0; i < 64; ++i) { const float vi = vn[i * 128 + e];
#pragma unroll
                    for (int d = 0; d < 64; ++d) S[d] += kd[i * 128 + db + d] * vi; }
            }
            __syncthreads();
        }
    }
}


struct ScanOps { bf16x8_t nw[4], qd[4], qk[2], kd[2]; u32x2_t ut; float gl; };
constexpr int ST_LD = 272, VT_LD = 144;
__device__ __forceinline__ void p3_scan_fast(Frame& F, const Args& a) {
    const bf16_t *NW = (const bf16_t*)(a.ws + WS_CH_NW), *UT = (const bf16_t*)(a.ws + WS_CH_U), *QD = (const bf16_t*)(a.ws + WS_CH_QD), *KDT = (const bf16_t*)(a.ws + WS_CH_KDT), *QK = (const bf16_t*)(a.ws + WS_CH_QK);
    const float* GL = (const float*)(a.ws + WS_CH_GL); bf16_t* O = (bf16_t*)(a.ws + WS_O); float* GL2 = (float*)(a.ws + WS_CTL) + 1024;
    LAS unsigned char* ST = F.lds + RING_OFF; LAS unsigned char* VT = ST + 32 * ST_LD;
    const int w = F.wave, lane = F.lane, fr = lane & 15, fq = lane >> 4, mt = w >> 1, nt = w & 1;
    for (int unit = F.vcu; unit < NB * NH * 4; unit += F.G) {
        const int bh = unit >> 2, s = unit & 3, h = bh % NH, b = bh / NH;
        f32x4 accS[2] = {(f32x4){0.f, 0.f, 0.f, 0.f}, (f32x4){0.f, 0.f, 0.f, 0.f}};
        for (int i = F.tid; i < 32 * ST_LD / 4; i += 512) ((LAS unsigned*)ST)[i] = 0u;
        __syncthreads();
#define SCAN_LOAD(ops, n_) do { const size_t cu_ = (size_t)(bh * NCH + (n_)); \
        _Pragma("unroll") for (int ks = 0; ks < 4; ++ks) { (ops).nw[ks] = *(const bf16x8_t*)(NW + cu_ * 8192 + (16 * mt + fr) * 128 + 32 * ks + 8 * fq); (ops).qd[ks] = *(const bf16x8_t*)(QD + cu_ * 8192 + (16 * mt + fr) * 128 + 32 * ks + 8 * fq); } \
        _Pragma("unroll") for (int ks = 0; ks < 2; ++ks) { (ops).qk[ks] = *(const bf16x8_t*)(QK + cu_ * 4096 + (16 * mt + fr) * 64 + 32 * ks + 8 * fq); (ops).kd[ks] = *(const bf16x8_t*)(KDT + cu_ * 8192 + (16 * w + fr) * 64 + 32 * ks + 8 * fq); } \
        (ops).ut = *(const u32x2_t*)(UT + cu_ * 8192 + (32 * s + 16 * nt + fr) * 64 + 16 * mt + 4 * fq); (ops).gl = GL[cu_]; } while (0)
#define SCAN_STEP(ops, n_) do { \
        f32x4 accV = (f32x4){__uint_as_float((ops).ut.x << 16), __uint_as_float((ops).ut.x & 0xffff0000u), __uint_as_float((ops).ut.y << 16), __uint_as_float((ops).ut.y & 0xffff0000u)}; \
        f32x4 accO = (f32x4){0.f, 0.f, 0.f, 0.f}; \
        _Pragma("unroll") for (int ks = 0; ks < 4; ++ks) { const bf16x8_t bS = *(const LAS bf16x8_t*)(ST + (16 * nt + fr) * ST_LD + (32 * ks + 8 * fq) * 2); \
            accV = __builtin_amdgcn_mfma_f32_16x16x32_bf16((ops).nw[ks], bS, accV, 0, 0, 0); accO = __builtin_amdgcn_mfma_f32_16x16x32_bf16((ops).qd[ks], bS, accO, 0, 0, 0); } \
        *(LAS u32x2_t*)(VT + (16 * nt + fr) * VT_LD + (16 * mt + 4 * fq) * 2) = pack4bf(accV); \
        __syncthreads(); \
        _Pragma("unroll") for (int ks = 0; ks < 2; ++ks) { const bf16x8_t bV = *(const LAS bf16x8_t*)(VT + (16 * nt + fr) * VT_LD + (32 * ks + 8 * fq) * 2); \
            accO = __builtin_amdgcn_mfma_f32_16x16x32_bf16((ops).qk[ks], bV, accO, 0, 0, 0); } \
        if ((n_) > 0) { bf16_t* op = O + (size_t)(b * SEQ + 64 * ((n_) - 1) + 16 * mt + 4 * fq) * DNW + h * HD + 32 * s + 16 * nt + fr; \
            _Pragma("unroll") for (int r = 0; r < 4; ++r) op[(size_t)r * DNW] = f2bf(accO[r]); } \
        _Pragma("unroll") for (int n2 = 0; n2 < 2; ++n2) { accS[n2] = accS[n2] * (ops).gl; \
            _Pragma("unroll") for (int ks = 0; ks < 2; ++ks) { const bf16x8_t bV = *(const LAS bf16x8_t*)(VT + (16 * n2 + fr) * VT_LD + (32 * ks + 8 * fq) * 2); \
                accS[n2] = __builtin_amdgcn_mfma_f32_16x16x32_bf16((ops).kd[ks], bV, accS[n2], 0, 0, 0); } \
            *(LAS u32x2_t*)(ST + (16 * n2 + fr) * ST_LD + (16 * w + 4 * fq) * 2) = pack4bf(accS[n2]); } \
        __syncthreads(); } while (0)
        unsigned dummy = 0u, tchA = 0u, tchB = 0u; constexpr int PF = 3;
        const unsigned char* tbase; { const int t = F.tid; size_t off;
            if (t < 128) off = WS_CH_NW + (size_t)t * 128; else if (t < 256) off = WS_CH_QD + (size_t)(t - 128) * 128; else if (t < 384) off = WS_CH_KDT + (size_t)(t - 256) * 128;
            else if (t < 448) off = WS_CH_QK + (size_t)(t - 384) * 128; else off = WS_CH_U + (size_t)s * 4096 + (size_t)(t - 448) * 128;
            tbase = a.ws + off; }
        const size_t tstride = F.tid < 384 ? 16384 : (F.tid < 448 ? 8192 : 16384);
#define SCAN_TOUCH(n_, tch) do { dummy += tch; if (F.tid < 480 && (n_) + PF < NCH) tch = __builtin_nontemporal_load((const unsigned*)(tbase + (size_t)(bh * NCH + (n_) + PF) * tstride)); } while (0)
        ScanOps opA, opB;
        if (F.tid < 480) { dummy += __builtin_nontemporal_load((const unsigned*)(tbase + (size_t)(bh * NCH + 1) * tstride)); dummy += __builtin_nontemporal_load((const unsigned*)(tbase + (size_t)(bh * NCH + 2) * tstride)); }
        SCAN_LOAD(opA, 0);
        for (int n = 0; n < NCH; n += 2) {
            if (n + 1 < NCH) SCAN_LOAD(opB, n + 1);
            SCAN_TOUCH(n, tchA);
            SCAN_STEP(opA, n);
            if (n + 1 < NCH) { if (n + 2 < NCH) SCAN_LOAD(opA, n + 2); SCAN_TOUCH(n + 1, tchB); SCAN_STEP(opB, n + 1); }
        }
        if (dummy == 0x9e3779b9u && tchA == 0x7f4a7c15u && tchB == 0x1234567u) GL2[0] = 1.f;
#undef SCAN_TOUCH
#undef SCAN_LOAD
#undef SCAN_STEP
    }
}

__device__ __forceinline__ void p3b_gnorm(Frame& F, const Args& a) {
    const bf16_t *O = (const bf16_t*)(a.ws + WS_O), *SZD = (const bf16_t*)(a.ws + WS_SZD); bf16_t* Y = (bf16_t*)(a.ws + WS_Y); const float* w = a.in[9];
    const int gw = F.vcu * NWAVES + F.wave, NGW = F.G * NWAVES, lane = F.lane;
    const float w0 = w[2 * lane], w1 = w[2 * lane + 1];
    for (int it = gw; it < MTOK * NH; it += NGW) {
        const size_t base = (size_t)(it >> 4) * DNW + (it & 15) * HD + 2 * lane, yb = (size_t)(it >> 4) * YLD + 1024 + (it & 15) * HD + 2 * lane;
        const unsigned ov = *(const unsigned*)(O + base), zv = *(const unsigned*)(SZD + base);
        const float a0 = __uint_as_float(ov << 16), a1 = __uint_as_float(ov & 0xffff0000u);
        const float rs = rsqrtf(wave_sum(a0 * a0 + a1 * a1) * (1.f / HD) + EPS);
        *(unsigned*)(Y + yb) = pk2(a0 * rs * w0 * __uint_as_float(zv << 16), a1 * rs * w1 * __uint_as_float(zv & 0xffff0000u));
    }
}

__device__ __forceinline__ void p6_final(Frame& F, const Args& a) {
    const float* w = a.in[13]; float* out = a.out;
    const int gw = F.vcu * NWAVES + F.wave, NGW = F.G * NWAVES;
    for (int r = gw; r < MTOK; r += NGW) {
        float* row = out + (size_t)r * DM;
        f32x4 v[8]; float s = 0.f;
#pragma unroll
        for (int j = 0; j < 8; ++j) { v[j] = *(const f32x4*)(row + 4 * F.lane + 256 * j); s += (v[j].x * v[j].x + v[j].y * v[j].y) + (v[j].z * v[j].z + v[j].w * v[j].w); }
        const float rs = rsqrtf(wave_sum(s) * (1.f / DM) + EPS);
#pragma unroll
        for (int j = 0; j < 8; ++j) { const f32x4 ww = *(const f32x4*)(w + 4 * F.lane + 256 * j); *(f32x4*)(row + 4 * F.lane + 256 * j) = v[j] * rs * ww; }
    }
}

struct PoolMixOrder {
    int G, c;
    __device__ bool next(int i, pg8::Unit& u) const { const int L = i * G + c; if (L >= 128) return false; u.pm = L >> 2; u.pn = L & 3; u.aoff = (L & 3) * 256; u.boff = 0; u.nt = 4; u.mode = 0; return true; }
};
struct MergeOrder {
    pg8::StaticOrder so;
    __device__ bool next(int i, pg8::Unit& u) const { if (!so.next(i >> 1, u)) return false; if ((i & 1) == 0) { u.nt = 16; u.mode = 0; } else { u.aoff = 1024; u.boff = 1024; u.nt = 32; u.mode = 1; } return true; }
};

constexpr int NPHASE = 8;
__global__ void __launch_bounds__(NWAVES * 64, 2) mega_fwd(Args args) {
    extern __shared__ __attribute__((aligned(16))) unsigned char lds[];
    Frame F;
    F.lds = (LAS unsigned char*)lds;
    F.tid = threadIdx.x; F.lane = F.tid & 63; F.wave = __builtin_amdgcn_readfirstlane(F.tid >> 6);
    F.G = gridDim.x; { const int bx = blockIdx.x; F.vcu = (F.G % 8 == 0) ? (bx % 8) * (F.G / 8) + bx / 8 : bx; }
    unsigned char* ws = args.ws;
    for (int u = F.tid; u < (LDS_BYTES - LDSCTL_OFF) / 4; u += NWAVES * 64) ((LAS unsigned*)(F.lds + LDSCTL_OFF))[u] = 0u;
    __syncthreads();
    const int lo = args.ph_lo, hi = args.ph_hi;
    XcdBarrier bar; bar.bar = (unsigned*)(ws + WS_CTL) + CW_BAR; bar.x = 0; bar.st = nullptr;
    if (hi - lo > 1 || DUP_MASK) bar = xcd_barrier_post((unsigned*)(ws + WS_CTL) + CW_BAR, (volatile LAS unsigned*)(F.lds + MISC_OFF) + 8);
#define DUP(k) ((DUP_MASK >> (k)) & 1)
#define PHASE(k, ...) do { if (lo <= (k) && (k) < hi) { __VA_ARGS__ if (DUP(k)) { xcd_barrier(bar); __VA_ARGS__ } if ((k) + 1 < hi) xcd_barrier(bar); } } while (0)
    PHASE(0, p0_prologue(F, args););
    PHASE(1, {
        pg8::Gemm g{(const bf16_t*)(ws + WS_XN), (const bf16_t*)(ws + WS_WINT), DM, DM}; pg8::StaticOrder S; S.init(MPAD / 256, NPAD1 / 256, DM / 64, F.G, (int)blockIdx.x);
        pg8::EpiProj E{(bf16_t*)(ws + WS_U), (bf16_t*)(ws + WS_SZP), (bf16_t*)(ws + WS_QKV), (bf16_t*)(ws + WS_SZD), (bf16_t*)(ws + WS_GATES), (float*)(ws + WS_BA)};
        pg8::gemm_phase<pg8::EpiProj, pg8::StaticOrder, true>(F.lds + RING_OFF, g, S, E); });
    PHASE(2, p2_pool(F, args); if (SIMPLE_PREP) p2_chunk_prep_simple(F, args); else p2_chunk_prep_fast(F, args););
    PHASE(3, if (SIMPLE_SCAN) p3_scan_simple(F, args); else p3_scan_fast(F, args););
    PHASE(4, {
        p3b_gnorm(F, args);
        pg8::Gemm g{(const bf16_t*)(ws + WS_POOLED), (const bf16_t*)(ws + WS_MIXT), PW, PGD}; PoolMixOrder S{F.G, F.vcu};
        pg8::EpiPoolMix E{(bf16_t*)(ws + WS_Y), (const bf16_t*)(ws + WS_SZP), args.in[8]};
        pg8::gemm_phase<pg8::EpiPoolMix, PoolMixOrder, false>(F.lds + RING_OFF, g, S, E); });
    PHASE(5, {
        pg8::Gemm g{(const bf16_t*)(ws + WS_Y), (const bf16_t*)(ws + WS_W2T), YLD, YLD}; MergeOrder S; S.so.init(MTOK / 256, DM / 256, 0, F.G, (int)blockIdx.x);
        pg8::EpiMerge E{(const bf16_t*)(ws + WS_GATES), (bf16_t*)(ws + WS_MERGED)};
        pg8::gemm_phase<pg8::EpiMerge, MergeOrder, false>(F.lds + RING_OFF, g, S, E); });
    PHASE(6, {
        pg8::Gemm g{(const bf16_t*)(ws + WS_MERGED), (const bf16_t*)(ws + WS_WOT), DM, DM}; pg8::StaticOrder S; S.init(MTOK / 256, DM / 256, DM / 64, F.G, (int)blockIdx.x);
        pg8::EpiResid E{args.in[0], args.out};
        pg8::gemm_phase<pg8::EpiResid, pg8::StaticOrder, false>(F.lds + RING_OFF, g, S, E); });
    PHASE(7, p6_final(F, args););
#undef PHASE
#undef DUP
}
#ifndef MIX
#define MIX 0
#endif
#ifndef NAIVE_MASK
#define NAIVE_MASK 0
#endif
#ifndef FUSE
#define FUSE 1
#endif
extern "C" void kernel_launch(void* const* d_in, const int* in_sizes, int n_in, void* d_out, int out_size, void* d_ws, size_t ws_size, hipStream_t stream) {
    static int grid = 0;
    if (grid == 0) {
        if (n_in != 14 || in_sizes[0] != MTOK * DM || out_size != MTOK * DM || ws_size < WS_END) { fprintf(stderr, "kernel_launch: unexpected shapes / workspace (%zu < %zu); nothing launched\n", ws_size, (size_t)WS_END); grid = -1; return; }
        int dev = 0, cus = 0;
        if (hipGetDevice(&dev) != hipSuccess || hipDeviceGetAttribute(&cus, hipDeviceAttributeMultiprocessorCount, dev) != hipSuccess) { grid = -1; return; }
        if (hipFuncSetAttribute((const void*)mega_fwd, hipFuncAttributeMaxDynamicSharedMemorySize, LDS_BYTES) != hipSuccess) { fprintf(stderr, "kernel_launch: hipFuncSetAttribute failed\n"); grid = -1; return; }
#if MIX
        if (hipFuncSetAttribute((const void*)nv_chunk_prep, hipFuncAttributeMaxDynamicSharedMemorySize, 140 * 1024) != hipSuccess) { grid = -1; return; }
#endif
        (void)hipGetLastError();
        grid = cus;
    }
    if (grid < 0) return;
    if (hipMemsetAsync((char*)d_ws + WS_CTL, 0, CTL_ZERO_BYTES, stream) != hipSuccess) return;
    Args a{};
    for (int i = 0; i < 14; ++i) a.in[i] = (const float*)d_in[i];
    a.out = (float*)d_out; a.ws = (unsigned char*)d_ws;
#if !MIX
    a.ph_lo = 0; a.ph_hi = NPHASE;
    hipLaunchKernelGGL(mega_fwd, dim3(grid), dim3(NWAVES * 64), LDS_BYTES, stream, a);
#else
    const float *x = a.in[0], *meta = a.in[1], *norm_w = a.in[2], *w_in = a.in[3], *conv_w = a.in[4], *A_log = a.in[5], *dt_bias = a.in[6], *pool_mix = a.in[7], *pool_scale = a.in[8],
                *dn_norm_w = a.in[9], *w_pool_out = a.in[10], *w_dn_out = a.in[11], *w_o = a.in[12], *final_norm_w = a.in[13];
    unsigned char* ws = (unsigned char*)d_ws; float* out = (float*)d_out;
    bf16_t *XN = (bf16_t*)(ws + WS_XN), *U = (bf16_t*)(ws + WS_U), *SZP = (bf16_t*)(ws + WS_SZP), *QKV = (bf16_t*)(ws + WS_QKV), *SZD = (bf16_t*)(ws + WS_SZD), *GATES = (bf16_t*)(ws + WS_GATES);
    float* BA = (float*)(ws + WS_BA);
    bf16_t *Y = (bf16_t*)(ws + WS_Y), *PO = (bf16_t*)(ws + WS_POOLED), *O = (bf16_t*)(ws + WS_O), *MG = (bf16_t*)(ws + WS_MERGED);
    bf16_t *cNW = (bf16_t*)(ws + WS_CH_NW), *cU = (bf16_t*)(ws + WS_CH_U), *cQD = (bf16_t*)(ws + WS_CH_QD), *cKDT = (bf16_t*)(ws + WS_CH_KDT), *cQK = (bf16_t*)(ws + WS_CH_QK);
    float* cGL = (float*)(ws + WS_CH_GL);
    int s = 0;
    while (s < NPHASE) {
        if (!((NAIVE_MASK >> s) & 1)) {
            int e = s + 1;
            if (FUSE) while (e < NPHASE && !((NAIVE_MASK >> e) & 1)) ++e;
            a.ph_lo = s; a.ph_hi = e;
            hipLaunchKernelGGL(mega_fwd, dim3(grid), dim3(NWAVES * 64), LDS_BYTES, stream, a);
            s = e; continue;
        }
        switch (s) {
        case 0: nv_prep<<<1024, 256, 0, stream>>>(x, meta, norm_w, XN); break;
        case 1: nv_gemm<EpiProj><<<dim3((INC + 127) / 128, (MROWS + 127) / 128), 256, 0, stream>>>(XN, DM, w_in, INC, MROWS, INC, DM, EpiProj{U, SZP, QKV, SZD, GATES, BA}); break;
        case 2: nv_pool<<<MTOK * PW / 256, 256, 0, stream>>>(U, PO);
                nv_chunk_prep<<<NUNITS, 256, 140 * 1024, stream>>>(QKV, BA, conv_w, A_log, dt_bias, cNW, cU, cQD, cKDT, cQK, cGL); break;
        case 3: nv_chunk_scan<<<NB * NH, 128, 0, stream>>>(cNW, cU, cQD, cKDT, cQK, cGL, O); break;
        case 4: nv_gnorm<<<MTOK * NH / 4, 256, 0, stream>>>(O, SZD, dn_norm_w, Y);
                for (int g = 0; g < 4; ++g)
                    nv_gemm<EpiPool><<<dim3(2, MTOK / 128), 256, 0, stream>>>(PO + g * PGD, PW, pool_mix + (size_t)g * PGD * PGD, PGD, MTOK, PGD, PGD, EpiPool{Y, SZP, pool_scale, g, 0});
                break;
        case 5: nv_gemm<EpiG2a><<<dim3(DM / 128, MTOK / 128), 256, 0, stream>>>(Y, YLD, w_pool_out, DM, MTOK, DM, PW, EpiG2a{out, GATES});
                nv_gemm<EpiG2b><<<dim3(DM / 128, MTOK / 128), 256, 0, stream>>>(Y + 1024, YLD, w_dn_out, DM, MTOK, DM, DNW, EpiG2b{out, GATES, MG}); break;
        case 6: nv_gemm<EpiG3><<<dim3(DM / 128, MTOK / 128), 256, 0, stream>>>(MG, DM, w_o, DM, MTOK, DM, DM, EpiG3{x, out}); break;
        case 7: nv_final<<<MTOK, 256, 0, stream>>>(out, final_norm_w); break;
        }
        ++s;
    }
#endif
}
```

```cpp
#define MIX 0
#include <hip/hip_runtime.h>
#include <cstdint>
#include <cstdio>

typedef unsigned short bf16_t;
__device__ __forceinline__ float bf2f(bf16_t v) { return __uint_as_float(((unsigned)v) << 16); }
__device__ __forceinline__ bf16_t f2bf(float f) { unsigned u = __float_as_uint(f); return (bf16_t)((u + 0x7fffu + ((u >> 16) & 1u)) >> 16); }
__device__ __forceinline__ float sigmoidf_(float x) { return 1.f / (1.f + __expf(-x)); }
__device__ __forceinline__ float siluf_(float x) { return x / (1.f + __expf(-x)); }
__device__ __forceinline__ float softplusf_(float x) { return x > 20.f ? x : log1pf(__expf(x)); }

constexpr int DM = 2048, NB = 4, SEQ = 2048, NMETA = 16, LEXT = SEQ + NMETA;
constexpr int PW = 1024, PGD = 256, NH = 16, HD = 128, DNW = 2048, CHUNK = 64, NCH = 33, PADF = 48;
constexpr int INC = 14368;
constexpr int C_U = 0, C_ZP = 1024, C_Q = 2048, C_ZD = 8192, C_B = 10240, C_GP = 10272;
constexpr int MTOK = NB * SEQ;
constexpr int MROWS = MTOK + NMETA;
constexpr int MPAD = 8448;
constexpr int NPAD1 = 14592;
constexpr int YLD = 3072;
constexpr float EPS = 1e-6f;
constexpr int NUNITS = NB * NH * NCH;

constexpr size_t MiB = 1u << 20;
constexpr size_t WS_CTL = 0, CTL_ZERO_BYTES = 1 * MiB;
constexpr size_t WS_CH = 1 * MiB;
constexpr size_t CH_ARR = (size_t)NUNITS * 8192 * 2;
constexpr size_t WS_CH_NW = WS_CH, WS_CH_U = WS_CH + CH_ARR, WS_CH_QD = WS_CH + 2 * CH_ARR, WS_CH_KDT = WS_CH + 3 * CH_ARR, WS_CH_QK = WS_CH + 4 * CH_ARR;
constexpr size_t WS_CH_GL = WS_CH_QK + (size_t)NUNITS * 4096 * 2;
constexpr size_t WS_WINT = WS_CH;
constexpr size_t WS_XN = WS_CH + 57 * MiB;
constexpr size_t WS_W2T = 150 * MiB;
constexpr size_t WS_WOT = 162 * MiB;
constexpr size_t WS_MIXT = 170 * MiB;
constexpr size_t WS_U = 171 * MiB;
constexpr size_t WS_SZP = WS_U + (size_t)MPAD * 1024 * 2;
constexpr size_t WS_QKV = WS_SZP + (size_t)MPAD * 1024 * 2;
constexpr size_t WS_BA = 303 * MiB;
constexpr size_t WS_O = 204 * MiB, WS_Y = 236 * MiB, WS_MERGED = 204 * MiB;
constexpr size_t WS_SZD = 304 * MiB + 512 * 1024;
constexpr size_t WS_GATES = WS_SZD + (size_t)MPAD * 2048 * 2;
constexpr size_t WS_POOLED = WS_GATES + (size_t)MPAD * 4096 * 2;
constexpr size_t WS_END = WS_POOLED + (size_t)MTOK * 1024 * 2;
static_assert(WS_CH_GL + NUNITS * 4 <= WS_W2T, "chunk arrays");
static_assert(WS_XN + (size_t)MPAD * 2048 * 2 <= WS_W2T, "xn");
static_assert(WS_QKV == 204 * MiB && WS_QKV + (size_t)MPAD * 6144 * 2 <= WS_BA, "qkv");
static_assert(WS_Y + (size_t)MTOK * YLD * 2 <= WS_BA, "y");
static_assert(WS_BA + (size_t)MPAD * 32 * 4 <= WS_SZD, "ba");
static_assert(WS_END <= 449 * MiB, "ws");

__device__ __forceinline__ int ext_row(int b, int p) { return p < NMETA ? MTOK + p : b * SEQ + (p - NMETA); }

__device__ __forceinline__ float wave_sum(float v) {
#pragma unroll
    for (int o = 1; o < 64; o <<= 1) v += __shfl_xor(v, o);
    return v;
}
#if MIX
__global__ void __launch_bounds__(256) nv_prep(const float* __restrict__ x, const float* __restrict__ meta, const float* __restrict__ nw, bf16_t* __restrict__ XN) {
    const int lane = threadIdx.x & 63, gw = (blockIdx.x * 256 + threadIdx.x) >> 6, ngw = gridDim.x * 4;
    for (int r = gw; r < MPAD; r += ngw) {
        bf16_t* o = XN + (size_t)r * DM;
        if (r >= MROWS) { for (int j = lane; j < DM; j += 64) o[j] = 0; continue; }
        const float* src = r < MTOK ? x + (size_t)r * DM : meta + (size_t)(r - MTOK) * DM;
        float v[32]; float s = 0.f;
#pragma unroll
        for (int j = 0; j < 32; ++j) { v[j] = src[lane + 64 * j]; s += v[j] * v[j]; }
        const float rs = rsqrtf(wave_sum(s) * (1.f / DM) + EPS);
#pragma unroll
        for (int j = 0; j < 32; ++j) o[lane + 64 * j] = f2bf(v[j] * rs * nw[lane + 64 * j]);
    }
}

template <class Epi>
__global__ void __launch_bounds__(256) nv_gemm(const bf16_t* __restrict__ A, int lda, const float* __restrict__ W, int ldw, int M, int N, int K, Epi epi) {
    __shared__ __attribute__((aligned(16))) float As[16][132];
    __shared__ __attribute__((aligned(16))) float Bs[16][132];
    const int tid = threadIdx.x, tx = tid & 15, ty = tid >> 4;
    const int m0 = blockIdx.y * 128, n0 = blockIdx.x * 128;
    float acc[8][8];
#pragma unroll
    for (int i = 0; i < 8; ++i)
#pragma unroll
        for (int j = 0; j < 8; ++j) acc[i][j] = 0.f;
    for (int k0 = 0; k0 < K; k0 += 16) {
        {
            const int r = tid >> 1, kc = (tid & 1) * 8, gm = m0 + r;
            uint4 v = make_uint4(0, 0, 0, 0);
            if (gm < M) v = *(const uint4*)(A + (size_t)gm * lda + k0 + kc);
            const unsigned w[4] = {v.x, v.y, v.z, v.w};
#pragma unroll
            for (int j = 0; j < 4; ++j) { As[kc + 2 * j][r] = __uint_as_float(w[j] << 16); As[kc + 2 * j + 1][r] = __uint_as_float(w[j] & 0xffff0000u); }
        }
        {
            const int kk = tid >> 4, nc = (tid & 15) * 8, gn = n0 + nc;
            float4 v0 = make_float4(0, 0, 0, 0), v1 = v0;
            if (gn < N) { const float* p = W + (size_t)(k0 + kk) * ldw + gn; v0 = *(const float4*)p; v1 = *(const float4*)(p + 4); }
            *(float4*)&Bs[kk][nc] = v0; *(float4*)&Bs[kk][nc + 4] = v1;
        }
        __syncthreads();
#pragma unroll
        for (int kk = 0; kk < 16; ++kk) {
            float a[8], b[8];
            *(float4*)&a[0] = *(const float4*)&As[kk][ty * 8]; *(float4*)&a[4] = *(const float4*)&As[kk][ty * 8 + 4];
            *(float4*)&b[0] = *(const float4*)&Bs[kk][tx * 8]; *(float4*)&b[4] = *(const float4*)&Bs[kk][tx * 8 + 4];
#pragma unroll
            for (int i = 0; i < 8; ++i)
#pragma unroll
                for (int j = 0; j < 8; ++j) acc[i][j] += a[i] * b[j];
        }
        __syncthreads();
    }
#pragma unroll
    for (int i = 0; i < 8; ++i)
#pragma unroll
        for (int j = 0; j < 8; ++j) { const int gm = m0 + ty * 8 + i, gn = n0 + tx * 8 + j; if (gm < M && gn < N) epi(gm, gn, acc[i][j]); }
}

struct EpiProj {
    bf16_t *U, *SZP, *QKV, *SZD, *GATES; float* BA;
    __device__ __forceinline__ void operator()(int m, int n, float v) const {
        if (n < C_ZP) U[(size_t)m * 1024 + n] = f2bf(v);
        else if (n < C_Q) SZP[(size_t)m * 1024 + (n - C_ZP)] = f2bf(siluf_(v));
        else if (n < C_ZD) QKV[(size_t)m * 6144 + (n - C_Q)] = f2bf(v);
        else if (n < C_B) SZD[(size_t)m * 2048 + (n - C_ZD)] = f2bf(siluf_(v));
        else if (n < C_GP) BA[(size_t)m * 32 + (n - C_B)] = v;
        else GATES[(size_t)m * 4096 + (n - C_GP)] = f2bf(sigmoidf_(v));
    }
};
struct EpiPool {
    bf16_t* Y; const bf16_t* SZP; const float* scale; int g, pad;
    __device__ __forceinline__ void operator()(int m, int n, float v) const {
        const int c = g * PGD + n; Y[(size_t)m * YLD + c] = f2bf(v * scale[c] * bf2f(SZP[(size_t)m * 1024 + c]));
    }
};
struct EpiG2a { float* T; const bf16_t* GATES; __device__ __forceinline__ void operator()(int m, int n, float v) const { T[(size_t)m * DM + n] = v * bf2f(GATES[(size_t)m * 4096 + n]); } };
struct EpiG2b { const float* T; const bf16_t* GATES; bf16_t* MG; __device__ __forceinline__ void operator()(int m, int n, float v) const { MG[(size_t)m * DM + n] = f2bf(T[(size_t)m * DM + n] + v * bf2f(GATES[(size_t)m * 4096 + 2048 + n])); } };
struct EpiG3 { const float* x; float* out; __device__ __forceinline__ void operator()(int m, int n, float v) const { out[(size_t)m * DM + n] = x[(size_t)m * DM + n] + v; } };

__global__ void __launch_bounds__(256) nv_pool(const bf16_t* __restrict__ U, bf16_t* __restrict__ PO) {
    const int idx = blockIdx.x * 256 + threadIdx.x; if (idx >= MTOK * PW) return;
    const int m = idx >> 10, c = idx & 1023, b = m >> 11, t = m & 2047, p = t + NMETA, win = 2 << (c >> 8);
    float s = 0.f;
    for (int j = 0; j < win; ++j) { const int pp = p - j; if (pp >= 0) s += bf2f(U[(size_t)ext_row(b, pp) * 1024 + c]); }
    const int cnt = (p + 1) < win ? (p + 1) : win;
    PO[idx] = f2bf(s / (float)cnt - bf2f(U[(size_t)m * 1024 + c]));
}

__global__ void __launch_bounds__(256) nv_chunk_prep(const bf16_t* __restrict__ QKV, const float* __restrict__ BA, const float* __restrict__ conv_w, const float* __restrict__ A_log,
                                                     const float* __restrict__ dt_bias, bf16_t* __restrict__ NW, bf16_t* __restrict__ UU, bf16_t* __restrict__ QD, bf16_t* __restrict__ KDT,
                                                     bf16_t* __restrict__ QK, float* __restrict__ GL) {
    extern __shared__ __attribute__((aligned(16))) float sm[];
    float *q = sm, *k = q + 8192, *v = k + 8192, *Am = v + 8192, *Tm = Am + 4096, *beta = Tm + 4096, *gc = beta + 64;
    const int cu = blockIdx.x, n = cu % NCH, bh = cu / NCH, h = bh % NH, b = bh / NH, tid = threadIdx.x, lane = tid & 63, wv = tid >> 6;
    const int p0 = CHUNK * n - PADF;
    for (int idx = tid; idx < 64 * 384; idx += 256) {
        const int i = idx / 384, c3 = idx % 384, which = c3 >> 7, d = c3 & 127, col = which * 2048 + h * HD + d, p = p0 + i;
        float val = 0.f;
        if (p >= 0) { float a = 0.f;
            for (int kk = 0; kk < 4; ++kk) { const int pp = p - 3 + kk; if (pp >= 0) a += conv_w[kk * 6144 + col] * bf2f(QKV[(size_t)ext_row(b, pp) * 6144 + col]); }
            val = siluf_(a); }
        (which == 0 ? q : which == 1 ? k : v)[i * 128 + d] = val;
    }
    if (tid < 64) { const int p = p0 + tid; float be = 0.f, g = 0.f;
        if (p >= 0) { const int r = ext_row(b, p); be = sigmoidf_(BA[(size_t)r * 32 + h]); g = -__expf(A_log[h]) * softplusf_(BA[(size_t)r * 32 + 16 + h] + dt_bias[h]); }
        beta[tid] = be; gc[tid] = g; }
    __syncthreads();
    if (tid == 0) { float s = 0.f; for (int i = 0; i < 64; ++i) { s += gc[i]; gc[i] = s; } }
    for (int r = wv; r < 128; r += 4) {
        float* row = (r < 64 ? q + r * 128 : k + (r - 64) * 128);
        const float a0 = row[lane], a1 = row[lane + 64];
        const float rs = rsqrtf(wave_sum(a0 * a0 + a1 * a1) + EPS) * (r < 64 ? 0.08838834764831845f : 1.f);
        row[lane] = a0 * rs; row[lane + 64] = a1 * rs;
    }
    __syncthreads();
    bf16_t* oQK = QK + (size_t)cu * 4096;
    for (int idx = tid; idx < 4096; idx += 256) {
        const int i = idx >> 6, j = idx & 63; float akk = 0.f, aqk = 0.f;
        if (j <= i) { for (int d = 0; d < 128; ++d) { const float kj = k[j * 128 + d]; akk += k[i * 128 + d] * kj; aqk += q[i * 128 + d] * kj; }
            const float dec = __expf(gc[i] - gc[j]); akk *= beta[i] * dec; aqk *= dec; }
        Am[idx] = j < i ? akk : 0.f; oQK[idx] = f2bf(j <= i ? aqk : 0.f);
    }
    __syncthreads();
    if (tid < 64) { const int c = tid;
        for (int i = 0; i < 64; ++i) { float s = (i == c) ? 1.f : 0.f; for (int j = c; j < i; ++j) s -= Am[i * 64 + j] * Tm[j * 64 + c]; Tm[i * 64 + c] = (i >= c) ? s : 0.f; } }
    __syncthreads();
    bf16_t *oNW = NW + (size_t)cu * 8192, *oU = UU + (size_t)cu * 8192, *oQD = QD + (size_t)cu * 8192, *oKDT = KDT + (size_t)cu * 8192;
    const float gl = gc[63];
    for (int idx = tid; idx < 8192; idx += 256) {
        const int i = idx >> 7, d = idx & 127; float su = 0.f, sw = 0.f;
        for (int j = 0; j <= i; ++j) { const float t = Tm[i * 64 + j] * beta[j]; su += t * v[j * 128 + d]; sw += t * __expf(gc[j]) * k[j * 128 + d]; }
        oU[idx] = f2bf(su); oNW[idx] = f2bf(-sw);
        oQD[idx] = f2bf(q[idx] * __expf(gc[i]));
        oKDT[d * 64 + i] = f2bf(k[idx] * __expf(gl - gc[i]));
    }
    if (tid == 0) GL[cu] = __expf(gl);
}

__global__ void __launch_bounds__(128) nv_chunk_scan(const bf16_t* __restrict__ NW, const bf16_t* __restrict__ UU, const bf16_t* __restrict__ QD, const bf16_t* __restrict__ KDT,
                                                     const bf16_t* __restrict__ QK, const float* __restrict__ GL, bf16_t* __restrict__ O) {
    __shared__ float vn[64][128];
    const int bh = blockIdx.x, h = bh % NH, b = bh / NH, e = threadIdx.x;
    float S[128];
#pragma unroll
    for (int d = 0; d < 128; ++d) S[d] = 0.f;
    for (int n = 0; n < NCH; ++n) {
        const int cu = bh * NCH + n;
        const bf16_t *nw = NW + (size_t)cu * 8192, *uu = UU + (size_t)cu * 8192, *qd = QD + (size_t)cu * 8192, *kdt = KDT + (size_t)cu * 8192, *qk = QK + (size_t)cu * 4096;
        const float gl = GL[cu];
        for (int i = 0; i < 64; ++i) { float a = bf2f(uu[i * 128 + e]);
#pragma unroll
            for (int d = 0; d < 128; ++d) a += bf2f(nw[i * 128 + d]) * S[d];
            vn[i][e] = a; }
        __syncthreads();
        if (n > 0) for (int i = 0; i < 64; ++i) { float a = 0.f;
#pragma unroll
            for (int d = 0; d < 128; ++d) a += bf2f(qd[i * 128 + d]) * S[d];
            for (int j = 0; j <= i; ++j) a += bf2f(qk[i * 64 + j]) * vn[j][e];
            O[(size_t)(b * SEQ + 64 * (n - 1) + i) * DNW + h * HD + e] = f2bf(a); }
#pragma unroll
        for (int d = 0; d < 128; ++d) { float s = S[d] * gl; for (int i = 0; i < 64; ++i) s += bf2f(kdt[d * 64 + i]) * vn[i][e]; S[d] = s; }
        __syncthreads();
    }
}

__global__ void __launch_bounds__(256) nv_gnorm(const bf16_t* __restrict__ O, const bf16_t* __restrict__ SZD, const float* __restrict__ w, bf16_t* __restrict__ Y) {
    const int lane = threadIdx.x & 63, gw = (blockIdx.x * 256 + threadIdx.x) >> 6; if (gw >= MTOK * NH) return;
    const size_t base = (size_t)(gw >> 4) * DNW + (gw & 15) * HD, yb = (size_t)(gw >> 4) * YLD + 1024 + (gw & 15) * HD;
    const float a0 = bf2f(O[base + lane]), a1 = bf2f(O[base + lane + 64]);
    const float rs = rsqrtf(wave_sum(a0 * a0 + a1 * a1) * (1.f / HD) + EPS);
    Y[yb + lane] = f2bf(a0 * rs * w[lane] * bf2f(SZD[base + lane]));
    Y[yb + lane + 64] = f2bf(a1 * rs * w[lane + 64] * bf2f(SZD[base + lane + 64]));
}

__global__ void __launch_bounds__(256) nv_final(float* __restrict__ out, const float* __restrict__ w) {
    __shared__ float red[4];
    float* row = out + (size_t)blockIdx.x * DM; const int tid = threadIdx.x;
    float v[8]; float s = 0.f;
#pragma unroll
    for (int j = 0; j < 8; ++j) { v[j] = row[tid + 256 * j]; s += v[j] * v[j]; }
    s = wave_sum(s); if ((tid & 63) == 0) red[tid >> 6] = s; __syncthreads();
    const float rs = rsqrtf((red[0] + red[1] + red[2] + red[3]) * (1.f / DM) + EPS);
#pragma unroll
    for (int j = 0; j < 8; ++j) row[tid + 256 * j] = v[j] * rs * w[tid + 256 * j];
}

#endif
namespace pg8 {
#define PG8_LAS __attribute__((address_space(3)))
typedef short bf16x8 __attribute__((ext_vector_type(8)));
typedef float f32x4 __attribute__((ext_vector_type(4)));
typedef unsigned u32x4 __attribute__((ext_vector_type(4)));
constexpr int BM = 256, BK = 64, HALF = 128, HTB = HALF * BK * 2  , STAGE_BYTES = 8 * HTB, NXCD = 8, WGM = 8;

__host__ __device__ __forceinline__ int lds_byte(int r, int c) { const int st = (r >> 4) * 2 + (c >> 5), rr = r & 15, cc = c & 31, ob = rr * 64 + cc * 2; return st * 1024 + (ob ^ (((ob >> 9) & 1) << 5)); }
__host__ __device__ __forceinline__ void stage_rc(int b, int& R, int& C) { const int st = b / 1024, sb = b % 1024, swz = sb ^ (((sb >> 9) & 1) << 5); R = (st >> 1) * 16 + swz / 64; C = (st & 1) * 32 + (swz % 64) / 2; }
__host__ __device__ __forceinline__ int perm32(int rho) { const int n = rho >> 4, i = rho & 15; return 8 * (i >> 2) + 4 * n + (i & 3); }

struct Unit { int pm, pn, aoff, boff, nt, mode; };
struct Gemm { const bf16_t* A; const bf16_t* Bt; int lda, ldb; };

struct StaticOrder {
    int nM, nN, nwg, G, c, nt;
    __device__ void init(int nM_, int nN_, int nt_, int G_, int c_) { nM = nM_; nN = nN_; nwg = nM * nN; G = G_; c = c_; nt = nt_; }
    __device__ bool next(int i, Unit& u) const {
        const long L = (long)i * G + c; if (L >= nwg) return false;
        int wgid = (int)L; { const int q = nwg / NXCD, r = nwg % NXCD, xcd = wgid % NXCD, off = wgid / NXCD; wgid = (xcd < r ? xcd * (q + 1) : r * (q + 1) + (xcd - r) * q) + off; }
        const int nig = WGM * nN, gid = wgid / nig, fm = gid * WGM, gsz = (nM - fm) < WGM ? (nM - fm) : WGM;
        u.pm = fm + ((wgid % nig) % gsz); u.pn = (wgid % nig) / gsz; u.aoff = 0; u.boff = 0; u.nt = nt; u.mode = 0; return true;
    }
};

typedef float f32x2_t __attribute__((ext_vector_type(2))); typedef __bf16 bf16x2_t __attribute__((ext_vector_type(2)));
__device__ __forceinline__ unsigned cvt_pk_bf16(float lo, float hi) { f32x2_t v = {lo, hi}; bf16x2_t b = __builtin_convertvector(v, bf16x2_t); return __builtin_bit_cast(unsigned, b); }
__device__ __forceinline__ u32x4 pack8(f32x4 v0, f32x4 v1) { u32x4 w; w.x = cvt_pk_bf16(v0[0], v0[1]); w.y = cvt_pk_bf16(v0[2], v0[3]); w.z = cvt_pk_bf16(v1[0], v1[1]); w.w = cvt_pk_bf16(v1[2], v1[3]); return w; }
__device__ __forceinline__ void unpack8(u32x4 w, f32x4& v0, f32x4& v1) {
    v0 = (f32x4){__uint_as_float(w.x << 16), __uint_as_float(w.x & 0xffff0000u), __uint_as_float(w.y << 16), __uint_as_float(w.y & 0xffff0000u)};
    v1 = (f32x4){__uint_as_float(w.z << 16), __uint_as_float(w.z & 0xffff0000u), __uint_as_float(w.w << 16), __uint_as_float(w.w & 0xffff0000u)};
}
__device__ __forceinline__ float fast_sigmoid(float x) { return __builtin_amdgcn_rcpf(1.f + __builtin_amdgcn_exp2f(-1.4426950408889634f * x)); }

struct EpiProj {
    static constexpr bool PERM = true;
    bf16_t *U, *SZP, *QKV, *SZD, *GATES; float* BA;
    __device__ __forceinline__ bool reset_after(const Unit&) const { return true; }
    __device__ __forceinline__ void operator()(f32x4 (&acc)[2][2][4][2], const Unit& u, int wr, int wc, int fr, int fq) const {
        const int row0 = u.pm * BM + wr * 64 + fr, pn = u.pn;
        if (pn == 56) {
            if (wc == 0) {
#pragma unroll
                for (int ai = 0; ai < 2; ++ai)
#pragma unroll
                    for (int m = 0; m < 4; ++m) { float* rowp = BA + (size_t)(row0 + ai * HALF + m * 16) * 32 + 8 * fq;
                        *(f32x4*)rowp = acc[ai][0][m][0]; *(f32x4*)(rowp + 4) = acc[ai][0][m][1]; }
            }
            return;
        }
        bf16_t* base; int ld, colt, act;
        if (pn < 4) { base = U; ld = 1024; colt = pn * 256; act = 0; }
        else if (pn < 8) { base = SZP; ld = 1024; colt = (pn - 4) * 256; act = 1; }
        else if (pn < 32) { base = QKV; ld = 6144; colt = (pn - 8) * 256; act = 0; }
        else if (pn < 40) { base = SZD; ld = 2048; colt = (pn - 32) * 256; act = 1; }
        else { base = GATES; ld = 4096; colt = (pn - 40) * 256; act = 2; }
        const int col0 = colt + wc * 32 + 8 * fq;
#pragma unroll
        for (int ai = 0; ai < 2; ++ai)
#pragma unroll
            for (int m = 0; m < 4; ++m) { bf16_t* rowp = base + (size_t)(row0 + ai * HALF + m * 16) * ld + col0;
#pragma unroll
                for (int bj = 0; bj < 2; ++bj) { f32x4 v0 = acc[ai][bj][m][0], v1 = acc[ai][bj][m][1];
                    if (act != 0) {
#pragma unroll
                        for (int j = 0; j < 4; ++j) { const float s0 = fast_sigmoid(v0[j]), s1 = fast_sigmoid(v1[j]); v0[j] = act == 1 ? v0[j] * s0 : s0; v1[j] = act == 1 ? v1[j] * s1 : s1; }
                    }
                    *(u32x4*)(rowp + bj * HALF) = pack8(v0, v1); } }
    }
};
struct EpiPoolMix {
    static constexpr bool PERM = true;
    bf16_t* Y; const bf16_t* SZP; const float* scale;
    __device__ __forceinline__ bool reset_after(const Unit&) const { return true; }
    __device__ __forceinline__ void operator()(f32x4 (&acc)[2][2][4][2], const Unit& u, int wr, int wc, int fr, int fq) const {
        const int row0 = u.pm * BM + wr * 64 + fr, col0 = u.pn * BM + wc * 32 + 8 * fq;
#pragma unroll
        for (int bj = 0; bj < 2; ++bj) { const f32x4 s0 = *(const f32x4*)(scale + col0 + bj * HALF), s1 = *(const f32x4*)(scale + col0 + bj * HALF + 4);
#pragma unroll
            for (int ai = 0; ai < 2; ++ai)
#pragma unroll
                for (int m = 0; m < 4; ++m) { const size_t r = (size_t)(row0 + ai * HALF + m * 16);
                    f32x4 z0, z1; unpack8(*(const u32x4*)(SZP + r * 1024 + col0 + bj * HALF), z0, z1);
                    *(u32x4*)(Y + r * YLD + col0 + bj * HALF) = pack8(acc[ai][bj][m][0] * s0 * z0, acc[ai][bj][m][1] * s1 * z1); } }
    }
};
struct EpiMerge {
    static constexpr bool PERM = true;
    const bf16_t* GATES; bf16_t* MG;
    __device__ __forceinline__ bool reset_after(const Unit& u) const { return u.mode != 0; }
    __device__ __forceinline__ void operator()(f32x4 (&acc)[2][2][4][2], const Unit& u, int wr, int wc, int fr, int fq) const {
        const int row0 = u.pm * BM + wr * 64 + fr, col0 = u.pn * BM + wc * 32 + 8 * fq;
#pragma unroll
        for (int ai = 0; ai < 2; ++ai)
#pragma unroll
            for (int m = 0; m < 4; ++m) { const size_t r = (size_t)(row0 + ai * HALF + m * 16);
#pragma unroll
                for (int bj = 0; bj < 2; ++bj) {
                    f32x4 d0, d1; unpack8(*(const u32x4*)(GATES + r * 4096 + 2048 + col0 + bj * HALF), d0, d1);
                    if (u.mode == 0) {
                        f32x4 p0, p1; unpack8(*(const u32x4*)(GATES + r * 4096 + col0 + bj * HALF), p0, p1);
#pragma unroll
                        for (int j = 0; j < 4; ++j) { acc[ai][bj][m][0][j] *= p0[j] / fmaxf(d0[j], 1e-30f); acc[ai][bj][m][1][j] *= p1[j] / fmaxf(d1[j], 1e-30f); }
                    } else {
                        *(u32x4*)(MG + r * DM + col0 + bj * HALF) = pack8(acc[ai][bj][m][0] * d0, acc[ai][bj][m][1] * d1);
                    } } }
    }
};
struct EpiResid {
    static constexpr bool PERM = false;
    const float* x; float* out;
    __device__ __forceinline__ bool reset_after(const Unit&) const { return true; }
    __device__ __forceinline__ void operator()(f32x4 (&acc)[2][2][4][2], const Unit& u, int wr, int wc, int fr, int fq) const {
        const int row0 = u.pm * BM + wr * 64 + fr, col0 = u.pn * BM + wc * 32 + 4 * fq;
#pragma unroll
        for (int ai = 0; ai < 2; ++ai)
#pragma unroll
            for (int m = 0; m < 4; ++m) { const size_t off = (size_t)(row0 + ai * HALF + m * 16) * DM + col0;
#pragma unroll
                for (int bj = 0; bj < 2; ++bj)
#pragma unroll
                    for (int n = 0; n < 2; ++n) *(f32x4*)(out + off + bj * HALF + n * 16) = *(const f32x4*)(x + off + bj * HALF + n * 16) + acc[ai][bj][m][n]; }
    }
};

template <class Epi, class Sched, bool ALIGN_EPI>
__device__ __forceinline__ void gemm_phase(PG8_LAS unsigned char* lds, const Gemm g, const Sched& S, const Epi& E) {
    const int tid = threadIdx.x, wid = __builtin_amdgcn_readfirstlane(tid >> 6), lane = tid & 63, wr = wid >> 2, wc = wid & 3, fr = lane & 15, fq = lane >> 4;
    const int lda = g.lda, ldb = g.ldb;
    unsigned voffA[2], voffB[2];
#pragma unroll
    for (int i = 0; i < 2; ++i) { int R, C; stage_rc(tid * 16 + i * 8192, R, C); const int Rb = Epi::PERM ? ((R & ~31) + perm32(R & 31)) : R;
        voffA[i] = (unsigned)(R * lda + C) * 2u; voffB[i] = (unsigned)(Rb * ldb + C) * 2u; }
    const size_t kstep = (size_t)(BK * 2);
    const size_t hstepA = (size_t)HALF * lda * 2, hstepB = (size_t)HALF * ldb * 2;
    const unsigned ldsw = (unsigned)wid * 1024u;
    const int aoff = lds_byte(wr * 64 + fr, fq * 8), boff = lds_byte(wc * 32 + fr, fq * 8);
#define PG8_SA(b, h) (((b) * 2 + (h)) * HTB)
#define PG8_SB(b, h) ((4 + (b) * 2 + (h)) * HTB)
#define PG8_STAGE(bufoff, gbase, voff) do { _Pragma("unroll") for (int _i = 0; _i < 2; ++_i) \
        __builtin_amdgcn_global_load_lds((const unsigned*)((const char*)(gbase) + (voff)[_i]), (PG8_LAS unsigned*)(lds + (bufoff) + ldsw + _i * 8192), 16, 0, 0); } while (0)
#define PG8_LDA(dst, b, h) do { _Pragma("unroll") for (int m = 0; m < 4; ++m) _Pragma("unroll") for (int k = 0; k < 2; ++k) dst[m][k] = *(const PG8_LAS bf16x8*)(lds + PG8_SA(b, h) + aoff + m * 2048 + k * 1024); } while (0)
#define PG8_LDB(dst, b, h) do { _Pragma("unroll") for (int n = 0; n < 2; ++n) _Pragma("unroll") for (int k = 0; k < 2; ++k) dst[n][k] = *(const PG8_LAS bf16x8*)(lds + PG8_SB(b, h) + boff + n * 2048 + k * 1024); } while (0)
#define PG8_MMA(ai, bj, At, Bt) do { __builtin_amdgcn_s_setprio(1); _Pragma("unroll") for (int m = 0; m < 4; ++m) _Pragma("unroll") for (int n = 0; n < 2; ++n) _Pragma("unroll") for (int k = 0; k < 2; ++k) \
        acc[ai][bj][m][n] = __builtin_amdgcn_mfma_f32_16x16x32_bf16(Bt[n][k], At[m][k], acc[ai][bj][m][n], 0, 0, 0); __builtin_amdgcn_s_setprio(0); } while (0)
#define PG8_WAIT_V(n) asm volatile("s_waitcnt vmcnt(" #n ")" ::: "memory")
#define PG8_WAIT_L(n) asm volatile("s_waitcnt lgkmcnt(" #n ")" ::: "memory")
#define PG8_BAR __builtin_amdgcn_s_barrier()
#define PG8_SCHED __builtin_amdgcn_sched_barrier(0)
#define PG8_UA(u) ((const char*)g.A + ((size_t)(u).pm * BM * lda + (u).aoff) * 2)
#define PG8_UB(u) ((const char*)g.Bt + ((size_t)(u).pn * BM * ldb + (u).boff) * 2)
    Unit cur, nxt; int ui = 0;
    if (!S.next(0, cur)) return;
    f32x4 acc[2][2][4][2];
#pragma unroll
    for (int a = 0; a < 2; ++a)
#pragma unroll
        for (int b = 0; b < 2; ++b)
#pragma unroll
            for (int m = 0; m < 4; ++m)
#pragma unroll
                for (int n = 0; n < 2; ++n) acc[a][b][m][n] = (f32x4){0.f, 0.f, 0.f, 0.f};
    bf16x8 At[4][2], B0[2][2], B1[2][2];
    const char* cA = PG8_UA(cur); const char* cB = PG8_UB(cur);
    PG8_STAGE(PG8_SB(0, 0), cB, voffB); PG8_STAGE(PG8_SB(0, 1), cB + hstepB, voffB); PG8_STAGE(PG8_SA(0, 0), cA, voffA); PG8_STAGE(PG8_SA(0, 1), cA + hstepA, voffA);
    if (wr == 1) PG8_BAR;
    PG8_WAIT_V(2); PG8_BAR;
    PG8_STAGE(PG8_SB(1, 0), cB + kstep, voffB); PG8_STAGE(PG8_SA(1, 0), cA + kstep, voffA); PG8_STAGE(PG8_SB(1, 1), cB + hstepB + kstep, voffB);
    PG8_WAIT_V(6); PG8_BAR;
    for (;;) {
        const bool has_next = S.next(ui + 1, nxt);
        const char* nA = has_next ? PG8_UA(nxt) : cA; const char* nB = has_next ? PG8_UB(nxt) : cB;
        const int nt = cur.nt;
        for (int t = 0; t < nt; t += 2) {
            const bool last = (t == nt - 2);
            const char* a1 = cA + (size_t)(t + 1) * kstep;
            const char* a2 = last ? nA : cA + (size_t)(t + 2) * kstep; const char* b2 = last ? nB : cB + (size_t)(t + 2) * kstep;
            const char* a3 = a2 + kstep; const char* b3 = b2 + kstep;
            PG8_LDB(B0, 0, 0); PG8_LDB(B1, 0, 1); PG8_SCHED; PG8_LDA(At, 0, 0); PG8_STAGE(PG8_SA(1, 1), a1 + hstepA, voffA);
            PG8_WAIT_V(8); PG8_WAIT_L(0); PG8_BAR; PG8_MMA(0, 0, At, B0); PG8_MMA(0, 1, At, B1); PG8_BAR; PG8_SCHED;
            PG8_LDA(At, 0, 1); PG8_STAGE(PG8_SB(0, 0), b2, voffB); PG8_STAGE(PG8_SB(0, 1), b2 + hstepB, voffB); PG8_STAGE(PG8_SA(0, 0), a2, voffA);
            PG8_WAIT_V(8); PG8_WAIT_L(0); PG8_BAR; PG8_MMA(1, 0, At, B0); PG8_MMA(1, 1, At, B1); PG8_BAR; PG8_SCHED;
            PG8_LDB(B0, 1, 0); PG8_LDB(B1, 1, 1); PG8_SCHED; PG8_LDA(At, 1, 0); PG8_STAGE(PG8_SA(0, 1), a2 + hstepA, voffA);
            PG8_WAIT_V(8); PG8_WAIT_L(0); PG8_BAR; PG8_MMA(0, 0, At, B0); PG8_MMA(0, 1, At, B1); PG8_BAR; PG8_SCHED;
            PG8_LDA(At, 1, 1); PG8_STAGE(PG8_SB(1, 0), b3, voffB); PG8_STAGE(PG8_SB(1, 1), b3 + hstepB, voffB); PG8_STAGE(PG8_SA(1, 0), a3, voffA);
            PG8_WAIT_V(8); PG8_WAIT_L(0); PG8_BAR; PG8_MMA(1, 0, At, B0); PG8_MMA(1, 1, At, B1); PG8_BAR; PG8_SCHED;
        }
        if constexpr (ALIGN_EPI) { if (wr == 0) PG8_BAR; }
        E(acc, cur, wr, wc, fr, fq);
        if (!has_next) break;
        if (E.reset_after(cur)) {
#pragma unroll
            for (int a = 0; a < 2; ++a)
#pragma unroll
                for (int b = 0; b < 2; ++b)
#pragma unroll
                    for (int m = 0; m < 4; ++m)
#pragma unroll
                        for (int n = 0; n < 2; ++n) acc[a][b][m][n] = (f32x4){0.f, 0.f, 0.f, 0.f};
        }
        cur = nxt; cA = nA; cB = nB; ++ui;
        if constexpr (ALIGN_EPI) { if (wr == 1) PG8_BAR; }
    }
    PG8_WAIT_V(0);
    if constexpr (!ALIGN_EPI) { if (wr == 0) PG8_BAR; }
    PG8_BAR;
#undef PG8_SA
#undef PG8_SB
#undef PG8_STAGE
#undef PG8_LDA
#undef PG8_LDB
#undef PG8_MMA
#undef PG8_WAIT_V
#undef PG8_WAIT_L
#undef PG8_BAR
#undef PG8_SCHED
#undef PG8_UA
#undef PG8_UB
}
}
#ifndef DUP_MASK
#define DUP_MASK 0
#endif
#ifndef SIMPLE_PREP
#define SIMPLE_PREP 0
#endif
#ifndef SIMPLE_SCAN
#define SIMPLE_SCAN 0
#endif
constexpr int NWAVES = 8;
constexpr int RING_OFF = 0, RING_BYTES = 131072;
constexpr int LDSCTL_OFF = RING_BYTES, MISC_OFF = LDSCTL_OFF + 320;
constexpr int XTRA_OFF = RING_BYTES + 1024;
constexpr int LDS_BYTES = 147456;
constexpr int CW_BAR = 4096;

#define GAS __attribute__((address_space(1)))
#define LAS __attribute__((address_space(3)))
typedef unsigned v4u __attribute__((ext_vector_type(4)));
typedef float f32x4 __attribute__((ext_vector_type(4)));
typedef GAS unsigned gu32;
#define LDS_WAIT() asm volatile("s_waitcnt lgkmcnt(0)" ::: "memory")
#define VM_WAIT() asm volatile("s_waitcnt vmcnt(0)" ::: "memory")
__device__ __forceinline__ unsigned pk2(float lo, float hi) { return (unsigned)f2bf(lo) | ((unsigned)f2bf(hi) << 16); }

#define XB_TMO      128
#define XB_XCNT(j)  (256  + 64 * (j))
#define XB_XSUB(j)  (1280 + 64 * (j))
#define XB_XGEN(j)  (2304 + 64 * (j))
#define XB_TOP      3328
#define XB_TOPGEN   3392
#define XCD_BAR_WORDS 3456
#define XB_SPIN_CAP (1u << 18)
__device__ __forceinline__ unsigned xb_ld(unsigned* p)              { return __hip_atomic_load(p, __ATOMIC_RELAXED, __HIP_MEMORY_SCOPE_AGENT); }
__device__ __forceinline__ unsigned xb_add(unsigned* p, unsigned v) { return __hip_atomic_fetch_add(p, v, __ATOMIC_RELAXED, __HIP_MEMORY_SCOPE_AGENT); }
__device__ __forceinline__ unsigned xb_xcc_id() { return (unsigned)__builtin_amdgcn_s_getreg((3 << 11) | 20) & 0xFu; }
#define XB_SPIN(cond, bar) do { unsigned _sp = 0; while (cond) { __builtin_amdgcn_s_sleep(1); \
    if ((++_sp & 255u) == 0u) { if (xb_ld(&(bar)[XB_TMO])) break; if (_sp > XB_SPIN_CAP) { atomicAdd(&(bar)[XB_TMO], 1u); break; } } } } while (0)
struct XcdBarrier { unsigned* bar; unsigned x; volatile LAS unsigned* st; };
__device__ __forceinline__ XcdBarrier xcd_barrier_post(unsigned* bar, volatile LAS unsigned* st) {
    XcdBarrier b; b.bar = bar; b.x = xb_xcc_id(); b.st = st;
    if (threadIdx.x == 0) (void)xb_add(&bar[XB_XCNT(b.x)], 1u);
    return b;
}
__device__ __forceinline__ void xcd_barrier_complete(unsigned* bar, unsigned x, unsigned& nloc, unsigned& nx) {
    const unsigned G = gridDim.x * gridDim.y * gridDim.z;
    unsigned sum, cnt, mine, sp = 0u;
    for (;;) {
        sum = 0u; cnt = 0u; mine = 0u;
#pragma unroll
        for (unsigned j = 0; j < 16; ++j) { const unsigned c = xb_ld(&bar[XB_XCNT(j)]); sum += c; cnt += (c > 0u) ? 1u : 0u; mine = (j == x) ? c : mine; }
        if (sum == G) break;
        __builtin_amdgcn_s_sleep(1);
        if ((++sp & 255u) == 0u) { if (xb_ld(&bar[XB_TMO])) break; if (sp > XB_SPIN_CAP) { atomicAdd(&bar[XB_TMO], 1u); break; } }
    }
    nloc = mine > 0u ? mine : 1u; nx = cnt > 0u ? cnt : 1u;
}
__device__ __forceinline__ void xcd_barrier(const XcdBarrier& b) {
    asm volatile("s_waitcnt vmcnt(0)" ::: "memory");
    __syncthreads();
    if (threadIdx.x == 0) {
        unsigned* bar = b.bar;
        __builtin_amdgcn_s_waitcnt(0);
        unsigned nloc = b.st[0], nx = b.st[1];
        if (nloc == 0u) { xcd_barrier_complete(bar, b.x, nloc, nx); b.st[0] = nloc; b.st[1] = nx; }
        const unsigned old = xb_add(&bar[XB_XSUB(b.x)], 1u);
        const unsigned gen = old / nloc;
        if (old + 1u == (gen + 1u) * nloc) {
            __builtin_amdgcn_fence(__ATOMIC_RELEASE, "agent");
            asm volatile("s_waitcnt vmcnt(0)" ::: "memory");
            const unsigned og = xb_add(&bar[XB_TOP], 1u);
            const unsigned tg = og / nx;
            if (og + 1u == (tg + 1u) * nx) xb_add(&bar[XB_TOPGEN], 1u);
            else XB_SPIN(xb_ld(&bar[XB_TOPGEN]) == tg, bar);
            __builtin_amdgcn_fence(__ATOMIC_ACQUIRE, "agent");
            xb_add(&bar[XB_XGEN(b.x)], 1u);
            asm volatile("s_waitcnt vmcnt(0)" ::: "memory");
        } else {
            XB_SPIN(xb_ld(&bar[XB_XGEN(b.x)]) == gen, bar);
            __builtin_amdgcn_fence(__ATOMIC_ACQUIRE, "agent");
            asm volatile("s_waitcnt vmcnt(0)" ::: "memory");
        }
    }
    __syncthreads();
}

struct Args { const float* in[14]; float* out; unsigned char* ws; int ph_lo, ph_hi; };

struct Frame {
    LAS unsigned char* lds; int tid, lane, wave, vcu, G;
};

__device__ __forceinline__ void p0_transpose_item(const float* __restrict__ W, int N, int k0, int n0, bf16_t* __restrict__ WT, int ldt, int dn0, int koff, LAS float* scr, int lane) {
#pragma unroll 8
    for (int i = 0; i < 32; ++i) { const int kk = 2 * i + (lane >> 5); scr[kk * 33 + (lane & 31)] = W[(size_t)(k0 + kk) * N + n0 + (lane & 31)]; }
    LDS_WAIT(); asm volatile("" ::: "memory");
    const int c = lane & 7;
#pragma unroll
    for (int j = 0; j < 4; ++j) { const int n = (lane >> 3) + 8 * j; const LAS float* s = scr + (8 * c) * 33 + n;
        v4u o; o.x = pk2(s[0 * 33], s[1 * 33]); o.y = pk2(s[2 * 33], s[3 * 33]); o.z = pk2(s[4 * 33], s[5 * 33]); o.w = pk2(s[6 * 33], s[7 * 33]);
        *(v4u*)(WT + (size_t)(dn0 + n) * ldt + koff + k0 + 8 * c) = o; }
    LDS_WAIT(); asm volatile("" ::: "memory");
}
__device__ __forceinline__ void p0_prologue(Frame& F, const Args& a) {
    unsigned char* ws = a.ws;
    bf16_t *WinT = (bf16_t*)(ws + WS_WINT), *W2T = (bf16_t*)(ws + WS_W2T), *WoT = (bf16_t*)(ws + WS_WOT), *MixT = (bf16_t*)(ws + WS_MIXT), *XN = (bf16_t*)(ws + WS_XN);
    LAS float* scr = (LAS float*)(F.lds + RING_OFF + F.wave * 16384);
    const int gw = F.vcu * NWAVES + F.wave, NGW = F.G * NWAVES;
    constexpr int I_IN = (DM / 64) * (INC / 32), I_PO = (PW / 64) * (DM / 32), I_DN = (DNW / 64) * (DM / 32), I_WO = (DM / 64) * (DM / 32), I_MX = 4 * (PGD / 64) * (PGD / 32);
    constexpr int NITEMS = I_IN + I_PO + I_DN + I_WO + I_MX;
    for (int it = gw; it < NITEMS; it += NGW) {
        int r = it;
        if (r < I_IN) { const int nblk = INC / 32, kb = r / nblk, nb = r % nblk, n0 = 32 * nb;
            const int dn0 = n0 < C_B ? n0 : (n0 < C_GP ? 14336 + (n0 - C_B) : n0 - 32);
            p0_transpose_item(a.in[3], INC, 64 * kb, n0, WinT, DM, dn0, 0, scr, F.lane); continue; } r -= I_IN;
        if (r < I_PO) { const int nblk = DM / 32, kb = r / nblk, nb = r % nblk; p0_transpose_item(a.in[10], DM, 64 * kb, 32 * nb, W2T, YLD, 32 * nb, 0, scr, F.lane); continue; } r -= I_PO;
        if (r < I_DN) { const int nblk = DM / 32, kb = r / nblk, nb = r % nblk; p0_transpose_item(a.in[11], DM, 64 * kb, 32 * nb, W2T, YLD, 32 * nb, 1024, scr, F.lane); continue; } r -= I_DN;
        if (r < I_WO) { const int nblk = DM / 32, kb = r / nblk, nb = r % nblk; p0_transpose_item(a.in[12], DM, 64 * kb, 32 * nb, WoT, DM, 32 * nb, 0, scr, F.lane); continue; } r -= I_WO;
        { const int g = r / 32, rr = r % 32, kb = rr / 8, nb = rr % 8;
          p0_transpose_item(a.in[7] + (size_t)g * PGD * PGD, PGD, 64 * kb, 32 * nb, MixT + (size_t)g * PGD * PGD, PGD, 32 * nb, 0, scr, F.lane); }
    }
    const float* nw = a.in[2];
    for (int r = gw; r < MPAD + (NPAD1 - INC); r += NGW) {
        if (r >= MROWS) { bf16_t* o = r < MPAD ? XN + (size_t)r * DM : WinT + (size_t)(INC + (r - MPAD)) * DM;
#pragma unroll
            for (int j = 0; j < 4; ++j) *(v4u*)(o + 8 * F.lane + 512 * j) = (v4u){0u, 0u, 0u, 0u};
            continue; }
        const float* src = r < MTOK ? a.in[0] + (size_t)r * DM : a.in[1] + (size_t)(r - MTOK) * DM;
        f32x4 v[8]; float s = 0.f;
#pragma unroll
        for (int j = 0; j < 8; ++j) { v[j] = *(const f32x4*)(src + 4 * F.lane + 256 * j); s += (v[j].x * v[j].x + v[j].y * v[j].y) + (v[j].z * v[j].z + v[j].w * v[j].w); }
        const float rs = rsqrtf(wave_sum(s) * (1.f / DM) + EPS);
        unsigned long long* o8 = (unsigned long long*)(XN + (size_t)r * DM) + F.lane;
#pragma unroll
        for (int j = 0; j < 8; ++j) { const f32x4 w = *(const f32x4*)(nw + 4 * F.lane + 256 * j);
            o8[64 * j] = (unsigned long long)pk2(v[j].x * rs * w.x, v[j].y * rs * w.y) | ((unsigned long long)pk2(v[j].z * rs * w.z, v[j].w * rs * w.w) << 32); }
    }
}

__device__ __forceinline__ void p2_pool(Frame& F, const Args& a) {
    const bf16_t* U = (const bf16_t*)(a.ws + WS_U); bf16_t* PO = (bf16_t*)(a.ws + WS_POOLED);
    const int gt = F.vcu * 512 + F.tid, NT = F.G * 512;
    for (int idx = gt; idx < MTOK * (PW / 8); idx += NT) {
        const int m = idx >> 7, c8 = (idx & 127) * 8, b = m >> 11, t = m & 2047, p = t + NMETA, win = 2 << (c8 >> 8);
        float s[8];
#pragma unroll
        for (int j = 0; j < 8; ++j) s[j] = 0.f;
        for (int w = 0; w < win; ++w) { const int pp = p - w;
            pg8::f32x4 x0, x1; pg8::unpack8(*(const pg8::u32x4*)(U + (size_t)ext_row(b, pp) * 1024 + c8), x0, x1);
#pragma unroll
            for (int j = 0; j < 4; ++j) { s[j] += x0[j]; s[4 + j] += x1[j]; } }
        pg8::f32x4 u0, u1; pg8::unpack8(*(const pg8::u32x4*)(U + (size_t)m * 1024 + c8), u0, u1);
        const float inv = 1.f / (float)win;
        pg8::f32x4 r0, r1;
#pragma unroll
        for (int j = 0; j < 4; ++j) { r0[j] = s[j] * inv - u0[j]; r1[j] = s[4 + j] * inv - u1[j]; }
        *(pg8::u32x4*)(PO + (size_t)m * 1024 + c8) = pg8::pack8(r0, r1);
    }
}
__device__ __forceinline__ void p2_chunk_prep_simple(Frame& F, const Args& a) {
    const bf16_t* QKV = (const bf16_t*)(a.ws + WS_QKV); const float* BA = (const float*)(a.ws + WS_BA);
    const float *conv_w = a.in[4], *A_log = a.in[5], *dt_bias = a.in[6];
    bf16_t *NW = (bf16_t*)(a.ws + WS_CH_NW), *UU = (bf16_t*)(a.ws + WS_CH_U), *QD = (bf16_t*)(a.ws + WS_CH_QD), *KDT = (bf16_t*)(a.ws + WS_CH_KDT), *QK = (bf16_t*)(a.ws + WS_CH_QK);
    float* GL = (float*)(a.ws + WS_CH_GL);
    LAS float* sm = (LAS float*)(F.lds + RING_OFF);
    LAS float *q = sm, *k = q + 8192, *v = k + 8192, *Am = v + 8192, *Tm = Am + 4096;
    LAS float *beta = (LAS float*)(F.lds + XTRA_OFF), *gc = beta + 64;
    const int tid = F.tid, lane = F.lane, wv = F.wave;
    for (int cu = F.vcu; cu < NUNITS; cu += F.G) {
        const int n = cu % NCH, bh = cu / NCH, h = bh % NH, b = bh / NH, p0 = CHUNK * n - PADF;
        for (int idx = tid; idx < 64 * 384; idx += 512) {
            const int i = idx / 384, c3 = idx % 384, which = c3 >> 7, d = c3 & 127, col = which * 2048 + h * HD + d, p = p0 + i;
            float val = 0.f;
            if (p >= 0) { float s = 0.f;
                for (int kk = 0; kk < 4; ++kk) { const int pp = p - 3 + kk; if (pp >= 0) s += conv_w[kk * 6144 + col] * bf2f(QKV[(size_t)ext_row(b, pp) * 6144 + col]); }
                val = siluf_(s); }
            (which == 0 ? q : which == 1 ? k : v)[i * 128 + d] = val;
        }
        if (tid < 64) { const int p = p0 + tid; float be = 0.f, g = 0.f;
            if (p >= 0) { const int r = ext_row(b, p); be = sigmoidf_(BA[(size_t)r * 32 + h]); g = -__expf(A_log[h]) * softplusf_(BA[(size_t)r * 32 + 16 + h] + dt_bias[h]); }
            beta[tid] = be; gc[tid] = g; }
        __syncthreads();
        if (tid == 0) { float s = 0.f; for (int i = 0; i < 64; ++i) { s += gc[i]; gc[i] = s; } }
        for (int r = wv; r < 128; r += 8) {
            LAS float* row = (r < 64 ? q + r * 128 : k + (r - 64) * 128);
            const float a0 = row[lane], a1 = row[lane + 64];
            const float rs = rsqrtf(wave_sum(a0 * a0 + a1 * a1) + EPS) * (r < 64 ? 0.08838834764831845f : 1.f);
            row[lane] = a0 * rs; row[lane + 64] = a1 * rs;
        }
        __syncthreads();
        bf16_t* oQK = QK + (size_t)cu * 4096;
        for (int idx = tid; idx < 4096; idx += 512) {
            const int i = idx >> 6, j = idx & 63; float akk = 0.f, aqk = 0.f;
            if (j <= i) { for (int d = 0; d < 128; ++d) { const float kj = k[j * 128 + d]; akk += k[i * 128 + d] * kj; aqk += q[i * 128 + d] * kj; }
                const float dec = __expf(gc[i] - gc[j]); akk *= beta[i] * dec; aqk *= dec; }
            Am[idx] = j < i ? akk : 0.f; oQK[idx] = f2bf(j <= i ? aqk : 0.f);
        }
        __syncthreads();
        if (tid < 64) { const int c = tid;
            for (int i = 0; i < 64; ++i) { float s = (i == c) ? 1.f : 0.f; for (int j = c; j < i; ++j) s -= Am[i * 64 + j] * Tm[j * 64 + c]; Tm[i * 64 + c] = (i >= c) ? s : 0.f; } }
        __syncthreads();
        bf16_t *oNW = NW + (size_t)cu * 8192, *oU = UU + (size_t)cu * 8192, *oQD = QD + (size_t)cu * 8192, *oKDT = KDT + (size_t)cu * 8192;
        const float gl = gc[63];
        for (int idx = tid; idx < 8192; idx += 512) {
            const int i = idx >> 7, d = idx & 127; float su = 0.f, sw = 0.f;
            for (int j = 0; j <= i; ++j) { const float t = Tm[i * 64 + j] * beta[j]; su += t * v[j * 128 + d]; sw += t * __expf(gc[j]) * k[j * 128 + d]; }
            oU[d * 64 + i] = f2bf(su); oNW[idx] = f2bf(-sw);
            oQD[idx] = f2bf(q[idx] * __expf(gc[i]));
            oKDT[d * 64 + i] = f2bf(k[idx] * __expf(gl - gc[i]));
        }
        if (tid == 0) GL[cu] = __expf(gl);
        __syncthreads();
    }
}

typedef short bf16x8_t __attribute__((ext_vector_type(8)));
typedef unsigned u32x2_t __attribute__((ext_vector_type(2)));
__device__ __forceinline__ u32x2_t pack4bf(f32x4 v) { u32x2_t r; r.x = pg8::cvt_pk_bf16(v[0], v[1]); r.y = pg8::cvt_pk_bf16(v[2], v[3]); return r; }

constexpr int QS_LD = 272, KT_LD = 144, AM_LD = 68;
constexpr int L_QS = 0, L_KS = 17408, L_KT = 34816, L_VT = 53248, L_AM = 71680, L_TM = 89088, L_TB = 106496, L_TW = 115712, L_XS = 124928;
static_assert(L_XS + 3 * 1152 <= RING_BYTES, "chunk-prep LDS map");
__device__ __forceinline__ void p2_chunk_prep_fast(Frame& F, const Args& a) {
    const bf16_t* QKV = (const bf16_t*)(a.ws + WS_QKV); const float* BA = (const float*)(a.ws + WS_BA);
    const float *conv_w = a.in[4], *A_log = a.in[5], *dt_bias = a.in[6];
    bf16_t *NW = (bf16_t*)(a.ws + WS_CH_NW), *UT = (bf16_t*)(a.ws + WS_CH_U), *QD = (bf16_t*)(a.ws + WS_CH_QD), *KDT = (bf16_t*)(a.ws + WS_CH_KDT), *QK = (bf16_t*)(a.ws + WS_CH_QK);
    float* GL = (float*)(a.ws + WS_CH_GL);
    LAS unsigned char* L = F.lds + RING_OFF;
    LAS float *Am = (LAS float*)(L + L_AM), *Tm = (LAS float*)(L + L_TM);
    LAS float *beta = (LAS float*)(F.lds + XTRA_OFF), *gc = beta + 64;
    const int tid = F.tid, lane = F.lane, w = F.wave, fr = lane & 15, fq = lane >> 4;
    for (int cu = F.vcu; cu < NUNITS; cu += F.G) {
        const int n = cu % NCH, bh = cu / NCH, h = bh % NH, b = bh / NH, p0 = CHUNK * n - PADF;
#pragma unroll 1
        for (int it = 0; it < 6; ++it) {
            const int item = tid + 512 * it, which = it >> 1, i = (item >> 4) & 63, d8 = (item & 15) * 8, col = which * 2048 + h * HD + d8, p = p0 + i;
            float v[8];
#pragma unroll
            for (int j = 0; j < 8; ++j) v[j] = 0.f;
            if (p >= 0) {
#pragma unroll
                for (int kk = 0; kk < 4; ++kk) { const int pp = p - 3 + kk;
                    if (pp >= 0) { pg8::f32x4 x0, x1; pg8::unpack8(*(const pg8::u32x4*)(QKV + (size_t)ext_row(b, pp) * 6144 + col), x0, x1);
                        const f32x4 w0 = *(const f32x4*)(conv_w + kk * 6144 + col), w1 = *(const f32x4*)(conv_w + kk * 6144 + col + 4);
#pragma unroll
                        for (int j = 0; j < 4; ++j) { v[j] += w0[j] * x0[j]; v[4 + j] += w1[j] * x1[j]; } } }
#pragma unroll
                for (int j = 0; j < 8; ++j) v[j] = siluf_(v[j]);
            }
            if (which < 2) { float ss = 0.f;
#pragma unroll
                for (int j = 0; j < 8; ++j) ss += v[j] * v[j];
                ss += __shfl_xor(ss, 1); ss += __shfl_xor(ss, 2); ss += __shfl_xor(ss, 4); ss += __shfl_xor(ss, 8);
                const float rs = rsqrtf(ss + EPS) * (which == 0 ? 0.08838834764831845f : 1.f);
#pragma unroll
                for (int j = 0; j < 8; ++j) v[j] *= rs; }
            const pg8::u32x4 pk = pg8::pack8((f32x4){v[0], v[1], v[2], v[3]}, (f32x4){v[4], v[5], v[6], v[7]});
            if (which < 2) *(LAS pg8::u32x4*)(L + (which == 0 ? L_QS : L_KS) + i * QS_LD + d8 * 2) = pk;
            if (which >= 1) { LAS unsigned char* T = L + (which == 1 ? L_KT : L_VT) + i * 2;
                const unsigned pw[4] = {pk.x, pk.y, pk.z, pk.w};
#pragma unroll
                for (int j = 0; j < 4; ++j) { *(LAS bf16_t*)(T + (d8 + 2 * j) * KT_LD) = (bf16_t)(pw[j] & 0xffffu); *(LAS bf16_t*)(T + (d8 + 2 * j + 1) * KT_LD) = (bf16_t)(pw[j] >> 16); } }
        }
        if (w == 7) {
            const int p = p0 + lane; float be = 0.f, g = 0.f;
            if (p >= 0) { const int r = ext_row(b, p); be = sigmoidf_(BA[(size_t)r * 32 + h]); g = -__expf(A_log[h]) * softplusf_(BA[(size_t)r * 32 + 16 + h] + dt_bias[h]); }
#pragma unroll
            for (int o = 1; o < 64; o <<= 1) { const float t = __shfl_up(g, o); if (lane >= o) g += t; }
            beta[lane] = be; gc[lane] = g;
        }
        __syncthreads();
        const float gl = gc[63];
        {
            const int kind = w >> 2, ti = w & 3;
            bf16x8_t af[4];
#pragma unroll
            for (int ks = 0; ks < 4; ++ks) af[ks] = *(const LAS bf16x8_t*)(L + L_KS + (16 * ti + fr) * QS_LD + (32 * ks + 8 * fq) * 2);
            bf16_t* oQK = QK + (size_t)cu * 4096;
#pragma unroll
            for (int tj = 0; tj < 4; ++tj) {
                if (kind == 0) {
                    if (tj > ti) continue;
                    f32x4 acc = (f32x4){0.f, 0.f, 0.f, 0.f};
#pragma unroll
                    for (int ks = 0; ks < 4; ++ks) acc = __builtin_amdgcn_mfma_f32_16x16x32_bf16(af[ks], *(const LAS bf16x8_t*)(L + L_KS + (16 * tj + fr) * QS_LD + (32 * ks + 8 * fq) * 2), acc, 0, 0, 0);
                    const int j = 16 * tj + fr; const float gj = gc[j];
#pragma unroll
                    for (int r = 0; r < 4; ++r) { const int i = 16 * ti + 4 * fq + r; Am[i * AM_LD + j] = j < i ? acc[r] * beta[i] * __expf(gc[i] - gj) : 0.f; }
                } else {
                    const int i = 16 * tj + fr; u32x2_t o = (u32x2_t){0u, 0u};
                    if (tj >= ti) {
                        f32x4 acc = (f32x4){0.f, 0.f, 0.f, 0.f};
#pragma unroll
                        for (int ks = 0; ks < 4; ++ks) acc = __builtin_amdgcn_mfma_f32_16x16x32_bf16(af[ks], *(const LAS bf16x8_t*)(L + L_QS + (16 * tj + fr) * QS_LD + (32 * ks + 8 * fq) * 2), acc, 0, 0, 0);
                        const float gi = gc[i];
#pragma unroll
                        for (int r = 0; r < 4; ++r) { const int j = 16 * ti + 4 * fq + r; acc[r] = j <= i ? acc[r] * __expf(gi - gc[j]) : 0.f; }
                        o = pack4bf(acc);
                    }
                    *(u32x2_t*)(oQK + i * 64 + 16 * ti + 4 * fq) = o;
                }
            }
        }
        __syncthreads();
        if (w == 0) {
            const int ab = fq, c = fr; float t[16];
#pragma unroll
            for (int r = 0; r < 16; ++r) { float s = (r == c) ? 1.f : 0.f;
#pragma unroll
                for (int m4 = 0; m4 < (r + 3) / 4; ++m4) { const f32x4 av = *(const LAS f32x4*)(Am + (16 * ab + r) * AM_LD + 16 * ab + 4 * m4);
#pragma unroll
                    for (int j = 0; j < 4; ++j) if (4 * m4 + j < r) s -= av[j] * t[4 * m4 + j]; }
                t[r] = s; Tm[(16 * ab + r) * AM_LD + 16 * ab + c] = s; }
        } else {
            bf16_t *oQD = QD + (size_t)cu * 8192, *oKDT = KDT + (size_t)cu * 8192;
            for (int idx = tid - 64; idx < 2048; idx += 448) {
                if (idx < 1024) { const int i = idx >> 4, d8 = (idx & 15) * 8; pg8::f32x4 x0, x1; pg8::unpack8(*(const LAS pg8::u32x4*)(L + L_QS + i * QS_LD + d8 * 2), x0, x1);
                    const float e = __expf(gc[i]); *(pg8::u32x4*)(oQD + i * 128 + d8) = pg8::pack8(x0 * e, x1 * e); }
                else { const int id = idx - 1024, d = id >> 3, i8 = (id & 7) * 8; pg8::f32x4 x0, x1; pg8::unpack8(*(const LAS pg8::u32x4*)(L + L_KT + d * KT_LD + i8 * 2), x0, x1);
#pragma unroll
                    for (int j = 0; j < 4; ++j) { x0[j] *= __expf(gl - gc[i8 + j]); x1[j] *= __expf(gl - gc[i8 + 4 + j]); }
                    *(pg8::u32x4*)(oKDT + d * 64 + i8) = pg8::pack8(x0, x1); }
            }
            if (tid == 64) GL[cu] = __expf(gl);
        }
        __syncthreads();
#pragma unroll
        for (int dd = 1; dd < 4; ++dd) {
            if (w < 4 - dd) {
                const int bb = w, ab = w + dd;
                f32x4 acc = (f32x4){0.f, 0.f, 0.f, 0.f};
                for (int c = bb; c < ab; ++c)
#pragma unroll
                    for (int ks = 0; ks < 4; ++ks) acc = __builtin_amdgcn_mfma_f32_16x16x4f32(Am[(16 * ab + fr) * AM_LD + 16 * c + 4 * ks + fq], Tm[(16 * c + 4 * ks + fq) * AM_LD + 16 * bb + fr], acc, 0, 0, 0);
                LAS float* Xs = (LAS float*)(L + L_XS + w * 1152);
#pragma unroll
                for (int r = 0; r < 4; ++r) Xs[(4 * fq + r) * 17 + fr] = acc[r];
                f32x4 acc2 = (f32x4){0.f, 0.f, 0.f, 0.f};
#pragma unroll
                for (int ks = 0; ks < 4; ++ks) acc2 = __builtin_amdgcn_mfma_f32_16x16x4f32(Tm[(16 * ab + fr) * AM_LD + 16 * ab + 4 * ks + fq], Xs[(4 * ks + fq) * 17 + fr], acc2, 0, 0, 0);
#pragma unroll
                for (int r = 0; r < 4; ++r) Tm[(16 * ab + 4 * fq + r) * AM_LD + 16 * bb + fr] = -acc2[r];
            }
            __syncthreads();
        }
        { const int i = tid >> 3, j8 = (tid & 7) * 8; f32x4 t0 = *(const LAS f32x4*)(Tm + i * AM_LD + j8), t1 = *(const LAS f32x4*)(Tm + i * AM_LD + j8 + 4); f32x4 b0, b1, w0, w1;
#pragma unroll
            for (int j = 0; j < 4; ++j) { const int ja = j8 + j, jb = j8 + 4 + j; const float ba = beta[ja], bb = beta[jb];
                b0[j] = ja <= i ? t0[j] * ba : 0.f; b1[j] = jb <= i ? t1[j] * bb : 0.f; w0[j] = b0[j] * __expf(gc[ja]); w1[j] = b1[j] * __expf(gc[jb]); }
            *(LAS pg8::u32x4*)(L + L_TB + i * KT_LD + j8 * 2) = pg8::pack8(b0, b1); *(LAS pg8::u32x4*)(L + L_TW + i * KT_LD + j8 * 2) = pg8::pack8(w0, w1); }
        __syncthreads();
        {
            bf16_t *oU = UT + (size_t)cu * 8192, *oNW = NW + (size_t)cu * 8192;
            bf16x8_t vf[2], kf[2];
#pragma unroll
            for (int ks = 0; ks < 2; ++ks) { vf[ks] = *(const LAS bf16x8_t*)(L + L_VT + (16 * w + fr) * KT_LD + (32 * ks + 8 * fq) * 2); kf[ks] = *(const LAS bf16x8_t*)(L + L_KT + (16 * w + fr) * KT_LD + (32 * ks + 8 * fq) * 2); }
#pragma unroll
            for (int mi = 0; mi < 4; ++mi) {
                f32x4 au = (f32x4){0.f, 0.f, 0.f, 0.f}, aw = (f32x4){0.f, 0.f, 0.f, 0.f};
#pragma unroll
                for (int ks = 0; ks < 2; ++ks) {
                    au = __builtin_amdgcn_mfma_f32_16x16x32_bf16(*(const LAS bf16x8_t*)(L + L_TB + (16 * mi + fr) * KT_LD + (32 * ks + 8 * fq) * 2), vf[ks], au, 0, 0, 0);
                    aw = __builtin_amdgcn_mfma_f32_16x16x32_bf16(kf[ks], *(const LAS bf16x8_t*)(L + L_TW + (16 * mi + fr) * KT_LD + (32 * ks + 8 * fq) * 2), aw, 0, 0, 0);
                }
                *(u32x2_t*)(oU + (16 * w + fr) * 64 + 16 * mi + 4 * fq) = pack4bf(au);
                *(u32x2_t*)(oNW + (16 * mi + fr) * 128 + 16 * w + 4 * fq) = pack4bf(-aw);
            }
        }
        __syncthreads();
    }
}

__device__ __forceinline__ void p3_scan_simple(Frame& F, const Args& a) {
    const bf16_t *NW = (const bf16_t*)(a.ws + WS_CH_NW), *UU = (const bf16_t*)(a.ws + WS_CH_U), *QD = (const bf16_t*)(a.ws + WS_CH_QD), *KDT = (const bf16_t*)(a.ws + WS_CH_KDT), *QK = (const bf16_t*)(a.ws + WS_CH_QK);
    const float* GL = (const float*)(a.ws + WS_CH_GL); bf16_t* O = (bf16_t*)(a.ws + WS_O);
    LAS float* sm = (LAS float*)(F.lds + RING_OFF);
    LAS float *nw = sm, *qd = sm + 8192, *kd = sm + 16384, *vn = sm + 24576;
    const int tid = F.tid, e = (tid >> 6) * 32 + (tid & 31), half = (tid >> 5) & 1, db = 64 * half; const bool act = tid < 256;
    for (int bh = F.vcu; bh < NB * NH; bh += F.G) {
        const int h = bh % NH, b = bh / NH;
        float S[64];
#pragma unroll
        for (int d = 0; d < 64; ++d) S[d] = 0.f;
        for (int n = 0; n < NCH; ++n) {
            const int cu = bh * NCH + n;
            for (int idx = tid; idx < 8192; idx += 512) { nw[idx] = bf2f(NW[(size_t)cu * 8192 + idx]); qd[idx] = bf2f(QD[(size_t)cu * 8192 + idx]);
                const int d = idx >> 6, i = idx & 63; kd[i * 128 + d] = bf2f(KDT[(size_t)cu * 8192 + idx]); }
            __syncthreads();
            const float gl = GL[cu];
            if (act) for (int i = 0; i < 64; ++i) { float s = 0.f;
#pragma unroll
                for (int d = 0; d < 64; ++d) s += nw[i * 128 + db + d] * S[d];
                s += __shfl_xor(s, 32); s += bf2f(UU[(size_t)cu * 8192 + e * 64 + i]);
                if (half == 0) vn[i * 128 + e] = s; }
            __syncthreads();
            if (act) {
                if (n > 0) for (int i = 0; i < 64; ++i) { float s = 0.f;
#pragma unroll
                    for (int d = 0; d < 64; ++d) s += qd[i * 128 + db + d] * S[d];
                    s += __shfl_xor(s, 32);
                    for (int j = 0; j <= i; ++j) s += bf2f(QK[(size_t)cu * 4096 + i * 64 + j]) * vn[j * 128 + e];
                    if (half == 0) O[(size_t)(b * SEQ + 64 * (n - 1) + i) * DNW + h * HD + e] = f2bf(s); }
#pragma unroll
                for (int d = 0; d < 64; ++d) S[d] *= gl;
                for (int i = 0; i < 64; ++i) { const float vi = vn[i * 128 + e];
#pragma unroll
                    for (int d = 0; d < 64; ++d) S[d] += kd[i * 128 + db + d] * vi; }
            }
            __syncthreads();
        }
    }
}


struct ScanOps { bf16x8_t a[4], qk[2], kd[2]; u32x2_t ut[2]; float gl; };
constexpr int ST_LD = 272, VT_LD = 144;
__device__ __forceinline__ void p3_scan_fast(Frame& F, const Args& a) {
    const bf16_t *NW = (const bf16_t*)(a.ws + WS_CH_NW), *UT = (const bf16_t*)(a.ws + WS_CH_U), *QD = (const bf16_t*)(a.ws + WS_CH_QD), *KDT = (const bf16_t*)(a.ws + WS_CH_KDT), *QK = (const bf16_t*)(a.ws + WS_CH_QK);
    const float* GL = (const float*)(a.ws + WS_CH_GL); bf16_t* O = (bf16_t*)(a.ws + WS_O);
    LAS unsigned char* ST = F.lds + RING_OFF; LAS unsigned char* VT = ST + 32 * ST_LD;
    const int w = F.wave, lane = F.lane, fr = lane & 15, fq = lane >> 4, mt = w & 3; const bool vw = w < 4;
    for (int unit = F.vcu; unit < NB * NH * 4; unit += F.G) {
        const int bh = unit >> 2, s = unit & 3, h = bh % NH, b = bh / NH;
        f32x4 accS[2] = {(f32x4){0.f, 0.f, 0.f, 0.f}, (f32x4){0.f, 0.f, 0.f, 0.f}};
        for (int i = F.tid; i < 32 * ST_LD / 4; i += 512) ((LAS unsigned*)ST)[i] = 0u;
        __syncthreads();
        const bf16_t* Asrc = vw ? NW : QD;
#define SCAN_LOAD(ops, n_) do { const size_t cu_ = (size_t)(bh * NCH + (n_)); \
        _Pragma("unroll") for (int ks = 0; ks < 4; ++ks) (ops).a[ks] = *(const bf16x8_t*)(Asrc + cu_ * 8192 + (16 * mt + fr) * 128 + 32 * ks + 8 * fq); \
        _Pragma("unroll") for (int ks = 0; ks < 2; ++ks) (ops).kd[ks] = *(const bf16x8_t*)(KDT + cu_ * 8192 + (16 * w + fr) * 64 + 32 * ks + 8 * fq); \
        if (vw) { _Pragma("unroll") for (int n2 = 0; n2 < 2; ++n2) (ops).ut[n2] = *(const u32x2_t*)(UT + cu_ * 8192 + (32 * s + 16 * n2 + fr) * 64 + 16 * mt + 4 * fq); } \
        else { _Pragma("unroll") for (int ks = 0; ks < 2; ++ks) (ops).qk[ks] = *(const bf16x8_t*)(QK + cu_ * 4096 + (16 * mt + fr) * 64 + 32 * ks + 8 * fq); } \
        (ops).gl = GL[cu_]; } while (0)
#define SCAN_STEP(ops, n_) do { \
        f32x4 acc[2]; \
        if (vw) { _Pragma("unroll") for (int n2 = 0; n2 < 2; ++n2) acc[n2] = (f32x4){__uint_as_float((ops).ut[n2].x << 16), __uint_as_float((ops).ut[n2].x & 0xffff0000u), __uint_as_float((ops).ut[n2].y << 16), __uint_as_float((ops).ut[n2].y & 0xffff0000u)}; } \
        else { acc[0] = (f32x4){0.f, 0.f, 0.f, 0.f}; acc[1] = acc[0]; } \
        _Pragma("unroll") for (int ks = 0; ks < 4; ++ks) _Pragma("unroll") for (int n2 = 0; n2 < 2; ++n2) \
            acc[n2] = __builtin_amdgcn_mfma_f32_16x16x32_bf16((ops).a[ks], *(const LAS bf16x8_t*)(ST + (16 * n2 + fr) * ST_LD + (32 * ks + 8 * fq) * 2), acc[n2], 0, 0, 0); \
        if (vw) { _Pragma("unroll") for (int n2 = 0; n2 < 2; ++n2) *(LAS u32x2_t*)(VT + (16 * n2 + fr) * VT_LD + (16 * mt + 4 * fq) * 2) = pack4bf(acc[n2]); } \
        __syncthreads(); \
        bf16x8_t bV[2][2]; \
        _Pragma("unroll") for (int n2 = 0; n2 < 2; ++n2) _Pragma("unroll") for (int ks = 0; ks < 2; ++ks) bV[n2][ks] = *(const LAS bf16x8_t*)(VT + (16 * n2 + fr) * VT_LD + (32 * ks + 8 * fq) * 2); \
        if (!vw) { _Pragma("unroll") for (int n2 = 0; n2 < 2; ++n2) _Pragma("unroll") for (int ks = 0; ks < 2; ++ks) acc[n2] = __builtin_amdgcn_mfma_f32_16x16x32_bf16((ops).qk[ks], bV[n2][ks], acc[n2], 0, 0, 0); \
            if ((n_) > 0) { bf16_t* op = O + (size_t)(b * SEQ + 64 * ((n_) - 1) + 16 * mt + 4 * fq) * DNW + h * HD + 32 * s + fr; \
                _Pragma("unroll") for (int n2 = 0; n2 < 2; ++n2) _Pragma("unroll") for (int r = 0; r < 4; ++r) op[(size_t)r * DNW + 16 * n2] = f2bf(acc[n2][r]); } } \
        _Pragma("unroll") for (int n2 = 0; n2 < 2; ++n2) { accS[n2] = accS[n2] * (ops).gl; \
            _Pragma("unroll") for (int ks = 0; ks < 2; ++ks) accS[n2] = __builtin_amdgcn_mfma_f32_16x16x32_bf16((ops).kd[ks], bV[n2][ks], accS[n2], 0, 0, 0); \
            *(LAS u32x2_t*)(ST + (16 * n2 + fr) * ST_LD + (16 * w + 4 * fq) * 2) = pack4bf(accS[n2]); } \
        __syncthreads(); } while (0)
        ScanOps opA, opB, opC;
        SCAN_LOAD(opA, 0); SCAN_LOAD(opB, 1);
        for (int n = 0; n < NCH; n += 3) {
            SCAN_LOAD(opC, n + 2); SCAN_STEP(opA, n);
            if (n + 3 < NCH) SCAN_LOAD(opA, n + 3); SCAN_STEP(opB, n + 1);
            if (n + 4 < NCH) SCAN_LOAD(opB, n + 4); SCAN_STEP(opC, n + 2);
        }
#undef SCAN_LOAD
#undef SCAN_STEP
    }
}

__device__ __forceinline__ void p3b_gnorm(Frame& F, const Args& a) {
    const bf16_t *O = (const bf16_t*)(a.ws + WS_O), *SZD = (const bf16_t*)(a.ws + WS_SZD); bf16_t* Y = (bf16_t*)(a.ws + WS_Y); const float* w = a.in[9];
    const int gw = F.vcu * NWAVES + F.wave, NGW = F.G * NWAVES, lane = F.lane;
    const float w0 = w[2 * lane], w1 = w[2 * lane + 1];
    for (int it = gw; it < MTOK * NH; it += NGW) {
        const size_t base = (size_t)(it >> 4) * DNW + (it & 15) * HD + 2 * lane, yb = (size_t)(it >> 4) * YLD + 1024 + (it & 15) * HD + 2 * lane;
        const unsigned ov = *(const unsigned*)(O + base), zv = *(const unsigned*)(SZD + base);
        const float a0 = __uint_as_float(ov << 16), a1 = __uint_as_float(ov & 0xffff0000u);
        const float rs = rsqrtf(wave_sum(a0 * a0 + a1 * a1) * (1.f / HD) + EPS);
        *(unsigned*)(Y + yb) = pk2(a0 * rs * w0 * __uint_as_float(zv << 16), a1 * rs * w1 * __uint_as_float(zv & 0xffff0000u));
    }
}

__device__ __forceinline__ void p6_final(Frame& F, const Args& a) {
    const float* w = a.in[13]; float* out = a.out;
    const int gw = F.vcu * NWAVES + F.wave, NGW = F.G * NWAVES;
    for (int r = gw; r < MTOK; r += NGW) {
        float* row = out + (size_t)r * DM;
        f32x4 v[8]; float s = 0.f;
#pragma unroll
        for (int j = 0; j < 8; ++j) { v[j] = *(const f32x4*)(row + 4 * F.lane + 256 * j); s += (v[j].x * v[j].x + v[j].y * v[j].y) + (v[j].z * v[j].z + v[j].w * v[j].w); }
        const float rs = rsqrtf(wave_sum(s) * (1.f / DM) + EPS);
#pragma unroll
        for (int j = 0; j < 8; ++j) { const f32x4 ww = *(const f32x4*)(w + 4 * F.lane + 256 * j); *(f32x4*)(row + 4 * F.lane + 256 * j) = v[j] * rs * ww; }
    }
}

struct PoolMixOrder {
    int G, c;
    __device__ bool next(int i, pg8::Unit& u) const { const int L = i * G + c; if (L >= 128) return false; u.pm = L >> 2; u.pn = L & 3; u.aoff = (L & 3) * 256; u.boff = 0; u.nt = 4; u.mode = 0; return true; }
};
struct MergeOrder {
    pg8::StaticOrder so;
    __device__ bool next(int i, pg8::Unit& u) const { if (!so.next(i >> 1, u)) return false; if ((i & 1) == 0) { u.nt = 16; u.mode = 0; } else { u.aoff = 1024; u.boff = 1024; u.nt = 32; u.mode = 1; } return true; }
};

constexpr int NPHASE = 8;
__global__ void __launch_bounds__(NWAVES * 64, 2) mega_fwd(Args args) {
    extern __shared__ __attribute__((aligned(16))) unsigned char lds[];
    Frame F;
    F.lds = (LAS unsigned char*)lds;
    F.tid = threadIdx.x; F.lane = F.tid & 63; F.wave = __builtin_amdgcn_readfirstlane(F.tid >> 6);
    F.G = gridDim.x; { const int bx = blockIdx.x; F.vcu = (F.G % 8 == 0) ? (bx % 8) * (F.G / 8) + bx / 8 : bx; }
    unsigned char* ws = args.ws;
    for (int u = F.tid; u < (LDS_BYTES - LDSCTL_OFF) / 4; u += NWAVES * 64) ((LAS unsigned*)(F.lds + LDSCTL_OFF))[u] = 0u;
    __syncthreads();
    const int lo = args.ph_lo, hi = args.ph_hi;
    XcdBarrier bar; bar.bar = (unsigned*)(ws + WS_CTL) + CW_BAR; bar.x = 0; bar.st = nullptr;
    if (hi - lo > 1 || DUP_MASK) bar = xcd_barrier_post((unsigned*)(ws + WS_CTL) + CW_BAR, (volatile LAS unsigned*)(F.lds + MISC_OFF) + 8);
#define DUP(k) ((DUP_MASK >> (k)) & 1)
#define PHASE(k, ...) do { if (lo <= (k) && (k) < hi) { __VA_ARGS__ if (DUP(k)) { xcd_barrier(bar); __VA_ARGS__ } if ((k) + 1 < hi) xcd_barrier(bar); } } while (0)
    PHASE(0, p0_prologue(F, args););
    PHASE(1, {
        pg8::Gemm g{(const bf16_t*)(ws + WS_XN), (const bf16_t*)(ws + WS_WINT), DM, DM}; pg8::StaticOrder S; S.init(MPAD / 256, NPAD1 / 256, DM / 64, F.G, (int)blockIdx.x);
        pg8::EpiProj E{(bf16_t*)(ws + WS_U), (bf16_t*)(ws + WS_SZP), (bf16_t*)(ws + WS_QKV), (bf16_t*)(ws + WS_SZD), (bf16_t*)(ws + WS_GATES), (float*)(ws + WS_BA)};
        pg8::gemm_phase<pg8::EpiProj, pg8::StaticOrder, true>(F.lds + RING_OFF, g, S, E); });
    PHASE(2, p2_pool(F, args); if (SIMPLE_PREP) p2_chunk_prep_simple(F, args); else p2_chunk_prep_fast(F, args););
    PHASE(3, if (SIMPLE_SCAN) p3_scan_simple(F, args); else p3_scan_fast(F, args););
    PHASE(4, {
        p3b_gnorm(F, args);
        pg8::Gemm g{(const bf16_t*)(ws + WS_POOLED), (const bf16_t*)(ws + WS_MIXT), PW, PGD}; PoolMixOrder S{F.G, F.vcu};
        pg8::EpiPoolMix E{(bf16_t*)(ws + WS_Y), (const bf16_t*)(ws + WS_SZP), args.in[8]};
        pg8::gemm_phase<pg8::EpiPoolMix, PoolMixOrder, false>(F.lds + RING_OFF, g, S, E); });
    PHASE(5, {
        pg8::Gemm g{(const bf16_t*)(ws + WS_Y), (const bf16_t*)(ws + WS_W2T), YLD, YLD}; MergeOrder S; S.so.init(MTOK / 256, DM / 256, 0, F.G, (int)blockIdx.x);
        pg8::EpiMerge E{(const bf16_t*)(ws + WS_GATES), (bf16_t*)(ws + WS_MERGED)};
        pg8::gemm_phase<pg8::EpiMerge, MergeOrder, false>(F.lds + RING_OFF, g, S, E); });
    PHASE(6, {
        pg8::Gemm g{(const bf16_t*)(ws + WS_MERGED), (const bf16_t*)(ws + WS_WOT), DM, DM}; pg8::StaticOrder S; S.init(MTOK / 256, DM / 256, DM / 64, F.G, (int)blockIdx.x);
        pg8::EpiResid E{args.in[0], args.out};
        pg8::gemm_phase<pg8::EpiResid, pg8::StaticOrder, false>(F.lds + RING_OFF, g, S, E); });
    PHASE(7, p6_final(F, args););
#undef PHASE
#undef DUP
}
#ifndef MIX
#define MIX 0
#endif
#ifndef NAIVE_MASK
#define NAIVE_MASK 0
#endif
#ifndef FUSE
#define FUSE 1
#endif
extern "C" void kernel_launch(void* const* d_in, const int* in_sizes, int n_in, void* d_out, int out_size, void* d_ws, size_t ws_size, hipStream_t stream) {
    static int grid = 0;
    if (grid == 0) {
        if (n_in != 14 || in_sizes[0] != MTOK * DM || out_size != MTOK * DM || ws_size < WS_END) { fprintf(stderr, "kernel_launch: unexpected shapes / workspace (%zu < %zu); nothing launched\n", ws_size, (size_t)WS_END); grid = -1; return; }
        int dev = 0, cus = 0;
        if (hipGetDevice(&dev) != hipSuccess || hipDeviceGetAttribute(&cus, hipDeviceAttributeMultiprocessorCount, dev) != hipSuccess) { grid = -1; return; }
        if (hipFuncSetAttribute((const void*)mega_fwd, hipFuncAttributeMaxDynamicSharedMemorySize, LDS_BYTES) != hipSuccess) { fprintf(stderr, "kernel_launch: hipFuncSetAttribute failed\n"); grid = -1; return; }
#if MIX
        if (hipFuncSetAttribute((const void*)nv_chunk_prep, hipFuncAttributeMaxDynamicSharedMemorySize, 140 * 1024) != hipSuccess) { grid = -1; return; }
#endif
        (void)hipGetLastError();
        grid = cus;
    }
    if (grid < 0) return;
    if (hipMemsetAsync((char*)d_ws + WS_CTL, 0, CTL_ZERO_BYTES, stream) != hipSuccess) return;
    Args a{};
    for (int i = 0; i < 14; ++i) a.in[i] = (const float*)d_in[i];
    a.out = (float*)d_out; a.ws = (unsigned char*)d_ws;
#if !MIX
    a.ph_lo = 0; a.ph_hi = NPHASE;
    hipLaunchKernelGGL(mega_fwd, dim3(grid), dim3(NWAVES * 64), LDS_BYTES, stream, a);
#else
    const float *x = a.in[0], *meta = a.in[1], *norm_w = a.in[2], *w_in = a.in[3], *conv_w = a.in[4], *A_log = a.in[5], *dt_bias = a.in[6], *pool_mix = a.in[7], *pool_scale = a.in[8],
                *dn_norm_w = a.in[9], *w_pool_out = a.in[10], *w_dn_out = a.in[11], *w_o = a.in[12], *final_norm_w = a.in[13];
    unsigned char* ws = (unsigned char*)d_ws; float* out = (float*)d_out;
    bf16_t *XN = (bf16_t*)(ws + WS_XN), *U = (bf16_t*)(ws + WS_U), *SZP = (bf16_t*)(ws + WS_SZP), *QKV = (bf16_t*)(ws + WS_QKV), *SZD = (bf16_t*)(ws + WS_SZD), *GATES = (bf16_t*)(ws + WS_GATES);
    float* BA = (float*)(ws + WS_BA);
    bf16_t *Y = (bf16_t*)(ws + WS_Y), *PO = (bf16_t*)(ws + WS_POOLED), *O = (bf16_t*)(ws + WS_O), *MG = (bf16_t*)(ws + WS_MERGED);
    bf16_t *cNW = (bf16_t*)(ws + WS_CH_NW), *cU = (bf16_t*)(ws + WS_CH_U), *cQD = (bf16_t*)(ws + WS_CH_QD), *cKDT = (bf16_t*)(ws + WS_CH_KDT), *cQK = (bf16_t*)(ws + WS_CH_QK);
    float* cGL = (float*)(ws + WS_CH_GL);
    int s = 0;
    while (s < NPHASE) {
        if (!((NAIVE_MASK >> s) & 1)) {
            int e = s + 1;
            if (FUSE) while (e < NPHASE && !((NAIVE_MASK >> e) & 1)) ++e;
            a.ph_lo = s; a.ph_hi = e;
            hipLaunchKernelGGL(mega_fwd, dim3(grid), dim3(NWAVES * 64), LDS_BYTES, stream, a);
            s = e; continue;
        }
        switch (s) {
        case 0: nv_prep<<<1024, 256, 0, stream>>>(x, meta, norm_w, XN); break;
        case 1: nv_gemm<EpiProj><<<dim3((INC + 127) / 128, (MROWS + 127) / 128), 256, 0, stream>>>(XN, DM, w_in, INC, MROWS, INC, DM, EpiProj{U, SZP, QKV, SZD, GATES, BA}); break;
        case 2: nv_pool<<<MTOK * PW / 256, 256, 0, stream>>>(U, PO);
                nv_chunk_prep<<<NUNITS, 256, 140 * 1024, stream>>>(QKV, BA, conv_w, A_log, dt_bias, cNW, cU, cQD, cKDT, cQK, cGL); break;
        case 3: nv_chunk_scan<<<NB * NH, 128, 0, stream>>>(cNW, cU, cQD, cKDT, cQK, cGL, O); break;
        case 4: nv_gnorm<<<MTOK * NH / 4, 256, 0, stream>>>(O, SZD, dn_norm_w, Y);
                for (int g = 0; g < 4; ++g)
                    nv_gemm<EpiPool><<<dim3(2, MTOK / 128), 256, 0, stream>>>(PO + g * PGD, PW, pool_mix + (size_t)g * PGD * PGD, PGD, MTOK, PGD, PGD, EpiPool{Y, SZP, pool_scale, g, 0});
                break;
        case 5: nv_gemm<EpiG2a><<<dim3(DM / 128, MTOK / 128), 256, 0, stream>>>(Y, YLD, w_pool_out, DM, MTOK, DM, PW, EpiG2a{out, GATES});
                nv_gemm<EpiG2b><<<dim3(DM / 128, MTOK / 128), 256, 0, stream>>>(Y + 1024, YLD, w_dn_out, DM, MTOK, DM, DNW, EpiG2b{out, GATES, MG}); break;
        case 6: nv_gemm<EpiG3><<<dim3(DM / 128, MTOK / 128), 256, 0, stream>>>(MG, DM, w_o, DM, MTOK, DM, DM, EpiG3{x, out}); break;
        case 7: nv_final<<<MTOK, 256, 0, stream>>>(out, final_norm_w); break;
        }
        ++s;
    }
#endif
}
```

```cpp
#define MIX 0
#include <hip/hip_runtime.h>
#include <cstdint>
#include <cstdio>

typedef unsigned short bf16_t;
__device__ __forceinline__ float bf2f(bf16_t v) { return __uint_as_float(((unsigned)v) << 16); }
__device__ __forceinline__ bf16_t f2bf(float f) { unsigned u = __float_as_uint(f); return (bf16_t)((u + 0x7fffu + ((u >> 16) & 1u)) >> 16); }
__device__ __forceinline__ float sigmoidf_(float x) { return 1.f / (1.f + __expf(-x)); }
__device__ __forceinline__ float siluf_(float x) { return x / (1.f + __expf(-x)); }
__device__ __forceinline__ float softplusf_(float x) { return x > 20.f ? x : log1pf(__expf(x)); }

constexpr int DM = 2048, NB = 4, SEQ = 2048, NMETA = 16, LEXT = SEQ + NMETA;
constexpr int PW = 1024, PGD = 256, NH = 16, HD = 128, DNW = 2048, CHUNK = 64, NCH = 33, PADF = 48;
constexpr int INC = 14368;
constexpr int C_U = 0, C_ZP = 1024, C_Q = 2048, C_ZD = 8192, C_B = 10240, C_GP = 10272;
constexpr int MTOK = NB * SEQ;
constexpr int MROWS = MTOK + NMETA;
constexpr int MPAD = 8448;
constexpr int NPAD1 = 14592;
constexpr int YLD = 3072;
constexpr float EPS = 1e-6f;
constexpr int NUNITS = NB * NH * NCH;

constexpr size_t MiB = 1u << 20;
constexpr size_t WS_CTL = 0, CTL_ZERO_BYTES = 1 * MiB;
constexpr size_t WS_CH = 1 * MiB;
constexpr size_t CH_ARR = (size_t)NUNITS * 8192 * 2;
constexpr size_t WS_CH_NW = WS_CH, WS_CH_U = WS_CH + CH_ARR, WS_CH_QD = WS_CH + 2 * CH_ARR, WS_CH_KDT = WS_CH + 3 * CH_ARR, WS_CH_QK = WS_CH + 4 * CH_ARR;
constexpr size_t WS_CH_GL = WS_CH_QK + (size_t)NUNITS * 4096 * 2;
constexpr size_t WS_WINT = WS_CH;
constexpr size_t WS_XN = WS_CH + 57 * MiB;
constexpr size_t WS_W2T = 150 * MiB;
constexpr size_t WS_WOT = 162 * MiB;
constexpr size_t WS_MIXT = 170 * MiB;
constexpr size_t WS_U = 171 * MiB;
constexpr size_t WS_SZP = WS_U + (size_t)MPAD * 1024 * 2;
constexpr size_t WS_QKV = WS_SZP + (size_t)MPAD * 1024 * 2;
constexpr size_t WS_BA = 303 * MiB;
constexpr size_t WS_O = 204 * MiB, WS_Y = 236 * MiB, WS_MERGED = 204 * MiB;
constexpr size_t WS_SZD = 304 * MiB + 512 * 1024;
constexpr size_t WS_GATES = WS_SZD + (size_t)MPAD * 2048 * 2;
constexpr size_t WS_POOLED = WS_GATES + (size_t)MPAD * 4096 * 2;
constexpr size_t WS_END = WS_POOLED + (size_t)MTOK * 1024 * 2;
static_assert(WS_CH_GL + NUNITS * 4 <= WS_W2T, "chunk arrays");
static_assert(WS_XN + (size_t)MPAD * 2048 * 2 <= WS_W2T, "xn");
static_assert(WS_QKV == 204 * MiB && WS_QKV + (size_t)MPAD * 6144 * 2 <= WS_BA, "qkv");
static_assert(WS_Y + (size_t)MTOK * YLD * 2 <= WS_BA, "y");
static_assert(WS_BA + (size_t)MPAD * 32 * 4 <= WS_SZD, "ba");
static_assert(WS_END <= 449 * MiB, "ws");

__device__ __forceinline__ int ext_row(int b, int p) { return p < NMETA ? MTOK + p : b * SEQ + (p - NMETA); }

__device__ __forceinline__ float wave_sum(float v) {
#pragma unroll
    for (int o = 1; o < 64; o <<= 1) v += __shfl_xor(v, o);
    return v;
}
#if MIX
__global__ void __launch_bounds__(256) nv_prep(const float* __restrict__ x, const float* __restrict__ meta, const float* __restrict__ nw, bf16_t* __restrict__ XN) {
    const int lane = threadIdx.x & 63, gw = (blockIdx.x * 256 + threadIdx.x) >> 6, ngw = gridDim.x * 4;
    for (int r = gw; r < MPAD; r += ngw) {
        bf16_t* o = XN + (size_t)r * DM;
        if (r >= MROWS) { for (int j = lane; j < DM; j += 64) o[j] = 0; continue; }
        const float* src = r < MTOK ? x + (size_t)r * DM : meta + (size_t)(r - MTOK) * DM;
        float v[32]; float s = 0.f;
#pragma unroll
        for (int j = 0; j < 32; ++j) { v[j] = src[lane + 64 * j]; s += v[j] * v[j]; }
        const float rs = rsqrtf(wave_sum(s) * (1.f / DM) + EPS);
#pragma unroll
        for (int j = 0; j < 32; ++j) o[lane + 64 * j] = f2bf(v[j] * rs * nw[lane + 64 * j]);
    }
}

template <class Epi>
__global__ void __launch_bounds__(256) nv_gemm(const bf16_t* __restrict__ A, int lda, const float* __restrict__ W, int ldw, int M, int N, int K, Epi epi) {
    __shared__ __attribute__((aligned(16))) float As[16][132];
    __shared__ __attribute__((aligned(16))) float Bs[16][132];
    const int tid = threadIdx.x, tx = tid & 15, ty = tid >> 4;
    const int m0 = blockIdx.y * 128, n0 = blockIdx.x * 128;
    float acc[8][8];
#pragma unroll
    for (int i = 0; i < 8; ++i)
#pragma unroll
        for (int j = 0; j < 8; ++j) acc[i][j] = 0.f;
    for (int k0 = 0; k0 < K; k0 += 16) {
        {
            const int r = tid >> 1, kc = (tid & 1) * 8, gm = m0 + r;
            uint4 v = make_uint4(0, 0, 0, 0);
            if (gm < M) v = *(const uint4*)(A + (size_t)gm * lda + k0 + kc);
            const unsigned w[4] = {v.x, v.y, v.z, v.w};
#pragma unroll
            for (int j = 0; j < 4; ++j) { As[kc + 2 * j][r] = __uint_as_float(w[j] << 16); As[kc + 2 * j + 1][r] = __uint_as_float(w[j] & 0xffff0000u); }
        }
        {
            const int kk = tid >> 4, nc = (tid & 15) * 8, gn = n0 + nc;
            float4 v0 = make_float4(0, 0, 0, 0), v1 = v0;
            if (gn < N) { const float* p = W + (size_t)(k0 + kk) * ldw + gn; v0 = *(const float4*)p; v1 = *(const float4*)(p + 4); }
            *(float4*)&Bs[kk][nc] = v0; *(float4*)&Bs[kk][nc + 4] = v1;
        }
        __syncthreads();
#pragma unroll
        for (int kk = 0; kk < 16; ++kk) {
            float a[8], b[8];
            *(float4*)&a[0] = *(const float4*)&As[kk][ty * 8]; *(float4*)&a[4] = *(const float4*)&As[kk][ty * 8 + 4];
            *(float4*)&b[0] = *(const float4*)&Bs[kk][tx * 8]; *(float4*)&b[4] = *(const float4*)&Bs[kk][tx * 8 + 4];
#pragma unroll
            for (int i = 0; i < 8; ++i)
#pragma unroll
                for (int j = 0; j < 8; ++j) acc[i][j] += a[i] * b[j];
        }
        __syncthreads();
    }
#pragma unroll
    for (int i = 0; i < 8; ++i)
#pragma unroll
        for (int j = 0; j < 8; ++j) { const int gm = m0 + ty * 8 + i, gn = n0 + tx * 8 + j; if (gm < M && gn < N) epi(gm, gn, acc[i][j]); }
}

struct EpiProj {
    bf16_t *U, *SZP, *QKV, *SZD, *GATES; float* BA;
    __device__ __forceinline__ void operator()(int m, int n, float v) const {
        if (n < C_ZP) U[(size_t)m * 1024 + n] = f2bf(v);
        else if (n < C_Q) SZP[(size_t)m * 1024 + (n - C_ZP)] = f2bf(siluf_(v));
        else if (n < C_ZD) QKV[(size_t)m * 6144 + (n - C_Q)] = f2bf(v);
        else if (n < C_B) SZD[(size_t)m * 2048 + (n - C_ZD)] = f2bf(siluf_(v));
        else if (n < C_GP) BA[(size_t)m * 32 + (n - C_B)] = v;
        else GATES[(size_t)m * 4096 + (n - C_GP)] = f2bf(sigmoidf_(v));
    }
};
struct EpiPool {
    bf16_t* Y; const bf16_t* SZP; const float* scale; int g, pad;
    __device__ __forceinline__ void operator()(int m, int n, float v) const {
        const int c = g * PGD + n; Y[(size_t)m * YLD + c] = f2bf(v * scale[c] * bf2f(SZP[(size_t)m * 1024 + c]));
    }
};
struct EpiG2a { float* T; const bf16_t* GATES; __device__ __forceinline__ void operator()(int m, int n, float v) const { T[(size_t)m * DM + n] = v * bf2f(GATES[(size_t)m * 4096 + n]); } };
struct EpiG2b { const float* T; const bf16_t* GATES; bf16_t* MG; __device__ __forceinline__ void operator()(int m, int n, float v) const { MG[(size_t)m * DM + n] = f2bf(T[(size_t)m * DM + n] + v * bf2f(GATES[(size_t)m * 4096 + 2048 + n])); } };
struct EpiG3 { const float* x; float* out; __device__ __forceinline__ void operator()(int m, int n, float v) const { out[(size_t)m * DM + n] = x[(size_t)m * DM + n] + v; } };

__global__ void __launch_bounds__(256) nv_pool(const bf16_t* __restrict__ U, bf16_t* __restrict__ PO) {
    const int idx = blockIdx.x * 256 + threadIdx.x; if (idx >= MTOK * PW) return;
    const int m = idx >> 10, c = idx & 1023, b = m >> 11, t = m & 2047, p = t + NMETA, win = 2 << (c >> 8);
    float s = 0.f;
    for (int j = 0; j < win; ++j) { const int pp = p - j; if (pp >= 0) s += bf2f(U[(size_t)ext_row(b, pp) * 1024 + c]); }
    const int cnt = (p + 1) < win ? (p + 1) : win;
    PO[idx] = f2bf(s / (float)cnt - bf2f(U[(size_t)m * 1024 + c]));
}

__global__ void __launch_bounds__(256) nv_chunk_prep(const bf16_t* __restrict__ QKV, const float* __restrict__ BA, const float* __restrict__ conv_w, const float* __restrict__ A_log,
                                                     const float* __restrict__ dt_bias, bf16_t* __restrict__ NW, bf16_t* __restrict__ UU, bf16_t* __restrict__ QD, bf16_t* __restrict__ KDT,
                                                     bf16_t* __restrict__ QK, float* __restrict__ GL) {
    extern __shared__ __attribute__((aligned(16))) float sm[];
    float *q = sm, *k = q + 8192, *v = k + 8192, *Am = v + 8192, *Tm = Am + 4096, *beta = Tm + 4096, *gc = beta + 64;
    const int cu = blockIdx.x, n = cu % NCH, bh = cu / NCH, h = bh % NH, b = bh / NH, tid = threadIdx.x, lane = tid & 63, wv = tid >> 6;
    const int p0 = CHUNK * n - PADF;
    for (int idx = tid; idx < 64 * 384; idx += 256) {
        const int i = idx / 384, c3 = idx % 384, which = c3 >> 7, d = c3 & 127, col = which * 2048 + h * HD + d, p = p0 + i;
        float val = 0.f;
        if (p >= 0) { float a = 0.f;
            for (int kk = 0; kk < 4; ++kk) { const int pp = p - 3 + kk; if (pp >= 0) a += conv_w[kk * 6144 + col] * bf2f(QKV[(size_t)ext_row(b, pp) * 6144 + col]); }
            val = siluf_(a); }
        (which == 0 ? q : which == 1 ? k : v)[i * 128 + d] = val;
    }
    if (tid < 64) { const int p = p0 + tid; float be = 0.f, g = 0.f;
        if (p >= 0) { const int r = ext_row(b, p); be = sigmoidf_(BA[(size_t)r * 32 + h]); g = -__expf(A_log[h]) * softplusf_(BA[(size_t)r * 32 + 16 + h] + dt_bias[h]); }
        beta[tid] = be; gc[tid] = g; }
    __syncthreads();
    if (tid == 0) { float s = 0.f; for (int i = 0; i < 64; ++i) { s += gc[i]; gc[i] = s; } }
    for (int r = wv; r < 128; r += 4) {
        float* row = (r < 64 ? q + r * 128 : k + (r - 64) * 128);
        const float a0 = row[lane], a1 = row[lane + 64];
        const float rs = rsqrtf(wave_sum(a0 * a0 + a1 * a1) + EPS) * (r < 64 ? 0.08838834764831845f : 1.f);
        row[lane] = a0 * rs; row[lane + 64] = a1 * rs;
    }
    __syncthreads();
    bf16_t* oQK = QK + (size_t)cu * 4096;
    for (int idx = tid; idx < 4096; idx += 256) {
        const int i = idx >> 6, j = idx & 63; float akk = 0.f, aqk = 0.f;
        if (j <= i) { for (int d = 0; d < 128; ++d) { const float kj = k[j * 128 + d]; akk += k[i * 128 + d] * kj; aqk += q[i * 128 + d] * kj; }
            const float dec = __expf(gc[i] - gc[j]); akk *= beta[i] * dec; aqk *= dec; }
        Am[idx] = j < i ? akk : 0.f; oQK[idx] = f2bf(j <= i ? aqk : 0.f);
    }
    __syncthreads();
    if (tid < 64) { const int c = tid;
        for (int i = 0; i < 64; ++i) { float s = (i == c) ? 1.f : 0.f; for (int j = c; j < i; ++j) s -= Am[i * 64 + j] * Tm[j * 64 + c]; Tm[i * 64 + c] = (i >= c) ? s : 0.f; } }
    __syncthreads();
    bf16_t *oNW = NW + (size_t)cu * 8192, *oU = UU + (size_t)cu * 8192, *oQD = QD + (size_t)cu * 8192, *oKDT = KDT + (size_t)cu * 8192;
    const float gl = gc[63];
    for (int idx = tid; idx < 8192; idx += 256) {
        const int i = idx >> 7, d = idx & 127; float su = 0.f, sw = 0.f;
        for (int j = 0; j <= i; ++j) { const float t = Tm[i * 64 + j] * beta[j]; su += t * v[j * 128 + d]; sw += t * __expf(gc[j]) * k[j * 128 + d]; }
        oU[idx] = f2bf(su); oNW[idx] = f2bf(-sw);
        oQD[idx] = f2bf(q[idx] * __expf(gc[i]));
        oKDT[d * 64 + i] = f2bf(k[idx] * __expf(gl - gc[i]));
    }
    if (tid == 0) GL[cu] = __expf(gl);
}

__global__ void __launch_bounds__(128) nv_chunk_scan(const bf16_t* __restrict__ NW, const bf16_t* __restrict__ UU, const bf16_t* __restrict__ QD, const bf16_t* __restrict__ KDT,
                                                     const bf16_t* __restrict__ QK, const float* __restrict__ GL, bf16_t* __restrict__ O) {
    __shared__ float vn[64][128];
    const int bh = blockIdx.x, h = bh % NH, b = bh / NH, e = threadIdx.x;
    float S[128];
#pragma unroll
    for (int d = 0; d < 128; ++d) S[d] = 0.f;
    for (int n = 0; n < NCH; ++n) {
        const int cu = bh * NCH + n;
        const bf16_t *nw = NW + (size_t)cu * 8192, *uu = UU + (size_t)cu * 8192, *qd = QD + (size_t)cu * 8192, *kdt = KDT + (size_t)cu * 8192, *qk = QK + (size_t)cu * 4096;
        const float gl = GL[cu];
        for (int i = 0; i < 64; ++i) { float a = bf2f(uu[i * 128 + e]);
#pragma unroll
            for (int d = 0; d < 128; ++d) a += bf2f(nw[i * 128 + d]) * S[d];
            vn[i][e] = a; }
        __syncthreads();
        if (n > 0) for (int i = 0; i < 64; ++i) { float a = 0.f;
#pragma unroll
            for (int d = 0; d < 128; ++d) a += bf2f(qd[i * 128 + d]) * S[d];
            for (int j = 0; j <= i; ++j) a += bf2f(qk[i * 64 + j]) * vn[j][e];
            O[(size_t)(b * SEQ + 64 * (n - 1) + i) * DNW + h * HD + e] = f2bf(a); }
#pragma unroll
        for (int d = 0; d < 128; ++d) { float s = S[d] * gl; for (int i = 0; i < 64; ++i) s += bf2f(kdt[d * 64 + i]) * vn[i][e]; S[d] = s; }
        __syncthreads();
    }
}

__global__ void __launch_bounds__(256) nv_gnorm(const bf16_t* __restrict__ O, const bf16_t* __restrict__ SZD, const float* __restrict__ w, bf16_t* __restrict__ Y) {
    const int lane = threadIdx.x & 63, gw = (blockIdx.x * 256 + threadIdx.x) >> 6; if (gw >= MTOK * NH) return;
    const size_t base = (size_t)(gw >> 4) * DNW + (gw & 15) * HD, yb = (size_t)(gw >> 4) * YLD + 1024 + (gw & 15) * HD;
    const float a0 = bf2f(O[base + lane]), a1 = bf2f(O[base + lane + 64]);
    const float rs = rsqrtf(wave_sum(a0 * a0 + a1 * a1) * (1.f / HD) + EPS);
    Y[yb + lane] = f2bf(a0 * rs * w[lane] * bf2f(SZD[base + lane]));
    Y[yb + lane + 64] = f2bf(a1 * rs * w[lane + 64] * bf2f(SZD[base + lane + 64]));
}

__global__ void __launch_bounds__(256) nv_final(float* __restrict__ out, const float* __restrict__ w) {
    __shared__ float red[4];
    float* row = out + (size_t)blockIdx.x * DM; const int tid = threadIdx.x;
    float v[8]; float s = 0.f;
#pragma unroll
    for (int j = 0; j < 8; ++j) { v[j] = row[tid + 256 * j]; s += v[j] * v[j]; }
    s = wave_sum(s); if ((tid & 63) == 0) red[tid >> 6] = s; __syncthreads();
    const float rs = rsqrtf((red[0] + red[1] + red[2] + red[3]) * (1.f / DM) + EPS);
#pragma unroll
    for (int j = 0; j < 8; ++j) row[tid + 256 * j] = v[j] * rs * w[tid + 256 * j];
}

#endif
namespace pg8 {
#define PG8_LAS __attribute__((address_space(3)))
typedef short bf16x8 __attribute__((ext_vector_type(8)));
typedef float f32x4 __attribute__((ext_vector_type(4)));
typedef unsigned u32x4 __attribute__((ext_vector_type(4)));
constexpr int BM = 256, BK = 64, HALF = 128, HTB = HALF * BK * 2  , STAGE_BYTES = 8 * HTB, NXCD = 8, WGM = 8;

__host__ __device__ __forceinline__ int lds_byte(int r, int c) { const int st = (r >> 4) * 2 + (c >> 5), rr = r & 15, cc = c & 31, ob = rr * 64 + cc * 2; return st * 1024 + (ob ^ (((ob >> 9) & 1) << 5)); }
__host__ __device__ __forceinline__ void stage_rc(int b, int& R, int& C) { const int st = b / 1024, sb = b % 1024, swz = sb ^ (((sb >> 9) & 1) << 5); R = (st >> 1) * 16 + swz / 64; C = (st & 1) * 32 + (swz % 64) / 2; }
__host__ __device__ __forceinline__ int perm32(int rho) { const int n = rho >> 4, i = rho & 15; return 8 * (i >> 2) + 4 * n + (i & 3); }

struct Unit { int pm, pn, aoff, boff, nt, mode; };
struct Gemm { const bf16_t* A; const bf16_t* Bt; int lda, ldb; };

struct StaticOrder {
    int nM, nN, nwg, G, c, nt;
    __device__ void init(int nM_, int nN_, int nt_, int G_, int c_) { nM = nM_; nN = nN_; nwg = nM * nN; G = G_; c = c_; nt = nt_; }
    __device__ bool next(int i, Unit& u) const {
        const long L = (long)i * G + c; if (L >= nwg) return false;
        int wgid = (int)L; { const int q = nwg / NXCD, r = nwg % NXCD, xcd = wgid % NXCD, off = wgid / NXCD; wgid = (xcd < r ? xcd * (q + 1) : r * (q + 1) + (xcd - r) * q) + off; }
        const int nig = WGM * nN, gid = wgid / nig, fm = gid * WGM, gsz = (nM - fm) < WGM ? (nM - fm) : WGM;
        u.pm = fm + ((wgid % nig) % gsz); u.pn = (wgid % nig) / gsz; u.aoff = 0; u.boff = 0; u.nt = nt; u.mode = 0; return true;
    }
};

typedef float f32x2_t __attribute__((ext_vector_type(2))); typedef __bf16 bf16x2_t __attribute__((ext_vector_type(2)));
__device__ __forceinline__ unsigned cvt_pk_bf16(float lo, float hi) { f32x2_t v = {lo, hi}; bf16x2_t b = __builtin_convertvector(v, bf16x2_t); return __builtin_bit_cast(unsigned, b); }
__device__ __forceinline__ u32x4 pack8(f32x4 v0, f32x4 v1) { u32x4 w; w.x = cvt_pk_bf16(v0[0], v0[1]); w.y = cvt_pk_bf16(v0[2], v0[3]); w.z = cvt_pk_bf16(v1[0], v1[1]); w.w = cvt_pk_bf16(v1[2], v1[3]); return w; }
__device__ __forceinline__ void unpack8(u32x4 w, f32x4& v0, f32x4& v1) {
    v0 = (f32x4){__uint_as_float(w.x << 16), __uint_as_float(w.x & 0xffff0000u), __uint_as_float(w.y << 16), __uint_as_float(w.y & 0xffff0000u)};
    v1 = (f32x4){__uint_as_float(w.z << 16), __uint_as_float(w.z & 0xffff0000u), __uint_as_float(w.w << 16), __uint_as_float(w.w & 0xffff0000u)};
}
__device__ __forceinline__ float fast_sigmoid(float x) { return __builtin_amdgcn_rcpf(1.f + __builtin_amdgcn_exp2f(-1.4426950408889634f * x)); }

struct EpiProj {
    static constexpr bool PERM = true;
    bf16_t *U, *SZP, *QKV, *SZD, *GATES; float* BA;
    __device__ __forceinline__ bool reset_after(const Unit&) const { return true; }
    __device__ __forceinline__ void operator()(f32x4 (&acc)[2][2][4][2], const Unit& u, int wr, int wc, int fr, int fq) const {
        const int row0 = u.pm * BM + wr * 64 + fr, pn = u.pn;
        if (pn == 56) {
            if (wc == 0) {
#pragma unroll
                for (int ai = 0; ai < 2; ++ai)
#pragma unroll
                    for (int m = 0; m < 4; ++m) { float* rowp = BA + (size_t)(row0 + ai * HALF + m * 16) * 32 + 8 * fq;
                        *(f32x4*)rowp = acc[ai][0][m][0]; *(f32x4*)(rowp + 4) = acc[ai][0][m][1]; }
            }
            return;
        }
        bf16_t* base; int ld, colt, act;
        if (pn < 4) { base = U; ld = 1024; colt = pn * 256; act = 0; }
        else if (pn < 8) { base = SZP; ld = 1024; colt = (pn - 4) * 256; act = 1; }
        else if (pn < 32) { base = QKV; ld = 6144; colt = (pn - 8) * 256; act = 0; }
        else if (pn < 40) { base = SZD; ld = 2048; colt = (pn - 32) * 256; act = 1; }
        else { base = GATES; ld = 4096; colt = (pn - 40) * 256; act = 2; }
        const int col0 = colt + wc * 32 + 8 * fq;
#pragma unroll
        for (int ai = 0; ai < 2; ++ai)
#pragma unroll
            for (int m = 0; m < 4; ++m) { bf16_t* rowp = base + (size_t)(row0 + ai * HALF + m * 16) * ld + col0;
#pragma unroll
                for (int bj = 0; bj < 2; ++bj) { f32x4 v0 = acc[ai][bj][m][0], v1 = acc[ai][bj][m][1];
                    if (act != 0) {
#pragma unroll
                        for (int j = 0; j < 4; ++j) { const float s0 = fast_sigmoid(v0[j]), s1 = fast_sigmoid(v1[j]); v0[j] = act == 1 ? v0[j] * s0 : s0; v1[j] = act == 1 ? v1[j] * s1 : s1; }
                    }
                    *(u32x4*)(rowp + bj * HALF) = pack8(v0, v1); } }
    }
};
struct EpiPoolMix {
    static constexpr bool PERM = true;
    bf16_t* Y; const bf16_t* SZP; const float* scale;
    __device__ __forceinline__ bool reset_after(const Unit&) const { return true; }
    __device__ __forceinline__ void operator()(f32x4 (&acc)[2][2][4][2], const Unit& u, int wr, int wc, int fr, int fq) const {
        const int row0 = u.pm * BM + wr * 64 + fr, col0 = u.pn * BM + wc * 32 + 8 * fq;
#pragma unroll
        for (int bj = 0; bj < 2; ++bj) { const f32x4 s0 = *(const f32x4*)(scale + col0 + bj * HALF), s1 = *(const f32x4*)(scale + col0 + bj * HALF + 4);
#pragma unroll
            for (int ai = 0; ai < 2; ++ai)
#pragma unroll
                for (int m = 0; m < 4; ++m) { const size_t r = (size_t)(row0 + ai * HALF + m * 16);
                    f32x4 z0, z1; unpack8(*(const u32x4*)(SZP + r * 1024 + col0 + bj * HALF), z0, z1);
                    *(u32x4*)(Y + r * YLD + col0 + bj * HALF) = pack8(acc[ai][bj][m][0] * s0 * z0, acc[ai][bj][m][1] * s1 * z1); } }
    }
};
struct EpiMerge {
    static constexpr bool PERM = true;
    const bf16_t* GATES; bf16_t* MG;
    __device__ __forceinline__ bool reset_after(const Unit& u) const { return u.mode != 0; }
    __device__ __forceinline__ void operator()(f32x4 (&acc)[2][2][4][2], const Unit& u, int wr, int wc, int fr, int fq) const {
        const int row0 = u.pm * BM + wr * 64 + fr, col0 = u.pn * BM + wc * 32 + 8 * fq;
#pragma unroll
        for (int ai = 0; ai < 2; ++ai)
#pragma unroll
            for (int m = 0; m < 4; ++m) { const size_t r = (size_t)(row0 + ai * HALF + m * 16);
#pragma unroll
                for (int bj = 0; bj < 2; ++bj) {
                    f32x4 d0, d1; unpack8(*(const u32x4*)(GATES + r * 4096 + 2048 + col0 + bj * HALF), d0, d1);
                    if (u.mode == 0) {
                        f32x4 p0, p1; unpack8(*(const u32x4*)(GATES + r * 4096 + col0 + bj * HALF), p0, p1);
#pragma unroll
                        for (int j = 0; j < 4; ++j) { acc[ai][bj][m][0][j] *= p0[j] / fmaxf(d0[j], 1e-30f); acc[ai][bj][m][1][j] *= p1[j] / fmaxf(d1[j], 1e-30f); }
                    } else {
                        *(u32x4*)(MG + r * DM + col0 + bj * HALF) = pack8(acc[ai][bj][m][0] * d0, acc[ai][bj][m][1] * d1);
                    } } }
    }
};
struct EpiResid {
    static constexpr bool PERM = false;
    const float* x; float* out;
    __device__ __forceinline__ bool reset_after(const Unit&) const { return true; }
    __device__ __forceinline__ void operator()(f32x4 (&acc)[2][2][4][2], const Unit& u, int wr, int wc, int fr, int fq) const {
        const int row0 = u.pm * BM + wr * 64 + fr, col0 = u.pn * BM + wc * 32 + 4 * fq;
#pragma unroll
        for (int ai = 0; ai < 2; ++ai)
#pragma unroll
            for (int m = 0; m < 4; ++m) { const size_t off = (size_t)(row0 + ai * HALF + m * 16) * DM + col0;
#pragma unroll
                for (int bj = 0; bj < 2; ++bj)
#pragma unroll
                    for (int n = 0; n < 2; ++n) *(f32x4*)(out + off + bj * HALF + n * 16) = *(const f32x4*)(x + off + bj * HALF + n * 16) + acc[ai][bj][m][n]; }
    }
};

template <class Epi, class Sched, bool ALIGN_EPI>
__device__ __forceinline__ void gemm_phase(PG8_LAS unsigned char* lds, const Gemm g, const Sched& S, const Epi& E) {
    const int tid = threadIdx.x, wid = __builtin_amdgcn_readfirstlane(tid >> 6), lane = tid & 63, wr = wid >> 2, wc = wid & 3, fr = lane & 15, fq = lane >> 4;
    const int lda = g.lda, ldb = g.ldb;
    unsigned voffA[2], voffB[2];
#pragma unroll
    for (int i = 0; i < 2; ++i) { int R, C; stage_rc(tid * 16 + i * 8192, R, C); const int Rb = Epi::PERM ? ((R & ~31) + perm32(R & 31)) : R;
        voffA[i] = (unsigned)(R * lda + C) * 2u; voffB[i] = (unsigned)(Rb * ldb + C) * 2u; }
    const size_t kstep = (size_t)(BK * 2);
    const size_t hstepA = (size_t)HALF * lda * 2, hstepB = (size_t)HALF * ldb * 2;
    const unsigned ldsw = (unsigned)wid * 1024u;
    const int aoff = lds_byte(wr * 64 + fr, fq * 8), boff = lds_byte(wc * 32 + fr, fq * 8);
#define PG8_SA(b, h) (((b) * 2 + (h)) * HTB)
#define PG8_SB(b, h) ((4 + (b) * 2 + (h)) * HTB)
#define PG8_STAGE(bufoff, gbase, voff) do { _Pragma("unroll") for (int _i = 0; _i < 2; ++_i) \
        __builtin_amdgcn_global_load_lds((const unsigned*)((const char*)(gbase) + (voff)[_i]), (PG8_LAS unsigned*)(lds + (bufoff) + ldsw + _i * 8192), 16, 0, 0); } while (0)
#define PG8_LDA(dst, b, h) do { _Pragma("unroll") for (int m = 0; m < 4; ++m) _Pragma("unroll") for (int k = 0; k < 2; ++k) dst[m][k] = *(const PG8_LAS bf16x8*)(lds + PG8_SA(b, h) + aoff + m * 2048 + k * 1024); } while (0)
#define PG8_LDB(dst, b, h) do { _Pragma("unroll") for (int n = 0; n < 2; ++n) _Pragma("unroll") for (int k = 0; k < 2; ++k) dst[n][k] = *(const PG8_LAS bf16x8*)(lds + PG8_SB(b, h) + boff + n * 2048 + k * 1024); } while (0)
#define PG8_MMA(ai, bj, At, Bt) do { __builtin_amdgcn_s_setprio(1); _Pragma("unroll") for (int m = 0; m < 4; ++m) _Pragma("unroll") for (int n = 0; n < 2; ++n) _Pragma("unroll") for (int k = 0; k < 2; ++k) \
        acc[ai][bj][m][n] = __builtin_amdgcn_mfma_f32_16x16x32_bf16(Bt[n][k], At[m][k], acc[ai][bj][m][n], 0, 0, 0); __builtin_amdgcn_s_setprio(0); } while (0)
#define PG8_WAIT_V(n) asm volatile("s_waitcnt vmcnt(" #n ")" ::: "memory")
#define PG8_WAIT_L(n) asm volatile("s_waitcnt lgkmcnt(" #n ")" ::: "memory")
#define PG8_BAR __builtin_amdgcn_s_barrier()
#define PG8_SCHED __builtin_amdgcn_sched_barrier(0)
#define PG8_UA(u) ((const char*)g.A + ((size_t)(u).pm * BM * lda + (u).aoff) * 2)
#define PG8_UB(u) ((const char*)g.Bt + ((size_t)(u).pn * BM * ldb + (u).boff) * 2)
    Unit cur, nxt; int ui = 0;
    if (!S.next(0, cur)) return;
    f32x4 acc[2][2][4][2];
#pragma unroll
    for (int a = 0; a < 2; ++a)
#pragma unroll
        for (int b = 0; b < 2; ++b)
#pragma unroll
            for (int m = 0; m < 4; ++m)
#pragma unroll
                for (int n = 0; n < 2; ++n) acc[a][b][m][n] = (f32x4){0.f, 0.f, 0.f, 0.f};
    bf16x8 At[4][2], B0[2][2], B1[2][2];
    const char* cA = PG8_UA(cur); const char* cB = PG8_UB(cur);
    PG8_STAGE(PG8_SB(0, 0), cB, voffB); PG8_STAGE(PG8_SB(0, 1), cB + hstepB, voffB); PG8_STAGE(PG8_SA(0, 0), cA, voffA); PG8_STAGE(PG8_SA(0, 1), cA + hstepA, voffA);
    if (wr == 1) PG8_BAR;
    PG8_WAIT_V(2); PG8_BAR;
    PG8_STAGE(PG8_SB(1, 0), cB + kstep, voffB); PG8_STAGE(PG8_SA(1, 0), cA + kstep, voffA); PG8_STAGE(PG8_SB(1, 1), cB + hstepB + kstep, voffB);
    PG8_WAIT_V(6); PG8_BAR;
    for (;;) {
        const bool has_next = S.next(ui + 1, nxt);
        const char* nA = has_next ? PG8_UA(nxt) : cA; const char* nB = has_next ? PG8_UB(nxt) : cB;
        const int nt = cur.nt;
        for (int t = 0; t < nt; t += 2) {
            const bool last = (t == nt - 2);
            const char* a1 = cA + (size_t)(t + 1) * kstep;
            const char* a2 = last ? nA : cA + (size_t)(t + 2) * kstep; const char* b2 = last ? nB : cB + (size_t)(t + 2) * kstep;
            const char* a3 = a2 + kstep; const char* b3 = b2 + kstep;
            PG8_LDB(B0, 0, 0); PG8_LDB(B1, 0, 1); PG8_SCHED; PG8_LDA(At, 0, 0); PG8_STAGE(PG8_SA(1, 1), a1 + hstepA, voffA);
            PG8_WAIT_V(8); PG8_WAIT_L(0); PG8_BAR; PG8_MMA(0, 0, At, B0); PG8_MMA(0, 1, At, B1); PG8_BAR; PG8_SCHED;
            PG8_LDA(At, 0, 1); PG8_STAGE(PG8_SB(0, 0), b2, voffB); PG8_STAGE(PG8_SB(0, 1), b2 + hstepB, voffB); PG8_STAGE(PG8_SA(0, 0), a2, voffA);
            PG8_WAIT_V(8); PG8_WAIT_L(0); PG8_BAR; PG8_MMA(1, 0, At, B0); PG8_MMA(1, 1, At, B1); PG8_BAR; PG8_SCHED;
            PG8_LDB(B0, 1, 0); PG8_LDB(B1, 1, 1); PG8_SCHED; PG8_LDA(At, 1, 0); PG8_STAGE(PG8_SA(0, 1), a2 + hstepA, voffA);
            PG8_WAIT_V(8); PG8_WAIT_L(0); PG8_BAR; PG8_MMA(0, 0, At, B0); PG8_MMA(0, 1, At, B1); PG8_BAR; PG8_SCHED;
            PG8_LDA(At, 1, 1); PG8_STAGE(PG8_SB(1, 0), b3, voffB); PG8_STAGE(PG8_SB(1, 1), b3 + hstepB, voffB); PG8_STAGE(PG8_SA(1, 0), a3, voffA);
            PG8_WAIT_V(8); PG8_WAIT_L(0); PG8_BAR; PG8_MMA(1, 0, At, B0); PG8_MMA(1, 1, At, B1); PG8_BAR; PG8_SCHED;
        }
        if constexpr (ALIGN_EPI) { if (wr == 0) PG8_BAR; }
        E(acc, cur, wr, wc, fr, fq);
        if (!has_next) break;
        if (E.reset_after(cur)) {
#pragma unroll
            for (int a = 0; a < 2; ++a)
#pragma unroll
                for (int b = 0; b < 2; ++b)
#pragma unroll
                    for (int m = 0; m < 4; ++m)
#pragma unroll
                        for (int n = 0; n < 2; ++n) acc[a][b][m][n] = (f32x4){0.f, 0.f, 0.f, 0.f};
        }
        cur = nxt; cA = nA; cB = nB; ++ui;
        if constexpr (ALIGN_EPI) { if (wr == 1) PG8_BAR; }
    }
    PG8_WAIT_V(0);
    if constexpr (!ALIGN_EPI) { if (wr == 0) PG8_BAR; }
    PG8_BAR;
#undef PG8_SA
#undef PG8_SB
#undef PG8_STAGE
#undef PG8_LDA
#undef PG8_LDB
#undef PG8_MMA
#undef PG8_WAIT_V
#undef PG8_WAIT_L
#undef PG8_BAR
#undef PG8_SCHED
#undef PG8_UA
#undef PG8_UB
}
}
#ifndef DUP_MASK
#define DUP_MASK 0
#endif
#ifndef SIMPLE_PREP
#define SIMPLE_PREP 0
#endif
#ifndef SIMPLE_SCAN
#define SIMPLE_SCAN 0
#endif
constexpr int NWAVES = 8;
constexpr int RING_OFF = 0, RING_BYTES = 131072;
constexpr int LDSCTL_OFF = RING_BYTES, MISC_OFF = LDSCTL_OFF + 320;
constexpr int XTRA_OFF = RING_BYTES + 1024;
constexpr int LDS_BYTES = 147456;
constexpr int CW_BAR = 4096;

#define GAS __attribute__((address_space(1)))
#define LAS __attribute__((address_space(3)))
typedef unsigned v4u __attribute__((ext_vector_type(4)));
typedef float f32x4 __attribute__((ext_vector_type(4)));
typedef GAS unsigned gu32;
#define LDS_WAIT() asm volatile("s_waitcnt lgkmcnt(0)" ::: "memory")
#define VM_WAIT() asm volatile("s_waitcnt vmcnt(0)" ::: "memory")
__device__ __forceinline__ unsigned pk2(float lo, float hi) { return (unsigned)f2bf(lo) | ((unsigned)f2bf(hi) << 16); }

#define XB_TMO      128
#define XB_XCNT(j)  (256  + 64 * (j))
#define XB_XSUB(j)  (1280 + 64 * (j))
#define XB_XGEN(j)  (2304 + 64 * (j))
#define XB_TOP      3328
#define XB_TOPGEN   3392
#define XCD_BAR_WORDS 3456
#define XB_SPIN_CAP (1u << 18)
__device__ __forceinline__ unsigned xb_ld(unsigned* p)              { return __hip_atomic_load(p, __ATOMIC_RELAXED, __HIP_MEMORY_SCOPE_AGENT); }
__device__ __forceinline__ unsigned xb_add(unsigned* p, unsigned v) { return __hip_atomic_fetch_add(p, v, __ATOMIC_RELAXED, __HIP_MEMORY_SCOPE_AGENT); }
__device__ __forceinline__ unsigned xb_xcc_id() { return (unsigned)__builtin_amdgcn_s_getreg((3 << 11) | 20) & 0xFu; }
#define XB_SPIN(cond, bar) do { unsigned _sp = 0; while (cond) { __builtin_amdgcn_s_sleep(1); \
    if ((++_sp & 255u) == 0u) { if (xb_ld(&(bar)[XB_TMO])) break; if (_sp > XB_SPIN_CAP) { atomicAdd(&(bar)[XB_TMO], 1u); break; } } } } while (0)
struct XcdBarrier { unsigned* bar; unsigned x; volatile LAS unsigned* st; };
__device__ __forceinline__ XcdBarrier xcd_barrier_post(unsigned* bar, volatile LAS unsigned* st) {
    XcdBarrier b; b.bar = bar; b.x = xb_xcc_id(); b.st = st;
    if (threadIdx.x == 0) (void)xb_add(&bar[XB_XCNT(b.x)], 1u);
    return b;
}
__device__ __forceinline__ void xcd_barrier_complete(unsigned* bar, unsigned x, unsigned& nloc, unsigned& nx) {
    const unsigned G = gridDim.x * gridDim.y * gridDim.z;
    unsigned sum, cnt, mine, sp = 0u;
    for (;;) {
        sum = 0u; cnt = 0u; mine = 0u;
#pragma unroll
        for (unsigned j = 0; j < 16; ++j) { const unsigned c = xb_ld(&bar[XB_XCNT(j)]); sum += c; cnt += (c > 0u) ? 1u : 0u; mine = (j == x) ? c : mine; }
        if (sum == G) break;
        __builtin_amdgcn_s_sleep(1);
        if ((++sp & 255u) == 0u) { if (xb_ld(&bar[XB_TMO])) break; if (sp > XB_SPIN_CAP) { atomicAdd(&bar[XB_TMO], 1u); break; } }
    }
    nloc = mine > 0u ? mine : 1u; nx = cnt > 0u ? cnt : 1u;
}
__device__ __forceinline__ void xcd_barrier(const XcdBarrier& b) {
    asm volatile("s_waitcnt vmcnt(0)" ::: "memory");
    __syncthreads();
    if (threadIdx.x == 0) {
        unsigned* bar = b.bar;
        __builtin_amdgcn_s_waitcnt(0);
        unsigned nloc = b.st[0], nx = b.st[1];
        if (nloc == 0u) { xcd_barrier_complete(bar, b.x, nloc, nx); b.st[0] = nloc; b.st[1] = nx; }
        const unsigned old = xb_add(&bar[XB_XSUB(b.x)], 1u);
        const unsigned gen = old / nloc;
        if (old + 1u == (gen + 1u) * nloc) {
            __builtin_amdgcn_fence(__ATOMIC_RELEASE, "agent");
            asm volatile("s_waitcnt vmcnt(0)" ::: "memory");
            const unsigned og = xb_add(&bar[XB_TOP], 1u);
            const unsigned tg = og / nx;
            if (og + 1u == (tg + 1u) * nx) xb_add(&bar[XB_TOPGEN], 1u);
            else XB_SPIN(xb_ld(&bar[XB_TOPGEN]) == tg, bar);
            __builtin_amdgcn_fence(__ATOMIC_ACQUIRE, "agent");
            xb_add(&bar[XB_XGEN(b.x)], 1u);
            asm volatile("s_waitcnt vmcnt(0)" ::: "memory");
        } else {
            XB_SPIN(xb_ld(&bar[XB_XGEN(b.x)]) == gen, bar);
            __builtin_amdgcn_fence(__ATOMIC_ACQUIRE, "agent");
            asm volatile("s_waitcnt vmcnt(0)" ::: "memory");
        }
    }
    __syncthreads();
}

struct Args { const float* in[14]; float* out; unsigned char* ws; int ph_lo, ph_hi; };

struct Frame {
    LAS unsigned char* lds; int tid, lane, wave, vcu, G;
};

__device__ __forceinline__ void p0_transpose_item(const float* __restrict__ W, int N, int k0, int n0, bf16_t* __restrict__ WT, int ldt, int dn0, int koff, LAS float* scr, int lane) {
#pragma unroll 8
    for (int i = 0; i < 32; ++i) { const int kk = 2 * i + (lane >> 5); scr[kk * 33 + (lane & 31)] = W[(size_t)(k0 + kk) * N + n0 + (lane & 31)]; }
    LDS_WAIT(); asm volatile("" ::: "memory");
    const int c = lane & 7;
#pragma unroll
    for (int j = 0; j < 4; ++j) { const int n = (lane >> 3) + 8 * j; const LAS float* s = scr + (8 * c) * 33 + n;
        v4u o; o.x = pk2(s[0 * 33], s[1 * 33]); o.y = pk2(s[2 * 33], s[3 * 33]); o.z = pk2(s[4 * 33], s[5 * 33]); o.w = pk2(s[6 * 33], s[7 * 33]);
        *(v4u*)(WT + (size_t)(dn0 + n) * ldt + koff + k0 + 8 * c) = o; }
    LDS_WAIT(); asm volatile("" ::: "memory");
}
__device__ __forceinline__ void p0_prologue(Frame& F, const Args& a) {
    unsigned char* ws = a.ws;
    bf16_t *WinT = (bf16_t*)(ws + WS_WINT), *W2T = (bf16_t*)(ws + WS_W2T), *WoT = (bf16_t*)(ws + WS_WOT), *MixT = (bf16_t*)(ws + WS_MIXT), *XN = (bf16_t*)(ws + WS_XN);
    LAS float* scr = (LAS float*)(F.lds + RING_OFF + F.wave * 16384);
    const int gw = F.vcu * NWAVES + F.wave, NGW = F.G * NWAVES;
    constexpr int I_IN = (DM / 64) * (INC / 32), I_PO = (PW / 64) * (DM / 32), I_DN = (DNW / 64) * (DM / 32), I_WO = (DM / 64) * (DM / 32), I_MX = 4 * (PGD / 64) * (PGD / 32);
    constexpr int NITEMS = I_IN + I_PO + I_DN + I_WO + I_MX;
    for (int it = gw; it < NITEMS; it += NGW) {
        int r = it;
        if (r < I_IN) { const int nblk = INC / 32, kb = r / nblk, nb = r % nblk, n0 = 32 * nb;
            const int dn0 = n0 < C_B ? n0 : (n0 < C_GP ? 14336 + (n0 - C_B) : n0 - 32);
            p0_transpose_item(a.in[3], INC, 64 * kb, n0, WinT, DM, dn0, 0, scr, F.lane); continue; } r -= I_IN;
        if (r < I_PO) { const int nblk = DM / 32, kb = r / nblk, nb = r % nblk; p0_transpose_item(a.in[10], DM, 64 * kb, 32 * nb, W2T, YLD, 32 * nb, 0, scr, F.lane); continue; } r -= I_PO;
        if (r < I_DN) { const int nblk = DM / 32, kb = r / nblk, nb = r % nblk; p0_transpose_item(a.in[11], DM, 64 * kb, 32 * nb, W2T, YLD, 32 * nb, 1024, scr, F.lane); continue; } r -= I_DN;
        if (r < I_WO) { const int nblk = DM / 32, kb = r / nblk, nb = r % nblk; p0_transpose_item(a.in[12], DM, 64 * kb, 32 * nb, WoT, DM, 32 * nb, 0, scr, F.lane); continue; } r -= I_WO;
        { const int g = r / 32, rr = r % 32, kb = rr / 8, nb = rr % 8;
          p0_transpose_item(a.in[7] + (size_t)g * PGD * PGD, PGD, 64 * kb, 32 * nb, MixT + (size_t)g * PGD * PGD, PGD, 32 * nb, 0, scr, F.lane); }
    }
    const float* nw = a.in[2];
    for (int r = gw; r < MPAD + (NPAD1 - INC); r += NGW) {
        if (r >= MROWS) { bf16_t* o = r < MPAD ? XN + (size_t)r * DM : WinT + (size_t)(INC + (r - MPAD)) * DM;
#pragma unroll
            for (int j = 0; j < 4; ++j) *(v4u*)(o + 8 * F.lane + 512 * j) = (v4u){0u, 0u, 0u, 0u};
            continue; }
        const float* src = r < MTOK ? a.in[0] + (size_t)r * DM : a.in[1] + (size_t)(r - MTOK) * DM;
        f32x4 v[8]; float s = 0.f;
#pragma unroll
        for (int j = 0; j < 8; ++j) { v[j] = *(const f32x4*)(src + 4 * F.lane + 256 * j); s += (v[j].x * v[j].x + v[j].y * v[j].y) + (v[j].z * v[j].z + v[j].w * v[j].w); }
        const float rs = rsqrtf(wave_sum(s) * (1.f / DM) + EPS);
        unsigned long long* o8 = (unsigned long long*)(XN + (size_t)r * DM) + F.lane;
#pragma unroll
        for (int j = 0; j < 8; ++j) { const f32x4 w = *(const f32x4*)(nw + 4 * F.lane + 256 * j);
            o8[64 * j] = (unsigned long long)pk2(v[j].x * rs * w.x, v[j].y * rs * w.y) | ((unsigned long long)pk2(v[j].z * rs * w.z, v[j].w * rs * w.w) << 32); }
    }
}

__device__ __forceinline__ void p2_pool(Frame& F, const Args& a) {
    const bf16_t* U = (const bf16_t*)(a.ws + WS_U); bf16_t* PO = (bf16_t*)(a.ws + WS_POOLED);
    const int gt = F.vcu * 512 + F.tid, NT = F.G * 512;
    for (int idx = gt; idx < MTOK * (PW / 8); idx += NT) {
        const int m = idx >> 7, c8 = (idx & 127) * 8, b = m >> 11, t = m & 2047, p = t + NMETA, win = 2 << (c8 >> 8);
        float s[8];
#pragma unroll
        for (int j = 0; j < 8; ++j) s[j] = 0.f;
        for (int w = 0; w < win; ++w) { const int pp = p - w;
            pg8::f32x4 x0, x1; pg8::unpack8(*(const pg8::u32x4*)(U + (size_t)ext_row(b, pp) * 1024 + c8), x0, x1);
#pragma unroll
            for (int j = 0; j < 4; ++j) { s[j] += x0[j]; s[4 + j] += x1[j]; } }
        pg8::f32x4 u0, u1; pg8::unpack8(*(const pg8::u32x4*)(U + (size_t)m * 1024 + c8), u0, u1);
        const float inv = 1.f / (float)win;
        pg8::f32x4 r0, r1;
#pragma unroll
        for (int j = 0; j < 4; ++j) { r0[j] = s[j] * inv - u0[j]; r1[j] = s[4 + j] * inv - u1[j]; }
        *(pg8::u32x4*)(PO + (size_t)m * 1024 + c8) = pg8::pack8(r0, r1);
    }
}
__device__ __forceinline__ void p2_chunk_prep_simple(Frame& F, const Args& a) {
    const bf16_t* QKV = (const bf16_t*)(a.ws + WS_QKV); const float* BA = (const float*)(a.ws + WS_BA);
    const float *conv_w = a.in[4], *A_log = a.in[5], *dt_bias = a.in[6];
    bf16_t *NW = (bf16_t*)(a.ws + WS_CH_NW), *UU = (bf16_t*)(a.ws + WS_CH_U), *QD = (bf16_t*)(a.ws + WS_CH_QD), *KDT = (bf16_t*)(a.ws + WS_CH_KDT), *QK = (bf16_t*)(a.ws + WS_CH_QK);
    float* GL = (float*)(a.ws + WS_CH_GL);
    LAS float* sm = (LAS float*)(F.lds + RING_OFF);
    LAS float *q = sm, *k = q + 8192, *v = k + 8192, *Am = v + 8192, *Tm = Am + 4096;
    LAS float *beta = (LAS float*)(F.lds + XTRA_OFF), *gc = beta + 64;
    const int tid = F.tid, lane = F.lane, wv = F.wave;
    for (int cu = F.vcu; cu < NUNITS; cu += F.G) {
        const int n = cu % NCH, bh = cu / NCH, h = bh % NH, b = bh / NH, p0 = CHUNK * n - PADF;
        for (int idx = tid; idx < 64 * 384; idx += 512) {
            const int i = idx / 384, c3 = idx % 384, which = c3 >> 7, d = c3 & 127, col = which * 2048 + h * HD + d, p = p0 + i;
            float val = 0.f;
            if (p >= 0) { float s = 0.f;
                for (int kk = 0; kk < 4; ++kk) { const int pp = p - 3 + kk; if (pp >= 0) s += conv_w[kk * 6144 + col] * bf2f(QKV[(size_t)ext_row(b, pp) * 6144 + col]); }
                val = siluf_(s); }
            (which == 0 ? q : which == 1 ? k : v)[i * 128 + d] = val;
        }
        if (tid < 64) { const int p = p0 + tid; float be = 0.f, g = 0.f;
            if (p >= 0) { const int r = ext_row(b, p); be = sigmoidf_(BA[(size_t)r * 32 + h]); g = -__expf(A_log[h]) * softplusf_(BA[(size_t)r * 32 + 16 + h] + dt_bias[h]); }
            beta[tid] = be; gc[tid] = g; }
        __syncthreads();
        if (tid == 0) { float s = 0.f; for (int i = 0; i < 64; ++i) { s += gc[i]; gc[i] = s; } }
        for (int r = wv; r < 128; r += 8) {
            LAS float* row = (r < 64 ? q + r * 128 : k + (r - 64) * 128);
            const float a0 = row[lane], a1 = row[lane + 64];
            const float rs = rsqrtf(wave_sum(a0 * a0 + a1 * a1) + EPS) * (r < 64 ? 0.08838834764831845f : 1.f);
            row[lane] = a0 * rs; row[lane + 64] = a1 * rs;
        }
        __syncthreads();
        bf16_t* oQK = QK + (size_t)cu * 4096;
        for (int idx = tid; idx < 4096; idx += 512) {
            const int i = idx >> 6, j = idx & 63; float akk = 0.f, aqk = 0.f;
            if (j <= i) { for (int d = 0; d < 128; ++d) { const float kj = k[j * 128 + d]; akk += k[i * 128 + d] * kj; aqk += q[i * 128 + d] * kj; }
                const float dec = __expf(gc[i] - gc[j]); akk *= beta[i] * dec; aqk *= dec; }
            Am[idx] = j < i ? akk : 0.f; oQK[idx] = f2bf(j <= i ? aqk : 0.f);
        }
        __syncthreads();
        if (tid < 64) { const int c = tid;
            for (int i = 0; i < 64; ++i) { float s = (i == c) ? 1.f : 0.f; for (int j = c; j < i; ++j) s -= Am[i * 64 + j] * Tm[j * 64 + c]; Tm[i * 64 + c] = (i >= c) ? s : 0.f; } }
        __syncthreads();
        bf16_t *oNW = NW + (size_t)cu * 8192, *oU = UU + (size_t)cu * 8192, *oQD = QD + (size_t)cu * 8192, *oKDT = KDT + (size_t)cu * 8192;
        const float gl = gc[63];
        for (int idx = tid; idx < 8192; idx += 512) {
            const int i = idx >> 7, d = idx & 127; float su = 0.f, sw = 0.f;
            for (int j = 0; j <= i; ++j) { const float t = Tm[i * 64 + j] * beta[j]; su += t * v[j * 128 + d]; sw += t * __expf(gc[j]) * k[j * 128 + d]; }
            oU[d * 64 + i] = f2bf(su); oNW[idx] = f2bf(-sw);
            oQD[idx] = f2bf(q[idx] * __expf(gc[i]));
            oKDT[d * 64 + i] = f2bf(k[idx] * __expf(gl - gc[i]));
        }
        if (tid == 0) GL[cu] = __expf(gl);
        __syncthreads();
    }
}

typedef short bf16x8_t __attribute__((ext_vector_type(8)));
typedef unsigned u32x2_t __attribute__((ext_vector_type(2)));
typedef unsigned u32x4_t __attribute__((ext_vector_type(4)));
__device__ __forceinline__ u32x2_t pack4bf(f32x4 v) { u32x2_t r; r.x = pg8::cvt_pk_bf16(v[0], v[1]); r.y = pg8::cvt_pk_bf16(v[2], v[3]); return r; }

constexpr int QS_LD = 272, KT_LD = 144, AM_LD = 68;
constexpr int L_QS = 0, L_KS = 17408, L_KT = 34816, L_VT = 53248, L_AM = 71680, L_TM = 89088, L_TB = 106496, L_TW = 115712, L_XS = 124928;
static_assert(L_XS + 3 * 1152 <= RING_BYTES, "chunk-prep LDS map");
__device__ __forceinline__ void p2_chunk_prep_fast(Frame& F, const Args& a) {
    const bf16_t* QKV = (const bf16_t*)(a.ws + WS_QKV); const float* BA = (const float*)(a.ws + WS_BA);
    const float *conv_w = a.in[4], *A_log = a.in[5], *dt_bias = a.in[6];
    bf16_t *NW = (bf16_t*)(a.ws + WS_CH_NW), *UT = (bf16_t*)(a.ws + WS_CH_U), *QD = (bf16_t*)(a.ws + WS_CH_QD), *KDT = (bf16_t*)(a.ws + WS_CH_KDT), *QK = (bf16_t*)(a.ws + WS_CH_QK);
    float* GL = (float*)(a.ws + WS_CH_GL);
    LAS unsigned char* L = F.lds + RING_OFF;
    LAS float *Am = (LAS float*)(L + L_AM), *Tm = (LAS float*)(L + L_TM);
    LAS float *beta = (LAS float*)(F.lds + XTRA_OFF), *gc = beta + 64;
    const int tid = F.tid, lane = F.lane, w = F.wave, fr = lane & 15, fq = lane >> 4;
    for (int cu = F.vcu; cu < NUNITS; cu += F.G) {
        const int n = cu % NCH, bh = cu / NCH, h = bh % NH, b = bh / NH, p0 = CHUNK * n - PADF;
#pragma unroll 1
        for (int it = 0; it < 6; ++it) {
            const int item = tid + 512 * it, which = it >> 1, i = (item >> 4) & 63, d8 = (item & 15) * 8, col = which * 2048 + h * HD + d8, p = p0 + i;
            float v[8];
#pragma unroll
            for (int j = 0; j < 8; ++j) v[j] = 0.f;
            if (p >= 0) {
#pragma unroll
                for (int kk = 0; kk < 4; ++kk) { const int pp = p - 3 + kk;
                    if (pp >= 0) { pg8::f32x4 x0, x1; pg8::unpack8(*(const pg8::u32x4*)(QKV + (size_t)ext_row(b, pp) * 6144 + col), x0, x1);
                        const f32x4 w0 = *(const f32x4*)(conv_w + kk * 6144 + col), w1 = *(const f32x4*)(conv_w + kk * 6144 + col + 4);
#pragma unroll
                        for (int j = 0; j < 4; ++j) { v[j] += w0[j] * x0[j]; v[4 + j] += w1[j] * x1[j]; } } }
#pragma unroll
                for (int j = 0; j < 8; ++j) v[j] = siluf_(v[j]);
            }
            if (which < 2) { float ss = 0.f;
#pragma unroll
                for (int j = 0; j < 8; ++j) ss += v[j] * v[j];
                ss += __shfl_xor(ss, 1); ss += __shfl_xor(ss, 2); ss += __shfl_xor(ss, 4); ss += __shfl_xor(ss, 8);
                const float rs = rsqrtf(ss + EPS) * (which == 0 ? 0.08838834764831845f : 1.f);
#pragma unroll
                for (int j = 0; j < 8; ++j) v[j] *= rs; }
            const pg8::u32x4 pk = pg8::pack8((f32x4){v[0], v[1], v[2], v[3]}, (f32x4){v[4], v[5], v[6], v[7]});
            if (which < 2) *(LAS pg8::u32x4*)(L + (which == 0 ? L_QS : L_KS) + i * QS_LD + d8 * 2) = pk;
            if (which >= 1) { LAS unsigned char* T = L + (which == 1 ? L_KT : L_VT) + i * 2;
                const unsigned pw[4] = {pk.x, pk.y, pk.z, pk.w};
#pragma unroll
                for (int j = 0; j < 4; ++j) { *(LAS bf16_t*)(T + (d8 + 2 * j) * KT_LD) = (bf16_t)(pw[j] & 0xffffu); *(LAS bf16_t*)(T + (d8 + 2 * j + 1) * KT_LD) = (bf16_t)(pw[j] >> 16); } }
        }
        if (w == 7) {
            const int p = p0 + lane; float be = 0.f, g = 0.f;
            if (p >= 0) { const int r = ext_row(b, p); be = sigmoidf_(BA[(size_t)r * 32 + h]); g = -__expf(A_log[h]) * softplusf_(BA[(size_t)r * 32 + 16 + h] + dt_bias[h]); }
#pragma unroll
            for (int o = 1; o < 64; o <<= 1) { const float t = __shfl_up(g, o); if (lane >= o) g += t; }
            beta[lane] = be; gc[lane] = g;
        }
        __syncthreads();
        const float gl = gc[63];
        {
            const int kind = w >> 2, ti = w & 3;
            bf16x8_t af[4];
#pragma unroll
            for (int ks = 0; ks < 4; ++ks) af[ks] = *(const LAS bf16x8_t*)(L + L_KS + (16 * ti + fr) * QS_LD + (32 * ks + 8 * fq) * 2);
            bf16_t* oQK = QK + (size_t)cu * 4096;
#pragma unroll
            for (int tj = 0; tj < 4; ++tj) {
                if (kind == 0) {
                    if (tj > ti) continue;
                    f32x4 acc = (f32x4){0.f, 0.f, 0.f, 0.f};
#pragma unroll
                    for (int ks = 0; ks < 4; ++ks) acc = __builtin_amdgcn_mfma_f32_16x16x32_bf16(af[ks], *(const LAS bf16x8_t*)(L + L_KS + (16 * tj + fr) * QS_LD + (32 * ks + 8 * fq) * 2), acc, 0, 0, 0);
                    const int j = 16 * tj + fr; const float gj = gc[j];
#pragma unroll
                    for (int r = 0; r < 4; ++r) { const int i = 16 * ti + 4 * fq + r; Am[i * AM_LD + j] = j < i ? acc[r] * beta[i] * __expf(gc[i] - gj) : 0.f; }
                } else {
                    const int i = 16 * tj + fr; u32x2_t o = (u32x2_t){0u, 0u};
                    if (tj >= ti) {
                        f32x4 acc = (f32x4){0.f, 0.f, 0.f, 0.f};
#pragma unroll
                        for (int ks = 0; ks < 4; ++ks) acc = __builtin_amdgcn_mfma_f32_16x16x32_bf16(af[ks], *(const LAS bf16x8_t*)(L + L_QS + (16 * tj + fr) * QS_LD + (32 * ks + 8 * fq) * 2), acc, 0, 0, 0);
                        const float gi = gc[i];
#pragma unroll
                        for (int r = 0; r < 4; ++r) { const int j = 16 * ti + 4 * fq + r; acc[r] = j <= i ? acc[r] * __expf(gi - gc[j]) : 0.f; }
                        o = pack4bf(acc);
                    }
                    *(u32x2_t*)(oQK + i * 64 + 16 * ti + 4 * fq) = o;
                }
            }
        }
        __syncthreads();
        if (w == 0) {
            const int ab = fq, c = fr; float t[16];
#pragma unroll
            for (int r = 0; r < 16; ++r) { float s = (r == c) ? 1.f : 0.f;
#pragma unroll
                for (int m4 = 0; m4 < (r + 3) / 4; ++m4) { const f32x4 av = *(const LAS f32x4*)(Am + (16 * ab + r) * AM_LD + 16 * ab + 4 * m4);
#pragma unroll
                    for (int j = 0; j < 4; ++j) if (4 * m4 + j < r) s -= av[j] * t[4 * m4 + j]; }
                t[r] = s; Tm[(16 * ab + r) * AM_LD + 16 * ab + c] = s; }
        } else {
            bf16_t *oQD = QD + (size_t)cu * 8192, *oKDT = KDT + (size_t)cu * 8192;
            for (int idx = tid - 64; idx < 2048; idx += 448) {
                if (idx < 1024) { const int i = idx >> 4, d8 = (idx & 15) * 8; pg8::f32x4 x0, x1; pg8::unpack8(*(const LAS pg8::u32x4*)(L + L_QS + i * QS_LD + d8 * 2), x0, x1);
                    const float e = __expf(gc[i]); *(pg8::u32x4*)(oQD + i * 128 + d8) = pg8::pack8(x0 * e, x1 * e); }
                else { const int id = idx - 1024, d = id >> 3, i8 = (id & 7) * 8; pg8::f32x4 x0, x1; pg8::unpack8(*(const LAS pg8::u32x4*)(L + L_KT + d * KT_LD + i8 * 2), x0, x1);
#pragma unroll
                    for (int j = 0; j < 4; ++j) { x0[j] *= __expf(gl - gc[i8 + j]); x1[j] *= __expf(gl - gc[i8 + 4 + j]); }
                    *(pg8::u32x4*)(oKDT + d * 64 + i8) = pg8::pack8(x0, x1); }
            }
            if (tid == 64) GL[cu] = __expf(gl);
        }
        __syncthreads();
#pragma unroll
        for (int dd = 1; dd < 4; ++dd) {
            if (w < 4 - dd) {
                const int bb = w, ab = w + dd;
                f32x4 acc = (f32x4){0.f, 0.f, 0.f, 0.f};
                for (int c = bb; c < ab; ++c)
#pragma unroll
                    for (int ks = 0; ks < 4; ++ks) acc = __builtin_amdgcn_mfma_f32_16x16x4f32(Am[(16 * ab + fr) * AM_LD + 16 * c + 4 * ks + fq], Tm[(16 * c + 4 * ks + fq) * AM_LD + 16 * bb + fr], acc, 0, 0, 0);
                LAS float* Xs = (LAS float*)(L + L_XS + w * 1152);
#pragma unroll
                for (int r = 0; r < 4; ++r) Xs[(4 * fq + r) * 17 + fr] = acc[r];
                f32x4 acc2 = (f32x4){0.f, 0.f, 0.f, 0.f};
#pragma unroll
                for (int ks = 0; ks < 4; ++ks) acc2 = __builtin_amdgcn_mfma_f32_16x16x4f32(Tm[(16 * ab + fr) * AM_LD + 16 * ab + 4 * ks + fq], Xs[(4 * ks + fq) * 17 + fr], acc2, 0, 0, 0);
#pragma unroll
                for (int r = 0; r < 4; ++r) Tm[(16 * ab + 4 * fq + r) * AM_LD + 16 * bb + fr] = -acc2[r];
            }
            __syncthreads();
        }
        { const int i = tid >> 3, j8 = (tid & 7) * 8; f32x4 t0 = *(const LAS f32x4*)(Tm + i * AM_LD + j8), t1 = *(const LAS f32x4*)(Tm + i * AM_LD + j8 + 4); f32x4 b0, b1, w0, w1;
#pragma unroll
            for (int j = 0; j < 4; ++j) { const int ja = j8 + j, jb = j8 + 4 + j; const float ba = beta[ja], bb = beta[jb];
                b0[j] = ja <= i ? t0[j] * ba : 0.f; b1[j] = jb <= i ? t1[j] * bb : 0.f; w0[j] = b0[j] * __expf(gc[ja]); w1[j] = b1[j] * __expf(gc[jb]); }
            *(LAS pg8::u32x4*)(L + L_TB + i * KT_LD + j8 * 2) = pg8::pack8(b0, b1); *(LAS pg8::u32x4*)(L + L_TW + i * KT_LD + j8 * 2) = pg8::pack8(w0, w1); }
        __syncthreads();
        {
            bf16_t *oU = UT + (size_t)cu * 8192, *oNW = NW + (size_t)cu * 8192;
            bf16x8_t vf[2], kf[2];
#pragma unroll
            for (int ks = 0; ks < 2; ++ks) { vf[ks] = *(const LAS bf16x8_t*)(L + L_VT + (16 * w + fr) * KT_LD + (32 * ks + 8 * fq) * 2); kf[ks] = *(const LAS bf16x8_t*)(L + L_KT + (16 * w + fr) * KT_LD + (32 * ks + 8 * fq) * 2); }
#pragma unroll
            for (int mi = 0; mi < 4; ++mi) {
                f32x4 au = (f32x4){0.f, 0.f, 0.f, 0.f}, aw = (f32x4){0.f, 0.f, 0.f, 0.f};
#pragma unroll
                for (int ks = 0; ks < 2; ++ks) {
                    au = __builtin_amdgcn_mfma_f32_16x16x32_bf16(*(const LAS bf16x8_t*)(L + L_TB + (16 * mi + fr) * KT_LD + (32 * ks + 8 * fq) * 2), vf[ks], au, 0, 0, 0);
                    aw = __builtin_amdgcn_mfma_f32_16x16x32_bf16(kf[ks], *(const LAS bf16x8_t*)(L + L_TW + (16 * mi + fr) * KT_LD + (32 * ks + 8 * fq) * 2), aw, 0, 0, 0);
                }
                *(u32x2_t*)(oU + (16 * w + fr) * 64 + 16 * mi + 4 * fq) = pack4bf(au);
                *(u32x2_t*)(oNW + (16 * mi + fr) * 128 + 16 * w + 4 * fq) = pack4bf(-aw);
            }
        }
        __syncthreads();
    }
}

__device__ __forceinline__ void p3_scan_simple(Frame& F, const Args& a) {
    const bf16_t *NW = (const bf16_t*)(a.ws + WS_CH_NW), *UU = (const bf16_t*)(a.ws + WS_CH_U), *QD = (const bf16_t*)(a.ws + WS_CH_QD), *KDT = (const bf16_t*)(a.ws + WS_CH_KDT), *QK = (const bf16_t*)(a.ws + WS_CH_QK);
    const float* GL = (const float*)(a.ws + WS_CH_GL); bf16_t* O = (bf16_t*)(a.ws + WS_O);
    LAS float* sm = (LAS float*)(F.lds + RING_OFF);
    LAS float *nw = sm, *qd = sm + 8192, *kd = sm + 16384, *vn = sm + 24576;
    const int tid = F.tid, e = (tid >> 6) * 32 + (tid & 31), half = (tid >> 5) & 1, db = 64 * half; const bool act = tid < 256;
    for (int bh = F.vcu; bh < NB * NH; bh += F.G) {
        const int h = bh % NH, b = bh / NH;
        float S[64];
#pragma unroll
        for (int d = 0; d < 64; ++d) S[d] = 0.f;
        for (int n = 0; n < NCH; ++n) {
            const int cu = bh * NCH + n;
            for (int idx = tid; idx < 8192; idx += 512) { nw[idx] = bf2f(NW[(size_t)cu * 8192 + idx]); qd[idx] = bf2f(QD[(size_t)cu * 8192 + idx]);
                const int d = idx >> 6, i = idx & 63; kd[i * 128 + d] = bf2f(KDT[(size_t)cu * 8192 + idx]); }
            __syncthreads();
            const float gl = GL[cu];
            if (act) for (int i = 0; i < 64; ++i) { float s = 0.f;
#pragma unroll
                for (int d = 0; d < 64; ++d) s += nw[i * 128 + db + d] * S[d];
                s += __shfl_xor(s, 32); s += bf2f(UU[(size_t)cu * 8192 + e * 64 + i]);
                if (half == 0) vn[i * 128 + e] = s; }
            __syncthreads();
            if (act) {
                if (n > 0) for (int i = 0; i < 64; ++i) { float s = 0.f;
#pragma unroll
                    for (int d = 0; d < 64; ++d) s += qd[i * 128 + db + d] * S[d];
                    s += __shfl_xor(s, 32);
                    for (int j = 0; j <= i; ++j) s += bf2f(QK[(size_t)cu * 4096 + i * 64 + j]) * vn[j * 128 + e];
                    if (half == 0) O[(size_t)(b * SEQ + 64 * (n - 1) + i) * DNW + h * HD + e] = f2bf(s); }
#pragma unroll
                for (int d = 0; d < 64; ++d) S[d] *= gl;
                for (int i = 0; i < 64; ++i) { const float vi = vn[i * 128 + e];
#pragma unroll
                    for (int d = 0; d < 64; ++d) S[d] += kd[i * 128 + db + d] * vi; }
            }
            __syncthreads();
        }
    }
}


struct ScanOps { bf16x8_t a[4], x[2], kd[2]; float gl; };
constexpr int ST_LD = 272, VT_LD = 144;
__device__ __forceinline__ void p3_scan_fast(Frame& F, const Args& a) {
    const bf16_t *NW = (const bf16_t*)(a.ws + WS_CH_NW), *UT = (const bf16_t*)(a.ws + WS_CH_U), *QD = (const bf16_t*)(a.ws + WS_CH_QD), *KDT = (const bf16_t*)(a.ws + WS_CH_KDT), *QK = (const bf16_t*)(a.ws + WS_CH_QK);
    const float* GL = (const float*)(a.ws + WS_CH_GL); bf16_t* O = (bf16_t*)(a.ws + WS_O);
    LAS unsigned char* ST = F.lds + RING_OFF; LAS unsigned char* VT = ST + 32 * ST_LD;
    const int w = F.wave, lane = F.lane, fr = lane & 15, fq = lane >> 4, mt = w & 3; const bool vw = w < 4;
    for (int unit = F.vcu; unit < NB * NH * 4; unit += F.G) {
        const int bh = unit >> 2, s = unit & 3, h = bh % NH, b = bh / NH;
        f32x4 accS[2] = {(f32x4){0.f, 0.f, 0.f, 0.f}, (f32x4){0.f, 0.f, 0.f, 0.f}};
        for (int i = F.tid; i < 32 * ST_LD / 4; i += 512) ((LAS unsigned*)ST)[i] = 0u;
        __syncthreads();
        const bf16_t* Asrc = (vw ? NW : QD) + (16 * mt + fr) * 128 + 8 * fq;
        const bf16_t* Ksrc = KDT + (16 * w + fr) * 64 + 8 * fq;
        const bf16_t* Xsrc = vw ? UT + (32 * s + fr) * 64 + 16 * mt + 8 * (fq >> 1) : QK + (16 * mt + fr) * 64 + 8 * fq;
        const size_t xstride = vw ? 8192 : 4096; const int xstep = vw ? 16 * 64 : 32; const bool hiq = (fq & 1) != 0;
#define SCAN_LOAD(ops, n_) do { const size_t cu_ = (size_t)(bh * NCH + (n_)); \
        _Pragma("unroll") for (int ks = 0; ks < 4; ++ks) (ops).a[ks] = *(const bf16x8_t*)(Asrc + cu_ * 8192 + 32 * ks); \
        _Pragma("unroll") for (int ks = 0; ks < 2; ++ks) (ops).kd[ks] = *(const bf16x8_t*)(Ksrc + cu_ * 8192 + 32 * ks); \
        (ops).x[0] = *(const bf16x8_t*)(Xsrc + cu_ * xstride); (ops).x[1] = *(const bf16x8_t*)(Xsrc + cu_ * xstride + xstep); \
        (ops).gl = GL[cu_]; } while (0)
#define SCAN_STEP(ops, n_) do { \
        f32x4 acc[2]; \
        _Pragma("unroll") for (int n2 = 0; n2 < 2; ++n2) { const unsigned u0_ = hiq ? (unsigned)__builtin_bit_cast(u32x4_t, (ops).x[n2]).z : (unsigned)__builtin_bit_cast(u32x4_t, (ops).x[n2]).x, u1_ = hiq ? (unsigned)__builtin_bit_cast(u32x4_t, (ops).x[n2]).w : (unsigned)__builtin_bit_cast(u32x4_t, (ops).x[n2]).y; \
            acc[n2] = vw ? (f32x4){__uint_as_float(u0_ << 16), __uint_as_float(u0_ & 0xffff0000u), __uint_as_float(u1_ << 16), __uint_as_float(u1_ & 0xffff0000u)} : (f32x4){0.f, 0.f, 0.f, 0.f}; } \
        _Pragma("unroll") for (int ks = 0; ks < 4; ++ks) _Pragma("unroll") for (int n2 = 0; n2 < 2; ++n2) \
            acc[n2] = __builtin_amdgcn_mfma_f32_16x16x32_bf16((ops).a[ks], *(const LAS bf16x8_t*)(ST + (16 * n2 + fr) * ST_LD + (32 * ks + 8 * fq) * 2), acc[n2], 0, 0, 0); \
        if (vw) { _Pragma("unroll") for (int n2 = 0; n2 < 2; ++n2) *(LAS u32x2_t*)(VT + (16 * n2 + fr) * VT_LD + (16 * mt + 4 * fq) * 2) = pack4bf(acc[n2]); } \
        __syncthreads(); \
        bf16x8_t bV[2][2]; \
        _Pragma("unroll") for (int n2 = 0; n2 < 2; ++n2) _Pragma("unroll") for (int ks = 0; ks < 2; ++ks) bV[n2][ks] = *(const LAS bf16x8_t*)(VT + (16 * n2 + fr) * VT_LD + (32 * ks + 8 * fq) * 2); \
        if (!vw) { _Pragma("unroll") for (int n2 = 0; n2 < 2; ++n2) _Pragma("unroll") for (int ks = 0; ks < 2; ++ks) acc[n2] = __builtin_amdgcn_mfma_f32_16x16x32_bf16((ops).x[ks], bV[n2][ks], acc[n2], 0, 0, 0); \
            if ((n_) > 0) { bf16_t* op = O + (size_t)(b * SEQ + 64 * ((n_) - 1) + 16 * mt + 4 * fq) * DNW + h * HD + 32 * s + fr; \
                _Pragma("unroll") for (int n2 = 0; n2 < 2; ++n2) _Pragma("unroll") for (int r = 0; r < 4; ++r) op[(size_t)r * DNW + 16 * n2] = f2bf(acc[n2][r]); } } \
        _Pragma("unroll") for (int n2 = 0; n2 < 2; ++n2) { accS[n2] = accS[n2] * (ops).gl; \
            _Pragma("unroll") for (int ks = 0; ks < 2; ++ks) accS[n2] = __builtin_amdgcn_mfma_f32_16x16x32_bf16((ops).kd[ks], bV[n2][ks], accS[n2], 0, 0, 0); \
            *(LAS u32x2_t*)(ST + (16 * n2 + fr) * ST_LD + (16 * w + 4 * fq) * 2) = pack4bf(accS[n2]); } \
        __syncthreads(); } while (0)
        ScanOps opA, opB, opC;
        SCAN_LOAD(opA, 0); SCAN_LOAD(opB, 1);
        for (int n = 0; n < NCH; n += 3) {
            SCAN_LOAD(opC, n + 2); SCAN_STEP(opA, n);
            if (n + 3 < NCH) SCAN_LOAD(opA, n + 3); SCAN_STEP(opB, n + 1);
            if (n + 4 < NCH) SCAN_LOAD(opB, n + 4); SCAN_STEP(opC, n + 2);
        }
#undef SCAN_LOAD
#undef SCAN_STEP
    }
}

__device__ __forceinline__ void p3b_gnorm(Frame& F, const Args& a) {
    const bf16_t *O = (const bf16_t*)(a.ws + WS_O), *SZD = (const bf16_t*)(a.ws + WS_SZD); bf16_t* Y = (bf16_t*)(a.ws + WS_Y); const float* w = a.in[9];
    const int gw = F.vcu * NWAVES + F.wave, NGW = F.G * NWAVES, lane = F.lane;
    const float w0 = w[2 * lane], w1 = w[2 * lane + 1];
    for (int it = gw; it < MTOK * NH; it += NGW) {
        const size_t base = (size_t)(it >> 4) * DNW + (it & 15) * HD + 2 * lane, yb = (size_t)(it >> 4) * YLD + 1024 + (it & 15) * HD + 2 * lane;
        const unsigned ov = *(const unsigned*)(O + base), zv = *(const unsigned*)(SZD + base);
        const float a0 = __uint_as_float(ov << 16), a1 = __uint_as_float(ov & 0xffff0000u);
        const float rs = rsqrtf(wave_sum(a0 * a0 + a1 * a1) * (1.f / HD) + EPS);
        *(unsigned*)(Y + yb) = pk2(a0 * rs * w0 * __uint_as_float(zv << 16), a1 * rs * w1 * __uint_as_float(zv & 0xffff0000u));
    }
}

__device__ __forceinline__ void p6_final(Frame& F, const Args& a) {
    const float* w = a.in[13]; float* out = a.out;
    const int gw = F.vcu * NWAVES + F.wave, NGW = F.G * NWAVES;
    for (int r = gw; r < MTOK; r += NGW) {
        float* row = out + (size_t)r * DM;
        f32x4 v[8]; float s = 0.f;
#pragma unroll
        for (int j = 0; j < 8; ++j) { v[j] = *(const f32x4*)(row + 4 * F.lane + 256 * j); s += (v[j].x * v[j].x + v[j].y * v[j].y) + (v[j].z * v[j].z + v[j].w * v[j].w); }
        const float rs = rsqrtf(wave_sum(s) * (1.f / DM) + EPS);
#pragma unroll
        for (int j = 0; j < 8; ++j) { const f32x4 ww = *(const f32x4*)(w + 4 * F.lane + 256 * j); *(f32x4*)(row + 4 * F.lane + 256 * j) = v[j] * rs * ww; }
    }
}

struct PoolMixOrder {
    int G, c;
    __device__ bool next(int i, pg8::Unit& u) const { const int L = i * G + c; if (L >= 128) return false; u.pm = L >> 2; u.pn = L & 3; u.aoff = (L & 3) * 256; u.boff = 0; u.nt = 4; u.mode = 0; return true; }
};
struct MergeOrder {
    pg8::StaticOrder so;
    __device__ bool next(int i, pg8::Unit& u) const { if (!so.next(i >> 1, u)) return false; if ((i & 1) == 0) { u.nt = 16; u.mode = 0; } else { u.aoff = 1024; u.boff = 1024; u.nt = 32; u.mode = 1; } return true; }
};

constexpr int NPHASE = 8;
__global__ void __launch_bounds__(NWAVES * 64, 2) mega_fwd(Args args) {
    extern __shared__ __attribute__((aligned(16))) unsigned char lds[];
    Frame F;
    F.lds = (LAS unsigned char*)lds;
    F.tid = threadIdx.x; F.lane = F.tid & 63; F.wave = __builtin_amdgcn_readfirstlane(F.tid >> 6);
    F.G = gridDim.x; { const int bx = blockIdx.x; F.vcu = (F.G % 8 == 0) ? (bx % 8) * (F.G / 8) + bx / 8 : bx; }
    unsigned char* ws = args.ws;
    for (int u = F.tid; u < (LDS_BYTES - LDSCTL_OFF) / 4; u += NWAVES * 64) ((LAS unsigned*)(F.lds + LDSCTL_OFF))[u] = 0u;
    __syncthreads();
    const int lo = args.ph_lo, hi = args.ph_hi;
    XcdBarrier bar; bar.bar = (unsigned*)(ws + WS_CTL) + CW_BAR; bar.x = 0; bar.st = nullptr;
    if (hi - lo > 1 || DUP_MASK) bar = xcd_barrier_post((unsigned*)(ws + WS_CTL) + CW_BAR, (volatile LAS unsigned*)(F.lds + MISC_OFF) + 8);
#define DUP(k) ((DUP_MASK >> (k)) & 1)
#define PHASE(k, ...) do { if (lo <= (k) && (k) < hi) { __VA_ARGS__ if (DUP(k)) { xcd_barrier(bar); __VA_ARGS__ } if ((k) + 1 < hi) xcd_barrier(bar); } } while (0)
    PHASE(0, p0_prologue(F, args););
    PHASE(1, {
        pg8::Gemm g{(const bf16_t*)(ws + WS_XN), (const bf16_t*)(ws + WS_WINT), DM, DM}; pg8::StaticOrder S; S.init(MPAD / 256, NPAD1 / 256, DM / 64, F.G, (int)blockIdx.x);
        pg8::EpiProj E{(bf16_t*)(ws + WS_U), (bf16_t*)(ws + WS_SZP), (bf16_t*)(ws + WS_QKV), (bf16_t*)(ws + WS_SZD), (bf16_t*)(ws + WS_GATES), (float*)(ws + WS_BA)};
        pg8::gemm_phase<pg8::EpiProj, pg8::StaticOrder, true>(F.lds + RING_OFF, g, S, E); });
    PHASE(2, p2_pool(F, args); if (SIMPLE_PREP) p2_chunk_prep_simple(F, args); else p2_chunk_prep_fast(F, args););
    PHASE(3, if (SIMPLE_SCAN) p3_scan_simple(F, args); else p3_scan_fast(F, args););
    PHASE(4, {
        p3b_gnorm(F, args);
        pg8::Gemm g{(const bf16_t*)(ws + WS_POOLED), (const bf16_t*)(ws + WS_MIXT), PW, PGD}; PoolMixOrder S{F.G, F.vcu};
        pg8::EpiPoolMix E{(bf16_t*)(ws + WS_Y), (const bf16_t*)(ws + WS_SZP), args.in[8]};
        pg8::gemm_phase<pg8::EpiPoolMix, PoolMixOrder, false>(F.lds + RING_OFF, g, S, E); });
    PHASE(5, {
        pg8::Gemm g{(const bf16_t*)(ws + WS_Y), (const bf16_t*)(ws + WS_W2T), YLD, YLD}; MergeOrder S; S.so.init(MTOK / 256, DM / 256, 0, F.G, (int)blockIdx.x);
        pg8::EpiMerge E{(const bf16_t*)(ws + WS_GATES), (bf16_t*)(ws + WS_MERGED)};
        pg8::gemm_phase<pg8::EpiMerge, MergeOrder, false>(F.lds + RING_OFF, g, S, E); });
    PHASE(6, {
        pg8::Gemm g{(const bf16_t*)(ws + WS_MERGED), (const bf16_t*)(ws + WS_WOT), DM, DM}; pg8::StaticOrder S; S.init(MTOK / 256, DM / 256, DM / 64, F.G, (int)blockIdx.x);
        pg8::EpiResid E{args.in[0], args.out};
        pg8::gemm_phase<pg8::EpiResid, pg8::StaticOrder, false>(F.lds + RING_OFF, g, S, E); });
    PHASE(7, p6_final(F, args););
#undef PHASE
#undef DUP
}
#ifndef MIX
#define MIX 0
#endif
#ifndef NAIVE_MASK
#define NAIVE_MASK 0
#endif
#ifndef FUSE
#define FUSE 1
#endif
extern "C" void kernel_launch(void* const* d_in, const int* in_sizes, int n_in, void* d_out, int out_size, void* d_ws, size_t ws_size, hipStream_t stream) {
    static int grid = 0;
    if (grid == 0) {
        if (n_in != 14 || in_sizes[0] != MTOK * DM || out_size != MTOK * DM || ws_size < WS_END) { fprintf(stderr, "kernel_launch: unexpected shapes / workspace (%zu < %zu); nothing launched\n", ws_size, (size_t)WS_END); grid = -1; return; }
        int dev = 0, cus = 0;
        if (hipGetDevice(&dev) != hipSuccess || hipDeviceGetAttribute(&cus, hipDeviceAttributeMultiprocessorCount, dev) != hipSuccess) { grid = -1; return; }
        if (hipFuncSetAttribute((const void*)mega_fwd, hipFuncAttributeMaxDynamicSharedMemorySize, LDS_BYTES) != hipSuccess) { fprintf(stderr, "kernel_launch: hipFuncSetAttribute failed\n"); grid = -1; return; }
#if MIX
        if (hipFuncSetAttribute((const void*)nv_chunk_prep, hipFuncAttributeMaxDynamicSharedMemorySize, 140 * 1024) != hipSuccess) { grid = -1; return; }
#endif
        (void)hipGetLastError();
        grid = cus;
    }
    if (grid < 0) return;
    if (hipMemsetAsync((char*)d_ws + WS_CTL, 0, CTL_ZERO_BYTES, stream) != hipSuccess) return;
    Args a{};
    for (int i = 0; i < 14; ++i) a.in[i] = (const float*)d_in[i];
    a.out = (float*)d_out; a.ws = (unsigned char*)d_ws;
#if !MIX
    a.ph_lo = 0; a.ph_hi = NPHASE;
    hipLaunchKernelGGL(mega_fwd, dim3(grid), dim3(NWAVES * 64), LDS_BYTES, stream, a);
#else
    const float *x = a.in[0], *meta = a.in[1], *norm_w = a.in[2], *w_in = a.in[3], *conv_w = a.in[4], *A_log = a.in[5], *dt_bias = a.in[6], *pool_mix = a.in[7], *pool_scale = a.in[8],
                *dn_norm_w = a.in[9], *w_pool_out = a.in[10], *w_dn_out = a.in[11], *w_o = a.in[12], *final_norm_w = a.in[13];
    unsigned char* ws = (unsigned char*)d_ws; float* out = (float*)d_out;
    bf16_t *XN = (bf16_t*)(ws + WS_XN), *U = (bf16_t*)(ws + WS_U), *SZP = (bf16_t*)(ws + WS_SZP), *QKV = (bf16_t*)(ws + WS_QKV), *SZD = (bf16_t*)(ws + WS_SZD), *GATES = (bf16_t*)(ws + WS_GATES);
    float* BA = (float*)(ws + WS_BA);
    bf16_t *Y = (bf16_t*)(ws + WS_Y), *PO = (bf16_t*)(ws + WS_POOLED), *O = (bf16_t*)(ws + WS_O), *MG = (bf16_t*)(ws + WS_MERGED);
    bf16_t *cNW = (bf16_t*)(ws + WS_CH_NW), *cU = (bf16_t*)(ws + WS_CH_U), *cQD = (bf16_t*)(ws + WS_CH_QD), *cKDT = (bf16_t*)(ws + WS_CH_KDT), *cQK = (bf16_t*)(ws + WS_CH_QK);
    float* cGL = (float*)(ws + WS_CH_GL);
    int s = 0;
    while (s < NPHASE) {
        if (!((NAIVE_MASK >> s) & 1)) {
            int e = s + 1;
            if (FUSE) while (e < NPHASE && !((NAIVE_MASK >> e) & 1)) ++e;
            a.ph_lo = s; a.ph_hi = e;
            hipLaunchKernelGGL(mega_fwd, dim3(grid), dim3(NWAVES * 64), LDS_BYTES, stream, a);
            s = e; continue;
        }
        switch (s) {
        case 0: nv_prep<<<1024, 256, 0, stream>>>(x, meta, norm_w, XN); break;
        case 1: nv_gemm<EpiProj><<<dim3((INC + 127) / 128, (MROWS + 127) / 128), 256, 0, stream>>>(XN, DM, w_in, INC, MROWS, INC, DM, EpiProj{U, SZP, QKV, SZD, GATES, BA}); break;
        case 2: nv_pool<<<MTOK * PW / 256, 256, 0, stream>>>(U, PO);
                nv_chunk_prep<<<NUNITS, 256, 140 * 1024, stream>>>(QKV, BA, conv_w, A_log, dt_bias, cNW, cU, cQD, cKDT, cQK, cGL); break;
        case 3: nv_chunk_scan<<<NB * NH, 128, 0, stream>>>(cNW, cU, cQD, cKDT, cQK, cGL, O); break;
        case 4: nv_gnorm<<<MTOK * NH / 4, 256, 0, stream>>>(O, SZD, dn_norm_w, Y);
                for (int g = 0; g < 4; ++g)
                    nv_gemm<EpiPool><<<dim3(2, MTOK / 128), 256, 0, stream>>>(PO + g * PGD, PW, pool_mix + (size_t)g * PGD * PGD, PGD, MTOK, PGD, PGD, EpiPool{Y, SZP, pool_scale, g, 0});
                break;
        case 5: nv_gemm<EpiG2a><<<dim3(DM / 128, MTOK / 128), 256, 0, stream>>>(Y, YLD, w_pool_out, DM, MTOK, DM, PW, EpiG2a{out, GATES});
                nv_gemm<EpiG2b><<<dim3(DM / 128, MTOK / 128), 256, 0, stream>>>(Y + 1024, YLD, w_dn_out, DM, MTOK, DM, DNW, EpiG2b{out, GATES, MG}); break;
        case 6: nv_gemm<EpiG3><<<dim3(DM / 128, MTOK / 128), 256, 0, stream>>>(MG, DM, w_o, DM, MTOK, DM, DM, EpiG3{x, out}); break;
        case 7: nv_final<<<MTOK, 256, 0, stream>>>(out, final_norm_w); break;
        }
        ++s;
    }
#endif
}
```

```cpp
#define MIX 0
#include <hip/hip_runtime.h>
#include <cstdint>
#include <cstdio>

typedef unsigned short bf16_t;
__device__ __forceinline__ float bf2f(bf16_t v) { return __uint_as_float(((unsigned)v) << 16); }
__device__ __forceinline__ bf16_t f2bf(float f) { unsigned u = __float_as_uint(f); return (bf16_t)((u + 0x7fffu + ((u >> 16) & 1u)) >> 16); }
__device__ __forceinline__ float sigmoidf_(float x) { return 1.f / (1.f + __expf(-x)); }
__device__ __forceinline__ float siluf_(float x) { return x / (1.f + __expf(-x)); }
__device__ __forceinline__ float softplusf_(float x) { return x > 20.f ? x : log1pf(__expf(x)); }

constexpr int DM = 2048, NB = 4, SEQ = 2048, NMETA = 16, LEXT = SEQ + NMETA;
constexpr int PW = 1024, PGD = 256, NH = 16, HD = 128, DNW = 2048, CHUNK = 64, NCH = 33, PADF = 48;
constexpr int INC = 14368;
constexpr int C_U = 0, C_ZP = 1024, C_Q = 2048, C_ZD = 8192, C_B = 10240, C_GP = 10272;
constexpr int MTOK = NB * SEQ;
constexpr int MROWS = MTOK + NMETA;
constexpr int MPAD = 8448;
constexpr int NPAD1 = 14592;
constexpr int YLD = 3072;
constexpr float EPS = 1e-6f;
constexpr int NUNITS = NB * NH * NCH;

constexpr size_t MiB = 1u << 20;
constexpr size_t WS_CTL = 0, CTL_ZERO_BYTES = 1 * MiB;
constexpr size_t WS_CH = 1 * MiB;
constexpr size_t CH_ARR = (size_t)NUNITS * 8192 * 2;
constexpr size_t WS_CH_NW = WS_CH, WS_CH_U = WS_CH + CH_ARR, WS_CH_QD = WS_CH + 2 * CH_ARR, WS_CH_KDT = WS_CH + 3 * CH_ARR, WS_CH_QK = WS_CH + 4 * CH_ARR;
constexpr size_t WS_CH_GL = WS_CH_QK + (size_t)NUNITS * 4096 * 2;
constexpr size_t WS_WINT = WS_CH;
constexpr size_t WS_XN = WS_CH + 57 * MiB;
constexpr size_t WS_W2T = 150 * MiB;
constexpr size_t WS_WOT = 162 * MiB;
constexpr size_t WS_MIXT = 170 * MiB;
constexpr size_t WS_U = 171 * MiB;
constexpr size_t WS_SZP = WS_U + (size_t)MPAD * 1024 * 2;
constexpr size_t WS_QKV = WS_SZP + (size_t)MPAD * 1024 * 2;
constexpr size_t WS_BA = 303 * MiB;
constexpr size_t WS_O = 204 * MiB, WS_Y = 236 * MiB, WS_MERGED = 204 * MiB;
constexpr size_t WS_SZD = 304 * MiB + 512 * 1024;
constexpr size_t WS_GATES = WS_SZD + (size_t)MPAD * 2048 * 2;
constexpr size_t WS_POOLED = WS_GATES + (size_t)MPAD * 4096 * 2;
constexpr size_t WS_END = WS_POOLED + (size_t)MTOK * 1024 * 2;
static_assert(WS_CH_GL + NUNITS * 4 <= WS_W2T, "chunk arrays");
static_assert(WS_XN + (size_t)MPAD * 2048 * 2 <= WS_W2T, "xn");
static_assert(WS_QKV == 204 * MiB && WS_QKV + (size_t)MPAD * 6144 * 2 <= WS_BA, "qkv");
static_assert(WS_Y + (size_t)MTOK * YLD * 2 <= WS_BA, "y");
static_assert(WS_BA + (size_t)MPAD * 32 * 4 <= WS_SZD, "ba");
static_assert(WS_END <= 449 * MiB, "ws");

__device__ __forceinline__ int ext_row(int b, int p) { return p < NMETA ? MTOK + p : b * SEQ + (p - NMETA); }

__device__ __forceinline__ float wave_sum(float v) {
#pragma unroll
    for (int o = 1; o < 64; o <<= 1) v += __shfl_xor(v, o);
    return v;
}
#if MIX
__global__ void __launch_bounds__(256) nv_prep(const float* __restrict__ x, const float* __restrict__ meta, const float* __restrict__ nw, bf16_t* __restrict__ XN) {
    const int lane = threadIdx.x & 63, gw = (blockIdx.x * 256 + threadIdx.x) >> 6, ngw = gridDim.x * 4;
    for (int r = gw; r < MPAD; r += ngw) {
        bf16_t* o = XN + (size_t)r * DM;
        if (r >= MROWS) { for (int j = lane; j < DM; j += 64) o[j] = 0; continue; }
        const float* src = r < MTOK ? x + (size_t)r * DM : meta + (size_t)(r - MTOK) * DM;
        float v[32]; float s = 0.f;
#pragma unroll
        for (int j = 0; j < 32; ++j) { v[j] = src[lane + 64 * j]; s += v[j] * v[j]; }
        const float rs = rsqrtf(wave_sum(s) * (1.f / DM) + EPS);
#pragma unroll
        for (int j = 0; j < 32; ++j) o[lane + 64 * j] = f2bf(v[j] * rs * nw[lane + 64 * j]);
    }
}

template <class Epi>
__global__ void __launch_bounds__(256) nv_gemm(const bf16_t* __restrict__ A, int lda, const float* __restrict__ W, int ldw, int M, int N, int K, Epi epi) {
    __shared__ __attribute__((aligned(16))) float As[16][132];
    __shared__ __attribute__((aligned(16))) float Bs[16][132];
    const int tid = threadIdx.x, tx = tid & 15, ty = tid >> 4;
    const int m0 = blockIdx.y * 128, n0 = blockIdx.x * 128;
    float acc[8][8];
#pragma unroll
    for (int i = 0; i < 8; ++i)
#pragma unroll
        for (int j = 0; j < 8; ++j) acc[i][j] = 0.f;
    for (int k0 = 0; k0 < K; k0 += 16) {
        {
            const int r = tid >> 1, kc = (tid & 1) * 8, gm = m0 + r;
            uint4 v = make_uint4(0, 0, 0, 0);
            if (gm < M) v = *(const uint4*)(A + (size_t)gm * lda + k0 + kc);
            const unsigned w[4] = {v.x, v.y, v.z, v.w};
#pragma unroll
            for (int j = 0; j < 4; ++j) { As[kc + 2 * j][r] = __uint_as_float(w[j] << 16); As[kc + 2 * j + 1][r] = __uint_as_float(w[j] & 0xffff0000u); }
        }
        {
            const int kk = tid >> 4, nc = (tid & 15) * 8, gn = n0 + nc;
            float4 v0 = make_float4(0, 0, 0, 0), v1 = v0;
            if (gn < N) { const float* p = W + (size_t)(k0 + kk) * ldw + gn; v0 = *(const float4*)p; v1 = *(const float4*)(p + 4); }
            *(float4*)&Bs[kk][nc] = v0; *(float4*)&Bs[kk][nc + 4] = v1;
        }
        __syncthreads();
#pragma unroll
        for (int kk = 0; kk < 16; ++kk) {
            float a[8], b[8];
            *(float4*)&a[0] = *(const float4*)&As[kk][ty * 8]; *(float4*)&a[4] = *(const float4*)&As[kk][ty * 8 + 4];
            *(float4*)&b[0] = *(const float4*)&Bs[kk][tx * 8]; *(float4*)&b[4] = *(const float4*)&Bs[kk][tx * 8 + 4];
#pragma unroll
            for (int i = 0; i < 8; ++i)
#pragma unroll
                for (int j = 0; j < 8; ++j) acc[i][j] += a[i] * b[j];
        }
        __syncthreads();
    }
#pragma unroll
    for (int i = 0; i < 8; ++i)
#pragma unroll
        for (int j = 0; j < 8; ++j) { const int gm = m0 + ty * 8 + i, gn = n0 + tx * 8 + j; if (gm < M && gn < N) epi(gm, gn, acc[i][j]); }
}

struct EpiProj {
    bf16_t *U, *SZP, *QKV, *SZD, *GATES; float* BA;
    __device__ __forceinline__ void operator()(int m, int n, float v) const {
        if (n < C_ZP) U[(size_t)m * 1024 + n] = f2bf(v);
        else if (n < C_Q) SZP[(size_t)m * 1024 + (n - C_ZP)] = f2bf(siluf_(v));
        else if (n < C_ZD) QKV[(size_t)m * 6144 + (n - C_Q)] = f2bf(v);
        else if (n < C_B) SZD[(size_t)m * 2048 + (n - C_ZD)] = f2bf(siluf_(v));
        else if (n < C_GP) BA[(size_t)m * 32 + (n - C_B)] = v;
        else GATES[(size_t)m * 4096 + (n - C_GP)] = f2bf(sigmoidf_(v));
    }
};
struct EpiPool {
    bf16_t* Y; const bf16_t* SZP; const float* scale; int g, pad;
    __device__ __forceinline__ void operator()(int m, int n, float v) const {
        const int c = g * PGD + n; Y[(size_t)m * YLD + c] = f2bf(v * scale[c] * bf2f(SZP[(size_t)m * 1024 + c]));
    }
};
struct EpiG2a { float* T; const bf16_t* GATES; __device__ __forceinline__ void operator()(int m, int n, float v) const { T[(size_t)m * DM + n] = v * bf2f(GATES[(size_t)m * 4096 + n]); } };
struct EpiG2b { const float* T; const bf16_t* GATES; bf16_t* MG; __device__ __forceinline__ void operator()(int m, int n, float v) const { MG[(size_t)m * DM + n] = f2bf(T[(size_t)m * DM + n] + v * bf2f(GATES[(size_t)m * 4096 + 2048 + n])); } };
struct EpiG3 { const float* x; float* out; __device__ __forceinline__ void operator()(int m, int n, float v) const { out[(size_t)m * DM + n] = x[(size_t)m * DM + n] + v; } };

__global__ void __launch_bounds__(256) nv_pool(const bf16_t* __restrict__ U, bf16_t* __restrict__ PO) {
    const int idx = blockIdx.x * 256 + threadIdx.x; if (idx >= MTOK * PW) return;
    const int m = idx >> 10, c = idx & 1023, b = m >> 11, t = m & 2047, p = t + NMETA, win = 2 << (c >> 8);
    float s = 0.f;
    for (int j = 0; j < win; ++j) { const int pp = p - j; if (pp >= 0) s += bf2f(U[(size_t)ext_row(b, pp) * 1024 + c]); }
    const int cnt = (p + 1) < win ? (p + 1) : win;
    PO[idx] = f2bf(s / (float)cnt - bf2f(U[(size_t)m * 1024 + c]));
}

__global__ void __launch_bounds__(256) nv_chunk_prep(const bf16_t* __restrict__ QKV, const float* __restrict__ BA, const float* __restrict__ conv_w, const float* __restrict__ A_log,
                                                     const float* __restrict__ dt_bias, bf16_t* __restrict__ NW, bf16_t* __restrict__ UU, bf16_t* __restrict__ QD, bf16_t* __restrict__ KDT,
                                                     bf16_t* __restrict__ QK, float* __restrict__ GL) {
    extern __shared__ __attribute__((aligned(16))) float sm[];
    float *q = sm, *k = q + 8192, *v = k + 8192, *Am = v + 8192, *Tm = Am + 4096, *beta = Tm + 4096, *gc = beta + 64;
    const int cu = blockIdx.x, n = cu % NCH, bh = cu / NCH, h = bh % NH, b = bh / NH, tid = threadIdx.x, lane = tid & 63, wv = tid >> 6;
    const int p0 = CHUNK * n - PADF;
    for (int idx = tid; idx < 64 * 384; idx += 256) {
        const int i = idx / 384, c3 = idx % 384, which = c3 >> 7, d = c3 & 127, col = which * 2048 + h * HD + d, p = p0 + i;
        float val = 0.f;
        if (p >= 0) { float a = 0.f;
            for (int kk = 0; kk < 4; ++kk) { const int pp = p - 3 + kk; if (pp >= 0) a += conv_w[kk * 6144 + col] * bf2f(QKV[(size_t)ext_row(b, pp) * 6144 + col]); }
            val = siluf_(a); }
        (which == 0 ? q : which == 1 ? k : v)[i * 128 + d] = val;
    }
    if (tid < 64) { const int p = p0 + tid; float be = 0.f, g = 0.f;
        if (p >= 0) { const int r = ext_row(b, p); be = sigmoidf_(BA[(size_t)r * 32 + h]); g = -__expf(A_log[h]) * softplusf_(BA[(size_t)r * 32 + 16 + h] + dt_bias[h]); }
        beta[tid] = be; gc[tid] = g; }
    __syncthreads();
    if (tid == 0) { float s = 0.f; for (int i = 0; i < 64; ++i) { s += gc[i]; gc[i] = s; } }
    for (int r = wv; r < 128; r += 4) {
        float* row = (r < 64 ? q + r * 128 : k + (r - 64) * 128);
        const float a0 = row[lane], a1 = row[lane + 64];
        const float rs = rsqrtf(wave_sum(a0 * a0 + a1 * a1) + EPS) * (r < 64 ? 0.08838834764831845f : 1.f);
        row[lane] = a0 * rs; row[lane + 64] = a1 * rs;
    }
    __syncthreads();
    bf16_t* oQK = QK + (size_t)cu * 4096;
    for (int idx = tid; idx < 4096; idx += 256) {
        const int i = idx >> 6, j = idx & 63; float akk = 0.f, aqk = 0.f;
        if (j <= i) { for (int d = 0; d < 128; ++d) { const float kj = k[j * 128 + d]; akk += k[i * 128 + d] * kj; aqk += q[i * 128 + d] * kj; }
            const float dec = __expf(gc[i] - gc[j]); akk *= beta[i] * dec; aqk *= dec; }
        Am[idx] = j < i ? akk : 0.f; oQK[idx] = f2bf(j <= i ? aqk : 0.f);
    }
    __syncthreads();
    if (tid < 64) { const int c = tid;
        for (int i = 0; i < 64; ++i) { float s = (i == c) ? 1.f : 0.f; for (int j = c; j < i; ++j) s -= Am[i * 64 + j] * Tm[j * 64 + c]; Tm[i * 64 + c] = (i >= c) ? s : 0.f; } }
    __syncthreads();
    bf16_t *oNW = NW + (size_t)cu * 8192, *oU = UU + (size_t)cu * 8192, *oQD = QD + (size_t)cu * 8192, *oKDT = KDT + (size_t)cu * 8192;
    const float gl = gc[63];
    for (int idx = tid; idx < 8192; idx += 256) {
        const int i = idx >> 7, d = idx & 127; float su = 0.f, sw = 0.f;
        for (int j = 0; j <= i; ++j) { const float t = Tm[i * 64 + j] * beta[j]; su += t * v[j * 128 + d]; sw += t * __expf(gc[j]) * k[j * 128 + d]; }
        oU[idx] = f2bf(su); oNW[idx] = f2bf(-sw);
        oQD[idx] = f2bf(q[idx] * __expf(gc[i]));
        oKDT[d * 64 + i] = f2bf(k[idx] * __expf(gl - gc[i]));
    }
    if (tid == 0) GL[cu] = __expf(gl);
}

__global__ void __launch_bounds__(128) nv_chunk_scan(const bf16_t* __restrict__ NW, const bf16_t* __restrict__ UU, const bf16_t* __restrict__ QD, const bf16_t* __restrict__ KDT,
                                                     const bf16_t* __restrict__ QK, const float* __restrict__ GL, bf16_t* __restrict__ O) {
    __shared__ float vn[64][128];
    const int bh = blockIdx.x, h = bh % NH, b = bh / NH, e = threadIdx.x;
    float S[128];
#pragma unroll
    for (int d = 0; d < 128; ++d) S[d] = 0.f;
    for (int n = 0; n < NCH; ++n) {
        const int cu = bh * NCH + n;
        const bf16_t *nw = NW + (size_t)cu * 8192, *uu = UU + (size_t)cu * 8192, *qd = QD + (size_t)cu * 8192, *kdt = KDT + (size_t)cu * 8192, *qk = QK + (size_t)cu * 4096;
        const float gl = GL[cu];
        for (int i = 0; i < 64; ++i) { float a = bf2f(uu[i * 128 + e]);
#pragma unroll
            for (int d = 0; d < 128; ++d) a += bf2f(nw[i * 128 + d]) * S[d];
            vn[i][e] = a; }
        __syncthreads();
        if (n > 0) for (int i = 0; i < 64; ++i) { float a = 0.f;
#pragma unroll
            for (int d = 0; d < 128; ++d) a += bf2f(qd[i * 128 + d]) * S[d];
            for (int j = 0; j <= i; ++j) a += bf2f(qk[i * 64 + j]) * vn[j][e];
            O[(size_t)(b * SEQ + 64 * (n - 1) + i) * DNW + h * HD + e] = f2bf(a); }
#pragma unroll
        for (int d = 0; d < 128; ++d) { float s = S[d] * gl; for (int i = 0; i < 64; ++i) s += bf2f(kdt[d * 64 + i]) * vn[i][e]; S[d] = s; }
        __syncthreads();
    }
}

__global__ void __launch_bounds__(256) nv_gnorm(const bf16_t* __restrict__ O, const bf16_t* __restrict__ SZD, const float* __restrict__ w, bf16_t* __restrict__ Y) {
    const int lane = threadIdx.x & 63, gw = (blockIdx.x * 256 + threadIdx.x) >> 6; if (gw >= MTOK * NH) return;
    const size_t base = (size_t)(gw >> 4) * DNW + (gw & 15) * HD, yb = (size_t)(gw >> 4) * YLD + 1024 + (gw & 15) * HD;
    const float a0 = bf2f(O[base + lane]), a1 = bf2f(O[base + lane + 64]);
    const float rs = rsqrtf(wave_sum(a0 * a0 + a1 * a1) * (1.f / HD) + EPS);
    Y[yb + lane] = f2bf(a0 * rs * w[lane] * bf2f(SZD[base + lane]));
    Y[yb + lane + 64] = f2bf(a1 * rs * w[lane + 64] * bf2f(SZD[base + lane + 64]));
}

__global__ void __launch_bounds__(256) nv_final(float* __restrict__ out, const float* __restrict__ w) {
    __shared__ float red[4];
    float* row = out + (size_t)blockIdx.x * DM; const int tid = threadIdx.x;
    float v[8]; float s = 0.f;
#pragma unroll
    for (int j = 0; j < 8; ++j) { v[j] = row[tid + 256 * j]; s += v[j] * v[j]; }
    s = wave_sum(s); if ((tid & 63) == 0) red[tid >> 6] = s; __syncthreads();
    const float rs = rsqrtf((red[0] + red[1] + red[2] + red[3]) * (1.f / DM) + EPS);
#pragma unroll
    for (int j = 0; j < 8; ++j) row[tid + 256 * j] = v[j] * rs * w[tid + 256 * j];
}

#endif
namespace pg8 {
#define PG8_LAS __attribute__((address_space(3)))
typedef short bf16x8 __attribute__((ext_vector_type(8)));
typedef float f32x4 __attribute__((ext_vector_type(4)));
typedef unsigned u32x4 __attribute__((ext_vector_type(4)));
constexpr int BM = 256, BK = 64, HALF = 128, HTB = HALF * BK * 2  , STAGE_BYTES = 8 * HTB, NXCD = 8, WGM = 8;

__host__ __device__ __forceinline__ int lds_byte(int r, int c) { const int st = (r >> 4) * 2 + (c >> 5), rr = r & 15, cc = c & 31, ob = rr * 64 + cc * 2; return st * 1024 + (ob ^ (((ob >> 9) & 1) << 5)); }
__host__ __device__ __forceinline__ void stage_rc(int b, int& R, int& C) { const int st = b / 1024, sb = b % 1024, swz = sb ^ (((sb >> 9) & 1) << 5); R = (st >> 1) * 16 + swz / 64; C = (st & 1) * 32 + (swz % 64) / 2; }
__host__ __device__ __forceinline__ int perm32(int rho) { const int n = rho >> 4, i = rho & 15; return 8 * (i >> 2) + 4 * n + (i & 3); }

struct Unit { int pm, pn, aoff, boff, nt, mode; };
struct Gemm { const bf16_t* A; const bf16_t* Bt; int lda, ldb; };

struct StaticOrder {
    int nM, nN, nwg, G, c, nt;
    __device__ void init(int nM_, int nN_, int nt_, int G_, int c_) { nM = nM_; nN = nN_; nwg = nM * nN; G = G_; c = c_; nt = nt_; }
    __device__ bool next(int i, Unit& u) const {
        const long L = (long)i * G + c; if (L >= nwg) return false;
        int wgid = (int)L; { const int q = nwg / NXCD, r = nwg % NXCD, xcd = wgid % NXCD, off = wgid / NXCD; wgid = (xcd < r ? xcd * (q + 1) : r * (q + 1) + (xcd - r) * q) + off; }
        const int nig = WGM * nN, gid = wgid / nig, fm = gid * WGM, gsz = (nM - fm) < WGM ? (nM - fm) : WGM;
        u.pm = fm + ((wgid % nig) % gsz); u.pn = (wgid % nig) / gsz; u.aoff = 0; u.boff = 0; u.nt = nt; u.mode = 0; return true;
    }
};

typedef float f32x2_t __attribute__((ext_vector_type(2))); typedef __bf16 bf16x2_t __attribute__((ext_vector_type(2)));
__device__ __forceinline__ unsigned cvt_pk_bf16(float lo, float hi) { f32x2_t v = {lo, hi}; bf16x2_t b = __builtin_convertvector(v, bf16x2_t); return __builtin_bit_cast(unsigned, b); }
__device__ __forceinline__ u32x4 pack8(f32x4 v0, f32x4 v1) { u32x4 w; w.x = cvt_pk_bf16(v0[0], v0[1]); w.y = cvt_pk_bf16(v0[2], v0[3]); w.z = cvt_pk_bf16(v1[0], v1[1]); w.w = cvt_pk_bf16(v1[2], v1[3]); return w; }
__device__ __forceinline__ void unpack8(u32x4 w, f32x4& v0, f32x4& v1) {
    v0 = (f32x4){__uint_as_float(w.x << 16), __uint_as_float(w.x & 0xffff0000u), __uint_as_float(w.y << 16), __uint_as_float(w.y & 0xffff0000u)};
    v1 = (f32x4){__uint_as_float(w.z << 16), __uint_as_float(w.z & 0xffff0000u), __uint_as_float(w.w << 16), __uint_as_float(w.w & 0xffff0000u)};
}
__device__ __forceinline__ float fast_sigmoid(float x) { return __builtin_amdgcn_rcpf(1.f + __builtin_amdgcn_exp2f(-1.4426950408889634f * x)); }

struct EpiProj {
    static constexpr bool PERM = true;
    bf16_t *U, *SZP, *QKV, *SZD, *GATES; float* BA;
    __device__ __forceinline__ bool reset_after(const Unit&) const { return true; }
    __device__ __forceinline__ void operator()(f32x4 (&acc)[2][2][4][2], const Unit& u, int wr, int wc, int fr, int fq) const {
        const int row0 = u.pm * BM + wr * 64 + fr, pn = u.pn;
        if (pn == 56) {
            if (wc == 0) {
#pragma unroll
                for (int ai = 0; ai < 2; ++ai)
#pragma unroll
                    for (int m = 0; m < 4; ++m) { float* rowp = BA + (size_t)(row0 + ai * HALF + m * 16) * 32 + 8 * fq;
                        *(f32x4*)rowp = acc[ai][0][m][0]; *(f32x4*)(rowp + 4) = acc[ai][0][m][1]; }
            }
            return;
        }
        bf16_t* base; int ld, colt, act;
        if (pn < 4) { base = U; ld = 1024; colt = pn * 256; act = 0; }
        else if (pn < 8) { base = SZP; ld = 1024; colt = (pn - 4) * 256; act = 1; }
        else if (pn < 32) { base = QKV; ld = 6144; colt = (pn - 8) * 256; act = 0; }
        else if (pn < 40) { base = SZD; ld = 2048; colt = (pn - 32) * 256; act = 1; }
        else { base = GATES; ld = 4096; colt = (pn - 40) * 256; act = 2; }
        const int col0 = colt + wc * 32 + 8 * fq;
#pragma unroll
        for (int ai = 0; ai < 2; ++ai)
#pragma unroll
            for (int m = 0; m < 4; ++m) { bf16_t* rowp = base + (size_t)(row0 + ai * HALF + m * 16) * ld + col0;
#pragma unroll
                for (int bj = 0; bj < 2; ++bj) { f32x4 v0 = acc[ai][bj][m][0], v1 = acc[ai][bj][m][1];
                    if (act != 0) {
#pragma unroll
                        for (int j = 0; j < 4; ++j) { const float s0 = fast_sigmoid(v0[j]), s1 = fast_sigmoid(v1[j]); v0[j] = act == 1 ? v0[j] * s0 : s0; v1[j] = act == 1 ? v1[j] * s1 : s1; }
                    }
                    *(u32x4*)(rowp + bj * HALF) = pack8(v0, v1); } }
    }
};
struct EpiPoolMix {
    static constexpr bool PERM = true;
    bf16_t* Y; const bf16_t* SZP; const float* scale;
    __device__ __forceinline__ bool reset_after(const Unit&) const { return true; }
    __device__ __forceinline__ void operator()(f32x4 (&acc)[2][2][4][2], const Unit& u, int wr, int wc, int fr, int fq) const {
        const int row0 = u.pm * BM + wr * 64 + fr, col0 = u.pn * BM + wc * 32 + 8 * fq;
#pragma unroll
        for (int bj = 0; bj < 2; ++bj) { const f32x4 s0 = *(const f32x4*)(scale + col0 + bj * HALF), s1 = *(const f32x4*)(scale + col0 + bj * HALF + 4);
#pragma unroll
            for (int ai = 0; ai < 2; ++ai)
#pragma unroll
                for (int m = 0; m < 4; ++m) { const size_t r = (size_t)(row0 + ai * HALF + m * 16);
                    f32x4 z0, z1; unpack8(*(const u32x4*)(SZP + r * 1024 + col0 + bj * HALF), z0, z1);
                    *(u32x4*)(Y + r * YLD + col0 + bj * HALF) = pack8(acc[ai][bj][m][0] * s0 * z0, acc[ai][bj][m][1] * s1 * z1); } }
    }
};
struct EpiMerge {
    static constexpr bool PERM = true;
    const bf16_t* GATES; bf16_t* MG;
    __device__ __forceinline__ bool reset_after(const Unit& u) const { return u.mode != 0; }
    __device__ __forceinline__ void operator()(f32x4 (&acc)[2][2][4][2], const Unit& u, int wr, int wc, int fr, int fq) const {
        const int row0 = u.pm * BM + wr * 64 + fr, col0 = u.pn * BM + wc * 32 + 8 * fq;
#pragma unroll
        for (int ai = 0; ai < 2; ++ai)
#pragma unroll
            for (int m = 0; m < 4; ++m) { const size_t r = (size_t)(row0 + ai * HALF + m * 16);
#pragma unroll
                for (int bj = 0; bj < 2; ++bj) {
                    f32x4 d0, d1; unpack8(*(const u32x4*)(GATES + r * 4096 + 2048 + col0 + bj * HALF), d0, d1);
                    if (u.mode == 0) {
                        f32x4 p0, p1; unpack8(*(const u32x4*)(GATES + r * 4096 + col0 + bj * HALF), p0, p1);
#pragma unroll
                        for (int j = 0; j < 4; ++j) { acc[ai][bj][m][0][j] *= p0[j] / fmaxf(d0[j], 1e-30f); acc[ai][bj][m][1][j] *= p1[j] / fmaxf(d1[j], 1e-30f); }
                    } else {
                        *(u32x4*)(MG + r * DM + col0 + bj * HALF) = pack8(acc[ai][bj][m][0] * d0, acc[ai][bj][m][1] * d1);
                    } } }
    }
};
struct EpiResid {
    static constexpr bool PERM = false;
    const float* x; float* out;
    __device__ __forceinline__ bool reset_after(const Unit&) const { return true; }
    __device__ __forceinline__ void operator()(f32x4 (&acc)[2][2][4][2], const Unit& u, int wr, int wc, int fr, int fq) const {
        const int row0 = u.pm * BM + wr * 64 + fr, col0 = u.pn * BM + wc * 32 + 4 * fq;
#pragma unroll
        for (int ai = 0; ai < 2; ++ai)
#pragma unroll
            for (int m = 0; m < 4; ++m) { const size_t off = (size_t)(row0 + ai * HALF + m * 16) * DM + col0;
#pragma unroll
                for (int bj = 0; bj < 2; ++bj)
#pragma unroll
                    for (int n = 0; n < 2; ++n) *(f32x4*)(out + off + bj * HALF + n * 16) = *(const f32x4*)(x + off + bj * HALF + n * 16) + acc[ai][bj][m][n]; }
    }
};

template <class Epi, class Sched, bool ALIGN_EPI>
__device__ __forceinline__ void gemm_phase(PG8_LAS unsigned char* lds, const Gemm g, const Sched& S, const Epi& E) {
    const int tid = threadIdx.x, wid = __builtin_amdgcn_readfirstlane(tid >> 6), lane = tid & 63, wr = wid >> 2, wc = wid & 3, fr = lane & 15, fq = lane >> 4;
    const int lda = g.lda, ldb = g.ldb;
    unsigned voffA[2], voffB[2];
#pragma unroll
    for (int i = 0; i < 2; ++i) { int R, C; stage_rc(tid * 16 + i * 8192, R, C); const int Rb = Epi::PERM ? ((R & ~31) + perm32(R & 31)) : R;
        voffA[i] = (unsigned)(R * lda + C) * 2u; voffB[i] = (unsigned)(Rb * ldb + C) * 2u; }
    const size_t kstep = (size_t)(BK * 2);
    const size_t hstepA = (size_t)HALF * lda * 2, hstepB = (size_t)HALF * ldb * 2;
    const unsigned ldsw = (unsigned)wid * 1024u;
    const int aoff = lds_byte(wr * 64 + fr, fq * 8), boff = lds_byte(wc * 32 + fr, fq * 8);
#define PG8_SA(b, h) (((b) * 2 + (h)) * HTB)
#define PG8_SB(b, h) ((4 + (b) * 2 + (h)) * HTB)
#define PG8_STAGE(bufoff, gbase, voff) do { _Pragma("unroll") for (int _i = 0; _i < 2; ++_i) \
        __builtin_amdgcn_global_load_lds((const unsigned*)((const char*)(gbase) + (voff)[_i]), (PG8_LAS unsigned*)(lds + (bufoff) + ldsw + _i * 8192), 16, 0, 0); } while (0)
#define PG8_LDA(dst, b, h) do { _Pragma("unroll") for (int m = 0; m < 4; ++m) _Pragma("unroll") for (int k = 0; k < 2; ++k) dst[m][k] = *(const PG8_LAS bf16x8*)(lds + PG8_SA(b, h) + aoff + m * 2048 + k * 1024); } while (0)
#define PG8_LDB(dst, b, h) do { _Pragma("unroll") for (int n = 0; n < 2; ++n) _Pragma("unroll") for (int k = 0; k < 2; ++k) dst[n][k] = *(const PG8_LAS bf16x8*)(lds + PG8_SB(b, h) + boff + n * 2048 + k * 1024); } while (0)
#define PG8_MMA(ai, bj, At, Bt) do { __builtin_amdgcn_s_setprio(1); _Pragma("unroll") for (int m = 0; m < 4; ++m) _Pragma("unroll") for (int n = 0; n < 2; ++n) _Pragma("unroll") for (int k = 0; k < 2; ++k) \
        acc[ai][bj][m][n] = __builtin_amdgcn_mfma_f32_16x16x32_bf16(Bt[n][k], At[m][k], acc[ai][bj][m][n], 0, 0, 0); __builtin_amdgcn_s_setprio(0); } while (0)
#define PG8_WAIT_V(n) asm volatile("s_waitcnt vmcnt(" #n ")" ::: "memory")
#define PG8_WAIT_L(n) asm volatile("s_waitcnt lgkmcnt(" #n ")" ::: "memory")
#define PG8_BAR __builtin_amdgcn_s_barrier()
#define PG8_SCHED __builtin_amdgcn_sched_barrier(0)
#define PG8_UA(u) ((const char*)g.A + ((size_t)(u).pm * BM * lda + (u).aoff) * 2)
#define PG8_UB(u) ((const char*)g.Bt + ((size_t)(u).pn * BM * ldb + (u).boff) * 2)
    Unit cur, nxt; int ui = 0;
    if (!S.next(0, cur)) return;
    f32x4 acc[2][2][4][2];
#pragma unroll
    for (int a = 0; a < 2; ++a)
#pragma unroll
        for (int b = 0; b < 2; ++b)
#pragma unroll
            for (int m = 0; m < 4; ++m)
#pragma unroll
                for (int n = 0; n < 2; ++n) acc[a][b][m][n] = (f32x4){0.f, 0.f, 0.f, 0.f};
    bf16x8 At[4][2], B0[2][2], B1[2][2];
    const char* cA = PG8_UA(cur); const char* cB = PG8_UB(cur);
    PG8_STAGE(PG8_SB(0, 0), cB, voffB); PG8_STAGE(PG8_SB(0, 1), cB + hstepB, voffB); PG8_STAGE(PG8_SA(0, 0), cA, voffA); PG8_STAGE(PG8_SA(0, 1), cA + hstepA, voffA);
    if (wr == 1) PG8_BAR;
    PG8_WAIT_V(2); PG8_BAR;
    PG8_STAGE(PG8_SB(1, 0), cB + kstep, voffB); PG8_STAGE(PG8_SA(1, 0), cA + kstep, voffA); PG8_STAGE(PG8_SB(1, 1), cB + hstepB + kstep, voffB);
    PG8_WAIT_V(6); PG8_BAR;
    for (;;) {
        const bool has_next = S.next(ui + 1, nxt);
        const char* nA = has_next ? PG8_UA(nxt) : cA; const char* nB = has_next ? PG8_UB(nxt) : cB;
        const int nt = cur.nt;
        for (int t = 0; t < nt; t += 2) {
            const bool last = (t == nt - 2);
            const char* a1 = cA + (size_t)(t + 1) * kstep;
            const char* a2 = last ? nA : cA + (size_t)(t + 2) * kstep; const char* b2 = last ? nB : cB + (size_t)(t + 2) * kstep;
            const char* a3 = a2 + kstep; const char* b3 = b2 + kstep;
            PG8_LDB(B0, 0, 0); PG8_LDB(B1, 0, 1); PG8_SCHED; PG8_LDA(At, 0, 0); PG8_STAGE(PG8_SA(1, 1), a1 + hstepA, voffA);
            PG8_WAIT_V(8); PG8_WAIT_L(0); PG8_BAR; PG8_MMA(0, 0, At, B0); PG8_MMA(0, 1, At, B1); PG8_BAR; PG8_SCHED;
            PG8_LDA(At, 0, 1); PG8_STAGE(PG8_SB(0, 0), b2, voffB); PG8_STAGE(PG8_SB(0, 1), b2 + hstepB, voffB); PG8_STAGE(PG8_SA(0, 0), a2, voffA);
            PG8_WAIT_V(8); PG8_WAIT_L(0); PG8_BAR; PG8_MMA(1, 0, At, B0); PG8_MMA(1, 1, At, B1); PG8_BAR; PG8_SCHED;
            PG8_LDB(B0, 1, 0); PG8_LDB(B1, 1, 1); PG8_SCHED; PG8_LDA(At, 1, 0); PG8_STAGE(PG8_SA(0, 1), a2 + hstepA, voffA);
            PG8_WAIT_V(8); PG8_WAIT_L(0); PG8_BAR; PG8_MMA(0, 0, At, B0); PG8_MMA(0, 1, At, B1); PG8_BAR; PG8_SCHED;
            PG8_LDA(At, 1, 1); PG8_STAGE(PG8_SB(1, 0), b3, voffB); PG8_STAGE(PG8_SB(1, 1), b3 + hstepB, voffB); PG8_STAGE(PG8_SA(1, 0), a3, voffA);
            PG8_WAIT_V(8); PG8_WAIT_L(0); PG8_BAR; PG8_MMA(1, 0, At, B0); PG8_MMA(1, 1, At, B1); PG8_BAR; PG8_SCHED;
        }
        if constexpr (ALIGN_EPI) { if (wr == 0) PG8_BAR; }
        E(acc, cur, wr, wc, fr, fq);
        if (!has_next) break;
        if (E.reset_after(cur)) {
#pragma unroll
            for (int a = 0; a < 2; ++a)
#pragma unroll
                for (int b = 0; b < 2; ++b)
#pragma unroll
                    for (int m = 0; m < 4; ++m)
#pragma unroll
                        for (int n = 0; n < 2; ++n) acc[a][b][m][n] = (f32x4){0.f, 0.f, 0.f, 0.f};
        }
        cur = nxt; cA = nA; cB = nB; ++ui;
        if constexpr (ALIGN_EPI) { if (wr == 1) PG8_BAR; }
    }
    PG8_WAIT_V(0);
    if constexpr (!ALIGN_EPI) { if (wr == 0) PG8_BAR; }
    PG8_BAR;
#undef PG8_SA
#undef PG8_SB
#undef PG8_STAGE
#undef PG8_LDA
#undef PG8_LDB
#undef PG8_MMA
#undef PG8_WAIT_V
#undef PG8_WAIT_L
#undef PG8_BAR
#undef PG8_SCHED
#undef PG8_UA
#undef PG8_UB
}
}
#ifndef DUP_MASK
#define DUP_MASK 0
#endif
#ifndef SIMPLE_PREP
#define SIMPLE_PREP 0
#endif
#ifndef SIMPLE_SCAN
#define SIMPLE_SCAN 0
#endif
constexpr int NWAVES = 8;
constexpr int RING_OFF = 0, RING_BYTES = 131072;
constexpr int LDSCTL_OFF = RING_BYTES, MISC_OFF = LDSCTL_OFF + 320;
constexpr int XTRA_OFF = RING_BYTES + 1024;
constexpr int LDS_BYTES = 147456;
constexpr int CW_BAR = 4096;

#define GAS __attribute__((address_space(1)))
#define LAS __attribute__((address_space(3)))
typedef unsigned v4u __attribute__((ext_vector_type(4)));
typedef float f32x4 __attribute__((ext_vector_type(4)));
typedef GAS unsigned gu32;
#define LDS_WAIT() asm volatile("s_waitcnt lgkmcnt(0)" ::: "memory")
#define VM_WAIT() asm volatile("s_waitcnt vmcnt(0)" ::: "memory")
__device__ __forceinline__ unsigned pk2(float lo, float hi) { return (unsigned)f2bf(lo) | ((unsigned)f2bf(hi) << 16); }

#define XB_TMO      128
#define XB_XCNT(j)  (256  + 64 * (j))
#define XB_XSUB(j)  (1280 + 64 * (j))
#define XB_XGEN(j)  (2304 + 64 * (j))
#define XB_TOP      3328
#define XB_TOPGEN   3392
#define XCD_BAR_WORDS 3456
#define XB_SPIN_CAP (1u << 18)
__device__ __forceinline__ unsigned xb_ld(unsigned* p)              { return __hip_atomic_load(p, __ATOMIC_RELAXED, __HIP_MEMORY_SCOPE_AGENT); }
__device__ __forceinline__ unsigned xb_add(unsigned* p, unsigned v) { return __hip_atomic_fetch_add(p, v, __ATOMIC_RELAXED, __HIP_MEMORY_SCOPE_AGENT); }
__device__ __forceinline__ unsigned xb_xcc_id() { return (unsigned)__builtin_amdgcn_s_getreg((3 << 11) | 20) & 0xFu; }
#define XB_SPIN(cond, bar) do { unsigned _sp = 0; while (cond) { __builtin_amdgcn_s_sleep(1); \
    if ((++_sp & 255u) == 0u) { if (xb_ld(&(bar)[XB_TMO])) break; if (_sp > XB_SPIN_CAP) { atomicAdd(&(bar)[XB_TMO], 1u); break; } } } } while (0)
struct XcdBarrier { unsigned* bar; unsigned x; volatile LAS unsigned* st; };
__device__ __forceinline__ XcdBarrier xcd_barrier_post(unsigned* bar, volatile LAS unsigned* st) {
    XcdBarrier b; b.bar = bar; b.x = xb_xcc_id(); b.st = st;
    if (threadIdx.x == 0) (void)xb_add(&bar[XB_XCNT(b.x)], 1u);
    return b;
}
__device__ __forceinline__ void xcd_barrier_complete(unsigned* bar, unsigned x, unsigned& nloc, unsigned& nx) {
    const unsigned G = gridDim.x * gridDim.y * gridDim.z;
    unsigned sum, cnt, mine, sp = 0u;
    for (;;) {
        sum = 0u; cnt = 0u; mine = 0u;
#pragma unroll
        for (unsigned j = 0; j < 16; ++j) { const unsigned c = xb_ld(&bar[XB_XCNT(j)]); sum += c; cnt += (c > 0u) ? 1u : 0u; mine = (j == x) ? c : mine; }
        if (sum == G) break;
        __builtin_amdgcn_s_sleep(1);
        if ((++sp & 255u) == 0u) { if (xb_ld(&bar[XB_TMO])) break; if (sp > XB_SPIN_CAP) { atomicAdd(&bar[XB_TMO], 1u); break; } }
    }
    nloc = mine > 0u ? mine : 1u; nx = cnt > 0u ? cnt : 1u;
}
__device__ __forceinline__ void xcd_barrier(const XcdBarrier& b) {
    asm volatile("s_waitcnt vmcnt(0)" ::: "memory");
    __syncthreads();
    if (threadIdx.x == 0) {
        unsigned* bar = b.bar;
        __builtin_amdgcn_s_waitcnt(0);
        unsigned nloc = b.st[0], nx = b.st[1];
        if (nloc == 0u) { xcd_barrier_complete(bar, b.x, nloc, nx); b.st[0] = nloc; b.st[1] = nx; }
        const unsigned old = xb_add(&bar[XB_XSUB(b.x)], 1u);
        const unsigned gen = old / nloc;
        if (old + 1u == (gen + 1u) * nloc) {
            __builtin_amdgcn_fence(__ATOMIC_RELEASE, "agent");
            asm volatile("s_waitcnt vmcnt(0)" ::: "memory");
            const unsigned og = xb_add(&bar[XB_TOP], 1u);
            const unsigned tg = og / nx;
            if (og + 1u == (tg + 1u) * nx) xb_add(&bar[XB_TOPGEN], 1u);
            else XB_SPIN(xb_ld(&bar[XB_TOPGEN]) == tg, bar);
            __builtin_amdgcn_fence(__ATOMIC_ACQUIRE, "agent");
            xb_add(&bar[XB_XGEN(b.x)], 1u);
            asm volatile("s_waitcnt vmcnt(0)" ::: "memory");
        } else {
            XB_SPIN(xb_ld(&bar[XB_XGEN(b.x)]) == gen, bar);
            __builtin_amdgcn_fence(__ATOMIC_ACQUIRE, "agent");
            asm volatile("s_waitcnt vmcnt(0)" ::: "memory");
        }
    }
    __syncthreads();
}

struct Args { const float* in[14]; float* out; unsigned char* ws; int ph_lo, ph_hi; };

struct Frame {
    LAS unsigned char* lds; int tid, lane, wave, vcu, G;
};

__device__ __forceinline__ void p0_transpose_item(const float* __restrict__ W, int N, int k0, int n0, bf16_t* __restrict__ WT, int ldt, int dn0, int koff, LAS float* scr, int lane) {
#pragma unroll 8
    for (int i = 0; i < 32; ++i) { const int kk = 2 * i + (lane >> 5); scr[kk * 33 + (lane & 31)] = W[(size_t)(k0 + kk) * N + n0 + (lane & 31)]; }
    LDS_WAIT(); asm volatile("" ::: "memory");
    const int c = lane & 7;
#pragma unroll
    for (int j = 0; j < 4; ++j) { const int n = (lane >> 3) + 8 * j; const LAS float* s = scr + (8 * c) * 33 + n;
        v4u o; o.x = pk2(s[0 * 33], s[1 * 33]); o.y = pk2(s[2 * 33], s[3 * 33]); o.z = pk2(s[4 * 33], s[5 * 33]); o.w = pk2(s[6 * 33], s[7 * 33]);
        *(v4u*)(WT + (size_t)(dn0 + n) * ldt + koff + k0 + 8 * c) = o; }
    LDS_WAIT(); asm volatile("" ::: "memory");
}
__device__ __forceinline__ void p0_prologue(Frame& F, const Args& a) {
    unsigned char* ws = a.ws;
    bf16_t *WinT = (bf16_t*)(ws + WS_WINT), *W2T = (bf16_t*)(ws + WS_W2T), *WoT = (bf16_t*)(ws + WS_WOT), *MixT = (bf16_t*)(ws + WS_MIXT), *XN = (bf16_t*)(ws + WS_XN);
    LAS float* scr = (LAS float*)(F.lds + RING_OFF + F.wave * 16384);
    const int gw = F.vcu * NWAVES + F.wave, NGW = F.G * NWAVES;
    constexpr int I_IN = (DM / 64) * (INC / 32), I_PO = (PW / 64) * (DM / 32), I_DN = (DNW / 64) * (DM / 32), I_WO = (DM / 64) * (DM / 32), I_MX = 4 * (PGD / 64) * (PGD / 32);
    constexpr int NITEMS = I_IN + I_PO + I_DN + I_WO + I_MX;
    for (int it = gw; it < NITEMS; it += NGW) {
        int r = it;
        if (r < I_IN) { const int nblk = INC / 32, kb = r / nblk, nb = r % nblk, n0 = 32 * nb;
            const int dn0 = n0 < C_B ? n0 : (n0 < C_GP ? 14336 + (n0 - C_B) : n0 - 32);
            p0_transpose_item(a.in[3], INC, 64 * kb, n0, WinT, DM, dn0, 0, scr, F.lane); continue; } r -= I_IN;
        if (r < I_PO) { const int nblk = DM / 32, kb = r / nblk, nb = r % nblk; p0_transpose_item(a.in[10], DM, 64 * kb, 32 * nb, W2T, YLD, 32 * nb, 0, scr, F.lane); continue; } r -= I_PO;
        if (r < I_DN) { const int nblk = DM / 32, kb = r / nblk, nb = r % nblk; p0_transpose_item(a.in[11], DM, 64 * kb, 32 * nb, W2T, YLD, 32 * nb, 1024, scr, F.lane); continue; } r -= I_DN;
        if (r < I_WO) { const int nblk = DM / 32, kb = r / nblk, nb = r % nblk; p0_transpose_item(a.in[12], DM, 64 * kb, 32 * nb, WoT, DM, 32 * nb, 0, scr, F.lane); continue; } r -= I_WO;
        { const int g = r / 32, rr = r % 32, kb = rr / 8, nb = rr % 8;
          p0_transpose_item(a.in[7] + (size_t)g * PGD * PGD, PGD, 64 * kb, 32 * nb, MixT + (size_t)g * PGD * PGD, PGD, 32 * nb, 0, scr, F.lane); }
    }
    const float* nw = a.in[2];
    for (int r = gw; r < MPAD + (NPAD1 - INC); r += NGW) {
        if (r >= MROWS) { bf16_t* o = r < MPAD ? XN + (size_t)r * DM : WinT + (size_t)(INC + (r - MPAD)) * DM;
#pragma unroll
            for (int j = 0; j < 4; ++j) *(v4u*)(o + 8 * F.lane + 512 * j) = (v4u){0u, 0u, 0u, 0u};
            continue; }
        const float* src = r < MTOK ? a.in[0] + (size_t)r * DM : a.in[1] + (size_t)(r - MTOK) * DM;
        f32x4 v[8]; float s = 0.f;
#pragma unroll
        for (int j = 0; j < 8; ++j) { v[j] = *(const f32x4*)(src + 4 * F.lane + 256 * j); s += (v[j].x * v[j].x + v[j].y * v[j].y) + (v[j].z * v[j].z + v[j].w * v[j].w); }
        const float rs = rsqrtf(wave_sum(s) * (1.f / DM) + EPS);
        unsigned long long* o8 = (unsigned long long*)(XN + (size_t)r * DM) + F.lane;
#pragma unroll
        for (int j = 0; j < 8; ++j) { const f32x4 w = *(const f32x4*)(nw + 4 * F.lane + 256 * j);
            o8[64 * j] = (unsigned long long)pk2(v[j].x * rs * w.x, v[j].y * rs * w.y) | ((unsigned long long)pk2(v[j].z * rs * w.z, v[j].w * rs * w.w) << 32); }
    }
}

__device__ __forceinline__ void p2_pool(Frame& F, const Args& a) {
    const bf16_t* U = (const bf16_t*)(a.ws + WS_U); bf16_t* PO = (bf16_t*)(a.ws + WS_POOLED);
    const int gt = F.vcu * 512 + F.tid, NT = F.G * 512;
    for (int idx = gt; idx < MTOK * (PW / 8); idx += NT) {
        const int m = idx >> 7, c8 = (idx & 127) * 8, b = m >> 11, t = m & 2047, p = t + NMETA, win = 2 << (c8 >> 8);
        float s[8];
#pragma unroll
        for (int j = 0; j < 8; ++j) s[j] = 0.f;
        for (int w = 0; w < win; ++w) { const int pp = p - w;
            pg8::f32x4 x0, x1; pg8::unpack8(*(const pg8::u32x4*)(U + (size_t)ext_row(b, pp) * 1024 + c8), x0, x1);
#pragma unroll
            for (int j = 0; j < 4; ++j) { s[j] += x0[j]; s[4 + j] += x1[j]; } }
        pg8::f32x4 u0, u1; pg8::unpack8(*(const pg8::u32x4*)(U + (size_t)m * 1024 + c8), u0, u1);
        const float inv = 1.f / (float)win;
        pg8::f32x4 r0, r1;
#pragma unroll
        for (int j = 0; j < 4; ++j) { r0[j] = s[j] * inv - u0[j]; r1[j] = s[4 + j] * inv - u1[j]; }
        *(pg8::u32x4*)(PO + (size_t)m * 1024 + c8) = pg8::pack8(r0, r1);
    }
}
__device__ __forceinline__ void p2_chunk_prep_simple(Frame& F, const Args& a) {
    const bf16_t* QKV = (const bf16_t*)(a.ws + WS_QKV); const float* BA = (const float*)(a.ws + WS_BA);
    const float *conv_w = a.in[4], *A_log = a.in[5], *dt_bias = a.in[6];
    bf16_t *NW = (bf16_t*)(a.ws + WS_CH_NW), *UU = (bf16_t*)(a.ws + WS_CH_U), *QD = (bf16_t*)(a.ws + WS_CH_QD), *KDT = (bf16_t*)(a.ws + WS_CH_KDT), *QK = (bf16_t*)(a.ws + WS_CH_QK);
    float* GL = (float*)(a.ws + WS_CH_GL);
    LAS float* sm = (LAS float*)(F.lds + RING_OFF);
    LAS float *q = sm, *k = q + 8192, *v = k + 8192, *Am = v + 8192, *Tm = Am + 4096;
    LAS float *beta = (LAS float*)(F.lds + XTRA_OFF), *gc = beta + 64;
    const int tid = F.tid, lane = F.lane, wv = F.wave;
    for (int cu = F.vcu; cu < NUNITS; cu += F.G) {
        const int n = cu % NCH, bh = cu / NCH, h = bh % NH, b = bh / NH, p0 = CHUNK * n - PADF;
        for (int idx = tid; idx < 64 * 384; idx += 512) {
            const int i = idx / 384, c3 = idx % 384, which = c3 >> 7, d = c3 & 127, col = which * 2048 + h * HD + d, p = p0 + i;
            float val = 0.f;
            if (p >= 0) { float s = 0.f;
                for (int kk = 0; kk < 4; ++kk) { const int pp = p - 3 + kk; if (pp >= 0) s += conv_w[kk * 6144 + col] * bf2f(QKV[(size_t)ext_row(b, pp) * 6144 + col]); }
                val = siluf_(s); }
            (which == 0 ? q : which == 1 ? k : v)[i * 128 + d] = val;
        }
        if (tid < 64) { const int p = p0 + tid; float be = 0.f, g = 0.f;
            if (p >= 0) { const int r = ext_row(b, p); be = sigmoidf_(BA[(size_t)r * 32 + h]); g = -__expf(A_log[h]) * softplusf_(BA[(size_t)r * 32 + 16 + h] + dt_bias[h]); }
            beta[tid] = be; gc[tid] = g; }
        __syncthreads();
        if (tid == 0) { float s = 0.f; for (int i = 0; i < 64; ++i) { s += gc[i]; gc[i] = s; } }
        for (int r = wv; r < 128; r += 8) {
            LAS float* row = (r < 64 ? q + r * 128 : k + (r - 64) * 128);
            const float a0 = row[lane], a1 = row[lane + 64];
            const float rs = rsqrtf(wave_sum(a0 * a0 + a1 * a1) + EPS) * (r < 64 ? 0.08838834764831845f : 1.f);
            row[lane] = a0 * rs; row[lane + 64] = a1 * rs;
        }
        __syncthreads();
        bf16_t* oQK = QK + (size_t)cu * 4096;
        for (int idx = tid; idx < 4096; idx += 512) {
            const int i = idx >> 6, j = idx & 63; float akk = 0.f, aqk = 0.f;
            if (j <= i) { for (int d = 0; d < 128; ++d) { const float kj = k[j * 128 + d]; akk += k[i * 128 + d] * kj; aqk += q[i * 128 + d] * kj; }
                const float dec = __expf(gc[i] - gc[j]); akk *= beta[i] * dec; aqk *= dec; }
            Am[idx] = j < i ? akk : 0.f; oQK[idx] = f2bf(j <= i ? aqk : 0.f);
        }
        __syncthreads();
        if (tid < 64) { const int c = tid;
            for (int i = 0; i < 64; ++i) { float s = (i == c) ? 1.f : 0.f; for (int j = c; j < i; ++j) s -= Am[i * 64 + j] * Tm[j * 64 + c]; Tm[i * 64 + c] = (i >= c) ? s : 0.f; } }
        __syncthreads();
        bf16_t *oNW = NW + (size_t)cu * 8192, *oU = UU + (size_t)cu * 8192, *oQD = QD + (size_t)cu * 8192, *oKDT = KDT + (size_t)cu * 8192;
        const float gl = gc[63];
        for (int idx = tid; idx < 8192; idx += 512) {
            const int i = idx >> 7, d = idx & 127; float su = 0.f, sw = 0.f;
            for (int j = 0; j <= i; ++j) { const float t = Tm[i * 64 + j] * beta[j]; su += t * v[j * 128 + d]; sw += t * __expf(gc[j]) * k[j * 128 + d]; }
            oU[d * 64 + i] = f2bf(su); oNW[idx] = f2bf(-sw);
            oQD[idx] = f2bf(q[idx] * __expf(gc[i]));
            oKDT[d * 64 + i] = f2bf(k[idx] * __expf(gl - gc[i]));
        }
        if (tid == 0) GL[cu] = __expf(gl);
        __syncthreads();
    }
}

typedef short bf16x8_t __attribute__((ext_vector_type(8)));
typedef unsigned u32x2_t __attribute__((ext_vector_type(2)));
typedef unsigned u32x4_t __attribute__((ext_vector_type(4)));
__device__ __forceinline__ u32x2_t pack4bf(f32x4 v) { u32x2_t r; r.x = pg8::cvt_pk_bf16(v[0], v[1]); r.y = pg8::cvt_pk_bf16(v[2], v[3]); return r; }

constexpr int QS_LD = 272, KT_LD = 144, AM_LD = 68;
constexpr int L_QS = 0, L_KS = 17408, L_KT = 34816, L_VT = 53248, L_AM = 71680, L_TM = 89088, L_TB = 106496, L_TW = 115712, L_XS = 124928;
static_assert(L_XS + 3 * 1152 <= RING_BYTES, "chunk-prep LDS map");
__device__ __forceinline__ void p2_chunk_prep_fast(Frame& F, const Args& a) {
    const bf16_t* QKV = (const bf16_t*)(a.ws + WS_QKV); const float* BA = (const float*)(a.ws + WS_BA);
    const float *conv_w = a.in[4], *A_log = a.in[5], *dt_bias = a.in[6];
    bf16_t *NW = (bf16_t*)(a.ws + WS_CH_NW), *UT = (bf16_t*)(a.ws + WS_CH_U), *QD = (bf16_t*)(a.ws + WS_CH_QD), *KDT = (bf16_t*)(a.ws + WS_CH_KDT), *QK = (bf16_t*)(a.ws + WS_CH_QK);
    float* GL = (float*)(a.ws + WS_CH_GL);
    LAS unsigned char* L = F.lds + RING_OFF;
    LAS float *Am = (LAS float*)(L + L_AM), *Tm = (LAS float*)(L + L_TM);
    LAS float *beta = (LAS float*)(F.lds + XTRA_OFF), *gc = beta + 64;
    const int tid = F.tid, lane = F.lane, w = F.wave, fr = lane & 15, fq = lane >> 4;
    for (int cu = F.vcu; cu < NUNITS; cu += F.G) {
        const int n = cu % NCH, bh = cu / NCH, h = bh % NH, b = bh / NH, p0 = CHUNK * n - PADF;
#pragma unroll 1
        for (int it = 0; it < 6; ++it) {
            const int item = tid + 512 * it, which = it >> 1, i = (item >> 4) & 63, d8 = (item & 15) * 8, col = which * 2048 + h * HD + d8, p = p0 + i;
            float v[8];
#pragma unroll
            for (int j = 0; j < 8; ++j) v[j] = 0.f;
            if (p >= 0) {
#pragma unroll
                for (int kk = 0; kk < 4; ++kk) { const int pp = p - 3 + kk;
                    if (pp >= 0) { pg8::f32x4 x0, x1; pg8::unpack8(*(const pg8::u32x4*)(QKV + (size_t)ext_row(b, pp) * 6144 + col), x0, x1);
                        const f32x4 w0 = *(const f32x4*)(conv_w + kk * 6144 + col), w1 = *(const f32x4*)(conv_w + kk * 6144 + col + 4);
#pragma unroll
                        for (int j = 0; j < 4; ++j) { v[j] += w0[j] * x0[j]; v[4 + j] += w1[j] * x1[j]; } } }
#pragma unroll
                for (int j = 0; j < 8; ++j) v[j] = siluf_(v[j]);
            }
            if (which < 2) { float ss = 0.f;
#pragma unroll
                for (int j = 0; j < 8; ++j) ss += v[j] * v[j];
                ss += __shfl_xor(ss, 1); ss += __shfl_xor(ss, 2); ss += __shfl_xor(ss, 4); ss += __shfl_xor(ss, 8);
                const float rs = rsqrtf(ss + EPS) * (which == 0 ? 0.08838834764831845f : 1.f);
#pragma unroll
                for (int j = 0; j < 8; ++j) v[j] *= rs; }
            const pg8::u32x4 pk = pg8::pack8((f32x4){v[0], v[1], v[2], v[3]}, (f32x4){v[4], v[5], v[6], v[7]});
            if (which < 2) *(LAS pg8::u32x4*)(L + (which == 0 ? L_QS : L_KS) + i * QS_LD + d8 * 2) = pk;
            if (which >= 1) { LAS unsigned char* T = L + (which == 1 ? L_KT : L_VT) + i * 2;
                const unsigned pw[4] = {pk.x, pk.y, pk.z, pk.w};
#pragma unroll
                for (int j = 0; j < 4; ++j) { *(LAS bf16_t*)(T + (d8 + 2 * j) * KT_LD) = (bf16_t)(pw[j] & 0xffffu); *(LAS bf16_t*)(T + (d8 + 2 * j + 1) * KT_LD) = (bf16_t)(pw[j] >> 16); } }
        }
        if (w == 7) {
            const int p = p0 + lane; float be = 0.f, g = 0.f;
            if (p >= 0) { const int r = ext_row(b, p); be = sigmoidf_(BA[(size_t)r * 32 + h]); g = -__expf(A_log[h]) * softplusf_(BA[(size_t)r * 32 + 16 + h] + dt_bias[h]); }
#pragma unroll
            for (int o = 1; o < 64; o <<= 1) { const float t = __shfl_up(g, o); if (lane >= o) g += t; }
            beta[lane] = be; gc[lane] = g;
        }
        __syncthreads();
        const float gl = gc[63];
        {
            const int kind = w >> 2, ti = w & 3;
            bf16x8_t af[4];
#pragma unroll
            for (int ks = 0; ks < 4; ++ks) af[ks] = *(const LAS bf16x8_t*)(L + L_KS + (16 * ti + fr) * QS_LD + (32 * ks + 8 * fq) * 2);
            bf16_t* oQK = QK + (size_t)cu * 4096;
#pragma unroll
            for (int tj = 0; tj < 4; ++tj) {
                if (kind == 0) {
                    if (tj > ti) continue;
                    f32x4 acc = (f32x4){0.f, 0.f, 0.f, 0.f};
#pragma unroll
                    for (int ks = 0; ks < 4; ++ks) acc = __builtin_amdgcn_mfma_f32_16x16x32_bf16(af[ks], *(const LAS bf16x8_t*)(L + L_KS + (16 * tj + fr) * QS_LD + (32 * ks + 8 * fq) * 2), acc, 0, 0, 0);
                    const int j = 16 * tj + fr; const float gj = gc[j];
#pragma unroll
                    for (int r = 0; r < 4; ++r) { const int i = 16 * ti + 4 * fq + r; Am[i * AM_LD + j] = j < i ? acc[r] * beta[i] * __expf(gc[i] - gj) : 0.f; }
                } else {
                    const int i = 16 * tj + fr; u32x2_t o = (u32x2_t){0u, 0u};
                    if (tj >= ti) {
                        f32x4 acc = (f32x4){0.f, 0.f, 0.f, 0.f};
#pragma unroll
                        for (int ks = 0; ks < 4; ++ks) acc = __builtin_amdgcn_mfma_f32_16x16x32_bf16(af[ks], *(const LAS bf16x8_t*)(L + L_QS + (16 * tj + fr) * QS_LD + (32 * ks + 8 * fq) * 2), acc, 0, 0, 0);
                        const float gi = gc[i];
#pragma unroll
                        for (int r = 0; r < 4; ++r) { const int j = 16 * ti + 4 * fq + r; acc[r] = j <= i ? acc[r] * __expf(gi - gc[j]) : 0.f; }
                        o = pack4bf(acc);
                    }
                    *(u32x2_t*)(oQK + i * 64 + 16 * ti + 4 * fq) = o;
                }
            }
        }
        __syncthreads();
        if (w == 0) {
            const int ab = fq, c = fr; float t[16];
#pragma unroll
            for (int r = 0; r < 16; ++r) { float s = (r == c) ? 1.f : 0.f;
#pragma unroll
                for (int m4 = 0; m4 < (r + 3) / 4; ++m4) { const f32x4 av = *(const LAS f32x4*)(Am + (16 * ab + r) * AM_LD + 16 * ab + 4 * m4);
#pragma unroll
                    for (int j = 0; j < 4; ++j) if (4 * m4 + j < r) s -= av[j] * t[4 * m4 + j]; }
                t[r] = s; Tm[(16 * ab + r) * AM_LD + 16 * ab + c] = s; }
        } else {
            bf16_t *oQD = QD + (size_t)cu * 8192, *oKDT = KDT + (size_t)cu * 8192;
            for (int idx = tid - 64; idx < 2048; idx += 448) {
                if (idx < 1024) { const int i = idx >> 4, d8 = (idx & 15) * 8; pg8::f32x4 x0, x1; pg8::unpack8(*(const LAS pg8::u32x4*)(L + L_QS + i * QS_LD + d8 * 2), x0, x1);
                    const float e = __expf(gc[i]); *(pg8::u32x4*)(oQD + i * 128 + d8) = pg8::pack8(x0 * e, x1 * e); }
                else { const int id = idx - 1024, d = id >> 3, i8 = (id & 7) * 8; pg8::f32x4 x0, x1; pg8::unpack8(*(const LAS pg8::u32x4*)(L + L_KT + d * KT_LD + i8 * 2), x0, x1);
#pragma unroll
                    for (int j = 0; j < 4; ++j) { x0[j] *= __expf(gl - gc[i8 + j]); x1[j] *= __expf(gl - gc[i8 + 4 + j]); }
                    *(pg8::u32x4*)(oKDT + d * 64 + i8) = pg8::pack8(x0, x1); }
            }
            if (tid == 64) GL[cu] = __expf(gl);
        }
        __syncthreads();
#pragma unroll
        for (int dd = 1; dd < 4; ++dd) {
            if (w < 4 - dd) {
                const int bb = w, ab = w + dd;
                f32x4 acc = (f32x4){0.f, 0.f, 0.f, 0.f};
                for (int c = bb; c < ab; ++c)
#pragma unroll
                    for (int ks = 0; ks < 4; ++ks) acc = __builtin_amdgcn_mfma_f32_16x16x4f32(Am[(16 * ab + fr) * AM_LD + 16 * c + 4 * ks + fq], Tm[(16 * c + 4 * ks + fq) * AM_LD + 16 * bb + fr], acc, 0, 0, 0);
                LAS float* Xs = (LAS float*)(L + L_XS + w * 1152);
#pragma unroll
                for (int r = 0; r < 4; ++r) Xs[(4 * fq + r) * 17 + fr] = acc[r];
                f32x4 acc2 = (f32x4){0.f, 0.f, 0.f, 0.f};
#pragma unroll
                for (int ks = 0; ks < 4; ++ks) acc2 = __builtin_amdgcn_mfma_f32_16x16x4f32(Tm[(16 * ab + fr) * AM_LD + 16 * ab + 4 * ks + fq], Xs[(4 * ks + fq) * 17 + fr], acc2, 0, 0, 0);
#pragma unroll
                for (int r = 0; r < 4; ++r) Tm[(16 * ab + 4 * fq + r) * AM_LD + 16 * bb + fr] = -acc2[r];
            }
            __syncthreads();
        }
        { const int i = tid >> 3, j8 = (tid & 7) * 8; f32x4 t0 = *(const LAS f32x4*)(Tm + i * AM_LD + j8), t1 = *(const LAS f32x4*)(Tm + i * AM_LD + j8 + 4); f32x4 b0, b1, w0, w1;
#pragma unroll
            for (int j = 0; j < 4; ++j) { const int ja = j8 + j, jb = j8 + 4 + j; const float ba = beta[ja], bb = beta[jb];
                b0[j] = ja <= i ? t0[j] * ba : 0.f; b1[j] = jb <= i ? t1[j] * bb : 0.f; w0[j] = b0[j] * __expf(gc[ja]); w1[j] = b1[j] * __expf(gc[jb]); }
            *(LAS pg8::u32x4*)(L + L_TB + i * KT_LD + j8 * 2) = pg8::pack8(b0, b1); *(LAS pg8::u32x4*)(L + L_TW + i * KT_LD + j8 * 2) = pg8::pack8(w0, w1); }
        __syncthreads();
        {
            bf16_t *oU = UT + (size_t)cu * 8192, *oNW = NW + (size_t)cu * 8192;
            bf16x8_t vf[2], kf[2];
#pragma unroll
            for (int ks = 0; ks < 2; ++ks) { vf[ks] = *(const LAS bf16x8_t*)(L + L_VT + (16 * w + fr) * KT_LD + (32 * ks + 8 * fq) * 2); kf[ks] = *(const LAS bf16x8_t*)(L + L_KT + (16 * w + fr) * KT_LD + (32 * ks + 8 * fq) * 2); }
#pragma unroll
            for (int mi = 0; mi < 4; ++mi) {
                f32x4 au = (f32x4){0.f, 0.f, 0.f, 0.f}, aw = (f32x4){0.f, 0.f, 0.f, 0.f};
#pragma unroll
                for (int ks = 0; ks < 2; ++ks) {
                    au = __builtin_amdgcn_mfma_f32_16x16x32_bf16(*(const LAS bf16x8_t*)(L + L_TB + (16 * mi + fr) * KT_LD + (32 * ks + 8 * fq) * 2), vf[ks], au, 0, 0, 0);
                    aw = __builtin_amdgcn_mfma_f32_16x16x32_bf16(kf[ks], *(const LAS bf16x8_t*)(L + L_TW + (16 * mi + fr) * KT_LD + (32 * ks + 8 * fq) * 2), aw, 0, 0, 0);
                }
                *(u32x2_t*)(oU + (16 * w + fr) * 64 + 16 * mi + 4 * fq) = pack4bf(au);
                *(u32x2_t*)(oNW + (16 * mi + fr) * 128 + 16 * w + 4 * fq) = pack4bf(-aw);
            }
        }
        __syncthreads();
    }
}

__device__ __forceinline__ void p3_scan_simple(Frame& F, const Args& a) {
    const bf16_t *NW = (const bf16_t*)(a.ws + WS_CH_NW), *UU = (const bf16_t*)(a.ws + WS_CH_U), *QD = (const bf16_t*)(a.ws + WS_CH_QD), *KDT = (const bf16_t*)(a.ws + WS_CH_KDT), *QK = (const bf16_t*)(a.ws + WS_CH_QK);
    const float* GL = (const float*)(a.ws + WS_CH_GL); bf16_t* O = (bf16_t*)(a.ws + WS_O);
    LAS float* sm = (LAS float*)(F.lds + RING_OFF);
    LAS float *nw = sm, *qd = sm + 8192, *kd = sm + 16384, *vn = sm + 24576;
    const int tid = F.tid, e = (tid >> 6) * 32 + (tid & 31), half = (tid >> 5) & 1, db = 64 * half; const bool act = tid < 256;
    for (int bh = F.vcu; bh < NB * NH; bh += F.G) {
        const int h = bh % NH, b = bh / NH;
        float S[64];
#pragma unroll
        for (int d = 0; d < 64; ++d) S[d] = 0.f;
        for (int n = 0; n < NCH; ++n) {
            const int cu = bh * NCH + n;
            for (int idx = tid; idx < 8192; idx += 512) { nw[idx] = bf2f(NW[(size_t)cu * 8192 + idx]); qd[idx] = bf2f(QD[(size_t)cu * 8192 + idx]);
                const int d = idx >> 6, i = idx & 63; kd[i * 128 + d] = bf2f(KDT[(size_t)cu * 8192 + idx]); }
            __syncthreads();
            const float gl = GL[cu];
            if (act) for (int i = 0; i < 64; ++i) { float s = 0.f;
#pragma unroll
                for (int d = 0; d < 64; ++d) s += nw[i * 128 + db + d] * S[d];
                s += __shfl_xor(s, 32); s += bf2f(UU[(size_t)cu * 8192 + e * 64 + i]);
                if (half == 0) vn[i * 128 + e] = s; }
            __syncthreads();
            if (act) {
                if (n > 0) for (int i = 0; i < 64; ++i) { float s = 0.f;
#pragma unroll
                    for (int d = 0; d < 64; ++d) s += qd[i * 128 + db + d] * S[d];
                    s += __shfl_xor(s, 32);
                    for (int j = 0; j <= i; ++j) s += bf2f(QK[(size_t)cu * 4096 + i * 64 + j]) * vn[j * 128 + e];
                    if (half == 0) O[(size_t)(b * SEQ + 64 * (n - 1) + i) * DNW + h * HD + e] = f2bf(s); }
#pragma unroll
                for (int d = 0; d < 64; ++d) S[d] *= gl;
                for (int i = 0; i < 64; ++i) { const float vi = vn[i * 128 + e];
#pragma unroll
                    for (int d = 0; d < 64; ++d) S[d] += kd[i * 128 + db + d] * vi; }
            }
            __syncthreads();
        }
    }
}


struct ScanOps { bf16x8_t a[4], x[2], kd[2]; float gl; };
constexpr int ST_LD = 272, VT_LD = 144;
__device__ __forceinline__ void p3_scan_fast(Frame& F, const Args& a) {
    const bf16_t *NW = (const bf16_t*)(a.ws + WS_CH_NW), *UT = (const bf16_t*)(a.ws + WS_CH_U), *QD = (const bf16_t*)(a.ws + WS_CH_QD), *KDT = (const bf16_t*)(a.ws + WS_CH_KDT), *QK = (const bf16_t*)(a.ws + WS_CH_QK);
    const float* GL = (const float*)(a.ws + WS_CH_GL); bf16_t* O = (bf16_t*)(a.ws + WS_O);
    LAS unsigned char* ST = F.lds + RING_OFF; LAS unsigned char* VT = ST + 32 * ST_LD;
    const int w = F.wave, lane = F.lane, fr = lane & 15, fq = lane >> 4, mt = w & 3; const bool vw = w < 4;
    for (int unit = F.vcu; unit < NB * NH * 4; unit += F.G) {
        const int bh = unit >> 2, s = unit & 3, h = bh % NH, b = bh / NH;
        f32x4 accS[2] = {(f32x4){0.f, 0.f, 0.f, 0.f}, (f32x4){0.f, 0.f, 0.f, 0.f}};
        for (int i = F.tid; i < 32 * ST_LD / 4; i += 512) ((LAS unsigned*)ST)[i] = 0u;
        __syncthreads();
        const bf16_t* Asrc = (vw ? NW : QD) + (16 * mt + fr) * 128 + 8 * fq;
        const bf16_t* Ksrc = KDT + (16 * w + fr) * 64 + 8 * fq;
        const bf16_t* Xsrc = vw ? UT + (32 * s + fr) * 64 + 16 * mt + 8 * (fq >> 1) : QK + (16 * mt + fr) * 64 + 8 * fq;
        const size_t xstride = vw ? 8192 : 4096; const int xstep = vw ? 16 * 64 : 32; const bool hiq = (fq & 1) != 0;
#define SCAN_LOAD(ops, n_) do { const size_t cu_ = (size_t)(bh * NCH + (n_)); \
        _Pragma("unroll") for (int ks = 0; ks < 4; ++ks) (ops).a[ks] = *(const bf16x8_t*)(Asrc + cu_ * 8192 + 32 * ks); \
        _Pragma("unroll") for (int ks = 0; ks < 2; ++ks) (ops).kd[ks] = *(const bf16x8_t*)(Ksrc + cu_ * 8192 + 32 * ks); \
        (ops).x[0] = *(const bf16x8_t*)(Xsrc + cu_ * xstride); (ops).x[1] = *(const bf16x8_t*)(Xsrc + cu_ * xstride + xstep); \
        (ops).gl = GL[cu_]; } while (0)
#define SCAN_STEP(ops, n_) do { \
        f32x4 acc[2]; \
        _Pragma("unroll") for (int n2 = 0; n2 < 2; ++n2) { const unsigned u0_ = hiq ? (unsigned)__builtin_bit_cast(u32x4_t, (ops).x[n2]).z : (unsigned)__builtin_bit_cast(u32x4_t, (ops).x[n2]).x, u1_ = hiq ? (unsigned)__builtin_bit_cast(u32x4_t, (ops).x[n2]).w : (unsigned)__builtin_bit_cast(u32x4_t, (ops).x[n2]).y; \
            acc[n2] = vw ? (f32x4){__uint_as_float(u0_ << 16), __uint_as_float(u0_ & 0xffff0000u), __uint_as_float(u1_ << 16), __uint_as_float(u1_ & 0xffff0000u)} : (f32x4){0.f, 0.f, 0.f, 0.f}; } \
        _Pragma("unroll") for (int ks = 0; ks < 4; ++ks) _Pragma("unroll") for (int n2 = 0; n2 < 2; ++n2) \
            acc[n2] = __builtin_amdgcn_mfma_f32_16x16x32_bf16((ops).a[ks], *(const LAS bf16x8_t*)(ST + (16 * n2 + fr) * ST_LD + (32 * ks + 8 * fq) * 2), acc[n2], 0, 0, 0); \
        if (vw) { _Pragma("unroll") for (int n2 = 0; n2 < 2; ++n2) *(LAS u32x2_t*)(VT + (16 * n2 + fr) * VT_LD + (16 * mt + 4 * fq) * 2) = pack4bf(acc[n2]); } \
        __syncthreads(); \
        bf16x8_t bV[2][2]; \
        _Pragma("unroll") for (int n2 = 0; n2 < 2; ++n2) _Pragma("unroll") for (int ks = 0; ks < 2; ++ks) bV[n2][ks] = *(const LAS bf16x8_t*)(VT + (16 * n2 + fr) * VT_LD + (32 * ks + 8 * fq) * 2); \
        if (!vw) { _Pragma("unroll") for (int n2 = 0; n2 < 2; ++n2) _Pragma("unroll") for (int ks = 0; ks < 2; ++ks) acc[n2] = __builtin_amdgcn_mfma_f32_16x16x32_bf16((ops).x[ks], bV[n2][ks], acc[n2], 0, 0, 0); \
            if ((n_) > 0) { bf16_t* op = O + (size_t)(b * SEQ + 64 * ((n_) - 1) + 16 * mt + 4 * fq) * DNW + h * HD + 32 * s + fr; \
                _Pragma("unroll") for (int n2 = 0; n2 < 2; ++n2) _Pragma("unroll") for (int r = 0; r < 4; ++r) op[(size_t)r * DNW + 16 * n2] = f2bf(acc[n2][r]); } } \
        _Pragma("unroll") for (int n2 = 0; n2 < 2; ++n2) { accS[n2] = accS[n2] * (ops).gl; \
            _Pragma("unroll") for (int ks = 0; ks < 2; ++ks) accS[n2] = __builtin_amdgcn_mfma_f32_16x16x32_bf16((ops).kd[ks], bV[n2][ks], accS[n2], 0, 0, 0); \
            *(LAS u32x2_t*)(ST + (16 * n2 + fr) * ST_LD + (16 * w + 4 * fq) * 2) = pack4bf(accS[n2]); } \
        __syncthreads(); } while (0)
        constexpr int PF = 4; unsigned dummy = 0u, tA = 0u, tB = 0u, tC = 0u; const unsigned char* tbase; size_t tstride;
        { const int t = F.tid;
          if (t < 112) { const int q = 112 * s + t;
              if (q < 128) { tbase = a.ws + WS_CH_NW + (size_t)q * 128; tstride = 16384; } else if (q < 256) { tbase = a.ws + WS_CH_QD + (size_t)(q - 128) * 128; tstride = 16384; }
              else if (q < 384) { tbase = a.ws + WS_CH_KDT + (size_t)(q - 256) * 128; tstride = 16384; } else { tbase = a.ws + WS_CH_QK + (size_t)(q - 384) * 128; tstride = 8192; } }
          else { tbase = a.ws + WS_CH_U + (size_t)s * 4096 + (size_t)((t - 112) & 31) * 128; tstride = 16384; } }
        const bool toucher = F.tid < 144;
#define SCAN_TOUCH(n_, tv) do { dummy += tv; if (toucher && (n_) + PF < NCH) tv = *(const volatile unsigned*)(tbase + (size_t)(bh * NCH + (n_) + PF) * tstride); } while (0)
        if (toucher) { _Pragma("unroll") for (int c = 2; c < PF; ++c) dummy += *(const volatile unsigned*)(tbase + (size_t)(bh * NCH + c) * tstride); }
        ScanOps opA, opB, opC;
        SCAN_LOAD(opA, 0); SCAN_LOAD(opB, 1);
        for (int n = 0; n < NCH; n += 3) {
            SCAN_LOAD(opC, n + 2); SCAN_TOUCH(n, tA); SCAN_STEP(opA, n);
            if (n + 3 < NCH) SCAN_LOAD(opA, n + 3); SCAN_TOUCH(n + 1, tB); SCAN_STEP(opB, n + 1);
            if (n + 4 < NCH) SCAN_LOAD(opB, n + 4); SCAN_TOUCH(n + 2, tC); SCAN_STEP(opC, n + 2);
        }
        if (dummy + tA + tB + tC == 0x9e3779b9u) ((float*)(a.ws + WS_CTL))[1024] = 1.f;
#undef SCAN_TOUCH
#undef SCAN_LOAD
#undef SCAN_STEP
    }
}

__device__ __forceinline__ void p3b_gnorm(Frame& F, const Args& a) {
    const bf16_t *O = (const bf16_t*)(a.ws + WS_O), *SZD = (const bf16_t*)(a.ws + WS_SZD); bf16_t* Y = (bf16_t*)(a.ws + WS_Y); const float* w = a.in[9];
    const int gw = F.vcu * NWAVES + F.wave, NGW = F.G * NWAVES, lane = F.lane;
    const float w0 = w[2 * lane], w1 = w[2 * lane + 1];
    for (int it = gw; it < MTOK * NH; it += NGW) {
        const size_t base = (size_t)(it >> 4) * DNW + (it & 15) * HD + 2 * lane, yb = (size_t)(it >> 4) * YLD + 1024 + (it & 15) * HD + 2 * lane;
        const unsigned ov = *(const unsigned*)(O + base), zv = *(const unsigned*)(SZD + base);
        const float a0 = __uint_as_float(ov << 16), a1 = __uint_as_float(ov & 0xffff0000u);
        const float rs = rsqrtf(wave_sum(a0 * a0 + a1 * a1) * (1.f / HD) + EPS);
        *(unsigned*)(Y + yb) = pk2(a0 * rs * w0 * __uint_as_float(zv << 16), a1 * rs * w1 * __uint_as_float(zv & 0xffff0000u));
    }
}

__device__ __forceinline__ void p6_final(Frame& F, const Args& a) {
    const float* w = a.in[13]; float* out = a.out;
    const int gw = F.vcu * NWAVES + F.wave, NGW = F.G * NWAVES;
    for (int r = gw; r < MTOK; r += NGW) {
        float* row = out + (size_t)r * DM;
        f32x4 v[8]; float s = 0.f;
#pragma unroll
        for (int j = 0; j < 8; ++j) { v[j] = *(const f32x4*)(row + 4 * F.lane + 256 * j); s += (v[j].x * v[j].x + v[j].y * v[j].y) + (v[j].z * v[j].z + v[j].w * v[j].w); }
        const float rs = rsqrtf(wave_sum(s) * (1.f / DM) + EPS);
#pragma unroll
        for (int j = 0; j < 8; ++j) { const f32x4 ww = *(const f32x4*)(w + 4 * F.lane + 256 * j); *(f32x4*)(row + 4 * F.lane + 256 * j) = v[j] * rs * ww; }
    }
}

struct PoolMixOrder {
    int G, c;
    __device__ bool next(int i, pg8::Unit& u) const { const int L = i * G + c; if (L >= 128) return false; u.pm = L >> 2; u.pn = L & 3; u.aoff = (L & 3) * 256; u.boff = 0; u.nt = 4; u.mode = 0; return true; }
};
struct MergeOrder {
    pg8::StaticOrder so;
    __device__ bool next(int i, pg8::Unit& u) const { if (!so.next(i >> 1, u)) return false; if ((i & 1) == 0) { u.nt = 16; u.mode = 0; } else { u.aoff = 1024; u.boff = 1024; u.nt = 32; u.mode = 1; } return true; }
};

constexpr int NPHASE = 8;
__global__ void __launch_bounds__(NWAVES * 64, 2) mega_fwd(Args args) {
    extern __shared__ __attribute__((aligned(16))) unsigned char lds[];
    Frame F;
    F.lds = (LAS unsigned char*)lds;
    F.tid = threadIdx.x; F.lane = F.tid & 63; F.wave = __builtin_amdgcn_readfirstlane(F.tid >> 6);
    F.G = gridDim.x; { const int bx = blockIdx.x; F.vcu = (F.G % 8 == 0) ? (bx % 8) * (F.G / 8) + bx / 8 : bx; }
    unsigned char* ws = args.ws;
    for (int u = F.tid; u < (LDS_BYTES - LDSCTL_OFF) / 4; u += NWAVES * 64) ((LAS unsigned*)(F.lds + LDSCTL_OFF))[u] = 0u;
    __syncthreads();
    const int lo = args.ph_lo, hi = args.ph_hi;
    XcdBarrier bar; bar.bar = (unsigned*)(ws + WS_CTL) + CW_BAR; bar.x = 0; bar.st = nullptr;
    if (hi - lo > 1 || DUP_MASK) bar = xcd_barrier_post((unsigned*)(ws + WS_CTL) + CW_BAR, (volatile LAS unsigned*)(F.lds + MISC_OFF) + 8);
#define DUP(k) ((DUP_MASK >> (k)) & 1)
#define PHASE(k, ...) do { if (lo <= (k) && (k) < hi) { __VA_ARGS__ if (DUP(k)) { xcd_barrier(bar); __VA_ARGS__ } if ((k) + 1 < hi) xcd_barrier(bar); } } while (0)
    PHASE(0, p0_prologue(F, args););
    PHASE(1, {
        pg8::Gemm g{(const bf16_t*)(ws + WS_XN), (const bf16_t*)(ws + WS_WINT), DM, DM}; pg8::StaticOrder S; S.init(MPAD / 256, NPAD1 / 256, DM / 64, F.G, (int)blockIdx.x);
        pg8::EpiProj E{(bf16_t*)(ws + WS_U), (bf16_t*)(ws + WS_SZP), (bf16_t*)(ws + WS_QKV), (bf16_t*)(ws + WS_SZD), (bf16_t*)(ws + WS_GATES), (float*)(ws + WS_BA)};
        pg8::gemm_phase<pg8::EpiProj, pg8::StaticOrder, true>(F.lds + RING_OFF, g, S, E); });
    PHASE(2, p2_pool(F, args); if (SIMPLE_PREP) p2_chunk_prep_simple(F, args); else p2_chunk_prep_fast(F, args););
    PHASE(3, if (SIMPLE_SCAN) p3_scan_simple(F, args); else p3_scan_fast(F, args););
    PHASE(4, {
        p3b_gnorm(F, args);
        pg8::Gemm g{(const bf16_t*)(ws + WS_POOLED), (const bf16_t*)(ws + WS_MIXT), PW, PGD}; PoolMixOrder S{F.G, F.vcu};
        pg8::EpiPoolMix E{(bf16_t*)(ws + WS_Y), (const bf16_t*)(ws + WS_SZP), args.in[8]};
        pg8::gemm_phase<pg8::EpiPoolMix, PoolMixOrder, false>(F.lds + RING_OFF, g, S, E); });
    PHASE(5, {
        pg8::Gemm g{(const bf16_t*)(ws + WS_Y), (const bf16_t*)(ws + WS_W2T), YLD, YLD}; MergeOrder S; S.so.init(MTOK / 256, DM / 256, 0, F.G, (int)blockIdx.x);
        pg8::EpiMerge E{(const bf16_t*)(ws + WS_GATES), (bf16_t*)(ws + WS_MERGED)};
        pg8::gemm_phase<pg8::EpiMerge, MergeOrder, false>(F.lds + RING_OFF, g, S, E); });
    PHASE(6, {
        pg8::Gemm g{(const bf16_t*)(ws + WS_MERGED), (const bf16_t*)(ws + WS_WOT), DM, DM}; pg8::StaticOrder S; S.init(MTOK / 256, DM / 256, DM / 64, F.G, (int)blockIdx.x);
        pg8::EpiResid E{args.in[0], args.out};
        pg8::gemm_phase<pg8::EpiResid, pg8::StaticOrder, false>(F.lds + RING_OFF, g, S, E); });
    PHASE(7, p6_final(F, args););
#undef PHASE
#undef DUP
}
#ifndef MIX
#define MIX 0
#endif
#ifndef NAIVE_MASK
#define NAIVE_MASK 0
#endif
#ifndef FUSE
#define FUSE 1
#endif
extern "C" void kernel_launch(void* const* d_in, const int* in_sizes, int n_in, void* d_out, int out_size, void* d_ws, size_t ws_size, hipStream_t stream) {
    static int grid = 0;
    if (grid == 0) {
        if (n_in != 14 || in_sizes[0] != MTOK * DM || out_size != MTOK * DM || ws_size < WS_END) { fprintf(stderr, "kernel_launch: unexpected shapes / workspace (%zu < %zu); nothing launched\n", ws_size, (size_t)WS_END); grid = -1; return; }
        int dev = 0, cus = 0;
        if (hipGetDevice(&dev) != hipSuccess || hipDeviceGetAttribute(&cus, hipDeviceAttributeMultiprocessorCount, dev) != hipSuccess) { grid = -1; return; }
        if (hipFuncSetAttribute((const void*)mega_fwd, hipFuncAttributeMaxDynamicSharedMemorySize, LDS_BYTES) != hipSuccess) { fprintf(stderr, "kernel_launch: hipFuncSetAttribute failed\n"); grid = -1; return; }
#if MIX
        if (hipFuncSetAttribute((const void*)nv_chunk_prep, hipFuncAttributeMaxDynamicSharedMemorySize, 140 * 1024) != hipSuccess) { grid = -1; return; }
#endif
        (void)hipGetLastError();
        grid = cus;
    }
    if (grid < 0) return;
    if (hipMemsetAsync((char*)d_ws + WS_CTL, 0, CTL_ZERO_BYTES, stream) != hipSuccess) return;
    Args a{};
    for (int i = 0; i < 14; ++i) a.in[i] = (const float*)d_in[i];
    a.out = (float*)d_out; a.ws = (unsigned char*)d_ws;
#if !MIX
    a.ph_lo = 0; a.ph_hi = NPHASE;
    hipLaunchKernelGGL(mega_fwd, dim3(grid), dim3(NWAVES * 64), LDS_BYTES, stream, a);
#else
    const float *x = a.in[0], *meta = a.in[1], *norm_w = a.in[2], *w_in = a.in[3], *conv_w = a.in[4], *A_log = a.in[5], *dt_bias = a.in[6], *pool_mix = a.in[7], *pool_scale = a.in[8],
                *dn_norm_w = a.in[9], *w_pool_out = a.in[10], *w_dn_out = a.in[11], *w_o = a.in[12], *final_norm_w = a.in[13];
    unsigned char* ws = (unsigned char*)d_ws; float* out = (float*)d_out;
    bf16_t *XN = (bf16_t*)(ws + WS_XN), *U = (bf16_t*)(ws + WS_U), *SZP = (bf16_t*)(ws + WS_SZP), *QKV = (bf16_t*)(ws + WS_QKV), *SZD = (bf16_t*)(ws + WS_SZD), *GATES = (bf16_t*)(ws + WS_GATES);
    float* BA = (float*)(ws + WS_BA);
    bf16_t *Y = (bf16_t*)(ws + WS_Y), *PO = (bf16_t*)(ws + WS_POOLED), *O = (bf16_t*)(ws + WS_O), *MG = (bf16_t*)(ws + WS_MERGED);
    bf16_t *cNW = (bf16_t*)(ws + WS_CH_NW), *cU = (bf16_t*)(ws + WS_CH_U), *cQD = (bf16_t*)(ws + WS_CH_QD), *cKDT = (bf16_t*)(ws + WS_CH_KDT), *cQK = (bf16_t*)(ws + WS_CH_QK);
    float* cGL = (float*)(ws + WS_CH_GL);
    int s = 0;
    while (s < NPHASE) {
        if (!((NAIVE_MASK >> s) & 1)) {
            int e = s + 1;
            if (FUSE) while (e < NPHASE && !((NAIVE_MASK >> e) & 1)) ++e;
            a.ph_lo = s; a.ph_hi = e;
            hipLaunchKernelGGL(mega_fwd, dim3(grid), dim3(NWAVES * 64), LDS_BYTES, stream, a);
            s = e; continue;
        }
        switch (s) {
        case 0: nv_prep<<<1024, 256, 0, stream>>>(x, meta, norm_w, XN); break;
        case 1: nv_gemm<EpiProj><<<dim3((INC + 127) / 128, (MROWS + 127) / 128), 256, 0, stream>>>(XN, DM, w_in, INC, MROWS, INC, DM, EpiProj{U, SZP, QKV, SZD, GATES, BA}); break;
        case 2: nv_pool<<<MTOK * PW / 256, 256, 0, stream>>>(U, PO);
                nv_chunk_prep<<<NUNITS, 256, 140 * 1024, stream>>>(QKV, BA, conv_w, A_log, dt_bias, cNW, cU, cQD, cKDT, cQK, cGL); break;
        case 3: nv_chunk_scan<<<NB * NH, 128, 0, stream>>>(cNW, cU, cQD, cKDT, cQK, cGL, O); break;
        case 4: nv_gnorm<<<MTOK * NH / 4, 256, 0, stream>>>(O, SZD, dn_norm_w, Y);
                for (int g = 0; g < 4; ++g)
                    nv_gemm<EpiPool><<<dim3(2, MTOK / 128), 256, 0, stream>>>(PO + g * PGD, PW, pool_mix + (size_t)g * PGD * PGD, PGD, MTOK, PGD, PGD, EpiPool{Y, SZP, pool_scale, g, 0});
                break;
        case 5: nv_gemm<EpiG2a><<<dim3(DM / 128, MTOK / 128), 256, 0, stream>>>(Y, YLD, w_pool_out, DM, MTOK, DM, PW, EpiG2a{out, GATES});
                nv_gemm<EpiG2b><<<dim3(DM / 128, MTOK / 128), 256, 0, stream>>>(Y + 1024, YLD, w_dn_out, DM, MTOK, DM, DNW, EpiG2b{out, GATES, MG}); break;
        case 6: nv_gemm<EpiG3><<<dim3(DM / 128, MTOK / 128), 256, 0, stream>>>(MG, DM, w_o, DM, MTOK, DM, DM, EpiG3{x, out}); break;
        case 7: nv_final<<<MTOK, 256, 0, stream>>>(out, final_norm_w); break;
        }
        ++s;
    }
#endif
}
```

```cpp
#define MIX 0
#include <hip/hip_runtime.h>
#include <cstdint>
#include <cstdio>

typedef unsigned short bf16_t;
__device__ __forceinline__ float bf2f(bf16_t v) { return __uint_as_float(((unsigned)v) << 16); }
__device__ __forceinline__ bf16_t f2bf(float f) { unsigned u = __float_as_uint(f); return (bf16_t)((u + 0x7fffu + ((u >> 16) & 1u)) >> 16); }
__device__ __forceinline__ float sigmoidf_(float x) { return 1.f / (1.f + __expf(-x)); }
__device__ __forceinline__ float siluf_(float x) { return x / (1.f + __expf(-x)); }
__device__ __forceinline__ float softplusf_(float x) { return x > 20.f ? x : log1pf(__expf(x)); }

constexpr int DM = 2048, NB = 4, SEQ = 2048, NMETA = 16, LEXT = SEQ + NMETA;
constexpr int PW = 1024, PGD = 256, NH = 16, HD = 128, DNW = 2048, CHUNK = 64, NCH = 33, PADF = 48;
constexpr int INC = 14368;
constexpr int C_U = 0, C_ZP = 1024, C_Q = 2048, C_ZD = 8192, C_B = 10240, C_GP = 10272;
constexpr int MTOK = NB * SEQ;
constexpr int MROWS = MTOK + NMETA;
constexpr int MPAD = 8448;
constexpr int NPAD1 = 14592;
constexpr int YLD = 3072;
constexpr float EPS = 1e-6f;
constexpr int NUNITS = NB * NH * NCH;

constexpr size_t MiB = 1u << 20;
constexpr size_t WS_CTL = 0, CTL_ZERO_BYTES = 1 * MiB;
constexpr size_t WS_CH = 1 * MiB;
constexpr size_t CH_ARR = (size_t)NUNITS * 8192 * 2;
constexpr size_t WS_CH_NW = WS_CH, WS_CH_U = WS_CH + CH_ARR, WS_CH_QD = WS_CH + 2 * CH_ARR, WS_CH_KDT = WS_CH + 3 * CH_ARR, WS_CH_QK = WS_CH + 4 * CH_ARR;
constexpr size_t WS_CH_GL = WS_CH_QK + (size_t)NUNITS * 4096 * 2;
constexpr size_t WS_WINT = WS_CH;
constexpr size_t WS_XN = WS_CH + 57 * MiB;
constexpr size_t WS_W2T = 150 * MiB;
constexpr size_t WS_WOT = 162 * MiB;
constexpr size_t WS_MIXT = 170 * MiB;
constexpr size_t WS_U = 171 * MiB;
constexpr size_t WS_SZP = WS_U + (size_t)MPAD * 1024 * 2;
constexpr size_t WS_QKV = WS_SZP + (size_t)MPAD * 1024 * 2;
constexpr size_t WS_BA = 303 * MiB;
constexpr size_t WS_O = 204 * MiB, WS_Y = 236 * MiB, WS_MERGED = 204 * MiB;
constexpr size_t WS_SZD = 304 * MiB + 512 * 1024;
constexpr size_t WS_GATES = WS_SZD + (size_t)MPAD * 2048 * 2;
constexpr size_t WS_POOLED = WS_GATES + (size_t)MPAD * 4096 * 2;
constexpr size_t WS_END = WS_POOLED + (size_t)MTOK * 1024 * 2;
static_assert(WS_CH_GL + NUNITS * 4 <= WS_W2T, "chunk arrays");
static_assert(WS_XN + (size_t)MPAD * 2048 * 2 <= WS_W2T, "xn");
static_assert(WS_QKV == 204 * MiB && WS_QKV + (size_t)MPAD * 6144 * 2 <= WS_BA, "qkv");
static_assert(WS_Y + (size_t)MTOK * YLD * 2 <= WS_BA, "y");
static_assert(WS_BA + (size_t)MPAD * 32 * 4 <= WS_SZD, "ba");
static_assert(WS_END <= 449 * MiB, "ws");

__device__ __forceinline__ int ext_row(int b, int p) { return p < NMETA ? MTOK + p : b * SEQ + (p - NMETA); }

__device__ __forceinline__ float wave_sum(float v) {
#pragma unroll
    for (int o = 1; o < 64; o <<= 1) v += __shfl_xor(v, o);
    return v;
}
#if MIX
__global__ void __launch_bounds__(256) nv_prep(const float* __restrict__ x, const float* __restrict__ meta, const float* __restrict__ nw, bf16_t* __restrict__ XN) {
    const int lane = threadIdx.x & 63, gw = (blockIdx.x * 256 + threadIdx.x) >> 6, ngw = gridDim.x * 4;
    for (int r = gw; r < MPAD; r += ngw) {
        bf16_t* o = XN + (size_t)r * DM;
        if (r >= MROWS) { for (int j = lane; j < DM; j += 64) o[j] = 0; continue; }
        const float* src = r < MTOK ? x + (size_t)r * DM : meta + (size_t)(r - MTOK) * DM;
        float v[32]; float s = 0.f;
#pragma unroll
        for (int j = 0; j < 32; ++j) { v[j] = src[lane + 64 * j]; s += v[j] * v[j]; }
        const float rs = rsqrtf(wave_sum(s) * (1.f / DM) + EPS);
#pragma unroll
        for (int j = 0; j < 32; ++j) o[lane + 64 * j] = f2bf(v[j] * rs * nw[lane + 64 * j]);
    }
}

template <class Epi>
__global__ void __launch_bounds__(256) nv_gemm(const bf16_t* __restrict__ A, int lda, const float* __restrict__ W, int ldw, int M, int N, int K, Epi epi) {
    __shared__ __attribute__((aligned(16))) float As[16][132];
    __shared__ __attribute__((aligned(16))) float Bs[16][132];
    const int tid = threadIdx.x, tx = tid & 15, ty = tid >> 4;
    const int m0 = blockIdx.y * 128, n0 = blockIdx.x * 128;
    float acc[8][8];
#pragma unroll
    for (int i = 0; i < 8; ++i)
#pragma unroll
        for (int j = 0; j < 8; ++j) acc[i][j] = 0.f;
    for (int k0 = 0; k0 < K; k0 += 16) {
        {
            const int r = tid >> 1, kc = (tid & 1) * 8, gm = m0 + r;
            uint4 v = make_uint4(0, 0, 0, 0);
            if (gm < M) v = *(const uint4*)(A + (size_t)gm * lda + k0 + kc);
            const unsigned w[4] = {v.x, v.y, v.z, v.w};
#pragma unroll
            for (int j = 0; j < 4; ++j) { As[kc + 2 * j][r] = __uint_as_float(w[j] << 16); As[kc + 2 * j + 1][r] = __uint_as_float(w[j] & 0xffff0000u); }
        }
        {
            const int kk = tid >> 4, nc = (tid & 15) * 8, gn = n0 + nc;
            float4 v0 = make_float4(0, 0, 0, 0), v1 = v0;
            if (gn < N) { const float* p = W + (size_t)(k0 + kk) * ldw + gn; v0 = *(const float4*)p; v1 = *(const float4*)(p + 4); }
            *(float4*)&Bs[kk][nc] = v0; *(float4*)&Bs[kk][nc + 4] = v1;
        }
        __syncthreads();
#pragma unroll
        for (int kk = 0; kk < 16; ++kk) {
            float a[8], b[8];
            *(float4*)&a[0] = *(const float4*)&As[kk][ty * 8]; *(float4*)&a[4] = *(const float4*)&As[kk][ty * 8 + 4];
            *(float4*)&b[0] = *(const float4*)&Bs[kk][tx * 8]; *(float4*)&b[4] = *(const float4*)&Bs[kk][tx * 8 + 4];
#pragma unroll
            for (int i = 0; i < 8; ++i)
#pragma unroll
                for (int j = 0; j < 8; ++j) acc[i][j] += a[i] * b[j];
        }
        __syncthreads();
    }
#pragma unroll
    for (int i = 0; i < 8; ++i)
#pragma unroll
        for (int j = 0; j < 8; ++j) { const int gm = m0 + ty * 8 + i, gn = n0 + tx * 8 + j; if (gm < M && gn < N) epi(gm, gn, acc[i][j]); }
}

struct EpiProj {
    bf16_t *U, *SZP, *QKV, *SZD, *GATES; float* BA;
    __device__ __forceinline__ void operator()(int m, int n, float v) const {
        if (n < C_ZP) U[(size_t)m * 1024 + n] = f2bf(v);
        else if (n < C_Q) SZP[(size_t)m * 1024 + (n - C_ZP)] = f2bf(siluf_(v));
        else if (n < C_ZD) QKV[(size_t)m * 6144 + (n - C_Q)] = f2bf(v);
        else if (n < C_B) SZD[(size_t)m * 2048 + (n - C_ZD)] = f2bf(siluf_(v));
        else if (n < C_GP) BA[(size_t)m * 32 + (n - C_B)] = v;
        else GATES[(size_t)m * 4096 + (n - C_GP)] = f2bf(sigmoidf_(v));
    }
};
struct EpiPool {
    bf16_t* Y; const bf16_t* SZP; const float* scale; int g, pad;
    __device__ __forceinline__ void operator()(int m, int n, float v) const {
        const int c = g * PGD + n; Y[(size_t)m * YLD + c] = f2bf(v * scale[c] * bf2f(SZP[(size_t)m * 1024 + c]));
    }
};
struct EpiG2a { float* T; const bf16_t* GATES; __device__ __forceinline__ void operator()(int m, int n, float v) const { T[(size_t)m * DM + n] = v * bf2f(GATES[(size_t)m * 4096 + n]); } };
struct EpiG2b { const float* T; const bf16_t* GATES; bf16_t* MG; __device__ __forceinline__ void operator()(int m, int n, float v) const { MG[(size_t)m * DM + n] = f2bf(T[(size_t)m * DM + n] + v * bf2f(GATES[(size_t)m * 4096 + 2048 + n])); } };
struct EpiG3 { const float* x; float* out; __device__ __forceinline__ void operator()(int m, int n, float v) const { out[(size_t)m * DM + n] = x[(size_t)m * DM + n] + v; } };

__global__ void __launch_bounds__(256) nv_pool(const bf16_t* __restrict__ U, bf16_t* __restrict__ PO) {
    const int idx = blockIdx.x * 256 + threadIdx.x; if (idx >= MTOK * PW) return;
    const int m = idx >> 10, c = idx & 1023, b = m >> 11, t = m & 2047, p = t + NMETA, win = 2 << (c >> 8);
    float s = 0.f;
    for (int j = 0; j < win; ++j) { const int pp = p - j; if (pp >= 0) s += bf2f(U[(size_t)ext_row(b, pp) * 1024 + c]); }
    const int cnt = (p + 1) < win ? (p + 1) : win;
    PO[idx] = f2bf(s / (float)cnt - bf2f(U[(size_t)m * 1024 + c]));
}

__global__ void __launch_bounds__(256) nv_chunk_prep(const bf16_t* __restrict__ QKV, const float* __restrict__ BA, const float* __restrict__ conv_w, const float* __restrict__ A_log,
                                                     const float* __restrict__ dt_bias, bf16_t* __restrict__ NW, bf16_t* __restrict__ UU, bf16_t* __restrict__ QD, bf16_t* __restrict__ KDT,
                                                     bf16_t* __restrict__ QK, float* __restrict__ GL) {
    extern __shared__ __attribute__((aligned(16))) float sm[];
    float *q = sm, *k = q + 8192, *v = k + 8192, *Am = v + 8192, *Tm = Am + 4096, *beta = Tm + 4096, *gc = beta + 64;
    const int cu = blockIdx.x, n = cu % NCH, bh = cu / NCH, h = bh % NH, b = bh / NH, tid = threadIdx.x, lane = tid & 63, wv = tid >> 6;
    const int p0 = CHUNK * n - PADF;
    for (int idx = tid; idx < 64 * 384; idx += 256) {
        const int i = idx / 384, c3 = idx % 384, which = c3 >> 7, d = c3 & 127, col = which * 2048 + h * HD + d, p = p0 + i;
        float val = 0.f;
        if (p >= 0) { float a = 0.f;
            for (int kk = 0; kk < 4; ++kk) { const int pp = p - 3 + kk; if (pp >= 0) a += conv_w[kk * 6144 + col] * bf2f(QKV[(size_t)ext_row(b, pp) * 6144 + col]); }
            val = siluf_(a); }
        (which == 0 ? q : which == 1 ? k : v)[i * 128 + d] = val;
    }
    if (tid < 64) { const int p = p0 + tid; float be = 0.f, g = 0.f;
        if (p >= 0) { const int r = ext_row(b, p); be = sigmoidf_(BA[(size_t)r * 32 + h]); g = -__expf(A_log[h]) * softplusf_(BA[(size_t)r * 32 + 16 + h] + dt_bias[h]); }
        beta[tid] = be; gc[tid] = g; }
    __syncthreads();
    if (tid == 0) { float s = 0.f; for (int i = 0; i < 64; ++i) { s += gc[i]; gc[i] = s; } }
    for (int r = wv; r < 128; r += 4) {
        float* row = (r < 64 ? q + r * 128 : k + (r - 64) * 128);
        const float a0 = row[lane], a1 = row[lane + 64];
        const float rs = rsqrtf(wave_sum(a0 * a0 + a1 * a1) + EPS) * (r < 64 ? 0.08838834764831845f : 1.f);
        row[lane] = a0 * rs; row[lane + 64] = a1 * rs;
    }
    __syncthreads();
    bf16_t* oQK = QK + (size_t)cu * 4096;
    for (int idx = tid; idx < 4096; idx += 256) {
        const int i = idx >> 6, j = idx & 63; float akk = 0.f, aqk = 0.f;
        if (j <= i) { for (int d = 0; d < 128; ++d) { const float kj = k[j * 128 + d]; akk += k[i * 128 + d] * kj; aqk += q[i * 128 + d] * kj; }
            const float dec = __expf(gc[i] - gc[j]); akk *= beta[i] * dec; aqk *= dec; }
        Am[idx] = j < i ? akk : 0.f; oQK[idx] = f2bf(j <= i ? aqk : 0.f);
    }
    __syncthreads();
    if (tid < 64) { const int c = tid;
        for (int i = 0; i < 64; ++i) { float s = (i == c) ? 1.f : 0.f; for (int j = c; j < i; ++j) s -= Am[i * 64 + j] * Tm[j * 64 + c]; Tm[i * 64 + c] = (i >= c) ? s : 0.f; } }
    __syncthreads();
    bf16_t *oNW = NW + (size_t)cu * 8192, *oU = UU + (size_t)cu * 8192, *oQD = QD + (size_t)cu * 8192, *oKDT = KDT + (size_t)cu * 8192;
    const float gl = gc[63];
    for (int idx = tid; idx < 8192; idx += 256) {
        const int i = idx >> 7, d = idx & 127; float su = 0.f, sw = 0.f;
        for (int j = 0; j <= i; ++j) { const float t = Tm[i * 64 + j] * beta[j]; su += t * v[j * 128 + d]; sw += t * __expf(gc[j]) * k[j * 128 + d]; }
        oU[idx] = f2bf(su); oNW[idx] = f2bf(-sw);
        oQD[idx] = f2bf(q[idx] * __expf(gc[i]));
        oKDT[d * 64 + i] = f2bf(k[idx] * __expf(gl - gc[i]));
    }
    if (tid == 0) GL[cu] = __expf(gl);
}

__global__ void __launch_bounds__(128) nv_chunk_scan(const bf16_t* __restrict__ NW, const bf16_t* __restrict__ UU, const bf16_t* __restrict__ QD, const bf16_t* __restrict__ KDT,
                                                     const bf16_t* __restrict__ QK, const float* __restrict__ GL, bf16_t* __restrict__ O) {
    __shared__ float vn[64][128];
    const int bh = blockIdx.x, h = bh % NH, b = bh / NH, e = threadIdx.x;
    float S[128];
#pragma unroll
    for (int d = 0; d < 128; ++d) S[d] = 0.f;
    for (int n = 0; n < NCH; ++n) {
        const int cu = bh * NCH + n;
        const bf16_t *nw = NW + (size_t)cu * 8192, *uu = UU + (size_t)cu * 8192, *qd = QD + (size_t)cu * 8192, *kdt = KDT + (size_t)cu * 8192, *qk = QK + (size_t)cu * 4096;
        const float gl = GL[cu];
        for (int i = 0; i < 64; ++i) { float a = bf2f(uu[i * 128 + e]);
#pragma unroll
            for (int d = 0; d < 128; ++d) a += bf2f(nw[i * 128 + d]) * S[d];
            vn[i][e] = a; }
        __syncthreads();
        if (n > 0) for (int i = 0; i < 64; ++i) { float a = 0.f;
#pragma unroll
            for (int d = 0; d < 128; ++d) a += bf2f(qd[i * 128 + d]) * S[d];
            for (int j = 0; j <= i; ++j) a += bf2f(qk[i * 64 + j]) * vn[j][e];
            O[(size_t)(b * SEQ + 64 * (n - 1) + i) * DNW + h * HD + e] = f2bf(a); }
#pragma unroll
        for (int d = 0; d < 128; ++d) { float s = S[d] * gl; for (int i = 0; i < 64; ++i) s += bf2f(kdt[d * 64 + i]) * vn[i][e]; S[d] = s; }
        __syncthreads();
    }
}

__global__ void __launch_bounds__(256) nv_gnorm(const bf16_t* __restrict__ O, const bf16_t* __restrict__ SZD, const float* __restrict__ w, bf16_t* __restrict__ Y) {
    const int lane = threadIdx.x & 63, gw = (blockIdx.x * 256 + threadIdx.x) >> 6; if (gw >= MTOK * NH) return;
    const size_t base = (size_t)(gw >> 4) * DNW + (gw & 15) * HD, yb = (size_t)(gw >> 4) * YLD + 1024 + (gw & 15) * HD;
    const float a0 = bf2f(O[base + lane]), a1 = bf2f(O[base + lane + 64]);
    const float rs = rsqrtf(wave_sum(a0 * a0 + a1 * a1) * (1.f / HD) + EPS);
    Y[yb + lane] = f2bf(a0 * rs * w[lane] * bf2f(SZD[base + lane]));
    Y[yb + lane + 64] = f2bf(a1 * rs * w[lane + 64] * bf2f(SZD[base + lane + 64]));
}

__global__ void __launch_bounds__(256) nv_final(float* __restrict__ out, const float* __restrict__ w) {
    __shared__ float red[4];
    float* row = out + (size_t)blockIdx.x * DM; const int tid = threadIdx.x;
    float v[8]; float s = 0.f;
#pragma unroll
    for (int j = 0; j < 8; ++j) { v[j] = row[tid + 256 * j]; s += v[j] * v[j]; }
    s = wave_sum(s); if ((tid & 63) == 0) red[tid >> 6] = s; __syncthreads();
    const float rs = rsqrtf((red[0] + red[1] + red[2] + red[3]) * (1.f / DM) + EPS);
#pragma unroll
    for (int j = 0; j < 8; ++j) row[tid + 256 * j] = v[j] * rs * w[tid + 256 * j];
}

#endif
namespace pg8 {
#define PG8_LAS __attribute__((address_space(3)))
typedef short bf16x8 __attribute__((ext_vector_type(8)));
typedef float f32x4 __attribute__((ext_vector_type(4)));
typedef unsigned u32x4 __attribute__((ext_vector_type(4)));
constexpr int BM = 256, BK = 64, HALF = 128, HTB = HALF * BK * 2  , STAGE_BYTES = 8 * HTB, NXCD = 8, WGM = 8;

__host__ __device__ __forceinline__ int lds_byte(int r, int c) { const int st = (r >> 4) * 2 + (c >> 5), rr = r & 15, cc = c & 31, ob = rr * 64 + cc * 2; return st * 1024 + (ob ^ (((ob >> 9) & 1) << 5)); }
__host__ __device__ __forceinline__ void stage_rc(int b, int& R, int& C) { const int st = b / 1024, sb = b % 1024, swz = sb ^ (((sb >> 9) & 1) << 5); R = (st >> 1) * 16 + swz / 64; C = (st & 1) * 32 + (swz % 64) / 2; }
__host__ __device__ __forceinline__ int perm32(int rho) { const int n = rho >> 4, i = rho & 15; return 8 * (i >> 2) + 4 * n + (i & 3); }

struct Unit { int pm, pn, aoff, boff, nt, mode; };
struct Gemm { const bf16_t* A; const bf16_t* Bt; int lda, ldb; };

struct StaticOrder {
    int nM, nN, nwg, G, c, nt;
    __device__ void init(int nM_, int nN_, int nt_, int G_, int c_) { nM = nM_; nN = nN_; nwg = nM * nN; G = G_; c = c_; nt = nt_; }
    __device__ bool next(int i, Unit& u) const {
        const long L = (long)i * G + c; if (L >= nwg) return false;
        int wgid = (int)L; { const int q = nwg / NXCD, r = nwg % NXCD, xcd = wgid % NXCD, off = wgid / NXCD; wgid = (xcd < r ? xcd * (q + 1) : r * (q + 1) + (xcd - r) * q) + off; }
        const int nig = WGM * nN, gid = wgid / nig, fm = gid * WGM, gsz = (nM - fm) < WGM ? (nM - fm) : WGM;
        u.pm = fm + ((wgid % nig) % gsz); u.pn = (wgid % nig) / gsz; u.aoff = 0; u.boff = 0; u.nt = nt; u.mode = 0; return true;
    }
};

typedef float f32x2_t __attribute__((ext_vector_type(2))); typedef __bf16 bf16x2_t __attribute__((ext_vector_type(2)));
__device__ __forceinline__ unsigned cvt_pk_bf16(float lo, float hi) { f32x2_t v = {lo, hi}; bf16x2_t b = __builtin_convertvector(v, bf16x2_t); return __builtin_bit_cast(unsigned, b); }
__device__ __forceinline__ u32x4 pack8(f32x4 v0, f32x4 v1) { u32x4 w; w.x = cvt_pk_bf16(v0[0], v0[1]); w.y = cvt_pk_bf16(v0[2], v0[3]); w.z = cvt_pk_bf16(v1[0], v1[1]); w.w = cvt_pk_bf16(v1[2], v1[3]); return w; }
__device__ __forceinline__ void unpack8(u32x4 w, f32x4& v0, f32x4& v1) {
    v0 = (f32x4){__uint_as_float(w.x << 16), __uint_as_float(w.x & 0xffff0000u), __uint_as_float(w.y << 16), __uint_as_float(w.y & 0xffff0000u)};
    v1 = (f32x4){__uint_as_float(w.z << 16), __uint_as_float(w.z & 0xffff0000u), __uint_as_float(w.w << 16), __uint_as_float(w.w & 0xffff0000u)};
}
__device__ __forceinline__ float fast_sigmoid(float x) { return __builtin_amdgcn_rcpf(1.f + __builtin_amdgcn_exp2f(-1.4426950408889634f * x)); }

struct EpiProj {
    static constexpr bool PERM = true;
    bf16_t *U, *SZP, *QKV, *SZD, *GATES; float* BA;
    __device__ __forceinline__ bool reset_after(const Unit&) const { return true; }
    __device__ __forceinline__ void operator()(f32x4 (&acc)[2][2][4][2], const Unit& u, int wr, int wc, int fr, int fq) const {
        const int row0 = u.pm * BM + wr * 64 + fr, pn = u.pn;
        if (pn == 56) {
            if (wc == 0) {
#pragma unroll
                for (int ai = 0; ai < 2; ++ai)
#pragma unroll
                    for (int m = 0; m < 4; ++m) { float* rowp = BA + (size_t)(row0 + ai * HALF + m * 16) * 32 + 8 * fq;
                        *(f32x4*)rowp = acc[ai][0][m][0]; *(f32x4*)(rowp + 4) = acc[ai][0][m][1]; }
            }
            return;
        }
        bf16_t* base; int ld, colt, act;
        if (pn < 4) { base = U; ld = 1024; colt = pn * 256; act = 0; }
        else if (pn < 8) { base = SZP; ld = 1024; colt = (pn - 4) * 256; act = 1; }
        else if (pn < 32) { base = QKV; ld = 6144; colt = (pn - 8) * 256; act = 0; }
        else if (pn < 40) { base = SZD; ld = 2048; colt = (pn - 32) * 256; act = 1; }
        else { base = GATES; ld = 4096; colt = (pn - 40) * 256; act = 2; }
        const int col0 = colt + wc * 32 + 8 * fq;
#pragma unroll
        for (int ai = 0; ai < 2; ++ai)
#pragma unroll
            for (int m = 0; m < 4; ++m) { bf16_t* rowp = base + (size_t)(row0 + ai * HALF + m * 16) * ld + col0;
#pragma unroll
                for (int bj = 0; bj < 2; ++bj) { f32x4 v0 = acc[ai][bj][m][0], v1 = acc[ai][bj][m][1];
                    if (act != 0) {
#pragma unroll
                        for (int j = 0; j < 4; ++j) { const float s0 = fast_sigmoid(v0[j]), s1 = fast_sigmoid(v1[j]); v0[j] = act == 1 ? v0[j] * s0 : s0; v1[j] = act == 1 ? v1[j] * s1 : s1; }
                    }
                    *(u32x4*)(rowp + bj * HALF) = pack8(v0, v1); } }
    }
};
struct EpiPoolMix {
    static constexpr bool PERM = true;
    bf16_t* Y; const bf16_t* SZP; const float* scale;
    __device__ __forceinline__ bool reset_after(const Unit&) const { return true; }
    __device__ __forceinline__ void operator()(f32x4 (&acc)[2][2][4][2], const Unit& u, int wr, int wc, int fr, int fq) const {
        const int row0 = u.pm * BM + wr * 64 + fr, col0 = u.pn * BM + wc * 32 + 8 * fq;
#pragma unroll
        for (int bj = 0; bj < 2; ++bj) { const f32x4 s0 = *(const f32x4*)(scale + col0 + bj * HALF), s1 = *(const f32x4*)(scale + col0 + bj * HALF + 4);
#pragma unroll
            for (int ai = 0; ai < 2; ++ai)
#pragma unroll
                for (int m = 0; m < 4; ++m) { const size_t r = (size_t)(row0 + ai * HALF + m * 16);
                    f32x4 z0, z1; unpack8(*(const u32x4*)(SZP + r * 1024 + col0 + bj * HALF), z0, z1);
                    *(u32x4*)(Y + r * YLD + col0 + bj * HALF) = pack8(acc[ai][bj][m][0] * s0 * z0, acc[ai][bj][m][1] * s1 * z1); } }
    }
};
struct EpiMerge {
    static constexpr bool PERM = true;
    const bf16_t* GATES; bf16_t* MG;
    __device__ __forceinline__ bool reset_after(const Unit& u) const { return u.mode != 0; }
    __device__ __forceinline__ void operator()(f32x4 (&acc)[2][2][4][2], const Unit& u, int wr, int wc, int fr, int fq) const {
        const int row0 = u.pm * BM + wr * 64 + fr, col0 = u.pn * BM + wc * 32 + 8 * fq;
#pragma unroll
        for (int ai = 0; ai < 2; ++ai)
#pragma unroll
            for (int m = 0; m < 4; ++m) { const size_t r = (size_t)(row0 + ai * HALF + m * 16);
#pragma unroll
                for (int bj = 0; bj < 2; ++bj) {
                    f32x4 d0, d1; unpack8(*(const u32x4*)(GATES + r * 4096 + 2048 + col0 + bj * HALF), d0, d1);
                    if (u.mode == 0) {
                        f32x4 p0, p1; unpack8(*(const u32x4*)(GATES + r * 4096 + col0 + bj * HALF), p0, p1);
#pragma unroll
                        for (int j = 0; j < 4; ++j) { acc[ai][bj][m][0][j] *= p0[j] / fmaxf(d0[j], 1e-30f); acc[ai][bj][m][1][j] *= p1[j] / fmaxf(d1[j], 1e-30f); }
                    } else {
                        *(u32x4*)(MG + r * DM + col0 + bj * HALF) = pack8(acc[ai][bj][m][0] * d0, acc[ai][bj][m][1] * d1);
                    } } }
    }
};
struct EpiResid {
    static constexpr bool PERM = false;
    const float* x; float* out;
    __device__ __forceinline__ bool reset_after(const Unit&) const { return true; }
    __device__ __forceinline__ void operator()(f32x4 (&acc)[2][2][4][2], const Unit& u, int wr, int wc, int fr, int fq) const {
        const int row0 = u.pm * BM + wr * 64 + fr, col0 = u.pn * BM + wc * 32 + 4 * fq;
#pragma unroll
        for (int ai = 0; ai < 2; ++ai)
#pragma unroll
            for (int m = 0; m < 4; ++m) { const size_t off = (size_t)(row0 + ai * HALF + m * 16) * DM + col0;
#pragma unroll
                for (int bj = 0; bj < 2; ++bj)
#pragma unroll
                    for (int n = 0; n < 2; ++n) *(f32x4*)(out + off + bj * HALF + n * 16) = *(const f32x4*)(x + off + bj * HALF + n * 16) + acc[ai][bj][m][n]; }
    }
};

template <class Epi, class Sched, bool ALIGN_EPI>
__device__ __forceinline__ void gemm_phase(PG8_LAS unsigned char* lds, const Gemm g, const Sched& S, const Epi& E) {
    const int tid = threadIdx.x, wid = __builtin_amdgcn_readfirstlane(tid >> 6), lane = tid & 63, wr = wid >> 2, wc = wid & 3, fr = lane & 15, fq = lane >> 4;
    const int lda = g.lda, ldb = g.ldb;
    unsigned voffA[2], voffB[2];
#pragma unroll
    for (int i = 0; i < 2; ++i) { int R, C; stage_rc(tid * 16 + i * 8192, R, C); const int Rb = Epi::PERM ? ((R & ~31) + perm32(R & 31)) : R;
        voffA[i] = (unsigned)(R * lda + C) * 2u; voffB[i] = (unsigned)(Rb * ldb + C) * 2u; }
    const size_t kstep = (size_t)(BK * 2);
    const size_t hstepA = (size_t)HALF * lda * 2, hstepB = (size_t)HALF * ldb * 2;
    const unsigned ldsw = (unsigned)wid * 1024u;
    const int aoff = lds_byte(wr * 64 + fr, fq * 8), boff = lds_byte(wc * 32 + fr, fq * 8);
#define PG8_SA(b, h) (((b) * 2 + (h)) * HTB)
#define PG8_SB(b, h) ((4 + (b) * 2 + (h)) * HTB)
#define PG8_STAGE(bufoff, gbase, voff) do { _Pragma("unroll") for (int _i = 0; _i < 2; ++_i) \
        __builtin_amdgcn_global_load_lds((const unsigned*)((const char*)(gbase) + (voff)[_i]), (PG8_LAS unsigned*)(lds + (bufoff) + ldsw + _i * 8192), 16, 0, 0); } while (0)
#define PG8_LDA(dst, b, h) do { _Pragma("unroll") for (int m = 0; m < 4; ++m) _Pragma("unroll") for (int k = 0; k < 2; ++k) dst[m][k] = *(const PG8_LAS bf16x8*)(lds + PG8_SA(b, h) + aoff + m * 2048 + k * 1024); } while (0)
#define PG8_LDB(dst, b, h) do { _Pragma("unroll") for (int n = 0; n < 2; ++n) _Pragma("unroll") for (int k = 0; k < 2; ++k) dst[n][k] = *(const PG8_LAS bf16x8*)(lds + PG8_SB(b, h) + boff + n * 2048 + k * 1024); } while (0)
#define PG8_MMA(ai, bj, At, Bt) do { __builtin_amdgcn_s_setprio(1); _Pragma("unroll") for (int m = 0; m < 4; ++m) _Pragma("unroll") for (int n = 0; n < 2; ++n) _Pragma("unroll") for (int k = 0; k < 2; ++k) \
        acc[ai][bj][m][n] = __builtin_amdgcn_mfma_f32_16x16x32_bf16(Bt[n][k], At[m][k], acc[ai][bj][m][n], 0, 0, 0); __builtin_amdgcn_s_setprio(0); } while (0)
#define PG8_WAIT_V(n) asm volatile("s_waitcnt vmcnt(" #n ")" ::: "memory")
#define PG8_WAIT_L(n) asm volatile("s_waitcnt lgkmcnt(" #n ")" ::: "memory")
#define PG8_BAR __builtin_amdgcn_s_barrier()
#define PG8_SCHED __builtin_amdgcn_sched_barrier(0)
#define PG8_UA(u) ((const char*)g.A + ((size_t)(u).pm * BM * lda + (u).aoff) * 2)
#define PG8_UB(u) ((const char*)g.Bt + ((size_t)(u).pn * BM * ldb + (u).boff) * 2)
    Unit cur, nxt; int ui = 0;
    if (!S.next(0, cur)) return;
    f32x4 acc[2][2][4][2];
#pragma unroll
    for (int a = 0; a < 2; ++a)
#pragma unroll
        for (int b = 0; b < 2; ++b)
#pragma unroll
            for (int m = 0; m < 4; ++m)
#pragma unroll
                for (int n = 0; n < 2; ++n) acc[a][b][m][n] = (f32x4){0.f, 0.f, 0.f, 0.f};
    bf16x8 At[4][2], B0[2][2], B1[2][2];
    const char* cA = PG8_UA(cur); const char* cB = PG8_UB(cur);
    PG8_STAGE(PG8_SB(0, 0), cB, voffB); PG8_STAGE(PG8_SB(0, 1), cB + hstepB, voffB); PG8_STAGE(PG8_SA(0, 0), cA, voffA); PG8_STAGE(PG8_SA(0, 1), cA + hstepA, voffA);
    if (wr == 1) PG8_BAR;
    PG8_WAIT_V(2); PG8_BAR;
    PG8_STAGE(PG8_SB(1, 0), cB + kstep, voffB); PG8_STAGE(PG8_SA(1, 0), cA + kstep, voffA); PG8_STAGE(PG8_SB(1, 1), cB + hstepB + kstep, voffB);
    PG8_WAIT_V(6); PG8_BAR;
    for (;;) {
        const bool has_next = S.next(ui + 1, nxt);
        const char* nA = has_next ? PG8_UA(nxt) : cA; const char* nB = has_next ? PG8_UB(nxt) : cB;
        const int nt = cur.nt;
        for (int t = 0; t < nt; t += 2) {
            const bool last = (t == nt - 2);
            const char* a1 = cA + (size_t)(t + 1) * kstep;
            const char* a2 = last ? nA : cA + (size_t)(t + 2) * kstep; const char* b2 = last ? nB : cB + (size_t)(t + 2) * kstep;
            const char* a3 = a2 + kstep; const char* b3 = b2 + kstep;
            PG8_LDB(B0, 0, 0); PG8_LDB(B1, 0, 1); PG8_SCHED; PG8_LDA(At, 0, 0); PG8_STAGE(PG8_SA(1, 1), a1 + hstepA, voffA);
            PG8_WAIT_V(8); PG8_WAIT_L(0); PG8_BAR; PG8_MMA(0, 0, At, B0); PG8_MMA(0, 1, At, B1); PG8_BAR; PG8_SCHED;
            PG8_LDA(At, 0, 1); PG8_STAGE(PG8_SB(0, 0), b2, voffB); PG8_STAGE(PG8_SB(0, 1), b2 + hstepB, voffB); PG8_STAGE(PG8_SA(0, 0), a2, voffA);
            PG8_WAIT_V(8); PG8_WAIT_L(0); PG8_BAR; PG8_MMA(1, 0, At, B0); PG8_MMA(1, 1, At, B1); PG8_BAR; PG8_SCHED;
            PG8_LDB(B0, 1, 0); PG8_LDB(B1, 1, 1); PG8_SCHED; PG8_LDA(At, 1, 0); PG8_STAGE(PG8_SA(0, 1), a2 + hstepA, voffA);
            PG8_WAIT_V(8); PG8_WAIT_L(0); PG8_BAR; PG8_MMA(0, 0, At, B0); PG8_MMA(0, 1, At, B1); PG8_BAR; PG8_SCHED;
            PG8_LDA(At, 1, 1); PG8_STAGE(PG8_SB(1, 0), b3, voffB); PG8_STAGE(PG8_SB(1, 1), b3 + hstepB, voffB); PG8_STAGE(PG8_SA(1, 0), a3, voffA);
            PG8_WAIT_V(8); PG8_WAIT_L(0); PG8_BAR; PG8_MMA(1, 0, At, B0); PG8_MMA(1, 1, At, B1); PG8_BAR; PG8_SCHED;
        }
        if constexpr (ALIGN_EPI) { if (wr == 0) PG8_BAR; }
        E(acc, cur, wr, wc, fr, fq);
        if (!has_next) break;
        if (E.reset_after(cur)) {
#pragma unroll
            for (int a = 0; a < 2; ++a)
#pragma unroll
                for (int b = 0; b < 2; ++b)
#pragma unroll
                    for (int m = 0; m < 4; ++m)
#pragma unroll
                        for (int n = 0; n < 2; ++n) acc[a][b][m][n] = (f32x4){0.f, 0.f, 0.f, 0.f};
        }
        cur = nxt; cA = nA; cB = nB; ++ui;
        if constexpr (ALIGN_EPI) { if (wr == 1) PG8_BAR; }
    }
    PG8_WAIT_V(0);
    if constexpr (!ALIGN_EPI) { if (wr == 0) PG8_BAR; }
    PG8_BAR;
#undef PG8_SA
#undef PG8_SB
#undef PG8_STAGE
#undef PG8_LDA
#undef PG8_LDB
#undef PG8_MMA
#undef PG8_WAIT_V
#undef PG8_WAIT_L
#undef PG8_BAR
#undef PG8_SCHED
#undef PG8_UA
#undef PG8_UB
}
}
#ifndef DUP_MASK
#define DUP_MASK 0
#endif
#ifndef SIMPLE_PREP
#define SIMPLE_PREP 0
#endif
#ifndef SIMPLE_SCAN
#define SIMPLE_SCAN 0
#endif
constexpr int NWAVES = 8;
constexpr int RING_OFF = 0, RING_BYTES = 131072;
constexpr int LDSCTL_OFF = RING_BYTES, MISC_OFF = LDSCTL_OFF + 320;
constexpr int XTRA_OFF = RING_BYTES + 1024;
constexpr int LDS_BYTES = 147456;
constexpr int CW_BAR = 4096;

#define GAS __attribute__((address_space(1)))
#define LAS __attribute__((address_space(3)))
typedef unsigned v4u __attribute__((ext_vector_type(4)));
typedef float f32x4 __attribute__((ext_vector_type(4)));
typedef GAS unsigned gu32;
#define LDS_WAIT() asm volatile("s_waitcnt lgkmcnt(0)" ::: "memory")
#define VM_WAIT() asm volatile("s_waitcnt vmcnt(0)" ::: "memory")
__device__ __forceinline__ unsigned pk2(float lo, float hi) { return (unsigned)f2bf(lo) | ((unsigned)f2bf(hi) << 16); }

#define XB_TMO      128
#define XB_XCNT(j)  (256  + 64 * (j))
#define XB_XSUB(j)  (1280 + 64 * (j))
#define XB_XGEN(j)  (2304 + 64 * (j))
#define XB_TOP      3328
#define XB_TOPGEN   3392
#define XCD_BAR_WORDS 3456
#define XB_SPIN_CAP (1u << 18)
__device__ __forceinline__ unsigned xb_ld(unsigned* p)              { return __hip_atomic_load(p, __ATOMIC_RELAXED, __HIP_MEMORY_SCOPE_AGENT); }
__device__ __forceinline__ unsigned xb_add(unsigned* p, unsigned v) { return __hip_atomic_fetch_add(p, v, __ATOMIC_RELAXED, __HIP_MEMORY_SCOPE_AGENT); }
__device__ __forceinline__ unsigned xb_xcc_id() { return (unsigned)__builtin_amdgcn_s_getreg((3 << 11) | 20) & 0xFu; }
#define XB_SPIN(cond, bar) do { unsigned _sp = 0; while (cond) { __builtin_amdgcn_s_sleep(1); \
    if ((++_sp & 255u) == 0u) { if (xb_ld(&(bar)[XB_TMO])) break; if (_sp > XB_SPIN_CAP) { atomicAdd(&(bar)[XB_TMO], 1u); break; } } } } while (0)
struct XcdBarrier { unsigned* bar; unsigned x; volatile LAS unsigned* st; };
__device__ __forceinline__ XcdBarrier xcd_barrier_post(unsigned* bar, volatile LAS unsigned* st) {
    XcdBarrier b; b.bar = bar; b.x = xb_xcc_id(); b.st = st;
    if (threadIdx.x == 0) (void)xb_add(&bar[XB_XCNT(b.x)], 1u);
    return b;
}
__device__ __forceinline__ void xcd_barrier_complete(unsigned* bar, unsigned x, unsigned& nloc, unsigned& nx) {
    const unsigned G = gridDim.x * gridDim.y * gridDim.z;
    unsigned sum, cnt, mine, sp = 0u;
    for (;;) {
        sum = 0u; cnt = 0u; mine = 0u;
#pragma unroll
        for (unsigned j = 0; j < 16; ++j) { const unsigned c = xb_ld(&bar[XB_XCNT(j)]); sum += c; cnt += (c > 0u) ? 1u : 0u; mine = (j == x) ? c : mine; }
        if (sum == G) break;
        __builtin_amdgcn_s_sleep(1);
        if ((++sp & 255u) == 0u) { if (xb_ld(&bar[XB_TMO])) break; if (sp > XB_SPIN_CAP) { atomicAdd(&bar[XB_TMO], 1u); break; } }
    }
    nloc = mine > 0u ? mine : 1u; nx = cnt > 0u ? cnt : 1u;
}
__device__ __forceinline__ void xcd_barrier(const XcdBarrier& b) {
    asm volatile("s_waitcnt vmcnt(0)" ::: "memory");
    __syncthreads();
    if (threadIdx.x == 0) {
        unsigned* bar = b.bar;
        __builtin_amdgcn_s_waitcnt(0);
        unsigned nloc = b.st[0], nx = b.st[1];
        if (nloc == 0u) { xcd_barrier_complete(bar, b.x, nloc, nx); b.st[0] = nloc; b.st[1] = nx; }
        const unsigned old = xb_add(&bar[XB_XSUB(b.x)], 1u);
        const unsigned gen = old / nloc;
        if (old + 1u == (gen + 1u) * nloc) {
            __builtin_amdgcn_fence(__ATOMIC_RELEASE, "agent");
            asm volatile("s_waitcnt vmcnt(0)" ::: "memory");
            const unsigned og = xb_add(&bar[XB_TOP], 1u);
            const unsigned tg = og / nx;
            if (og + 1u == (tg + 1u) * nx) xb_add(&bar[XB_TOPGEN], 1u);
            else XB_SPIN(xb_ld(&bar[XB_TOPGEN]) == tg, bar);
            __builtin_amdgcn_fence(__ATOMIC_ACQUIRE, "agent");
            xb_add(&bar[XB_XGEN(b.x)], 1u);
            asm volatile("s_waitcnt vmcnt(0)" ::: "memory");
        } else {
            XB_SPIN(xb_ld(&bar[XB_XGEN(b.x)]) == gen, bar);
            __builtin_amdgcn_fence(__ATOMIC_ACQUIRE, "agent");
            asm volatile("s_waitcnt vmcnt(0)" ::: "memory");
        }
    }
    __syncthreads();
}

struct Args { const float* in[14]; float* out; unsigned char* ws; int ph_lo, ph_hi; };

struct Frame {
    LAS unsigned char* lds; int tid, lane, wave, vcu, G;
};

__device__ __forceinline__ void p0_transpose_item(const float* __restrict__ W, int N, int k0, int n0, bf16_t* __restrict__ WT, int ldt, int dn0, int koff, LAS float* scr, int lane) {
#pragma unroll 8
    for (int i = 0; i < 32; ++i) { const int kk = 2 * i + (lane >> 5); scr[kk * 33 + (lane & 31)] = W[(size_t)(k0 + kk) * N + n0 + (lane & 31)]; }
    LDS_WAIT(); asm volatile("" ::: "memory");
    const int c = lane & 7;
#pragma unroll
    for (int j = 0; j < 4; ++j) { const int n = (lane >> 3) + 8 * j; const LAS float* s = scr + (8 * c) * 33 + n;
        v4u o; o.x = pk2(s[0 * 33], s[1 * 33]); o.y = pk2(s[2 * 33], s[3 * 33]); o.z = pk2(s[4 * 33], s[5 * 33]); o.w = pk2(s[6 * 33], s[7 * 33]);
        *(v4u*)(WT + (size_t)(dn0 + n) * ldt + koff + k0 + 8 * c) = o; }
    LDS_WAIT(); asm volatile("" ::: "memory");
}
__device__ __forceinline__ void p0_prologue(Frame& F, const Args& a) {
    unsigned char* ws = a.ws;
    bf16_t *WinT = (bf16_t*)(ws + WS_WINT), *W2T = (bf16_t*)(ws + WS_W2T), *WoT = (bf16_t*)(ws + WS_WOT), *MixT = (bf16_t*)(ws + WS_MIXT), *XN = (bf16_t*)(ws + WS_XN);
    LAS float* scr = (LAS float*)(F.lds + RING_OFF + F.wave * 16384);
    const int gw = F.vcu * NWAVES + F.wave, NGW = F.G * NWAVES;
    constexpr int I_IN = (DM / 64) * (INC / 32), I_PO = (PW / 64) * (DM / 32), I_DN = (DNW / 64) * (DM / 32), I_WO = (DM / 64) * (DM / 32), I_MX = 4 * (PGD / 64) * (PGD / 32);
    constexpr int NITEMS = I_IN + I_PO + I_DN + I_WO + I_MX;
    for (int it = gw; it < NITEMS; it += NGW) {
        int r = it;
        if (r < I_IN) { const int nblk = INC / 32, kb = r / nblk, nb = r % nblk, n0 = 32 * nb;
            const int dn0 = n0 < C_B ? n0 : (n0 < C_GP ? 14336 + (n0 - C_B) : n0 - 32);
            p0_transpose_item(a.in[3], INC, 64 * kb, n0, WinT, DM, dn0, 0, scr, F.lane); continue; } r -= I_IN;
        if (r < I_PO) { const int nblk = DM / 32, kb = r / nblk, nb = r % nblk; p0_transpose_item(a.in[10], DM, 64 * kb, 32 * nb, W2T, YLD, 32 * nb, 0, scr, F.lane); continue; } r -= I_PO;
        if (r < I_DN) { const int nblk = DM / 32, kb = r / nblk, nb = r % nblk; p0_transpose_item(a.in[11], DM, 64 * kb, 32 * nb, W2T, YLD, 32 * nb, 1024, scr, F.lane); continue; } r -= I_DN;
        if (r < I_WO) { const int nblk = DM / 32, kb = r / nblk, nb = r % nblk; p0_transpose_item(a.in[12], DM, 64 * kb, 32 * nb, WoT, DM, 32 * nb, 0, scr, F.lane); continue; } r -= I_WO;
        { const int g = r / 32, rr = r % 32, kb = rr / 8, nb = rr % 8;
          p0_transpose_item(a.in[7] + (size_t)g * PGD * PGD, PGD, 64 * kb, 32 * nb, MixT + (size_t)g * PGD * PGD, PGD, 32 * nb, 0, scr, F.lane); }
    }
    const float* nw = a.in[2];
    for (int r = gw; r < MPAD + (NPAD1 - INC); r += NGW) {
        if (r >= MROWS) { bf16_t* o = r < MPAD ? XN + (size_t)r * DM : WinT + (size_t)(INC + (r - MPAD)) * DM;
#pragma unroll
            for (int j = 0; j < 4; ++j) *(v4u*)(o + 8 * F.lane + 512 * j) = (v4u){0u, 0u, 0u, 0u};
            continue; }
        const float* src = r < MTOK ? a.in[0] + (size_t)r * DM : a.in[1] + (size_t)(r - MTOK) * DM;
        f32x4 v[8]; float s = 0.f;
#pragma unroll
        for (int j = 0; j < 8; ++j) { v[j] = *(const f32x4*)(src + 4 * F.lane + 256 * j); s += (v[j].x * v[j].x + v[j].y * v[j].y) + (v[j].z * v[j].z + v[j].w * v[j].w); }
        const float rs = rsqrtf(wave_sum(s) * (1.f / DM) + EPS);
        unsigned long long* o8 = (unsigned long long*)(XN + (size_t)r * DM) + F.lane;
#pragma unroll
        for (int j = 0; j < 8; ++j) { const f32x4 w = *(const f32x4*)(nw + 4 * F.lane + 256 * j);
            o8[64 * j] = (unsigned long long)pk2(v[j].x * rs * w.x, v[j].y * rs * w.y) | ((unsigned long long)pk2(v[j].z * rs * w.z, v[j].w * rs * w.w) << 32); }
    }
}

__device__ __forceinline__ void p2_pool(Frame& F, const Args& a) {
    const bf16_t* U = (const bf16_t*)(a.ws + WS_U); bf16_t* PO = (bf16_t*)(a.ws + WS_POOLED);
    const int gt = F.vcu * 512 + F.tid, NT = F.G * 512;
    for (int idx = gt; idx < MTOK * (PW / 8); idx += NT) {
        const int m = idx >> 7, c8 = (idx & 127) * 8, b = m >> 11, t = m & 2047, p = t + NMETA, win = 2 << (c8 >> 8);
        float s[8];
#pragma unroll
        for (int j = 0; j < 8; ++j) s[j] = 0.f;
        for (int w = 0; w < win; ++w) { const int pp = p - w;
            pg8::f32x4 x0, x1; pg8::unpack8(*(const pg8::u32x4*)(U + (size_t)ext_row(b, pp) * 1024 + c8), x0, x1);
#pragma unroll
            for (int j = 0; j < 4; ++j) { s[j] += x0[j]; s[4 + j] += x1[j]; } }
        pg8::f32x4 u0, u1; pg8::unpack8(*(const pg8::u32x4*)(U + (size_t)m * 1024 + c8), u0, u1);
        const float inv = 1.f / (float)win;
        pg8::f32x4 r0, r1;
#pragma unroll
        for (int j = 0; j < 4; ++j) { r0[j] = s[j] * inv - u0[j]; r1[j] = s[4 + j] * inv - u1[j]; }
        *(pg8::u32x4*)(PO + (size_t)m * 1024 + c8) = pg8::pack8(r0, r1);
    }
}
__device__ __forceinline__ void p2_chunk_prep_simple(Frame& F, const Args& a) {
    const bf16_t* QKV = (const bf16_t*)(a.ws + WS_QKV); const float* BA = (const float*)(a.ws + WS_BA);
    const float *conv_w = a.in[4], *A_log = a.in[5], *dt_bias = a.in[6];
    bf16_t *NW = (bf16_t*)(a.ws + WS_CH_NW), *UU = (bf16_t*)(a.ws + WS_CH_U), *QD = (bf16_t*)(a.ws + WS_CH_QD), *KDT = (bf16_t*)(a.ws + WS_CH_KDT), *QK = (bf16_t*)(a.ws + WS_CH_QK);
    float* GL = (float*)(a.ws + WS_CH_GL);
    LAS float* sm = (LAS float*)(F.lds + RING_OFF);
    LAS float *q = sm, *k = q + 8192, *v = k + 8192, *Am = v + 8192, *Tm = Am + 4096;
    LAS float *beta = (LAS float*)(F.lds + XTRA_OFF), *gc = beta + 64;
    const int tid = F.tid, lane = F.lane, wv = F.wave;
    for (int cu = F.vcu; cu < NUNITS; cu += F.G) {
        const int n = cu % NCH, bh = cu / NCH, h = bh % NH, b = bh / NH, p0 = CHUNK * n - PADF;
        for (int idx = tid; idx < 64 * 384; idx += 512) {
            const int i = idx / 384, c3 = idx % 384, which = c3 >> 7, d = c3 & 127, col = which * 2048 + h * HD + d, p = p0 + i;
            float val = 0.f;
            if (p >= 0) { float s = 0.f;
                for (int kk = 0; kk < 4; ++kk) { const int pp = p - 3 + kk; if (pp >= 0) s += conv_w[kk * 6144 + col] * bf2f(QKV[(size_t)ext_row(b, pp) * 6144 + col]); }
                val = siluf_(s); }
            (which == 0 ? q : which == 1 ? k : v)[i * 128 + d] = val;
        }
        if (tid < 64) { const int p = p0 + tid; float be = 0.f, g = 0.f;
            if (p >= 0) { const int r = ext_row(b, p); be = sigmoidf_(BA[(size_t)r * 32 + h]); g = -__expf(A_log[h]) * softplusf_(BA[(size_t)r * 32 + 16 + h] + dt_bias[h]); }
            beta[tid] = be; gc[tid] = g; }
        __syncthreads();
        if (tid == 0) { float s = 0.f; for (int i = 0; i < 64; ++i) { s += gc[i]; gc[i] = s; } }
        for (int r = wv; r < 128; r += 8) {
            LAS float* row = (r < 64 ? q + r * 128 : k + (r - 64) * 128);
            const float a0 = row[lane], a1 = row[lane + 64];
            const float rs = rsqrtf(wave_sum(a0 * a0 + a1 * a1) + EPS) * (r < 64 ? 0.08838834764831845f : 1.f);
            row[lane] = a0 * rs; row[lane + 64] = a1 * rs;
        }
        __syncthreads();
        bf16_t* oQK = QK + (size_t)cu * 4096;
        for (int idx = tid; idx < 4096; idx += 512) {
            const int i = idx >> 6, j = idx & 63; float akk = 0.f, aqk = 0.f;
            if (j <= i) { for (int d = 0; d < 128; ++d) { const float kj = k[j * 128 + d]; akk += k[i * 128 + d] * kj; aqk += q[i * 128 + d] * kj; }
                const float dec = __expf(gc[i] - gc[j]); akk *= beta[i] * dec; aqk *= dec; }
            Am[idx] = j < i ? akk : 0.f; oQK[idx] = f2bf(j <= i ? aqk : 0.f);
        }
        __syncthreads();
        if (tid < 64) { const int c = tid;
            for (int i = 0; i < 64; ++i) { float s = (i == c) ? 1.f : 0.f; for (int j = c; j < i; ++j) s -= Am[i * 64 + j] * Tm[j * 64 + c]; Tm[i * 64 + c] = (i >= c) ? s : 0.f; } }
        __syncthreads();
        bf16_t *oNW = NW + (size_t)cu * 8192, *oU = UU + (size_t)cu * 8192, *oQD = QD + (size_t)cu * 8192, *oKDT = KDT + (size_t)cu * 8192;
        const float gl = gc[63];
        for (int idx = tid; idx < 8192; idx += 512) {
            const int i = idx >> 7, d = idx & 127; float su = 0.f, sw = 0.f;
            for (int j = 0; j <= i; ++j) { const float t = Tm[i * 64 + j] * beta[j]; su += t * v[j * 128 + d]; sw += t * __expf(gc[j]) * k[j * 128 + d]; }
            oU[d * 64 + i] = f2bf(su); oNW[idx] = f2bf(-sw);
            oQD[idx] = f2bf(q[idx] * __expf(gc[i]));
            oKDT[d * 64 + i] = f2bf(k[idx] * __expf(gl - gc[i]));
        }
        if (tid == 0) GL[cu] = __expf(gl);
        __syncthreads();
    }
}

typedef short bf16x8_t __attribute__((ext_vector_type(8)));
typedef unsigned u32x2_t __attribute__((ext_vector_type(2)));
typedef unsigned u32x4_t __attribute__((ext_vector_type(4)));
__device__ __forceinline__ u32x2_t pack4bf(f32x4 v) { u32x2_t r; r.x = pg8::cvt_pk_bf16(v[0], v[1]); r.y = pg8::cvt_pk_bf16(v[2], v[3]); return r; }

constexpr int QS_LD = 272, KT_LD = 144, AM_LD = 68;
constexpr int L_QS = 0, L_KS = 17408, L_KT = 34816, L_VT = 53248, L_AM = 71680, L_TM = 89088, L_TB = 106496, L_TW = 115712, L_XS = 124928;
static_assert(L_XS + 3 * 1152 <= RING_BYTES, "chunk-prep LDS map");
__device__ __forceinline__ void p2_chunk_prep_fast(Frame& F, const Args& a) {
    const bf16_t* QKV = (const bf16_t*)(a.ws + WS_QKV); const float* BA = (const float*)(a.ws + WS_BA);
    const float *conv_w = a.in[4], *A_log = a.in[5], *dt_bias = a.in[6];
    bf16_t *NW = (bf16_t*)(a.ws + WS_CH_NW), *UT = (bf16_t*)(a.ws + WS_CH_U), *QD = (bf16_t*)(a.ws + WS_CH_QD), *KDT = (bf16_t*)(a.ws + WS_CH_KDT), *QK = (bf16_t*)(a.ws + WS_CH_QK);
    float* GL = (float*)(a.ws + WS_CH_GL);
    LAS unsigned char* L = F.lds + RING_OFF;
    LAS float *Am = (LAS float*)(L + L_AM), *Tm = (LAS float*)(L + L_TM);
    LAS float *beta = (LAS float*)(F.lds + XTRA_OFF), *gc = beta + 64;
    const int tid = F.tid, lane = F.lane, w = F.wave, fr = lane & 15, fq = lane >> 4;
    for (int cu = F.vcu; cu < NUNITS; cu += F.G) {
        const int n = cu % NCH, bh = cu / NCH, h = bh % NH, b = bh / NH, p0 = CHUNK * n - PADF;
#pragma unroll 1
        for (int it = 0; it < 6; ++it) {
            const int item = tid + 512 * it, which = it >> 1, i = (item >> 4) & 63, d8 = (item & 15) * 8, col = which * 2048 + h * HD + d8, p = p0 + i;
            float v[8];
#pragma unroll
            for (int j = 0; j < 8; ++j) v[j] = 0.f;
            if (p >= 0) {
#pragma unroll
                for (int kk = 0; kk < 4; ++kk) { const int pp = p - 3 + kk;
                    if (pp >= 0) { pg8::f32x4 x0, x1; pg8::unpack8(*(const pg8::u32x4*)(QKV + (size_t)ext_row(b, pp) * 6144 + col), x0, x1);
                        const f32x4 w0 = *(const f32x4*)(conv_w + kk * 6144 + col), w1 = *(const f32x4*)(conv_w + kk * 6144 + col + 4);
#pragma unroll
                        for (int j = 0; j < 4; ++j) { v[j] += w0[j] * x0[j]; v[4 + j] += w1[j] * x1[j]; } } }
#pragma unroll
                for (int j = 0; j < 8; ++j) v[j] = siluf_(v[j]);
            }
            if (which < 2) { float ss = 0.f;
#pragma unroll
                for (int j = 0; j < 8; ++j) ss += v[j] * v[j];
                ss += __shfl_xor(ss, 1); ss += __shfl_xor(ss, 2); ss += __shfl_xor(ss, 4); ss += __shfl_xor(ss, 8);
                const float rs = rsqrtf(ss + EPS) * (which == 0 ? 0.08838834764831845f : 1.f);
#pragma unroll
                for (int j = 0; j < 8; ++j) v[j] *= rs; }
            const pg8::u32x4 pk = pg8::pack8((f32x4){v[0], v[1], v[2], v[3]}, (f32x4){v[4], v[5], v[6], v[7]});
            if (which < 2) *(LAS pg8::u32x4*)(L + (which == 0 ? L_QS : L_KS) + i * QS_LD + d8 * 2) = pk;
            if (which >= 1) { LAS unsigned char* T = L + (which == 1 ? L_KT : L_VT) + i * 2;
                const unsigned pw[4] = {pk.x, pk.y, pk.z, pk.w};
#pragma unroll
                for (int j = 0; j < 4; ++j) { *(LAS bf16_t*)(T + (d8 + 2 * j) * KT_LD) = (bf16_t)(pw[j] & 0xffffu); *(LAS bf16_t*)(T + (d8 + 2 * j + 1) * KT_LD) = (bf16_t)(pw[j] >> 16); } }
        }
        if (w == 7) {
            const int p = p0 + lane; float be = 0.f, g = 0.f;
            if (p >= 0) { const int r = ext_row(b, p); be = sigmoidf_(BA[(size_t)r * 32 + h]); g = -__expf(A_log[h]) * softplusf_(BA[(size_t)r * 32 + 16 + h] + dt_bias[h]); }
#pragma unroll
            for (int o = 1; o < 64; o <<= 1) { const float t = __shfl_up(g, o); if (lane >= o) g += t; }
            beta[lane] = be; gc[lane] = g;
        }
        __syncthreads();
        const float gl = gc[63];
        {
            const int kind = w >> 2, ti = w & 3;
            bf16x8_t af[4];
#pragma unroll
            for (int ks = 0; ks < 4; ++ks) af[ks] = *(const LAS bf16x8_t*)(L + L_KS + (16 * ti + fr) * QS_LD + (32 * ks + 8 * fq) * 2);
            bf16_t* oQK = QK + (size_t)cu * 4096;
#pragma unroll
            for (int tj = 0; tj < 4; ++tj) {
                if (kind == 0) {
                    if (tj > ti) continue;
                    f32x4 acc = (f32x4){0.f, 0.f, 0.f, 0.f};
#pragma unroll
                    for (int ks = 0; ks < 4; ++ks) acc = __builtin_amdgcn_mfma_f32_16x16x32_bf16(af[ks], *(const LAS bf16x8_t*)(L + L_KS + (16 * tj + fr) * QS_LD + (32 * ks + 8 * fq) * 2), acc, 0, 0, 0);
                    const int j = 16 * tj + fr; const float gj = gc[j];
#pragma unroll
                    for (int r = 0; r < 4; ++r) { const int i = 16 * ti + 4 * fq + r; Am[i * AM_LD + j] = j < i ? acc[r] * beta[i] * __expf(gc[i] - gj) : 0.f; }
                } else {
                    const int i = 16 * tj + fr; u32x2_t o = (u32x2_t){0u, 0u};
                    if (tj >= ti) {
                        f32x4 acc = (f32x4){0.f, 0.f, 0.f, 0.f};
#pragma unroll
                        for (int ks = 0; ks < 4; ++ks) acc = __builtin_amdgcn_mfma_f32_16x16x32_bf16(af[ks], *(const LAS bf16x8_t*)(L + L_QS + (16 * tj + fr) * QS_LD + (32 * ks + 8 * fq) * 2), acc, 0, 0, 0);
                        const float gi = gc[i];
#pragma unroll
                        for (int r = 0; r < 4; ++r) { const int j = 16 * ti + 4 * fq + r; acc[r] = j <= i ? acc[r] * __expf(gi - gc[j]) : 0.f; }
                        o = pack4bf(acc);
                    }
                    *(u32x2_t*)(oQK + i * 64 + 16 * ti + 4 * fq) = o;
                }
            }
        }
        __syncthreads();
        if (w == 0) {
            const int ab = fq, c = fr; float t[16];
#pragma unroll
            for (int r = 0; r < 16; ++r) { float s = (r == c) ? 1.f : 0.f;
#pragma unroll
                for (int m4 = 0; m4 < (r + 3) / 4; ++m4) { const f32x4 av = *(const LAS f32x4*)(Am + (16 * ab + r) * AM_LD + 16 * ab + 4 * m4);
#pragma unroll
                    for (int j = 0; j < 4; ++j) if (4 * m4 + j < r) s -= av[j] * t[4 * m4 + j]; }
                t[r] = s; Tm[(16 * ab + r) * AM_LD + 16 * ab + c] = s; }
        } else {
            bf16_t *oQD = QD + (size_t)cu * 8192, *oKDT = KDT + (size_t)cu * 8192;
            for (int idx = tid - 64; idx < 2048; idx += 448) {
                if (idx < 1024) { const int i = idx >> 4, d8 = (idx & 15) * 8; pg8::f32x4 x0, x1; pg8::unpack8(*(const LAS pg8::u32x4*)(L + L_QS + i * QS_LD + d8 * 2), x0, x1);
                    const float e = __expf(gc[i]); *(pg8::u32x4*)(oQD + i * 128 + d8) = pg8::pack8(x0 * e, x1 * e); }
                else { const int id = idx - 1024, d = id >> 3, i8 = (id & 7) * 8; pg8::f32x4 x0, x1; pg8::unpack8(*(const LAS pg8::u32x4*)(L + L_KT + d * KT_LD + i8 * 2), x0, x1);
#pragma unroll
                    for (int j = 0; j < 4; ++j) { x0[j] *= __expf(gl - gc[i8 + j]); x1[j] *= __expf(gl - gc[i8 + 4 + j]); }
                    *(pg8::u32x4*)(oKDT + d * 64 + i8) = pg8::pack8(x0, x1); }
            }
            if (tid == 64) GL[cu] = __expf(gl);
        }
        __syncthreads();
#pragma unroll
        for (int dd = 1; dd < 4; ++dd) {
            if (w < 4 - dd) {
                const int bb = w, ab = w + dd;
                f32x4 acc = (f32x4){0.f, 0.f, 0.f, 0.f};
                for (int c = bb; c < ab; ++c)
#pragma unroll
                    for (int ks = 0; ks < 4; ++ks) acc = __builtin_amdgcn_mfma_f32_16x16x4f32(Am[(16 * ab + fr) * AM_LD + 16 * c + 4 * ks + fq], Tm[(16 * c + 4 * ks + fq) * AM_LD + 16 * bb + fr], acc, 0, 0, 0);
                LAS float* Xs = (LAS float*)(L + L_XS + w * 1152);
#pragma unroll
                for (int r = 0; r < 4; ++r) Xs[(4 * fq + r) * 17 + fr] = acc[r];
                f32x4 acc2 = (f32x4){0.f, 0.f, 0.f, 0.f};
#pragma unroll
                for (int ks = 0; ks < 4; ++ks) acc2 = __builtin_amdgcn_mfma_f32_16x16x4f32(Tm[(16 * ab + fr) * AM_LD + 16 * ab + 4 * ks + fq], Xs[(4 * ks + fq) * 17 + fr], acc2, 0, 0, 0);
#pragma unroll
                for (int r = 0; r < 4; ++r) Tm[(16 * ab + 4 * fq + r) * AM_LD + 16 * bb + fr] = -acc2[r];
            }
            __syncthreads();
        }
        { const int i = tid >> 3, j8 = (tid & 7) * 8; f32x4 t0 = *(const LAS f32x4*)(Tm + i * AM_LD + j8), t1 = *(const LAS f32x4*)(Tm + i * AM_LD + j8 + 4); f32x4 b0, b1, w0, w1;
#pragma unroll
            for (int j = 0; j < 4; ++j) { const int ja = j8 + j, jb = j8 + 4 + j; const float ba = beta[ja], bb = beta[jb];
                b0[j] = ja <= i ? t0[j] * ba : 0.f; b1[j] = jb <= i ? t1[j] * bb : 0.f; w0[j] = b0[j] * __expf(gc[ja]); w1[j] = b1[j] * __expf(gc[jb]); }
            *(LAS pg8::u32x4*)(L + L_TB + i * KT_LD + j8 * 2) = pg8::pack8(b0, b1); *(LAS pg8::u32x4*)(L + L_TW + i * KT_LD + j8 * 2) = pg8::pack8(w0, w1); }
        __syncthreads();
        {
            bf16_t *oU = UT + (size_t)cu * 8192, *oNW = NW + (size_t)cu * 8192;
            bf16x8_t vf[2], kf[2];
#pragma unroll
            for (int ks = 0; ks < 2; ++ks) { vf[ks] = *(const LAS bf16x8_t*)(L + L_VT + (16 * w + fr) * KT_LD + (32 * ks + 8 * fq) * 2); kf[ks] = *(const LAS bf16x8_t*)(L + L_KT + (16 * w + fr) * KT_LD + (32 * ks + 8 * fq) * 2); }
#pragma unroll
            for (int mi = 0; mi < 4; ++mi) {
                f32x4 au = (f32x4){0.f, 0.f, 0.f, 0.f}, aw = (f32x4){0.f, 0.f, 0.f, 0.f};
#pragma unroll
                for (int ks = 0; ks < 2; ++ks) {
                    au = __builtin_amdgcn_mfma_f32_16x16x32_bf16(*(const LAS bf16x8_t*)(L + L_TB + (16 * mi + fr) * KT_LD + (32 * ks + 8 * fq) * 2), vf[ks], au, 0, 0, 0);
                    aw = __builtin_amdgcn_mfma_f32_16x16x32_bf16(kf[ks], *(const LAS bf16x8_t*)(L + L_TW + (16 * mi + fr) * KT_LD + (32 * ks + 8 * fq) * 2), aw, 0, 0, 0);
                }
                *(u32x2_t*)(oU + (16 * w + fr) * 64 + 16 * mi + 4 * fq) = pack4bf(au);
                *(u32x2_t*)(oNW + (16 * mi + fr) * 128 + 16 * w + 4 * fq) = pack4bf(-aw);
            }
        }
        __syncthreads();
    }
}

__device__ __forceinline__ void p3_scan_simple(Frame& F, const Args& a) {
    const bf16_t *NW = (const bf16_t*)(a.ws + WS_CH_NW), *UU = (const bf16_t*)(a.ws + WS_CH_U), *QD = (const bf16_t*)(a.ws + WS_CH_QD), *KDT = (const bf16_t*)(a.ws + WS_CH_KDT), *QK = (const bf16_t*)(a.ws + WS_CH_QK);
    const float* GL = (const float*)(a.ws + WS_CH_GL); bf16_t* O = (bf16_t*)(a.ws + WS_O);
    LAS float* sm = (LAS float*)(F.lds + RING_OFF);
    LAS float *nw = sm, *qd = sm + 8192, *kd = sm + 16384, *vn = sm + 24576;
    const int tid = F.tid, e = (tid >> 6) * 32 + (tid & 31), half = (tid >> 5) & 1, db = 64 * half; const bool act = tid < 256;
    for (int bh = F.vcu; bh < NB * NH; bh += F.G) {
        const int h = bh % NH, b = bh / NH;
        float S[64];
#pragma unroll
        for (int d = 0; d < 64; ++d) S[d] = 0.f;
        for (int n = 0; n < NCH; ++n) {
            const int cu = bh * NCH + n;
            for (int idx = tid; idx < 8192; idx += 512) { nw[idx] = bf2f(NW[(size_t)cu * 8192 + idx]); qd[idx] = bf2f(QD[(size_t)cu * 8192 + idx]);
                const int d = idx >> 6, i = idx & 63; kd[i * 128 + d] = bf2f(KDT[(size_t)cu * 8192 + idx]); }
            __syncthreads();
            const float gl = GL[cu];
            if (act) for (int i = 0; i < 64; ++i) { float s = 0.f;
#pragma unroll
                for (int d = 0; d < 64; ++d) s += nw[i * 128 + db + d] * S[d];
                s += __shfl_xor(s, 32); s += bf2f(UU[(size_t)cu * 8192 + e * 64 + i]);
                if (half == 0) vn[i * 128 + e] = s; }
            __syncthreads();
            if (act) {
                if (n > 0) for (int i = 0; i < 64; ++i) { float s = 0.f;
#pragma unroll
                    for (int d = 0; d < 64; ++d) s += qd[i * 128 + db + d] * S[d];
                    s += __shfl_xor(s, 32);
                    for (int j = 0; j <= i; ++j) s += bf2f(QK[(size_t)cu * 4096 + i * 64 + j]) * vn[j * 128 + e];
                    if (half == 0) O[(size_t)(b * SEQ + 64 * (n - 1) + i) * DNW + h * HD + e] = f2bf(s); }
#pragma unroll
                for (int d = 0; d < 64; ++d) S[d] *= gl;
                for (int i = 0; i < 64; ++i) { const float vi = vn[i * 128 + e];
#pragma unroll
                    for (int d = 0; d < 64; ++d) S[d] += kd[i * 128 + db + d] * vi; }
            }
            __syncthreads();
        }
    }
}


struct ScanOps { bf16x8_t a[4], x[2], kd[2]; float gl; };
constexpr int ST_LD = 272, VT_LD = 144;
template <int PROBE>
__device__ __forceinline__ void p3_scan_fast(Frame& F, const Args& a) {
    const bf16_t *NW = (const bf16_t*)(a.ws + WS_CH_NW), *UT = (const bf16_t*)(a.ws + WS_CH_U), *QD = (const bf16_t*)(a.ws + WS_CH_QD), *KDT = (const bf16_t*)(a.ws + WS_CH_KDT), *QK = (const bf16_t*)(a.ws + WS_CH_QK);
    const float* GL = (const float*)(a.ws + WS_CH_GL); bf16_t* O = (bf16_t*)(a.ws + (PROBE ? WS_Y : WS_O));
    LAS unsigned char* ST = F.lds + RING_OFF; LAS unsigned char* VT = ST + 32 * ST_LD;
    const int w = F.wave, lane = F.lane, fr = lane & 15, fq = lane >> 4, mt = w & 3; const bool vw = w < 4;
    for (int unit = F.vcu; unit < NB * NH * 4; unit += F.G) {
        const int bh = unit >> 2, s = unit & 3, h = bh % NH, b = bh / NH;
        f32x4 accS[2] = {(f32x4){0.f, 0.f, 0.f, 0.f}, (f32x4){0.f, 0.f, 0.f, 0.f}};
        for (int i = F.tid; i < 32 * ST_LD / 4; i += 512) ((LAS unsigned*)ST)[i] = 0u;
        __syncthreads();
        const bf16_t* Asrc = (vw ? NW : QD) + (16 * mt + fr) * 128 + 8 * fq;
        const bf16_t* Ksrc = KDT + (16 * w + fr) * 64 + 8 * fq;
        const bf16_t* Xsrc = vw ? UT + (32 * s + fr) * 64 + 16 * mt + 8 * (fq >> 1) : QK + (16 * mt + fr) * 64 + 8 * fq;
        const size_t xstride = vw ? 8192 : 4096; const int xstep = vw ? 16 * 64 : 32; const bool hiq = (fq & 1) != 0;
#define SCAN_LOAD(ops, n_) do { const size_t cu_ = (size_t)(bh * NCH + (PROBE != 0 ? 0 : (n_))); \
        _Pragma("unroll") for (int ks = 0; ks < 4; ++ks) (ops).a[ks] = *(const bf16x8_t*)(Asrc + cu_ * 8192 + 32 * ks); \
        _Pragma("unroll") for (int ks = 0; ks < 2; ++ks) (ops).kd[ks] = *(const bf16x8_t*)(Ksrc + cu_ * 8192 + 32 * ks); \
        (ops).x[0] = *(const bf16x8_t*)(Xsrc + cu_ * xstride); (ops).x[1] = *(const bf16x8_t*)(Xsrc + cu_ * xstride + xstep); \
        (ops).gl = GL[cu_]; } while (0)
#define SCAN_STEP(ops, n_) do { \
        f32x4 acc[2]; \
        _Pragma("unroll") for (int n2 = 0; n2 < 2; ++n2) { const unsigned u0_ = hiq ? (unsigned)__builtin_bit_cast(u32x4_t, (ops).x[n2]).z : (unsigned)__builtin_bit_cast(u32x4_t, (ops).x[n2]).x, u1_ = hiq ? (unsigned)__builtin_bit_cast(u32x4_t, (ops).x[n2]).w : (unsigned)__builtin_bit_cast(u32x4_t, (ops).x[n2]).y; \
            acc[n2] = vw ? (f32x4){__uint_as_float(u0_ << 16), __uint_as_float(u0_ & 0xffff0000u), __uint_as_float(u1_ << 16), __uint_as_float(u1_ & 0xffff0000u)} : (f32x4){0.f, 0.f, 0.f, 0.f}; } \
        _Pragma("unroll") for (int ks = 0; ks < 4; ++ks) _Pragma("unroll") for (int n2 = 0; n2 < 2; ++n2) \
            acc[n2] = __builtin_amdgcn_mfma_f32_16x16x32_bf16((ops).a[ks], *(const LAS bf16x8_t*)(ST + (16 * n2 + fr) * ST_LD + (32 * ks + 8 * fq) * 2), acc[n2], 0, 0, 0); \
        if (vw) { _Pragma("unroll") for (int n2 = 0; n2 < 2; ++n2) *(LAS u32x2_t*)(VT + (16 * n2 + fr) * VT_LD + (16 * mt + 4 * fq) * 2) = pack4bf(acc[n2]); } \
        __syncthreads(); \
        bf16x8_t bV[2][2]; \
        _Pragma("unroll") for (int n2 = 0; n2 < 2; ++n2) _Pragma("unroll") for (int ks = 0; ks < 2; ++ks) bV[n2][ks] = *(const LAS bf16x8_t*)(VT + (16 * n2 + fr) * VT_LD + (32 * ks + 8 * fq) * 2); \
        if (!vw) { _Pragma("unroll") for (int n2 = 0; n2 < 2; ++n2) _Pragma("unroll") for (int ks = 0; ks < 2; ++ks) acc[n2] = __builtin_amdgcn_mfma_f32_16x16x32_bf16((ops).x[ks], bV[n2][ks], acc[n2], 0, 0, 0); \
            if ((n_) > 0 && PROBE != 2) { bf16_t* op = O + (size_t)(b * SEQ + 64 * ((n_) - 1) + 16 * mt + 4 * fq) * DNW + h * HD + 32 * s + fr; \
                _Pragma("unroll") for (int n2 = 0; n2 < 2; ++n2) _Pragma("unroll") for (int r = 0; r < 4; ++r) op[(size_t)r * DNW + 16 * n2] = f2bf(acc[n2][r]); } } \
        _Pragma("unroll") for (int n2 = 0; n2 < 2; ++n2) { accS[n2] = accS[n2] * (ops).gl; \
            _Pragma("unroll") for (int ks = 0; ks < 2; ++ks) accS[n2] = __builtin_amdgcn_mfma_f32_16x16x32_bf16((ops).kd[ks], bV[n2][ks], accS[n2], 0, 0, 0); \
            *(LAS u32x2_t*)(ST + (16 * n2 + fr) * ST_LD + (16 * w + 4 * fq) * 2) = pack4bf(accS[n2]); } \
        __syncthreads(); } while (0)
        ScanOps opA, opB, opC;
        SCAN_LOAD(opA, 0); SCAN_LOAD(opB, 1);
        for (int n = 0; n < NCH; n += 3) {
            SCAN_LOAD(opC, n + 2); SCAN_STEP(opA, n);
            SCAN_LOAD(opA, n + 3 < NCH ? n + 3 : NCH - 1); SCAN_STEP(opB, n + 1);
            SCAN_LOAD(opB, n + 4 < NCH ? n + 4 : NCH - 1); SCAN_STEP(opC, n + 2);
        }
#undef SCAN_LOAD
#undef SCAN_STEP
    }
}

__device__ __forceinline__ void p3b_gnorm(Frame& F, const Args& a) {
    const bf16_t *O = (const bf16_t*)(a.ws + WS_O), *SZD = (const bf16_t*)(a.ws + WS_SZD); bf16_t* Y = (bf16_t*)(a.ws + WS_Y); const float* w = a.in[9];
    const int gw = F.vcu * NWAVES + F.wave, NGW = F.G * NWAVES, lane = F.lane;
    const float w0 = w[2 * lane], w1 = w[2 * lane + 1];
    for (int it = gw; it < MTOK * NH; it += NGW) {
        const size_t base = (size_t)(it >> 4) * DNW + (it & 15) * HD + 2 * lane, yb = (size_t)(it >> 4) * YLD + 1024 + (it & 15) * HD + 2 * lane;
        const unsigned ov = *(const unsigned*)(O + base), zv = *(const unsigned*)(SZD + base);
        const float a0 = __uint_as_float(ov << 16), a1 = __uint_as_float(ov & 0xffff0000u);
        const float rs = rsqrtf(wave_sum(a0 * a0 + a1 * a1) * (1.f / HD) + EPS);
        *(unsigned*)(Y + yb) = pk2(a0 * rs * w0 * __uint_as_float(zv << 16), a1 * rs * w1 * __uint_as_float(zv & 0xffff0000u));
    }
}

__device__ __forceinline__ void p6_final(Frame& F, const Args& a) {
    const float* w = a.in[13]; float* out = a.out;
    const int gw = F.vcu * NWAVES + F.wave, NGW = F.G * NWAVES;
    for (int r = gw; r < MTOK; r += NGW) {
        float* row = out + (size_t)r * DM;
        f32x4 v[8]; float s = 0.f;
#pragma unroll
        for (int j = 0; j < 8; ++j) { v[j] = *(const f32x4*)(row + 4 * F.lane + 256 * j); s += (v[j].x * v[j].x + v[j].y * v[j].y) + (v[j].z * v[j].z + v[j].w * v[j].w); }
        const float rs = rsqrtf(wave_sum(s) * (1.f / DM) + EPS);
#pragma unroll
        for (int j = 0; j < 8; ++j) { const f32x4 ww = *(const f32x4*)(w + 4 * F.lane + 256 * j); *(f32x4*)(row + 4 * F.lane + 256 * j) = v[j] * rs * ww; }
    }
}

struct PoolMixOrder {
    int G, c;
    __device__ bool next(int i, pg8::Unit& u) const { const int L = i * G + c; if (L >= 128) return false; u.pm = L >> 2; u.pn = L & 3; u.aoff = (L & 3) * 256; u.boff = 0; u.nt = 4; u.mode = 0; return true; }
};
struct MergeOrder {
    pg8::StaticOrder so;
    __device__ bool next(int i, pg8::Unit& u) const { if (!so.next(i >> 1, u)) return false; if ((i & 1) == 0) { u.nt = 16; u.mode = 0; } else { u.aoff = 1024; u.boff = 1024; u.nt = 32; u.mode = 1; } return true; }
};

constexpr int NPHASE = 8;
__global__ void __launch_bounds__(NWAVES * 64, 2) mega_fwd(Args args) {
    extern __shared__ __attribute__((aligned(16))) unsigned char lds[];
    Frame F;
    F.lds = (LAS unsigned char*)lds;
    F.tid = threadIdx.x; F.lane = F.tid & 63; F.wave = __builtin_amdgcn_readfirstlane(F.tid >> 6);
    F.G = gridDim.x; { const int bx = blockIdx.x; F.vcu = (F.G % 8 == 0) ? (bx % 8) * (F.G / 8) + bx / 8 : bx; }
    unsigned char* ws = args.ws;
    for (int u = F.tid; u < (LDS_BYTES - LDSCTL_OFF) / 4; u += NWAVES * 64) ((LAS unsigned*)(F.lds + LDSCTL_OFF))[u] = 0u;
    __syncthreads();
    const int lo = args.ph_lo, hi = args.ph_hi;
    XcdBarrier bar; bar.bar = (unsigned*)(ws + WS_CTL) + CW_BAR; bar.x = 0; bar.st = nullptr;
    if (hi - lo > 1 || DUP_MASK) bar = xcd_barrier_post((unsigned*)(ws + WS_CTL) + CW_BAR, (volatile LAS unsigned*)(F.lds + MISC_OFF) + 8);
#define DUP(k) ((DUP_MASK >> (k)) & 1)
#define PHASE(k, ...) do { if (lo <= (k) && (k) < hi) { __VA_ARGS__ if (DUP(k)) { xcd_barrier(bar); __VA_ARGS__ } if ((k) + 1 < hi) xcd_barrier(bar); } } while (0)
    PHASE(0, p0_prologue(F, args););
    PHASE(1, {
        pg8::Gemm g{(const bf16_t*)(ws + WS_XN), (const bf16_t*)(ws + WS_WINT), DM, DM}; pg8::StaticOrder S; S.init(MPAD / 256, NPAD1 / 256, DM / 64, F.G, (int)blockIdx.x);
        pg8::EpiProj E{(bf16_t*)(ws + WS_U), (bf16_t*)(ws + WS_SZP), (bf16_t*)(ws + WS_QKV), (bf16_t*)(ws + WS_SZD), (bf16_t*)(ws + WS_GATES), (float*)(ws + WS_BA)};
        pg8::gemm_phase<pg8::EpiProj, pg8::StaticOrder, true>(F.lds + RING_OFF, g, S, E); });
    PHASE(2, p2_pool(F, args); if (SIMPLE_PREP) p2_chunk_prep_simple(F, args); else p2_chunk_prep_fast(F, args););
    #ifndef SCAN_PROBE
#define SCAN_PROBE 0
#endif
    PHASE(3, if (SIMPLE_SCAN) p3_scan_simple(F, args); else { if (SCAN_PROBE) p3_scan_fast<SCAN_PROBE>(F, args); p3_scan_fast<0>(F, args); });
    PHASE(4, {
        p3b_gnorm(F, args);
        pg8::Gemm g{(const bf16_t*)(ws + WS_POOLED), (const bf16_t*)(ws + WS_MIXT), PW, PGD}; PoolMixOrder S{F.G, F.vcu};
        pg8::EpiPoolMix E{(bf16_t*)(ws + WS_Y), (const bf16_t*)(ws + WS_SZP), args.in[8]};
        pg8::gemm_phase<pg8::EpiPoolMix, PoolMixOrder, false>(F.lds + RING_OFF, g, S, E); });
    PHASE(5, {
        pg8::Gemm g{(const bf16_t*)(ws + WS_Y), (const bf16_t*)(ws + WS_W2T), YLD, YLD}; MergeOrder S; S.so.init(MTOK / 256, DM / 256, 0, F.G, (int)blockIdx.x);
        pg8::EpiMerge E{(const bf16_t*)(ws + WS_GATES), (bf16_t*)(ws + WS_MERGED)};
        pg8::gemm_phase<pg8::EpiMerge, MergeOrder, false>(F.lds + RING_OFF, g, S, E); });
    PHASE(6, {
        pg8::Gemm g{(const bf16_t*)(ws + WS_MERGED), (const bf16_t*)(ws + WS_WOT), DM, DM}; pg8::StaticOrder S; S.init(MTOK / 256, DM / 256, DM / 64, F.G, (int)blockIdx.x);
        pg8::EpiResid E{args.in[0], args.out};
        pg8::gemm_phase<pg8::EpiResid, pg8::StaticOrder, false>(F.lds + RING_OFF, g, S, E); });
    PHASE(7, p6_final(F, args););
#undef PHASE
#undef DUP
}
#ifndef MIX
#define MIX 0
#endif
#ifndef NAIVE_MASK
#define NAIVE_MASK 0
#endif
#ifndef FUSE
#define FUSE 1
#endif
extern "C" void kernel_launch(void* const* d_in, const int* in_sizes, int n_in, void* d_out, int out_size, void* d_ws, size_t ws_size, hipStream_t stream) {
    static int grid = 0;
    if (grid == 0) {
        if (n_in != 14 || in_sizes[0] != MTOK * DM || out_size != MTOK * DM || ws_size < WS_END) { fprintf(stderr, "kernel_launch: unexpected shapes / workspace (%zu < %zu); nothing launched\n", ws_size, (size_t)WS_END); grid = -1; return; }
        int dev = 0, cus = 0;
        if (hipGetDevice(&dev) != hipSuccess || hipDeviceGetAttribute(&cus, hipDeviceAttributeMultiprocessorCount, dev) != hipSuccess) { grid = -1; return; }
        if (hipFuncSetAttribute((const void*)mega_fwd, hipFuncAttributeMaxDynamicSharedMemorySize, LDS_BYTES) != hipSuccess) { fprintf(stderr, "kernel_launch: hipFuncSetAttribute failed\n"); grid = -1; return; }
#if MIX
        if (hipFuncSetAttribute((const void*)nv_chunk_prep, hipFuncAttributeMaxDynamicSharedMemorySize, 140 * 1024) != hipSuccess) { grid = -1; return; }
#endif
        (void)hipGetLastError();
        grid = cus;
    }
    if (grid < 0) return;
    if (hipMemsetAsync((char*)d_ws + WS_CTL, 0, CTL_ZERO_BYTES, stream) != hipSuccess) return;
    Args a{};
    for (int i = 0; i < 14; ++i) a.in[i] = (const float*)d_in[i];
    a.out = (float*)d_out; a.ws = (unsigned char*)d_ws;
#if !MIX
    a.ph_lo = 0; a.ph_hi = NPHASE;
    hipLaunchKernelGGL(mega_fwd, dim3(grid), dim3(NWAVES * 64), LDS_BYTES, stream, a);
#else
    const float *x = a.in[0], *meta = a.in[1], *norm_w = a.in[2], *w_in = a.in[3], *conv_w = a.in[4], *A_log = a.in[5], *dt_bias = a.in[6], *pool_mix = a.in[7], *pool_scale = a.in[8],
                *dn_norm_w = a.in[9], *w_pool_out = a.in[10], *w_dn_out = a.in[11], *w_o = a.in[12], *final_norm_w = a.in[13];
    unsigned char* ws = (unsigned char*)d_ws; float* out = (float*)d_out;
    bf16_t *XN = (bf16_t*)(ws + WS_XN), *U = (bf16_t*)(ws + WS_U), *SZP = (bf16_t*)(ws + WS_SZP), *QKV = (bf16_t*)(ws + WS_QKV), *SZD = (bf16_t*)(ws + WS_SZD), *GATES = (bf16_t*)(ws + WS_GATES);
    float* BA = (float*)(ws + WS_BA);
    bf16_t *Y = (bf16_t*)(ws + WS_Y), *PO = (bf16_t*)(ws + WS_POOLED), *O = (bf16_t*)(ws + WS_O), *MG = (bf16_t*)(ws + WS_MERGED);
    bf16_t *cNW = (bf16_t*)(ws + WS_CH_NW), *cU = (bf16_t*)(ws + WS_CH_U), *cQD = (bf16_t*)(ws + WS_CH_QD), *cKDT = (bf16_t*)(ws + WS_CH_KDT), *cQK = (bf16_t*)(ws + WS_CH_QK);
    float* cGL = (float*)(ws + WS_CH_GL);
    int s = 0;
    while (s < NPHASE) {
        if (!((NAIVE_MASK >> s) & 1)) {
            int e = s + 1;
            if (FUSE) while (e < NPHASE && !((NAIVE_MASK >> e) & 1)) ++e;
            a.ph_lo = s; a.ph_hi = e;
            hipLaunchKernelGGL(mega_fwd, dim3(grid), dim3(NWAVES * 64), LDS_BYTES, stream, a);
            s = e; continue;
        }
        switch (s) {
        case 0: nv_prep<<<1024, 256, 0, stream>>>(x, meta, norm_w, XN); break;
        case 1: nv_gemm<EpiProj><<<dim3((INC + 127) / 128, (MROWS + 127) / 128), 256, 0, stream>>>(XN, DM, w_in, INC, MROWS, INC, DM, EpiProj{U, SZP, QKV, SZD, GATES, BA}); break;
        case 2: nv_pool<<<MTOK * PW / 256, 256, 0, stream>>>(U, PO);
                nv_chunk_prep<<<NUNITS, 256, 140 * 1024, stream>>>(QKV, BA, conv_w, A_log, dt_bias, cNW, cU, cQD, cKDT, cQK, cGL); break;
        case 3: nv_chunk_scan<<<NB * NH, 128, 0, stream>>>(cNW, cU, cQD, cKDT, cQK, cGL, O); break;
        case 4: nv_gnorm<<<MTOK * NH / 4, 256, 0, stream>>>(O, SZD, dn_norm_w, Y);
                for (int g = 0; g < 4; ++g)
                    nv_gemm<EpiPool><<<dim3(2, MTOK / 128), 256, 0, stream>>>(PO + g * PGD, PW, pool_mix + (size_t)g * PGD * PGD, PGD, MTOK, PGD, PGD, EpiPool{Y, SZP, pool_scale, g, 0});
                break;
        case 5: nv_gemm<EpiG2a><<<dim3(DM / 128, MTOK / 128), 256, 0, stream>>>(Y, YLD, w_pool_out, DM, MTOK, DM, PW, EpiG2a{out, GATES});
                nv_gemm<EpiG2b><<<dim3(DM / 128, MTOK / 128), 256, 0, stream>>>(Y + 1024, YLD, w_dn_out, DM, MTOK, DM, DNW, EpiG2b{out, GATES, MG}); break;
        case 6: nv_gemm<EpiG3><<<dim3(DM / 128, MTOK / 128), 256, 0, stream>>>(MG, DM, w_o, DM, MTOK, DM, DM, EpiG3{x, out}); break;
        case 7: nv_final<<<MTOK, 256, 0, stream>>>(out, final_norm_w); break;
        }
        ++s;
    }
#endif
}
```

```cpp
#define MIX 0
#include <hip/hip_runtime.h>
#include <cstdint>
#include <cstdio>

typedef unsigned short bf16_t;
__device__ __forceinline__ float bf2f(bf16_t v) { return __uint_as_float(((unsigned)v) << 16); }
__device__ __forceinline__ bf16_t f2bf(float f) { unsigned u = __float_as_uint(f); return (bf16_t)((u + 0x7fffu + ((u >> 16) & 1u)) >> 16); }
__device__ __forceinline__ float sigmoidf_(float x) { return 1.f / (1.f + __expf(-x)); }
__device__ __forceinline__ float siluf_(float x) { return x / (1.f + __expf(-x)); }
__device__ __forceinline__ float softplusf_(float x) { return x > 20.f ? x : log1pf(__expf(x)); }

constexpr int DM = 2048, NB = 4, SEQ = 2048, NMETA = 16, LEXT = SEQ + NMETA;
constexpr int PW = 1024, PGD = 256, NH = 16, HD = 128, DNW = 2048, CHUNK = 64, NCH = 33, PADF = 48;
constexpr int INC = 14368;
constexpr int C_U = 0, C_ZP = 1024, C_Q = 2048, C_ZD = 8192, C_B = 10240, C_GP = 10272;
constexpr int MTOK = NB * SEQ;
constexpr int MROWS = MTOK + NMETA;
constexpr int MPAD = 8448;
constexpr int NPAD1 = 14592;
constexpr int YLD = 3072;
constexpr float EPS = 1e-6f;
constexpr int NUNITS = NB * NH * NCH;

constexpr size_t MiB = 1u << 20;
constexpr size_t WS_CTL = 0, CTL_ZERO_BYTES = 1 * MiB;
constexpr size_t WS_CH = 1 * MiB;
constexpr size_t CH_ARR = (size_t)NUNITS * 8192 * 2;
constexpr size_t WS_CH_NW = WS_CH, WS_CH_U = WS_CH + CH_ARR, WS_CH_QD = WS_CH + 2 * CH_ARR, WS_CH_KDT = WS_CH + 3 * CH_ARR, WS_CH_QK = WS_CH + 4 * CH_ARR;
constexpr size_t WS_CH_GL = WS_CH_QK + (size_t)NUNITS * 4096 * 2;
constexpr size_t WS_WINT = WS_CH;
constexpr size_t WS_XN = WS_CH + 57 * MiB;
constexpr size_t WS_W2T = 150 * MiB;
constexpr size_t WS_WOT = 162 * MiB;
constexpr size_t WS_MIXT = 170 * MiB;
constexpr size_t WS_U = 171 * MiB;
constexpr size_t WS_SZP = WS_U + (size_t)MPAD * 1024 * 2;
constexpr size_t WS_QKV = WS_SZP + (size_t)MPAD * 1024 * 2;
constexpr size_t WS_BA = 303 * MiB;
constexpr size_t WS_O = 204 * MiB, WS_Y = 236 * MiB, WS_MERGED = 204 * MiB;
constexpr size_t WS_SZD = 304 * MiB + 512 * 1024;
constexpr size_t WS_GATES = WS_SZD + (size_t)MPAD * 2048 * 2;
constexpr size_t WS_POOLED = WS_GATES + (size_t)MPAD * 4096 * 2;
constexpr size_t WS_END = WS_POOLED + (size_t)MTOK * 1024 * 2;
static_assert(WS_CH_GL + NUNITS * 4 <= WS_W2T, "chunk arrays");
static_assert(WS_XN + (size_t)MPAD * 2048 * 2 <= WS_W2T, "xn");
static_assert(WS_QKV == 204 * MiB && WS_QKV + (size_t)MPAD * 6144 * 2 <= WS_BA, "qkv");
static_assert(WS_Y + (size_t)MTOK * YLD * 2 <= WS_BA, "y");
static_assert(WS_BA + (size_t)MPAD * 32 * 4 <= WS_SZD, "ba");
static_assert(WS_END <= 449 * MiB, "ws");

__device__ __forceinline__ int ext_row(int b, int p) { return p < NMETA ? MTOK + p : b * SEQ + (p - NMETA); }

__device__ __forceinline__ float wave_sum(float v) {
#pragma unroll
    for (int o = 1; o < 64; o <<= 1) v += __shfl_xor(v, o);
    return v;
}
#if MIX
__global__ void __launch_bounds__(256) nv_prep(const float* __restrict__ x, const float* __restrict__ meta, const float* __restrict__ nw, bf16_t* __restrict__ XN) {
    const int lane = threadIdx.x & 63, gw = (blockIdx.x * 256 + threadIdx.x) >> 6, ngw = gridDim.x * 4;
    for (int r = gw; r < MPAD; r += ngw) {
        bf16_t* o = XN + (size_t)r * DM;
        if (r >= MROWS) { for (int j = lane; j < DM; j += 64) o[j] = 0; continue; }
        const float* src = r < MTOK ? x + (size_t)r * DM : meta + (size_t)(r - MTOK) * DM;
        float v[32]; float s = 0.f;
#pragma unroll
        for (int j = 0; j < 32; ++j) { v[j] = src[lane + 64 * j]; s += v[j] * v[j]; }
        const float rs = rsqrtf(wave_sum(s) * (1.f / DM) + EPS);
#pragma unroll
        for (int j = 0; j < 32; ++j) o[lane + 64 * j] = f2bf(v[j] * rs * nw[lane + 64 * j]);
    }
}

template <class Epi>
__global__ void __launch_bounds__(256) nv_gemm(const bf16_t* __restrict__ A, int lda, const float* __restrict__ W, int ldw, int M, int N, int K, Epi epi) {
    __shared__ __attribute__((aligned(16))) float As[16][132];
    __shared__ __attribute__((aligned(16))) float Bs[16][132];
    const int tid = threadIdx.x, tx = tid & 15, ty = tid >> 4;
    const int m0 = blockIdx.y * 128, n0 = blockIdx.x * 128;
    float acc[8][8];
#pragma unroll
    for (int i = 0; i < 8; ++i)
#pragma unroll
        for (int j = 0; j < 8; ++j) acc[i][j] = 0.f;
    for (int k0 = 0; k0 < K; k0 += 16) {
        {
            const int r = tid >> 1, kc = (tid & 1) * 8, gm = m0 + r;
            uint4 v = make_uint4(0, 0, 0, 0);
            if (gm < M) v = *(const uint4*)(A + (size_t)gm * lda + k0 + kc);
            const unsigned w[4] = {v.x, v.y, v.z, v.w};
#pragma unroll
            for (int j = 0; j < 4; ++j) { As[kc + 2 * j][r] = __uint_as_float(w[j] << 16); As[kc + 2 * j + 1][r] = __uint_as_float(w[j] & 0xffff0000u); }
        }
        {
            const int kk = tid >> 4, nc = (tid & 15) * 8, gn = n0 + nc;
            float4 v0 = make_float4(0, 0, 0, 0), v1 = v0;
            if (gn < N) { const float* p = W + (size_t)(k0 + kk) * ldw + gn; v0 = *(const float4*)p; v1 = *(const float4*)(p + 4); }
            *(float4*)&Bs[kk][nc] = v0; *(float4*)&Bs[kk][nc + 4] = v1;
        }
        __syncthreads();
#pragma unroll
        for (int kk = 0; kk < 16; ++kk) {
            float a[8], b[8];
            *(float4*)&a[0] = *(const float4*)&As[kk][ty * 8]; *(float4*)&a[4] = *(const float4*)&As[kk][ty * 8 + 4];
            *(float4*)&b[0] = *(const float4*)&Bs[kk][tx * 8]; *(float4*)&b[4] = *(const float4*)&Bs[kk][tx * 8 + 4];
#pragma unroll
            for (int i = 0; i < 8; ++i)
#pragma unroll
                for (int j = 0; j < 8; ++j) acc[i][j] += a[i] * b[j];
        }
        __syncthreads();
    }
#pragma unroll
    for (int i = 0; i < 8; ++i)
#pragma unroll
        for (int j = 0; j < 8; ++j) { const int gm = m0 + ty * 8 + i, gn = n0 + tx * 8 + j; if (gm < M && gn < N) epi(gm, gn, acc[i][j]); }
}

struct EpiProj {
    bf16_t *U, *SZP, *QKV, *SZD, *GATES; float* BA;
    __device__ __forceinline__ void operator()(int m, int n, float v) const {
        if (n < C_ZP) U[(size_t)m * 1024 + n] = f2bf(v);
        else if (n < C_Q) SZP[(size_t)m * 1024 + (n - C_ZP)] = f2bf(siluf_(v));
        else if (n < C_ZD) QKV[(size_t)m * 6144 + (n - C_Q)] = f2bf(v);
        else if (n < C_B) SZD[(size_t)m * 2048 + (n - C_ZD)] = f2bf(siluf_(v));
        else if (n < C_GP) BA[(size_t)m * 32 + (n - C_B)] = v;
        else GATES[(size_t)m * 4096 + (n - C_GP)] = f2bf(sigmoidf_(v));
    }
};
struct EpiPool {
    bf16_t* Y; const bf16_t* SZP; const float* scale; int g, pad;
    __device__ __forceinline__ void operator()(int m, int n, float v) const {
        const int c = g * PGD + n; Y[(size_t)m * YLD + c] = f2bf(v * scale[c] * bf2f(SZP[(size_t)m * 1024 + c]));
    }
};
struct EpiG2a { float* T; const bf16_t* GATES; __device__ __forceinline__ void operator()(int m, int n, float v) const { T[(size_t)m * DM + n] = v * bf2f(GATES[(size_t)m * 4096 + n]); } };
struct EpiG2b { const float* T; const bf16_t* GATES; bf16_t* MG; __device__ __forceinline__ void operator()(int m, int n, float v) const { MG[(size_t)m * DM + n] = f2bf(T[(size_t)m * DM + n] + v * bf2f(GATES[(size_t)m * 4096 + 2048 + n])); } };
struct EpiG3 { const float* x; float* out; __device__ __forceinline__ void operator()(int m, int n, float v) const { out[(size_t)m * DM + n] = x[(size_t)m * DM + n] + v; } };

__global__ void __launch_bounds__(256) nv_pool(const bf16_t* __restrict__ U, bf16_t* __restrict__ PO) {
    const int idx = blockIdx.x * 256 + threadIdx.x; if (idx >= MTOK * PW) return;
    const int m = idx >> 10, c = idx & 1023, b = m >> 11, t = m & 2047, p = t + NMETA, win = 2 << (c >> 8);
    float s = 0.f;
    for (int j = 0; j < win; ++j) { const int pp = p - j; if (pp >= 0) s += bf2f(U[(size_t)ext_row(b, pp) * 1024 + c]); }
    const int cnt = (p + 1) < win ? (p + 1) : win;
    PO[idx] = f2bf(s / (float)cnt - bf2f(U[(size_t)m * 1024 + c]));
}

__global__ void __launch_bounds__(256) nv_chunk_prep(const bf16_t* __restrict__ QKV, const float* __restrict__ BA, const float* __restrict__ conv_w, const float* __restrict__ A_log,
                                                     const float* __restrict__ dt_bias, bf16_t* __restrict__ NW, bf16_t* __restrict__ UU, bf16_t* __restrict__ QD, bf16_t* __restrict__ KDT,
                                                     bf16_t* __restrict__ QK, float* __restrict__ GL) {
    extern __shared__ __attribute__((aligned(16))) float sm[];
    float *q = sm, *k = q + 8192, *v = k + 8192, *Am = v + 8192, *Tm = Am + 4096, *beta = Tm + 4096, *gc = beta + 64;
    const int cu = blockIdx.x, n = cu % NCH, bh = cu / NCH, h = bh % NH, b = bh / NH, tid = threadIdx.x, lane = tid & 63, wv = tid >> 6;
    const int p0 = CHUNK * n - PADF;
    for (int idx = tid; idx < 64 * 384; idx += 256) {
        const int i = idx / 384, c3 = idx % 384, which = c3 >> 7, d = c3 & 127, col = which * 2048 + h * HD + d, p = p0 + i;
        float val = 0.f;
        if (p >= 0) { float a = 0.f;
            for (int kk = 0; kk < 4; ++kk) { const int pp = p - 3 + kk; if (pp >= 0) a += conv_w[kk * 6144 + col] * bf2f(QKV[(size_t)ext_row(b, pp) * 6144 + col]); }
            val = siluf_(a); }
        (which == 0 ? q : which == 1 ? k : v)[i * 128 + d] = val;
    }
    if (tid < 64) { const int p = p0 + tid; float be = 0.f, g = 0.f;
        if (p >= 0) { const int r = ext_row(b, p); be = sigmoidf_(BA[(size_t)r * 32 + h]); g = -__expf(A_log[h]) * softplusf_(BA[(size_t)r * 32 + 16 + h] + dt_bias[h]); }
        beta[tid] = be; gc[tid] = g; }
    __syncthreads();
    if (tid == 0) { float s = 0.f; for (int i = 0; i < 64; ++i) { s += gc[i]; gc[i] = s; } }
    for (int r = wv; r < 128; r += 4) {
        float* row = (r < 64 ? q + r * 128 : k + (r - 64) * 128);
        const float a0 = row[lane], a1 = row[lane + 64];
        const float rs = rsqrtf(wave_sum(a0 * a0 + a1 * a1) + EPS) * (r < 64 ? 0.08838834764831845f : 1.f);
        row[lane] = a0 * rs; row[lane + 64] = a1 * rs;
    }
    __syncthreads();
    bf16_t* oQK = QK + (size_t)cu * 4096;
    for (int idx = tid; idx < 4096; idx += 256) {
        const int i = idx >> 6, j = idx & 63; float akk = 0.f, aqk = 0.f;
        if (j <= i) { for (int d = 0; d < 128; ++d) { const float kj = k[j * 128 + d]; akk += k[i * 128 + d] * kj; aqk += q[i * 128 + d] * kj; }
            const float dec = __expf(gc[i] - gc[j]); akk *= beta[i] * dec; aqk *= dec; }
        Am[idx] = j < i ? akk : 0.f; oQK[idx] = f2bf(j <= i ? aqk : 0.f);
    }
    __syncthreads();
    if (tid < 64) { const int c = tid;
        for (int i = 0; i < 64; ++i) { float s = (i == c) ? 1.f : 0.f; for (int j = c; j < i; ++j) s -= Am[i * 64 + j] * Tm[j * 64 + c]; Tm[i * 64 + c] = (i >= c) ? s : 0.f; } }
    __syncthreads();
    bf16_t *oNW = NW + (size_t)cu * 8192, *oU = UU + (size_t)cu * 8192, *oQD = QD + (size_t)cu * 8192, *oKDT = KDT + (size_t)cu * 8192;
    const float gl = gc[63];
    for (int idx = tid; idx < 8192; idx += 256) {
        const int i = idx >> 7, d = idx & 127; float su = 0.f, sw = 0.f;
        for (int j = 0; j <= i; ++j) { const float t = Tm[i * 64 + j] * beta[j]; su += t * v[j * 128 + d]; sw += t * __expf(gc[j]) * k[j * 128 + d]; }
        oU[idx] = f2bf(su); oNW[idx] = f2bf(-sw);
        oQD[idx] = f2bf(q[idx] * __expf(gc[i]));
        oKDT[d * 64 + i] = f2bf(k[idx] * __expf(gl - gc[i]));
    }
    if (tid == 0) GL[cu] = __expf(gl);
}

__global__ void __launch_bounds__(128) nv_chunk_scan(const bf16_t* __restrict__ NW, const bf16_t* __restrict__ UU, const bf16_t* __restrict__ QD, const bf16_t* __restrict__ KDT,
                                                     const bf16_t* __restrict__ QK, const float* __restrict__ GL, bf16_t* __restrict__ O) {
    __shared__ float vn[64][128];
    const int bh = blockIdx.x, h = bh % NH, b = bh / NH, e = threadIdx.x;
    float S[128];
#pragma unroll
    for (int d = 0; d < 128; ++d) S[d] = 0.f;
    for (int n = 0; n < NCH; ++n) {
        const int cu = bh * NCH + n;
        const bf16_t *nw = NW + (size_t)cu * 8192, *uu = UU + (size_t)cu * 8192, *qd = QD + (size_t)cu * 8192, *kdt = KDT + (size_t)cu * 8192, *qk = QK + (size_t)cu * 4096;
        const float gl = GL[cu];
        for (int i = 0; i < 64; ++i) { float a = bf2f(uu[i * 128 + e]);
#pragma unroll
            for (int d = 0; d < 128; ++d) a += bf2f(nw[i * 128 + d]) * S[d];
            vn[i][e] = a; }
        __syncthreads();
        if (n > 0) for (int i = 0; i < 64; ++i) { float a = 0.f;
#pragma unroll
            for (int d = 0; d < 128; ++d) a += bf2f(qd[i * 128 + d]) * S[d];
            for (int j = 0; j <= i; ++j) a += bf2f(qk[i * 64 + j]) * vn[j][e];
            O[(size_t)(b * SEQ + 64 * (n - 1) + i) * DNW + h * HD + e] = f2bf(a); }
#pragma unroll
        for (int d = 0; d < 128; ++d) { float s = S[d] * gl; for (int i = 0; i < 64; ++i) s += bf2f(kdt[d * 64 + i]) * vn[i][e]; S[d] = s; }
        __syncthreads();
    }
}

__global__ void __launch_bounds__(256) nv_gnorm(const bf16_t* __restrict__ O, const bf16_t* __restrict__ SZD, const float* __restrict__ w, bf16_t* __restrict__ Y) {
    const int lane = threadIdx.x & 63, gw = (blockIdx.x * 256 + threadIdx.x) >> 6; if (gw >= MTOK * NH) return;
    const size_t base = (size_t)(gw >> 4) * DNW + (gw & 15) * HD, yb = (size_t)(gw >> 4) * YLD + 1024 + (gw & 15) * HD;
    const float a0 = bf2f(O[base + lane]), a1 = bf2f(O[base + lane + 64]);
    const float rs = rsqrtf(wave_sum(a0 * a0 + a1 * a1) * (1.f / HD) + EPS);
    Y[yb + lane] = f2bf(a0 * rs * w[lane] * bf2f(SZD[base + lane]));
    Y[yb + lane + 64] = f2bf(a1 * rs * w[lane + 64] * bf2f(SZD[base + lane + 64]));
}

__global__ void __launch_bounds__(256) nv_final(float* __restrict__ out, const float* __restrict__ w) {
    __shared__ float red[4];
    float* row = out + (size_t)blockIdx.x * DM; const int tid = threadIdx.x;
    float v[8]; float s = 0.f;
#pragma unroll
    for (int j = 0; j < 8; ++j) { v[j] = row[tid + 256 * j]; s += v[j] * v[j]; }
    s = wave_sum(s); if ((tid & 63) == 0) red[tid >> 6] = s; __syncthreads();
    const float rs = rsqrtf((red[0] + red[1] + red[2] + red[3]) * (1.f / DM) + EPS);
#pragma unroll
    for (int j = 0; j < 8; ++j) row[tid + 256 * j] = v[j] * rs * w[tid + 256 * j];
}

#endif
namespace pg8 {
#define PG8_LAS __attribute__((address_space(3)))
typedef short bf16x8 __attribute__((ext_vector_type(8)));
typedef float f32x4 __attribute__((ext_vector_type(4)));
typedef unsigned u32x4 __attribute__((ext_vector_type(4)));
constexpr int BM = 256, BK = 64, HALF = 128, HTB = HALF * BK * 2  , STAGE_BYTES = 8 * HTB, NXCD = 8, WGM = 8;

__host__ __device__ __forceinline__ int lds_byte(int r, int c) { const int st = (r >> 4) * 2 + (c >> 5), rr = r & 15, cc = c & 31, ob = rr * 64 + cc * 2; return st * 1024 + (ob ^ (((ob >> 9) & 1) << 5)); }
__host__ __device__ __forceinline__ void stage_rc(int b, int& R, int& C) { const int st = b / 1024, sb = b % 1024, swz = sb ^ (((sb >> 9) & 1) << 5); R = (st >> 1) * 16 + swz / 64; C = (st & 1) * 32 + (swz % 64) / 2; }
__host__ __device__ __forceinline__ int perm32(int rho) { const int n = rho >> 4, i = rho & 15; return 8 * (i >> 2) + 4 * n + (i & 3); }

struct Unit { int pm, pn, aoff, boff, nt, mode; };
struct Gemm { const bf16_t* A; const bf16_t* Bt; int lda, ldb; };

struct StaticOrder {
    int nM, nN, nwg, G, c, nt;
    __device__ void init(int nM_, int nN_, int nt_, int G_, int c_) { nM = nM_; nN = nN_; nwg = nM * nN; G = G_; c = c_; nt = nt_; }
    __device__ bool next(int i, Unit& u) const {
        const long L = (long)i * G + c; if (L >= nwg) return false;
        int wgid = (int)L; { const int q = nwg / NXCD, r = nwg % NXCD, xcd = wgid % NXCD, off = wgid / NXCD; wgid = (xcd < r ? xcd * (q + 1) : r * (q + 1) + (xcd - r) * q) + off; }
        const int nig = WGM * nN, gid = wgid / nig, fm = gid * WGM, gsz = (nM - fm) < WGM ? (nM - fm) : WGM;
        u.pm = fm + ((wgid % nig) % gsz); u.pn = (wgid % nig) / gsz; u.aoff = 0; u.boff = 0; u.nt = nt; u.mode = 0; return true;
    }
};

typedef float f32x2_t __attribute__((ext_vector_type(2))); typedef __bf16 bf16x2_t __attribute__((ext_vector_type(2)));
__device__ __forceinline__ unsigned cvt_pk_bf16(float lo, float hi) { f32x2_t v = {lo, hi}; bf16x2_t b = __builtin_convertvector(v, bf16x2_t); return __builtin_bit_cast(unsigned, b); }
__device__ __forceinline__ u32x4 pack8(f32x4 v0, f32x4 v1) { u32x4 w; w.x = cvt_pk_bf16(v0[0], v0[1]); w.y = cvt_pk_bf16(v0[2], v0[3]); w.z = cvt_pk_bf16(v1[0], v1[1]); w.w = cvt_pk_bf16(v1[2], v1[3]); return w; }
__device__ __forceinline__ void unpack8(u32x4 w, f32x4& v0, f32x4& v1) {
    v0 = (f32x4){__uint_as_float(w.x << 16), __uint_as_float(w.x & 0xffff0000u), __uint_as_float(w.y << 16), __uint_as_float(w.y & 0xffff0000u)};
    v1 = (f32x4){__uint_as_float(w.z << 16), __uint_as_float(w.z & 0xffff0000u), __uint_as_float(w.w << 16), __uint_as_float(w.w & 0xffff0000u)};
}
__device__ __forceinline__ float fast_sigmoid(float x) { return __builtin_amdgcn_rcpf(1.f + __builtin_amdgcn_exp2f(-1.4426950408889634f * x)); }

struct EpiProj {
    static constexpr bool PERM = true;
    bf16_t *U, *SZP, *QKV, *SZD, *GATES; float* BA;
    __device__ __forceinline__ bool reset_after(const Unit&) const { return true; }
    __device__ __forceinline__ void operator()(f32x4 (&acc)[2][2][4][2], const Unit& u, int wr, int wc, int fr, int fq) const {
        const int row0 = u.pm * BM + wr * 64 + fr, pn = u.pn;
        if (pn == 56) {
            if (wc == 0) {
#pragma unroll
                for (int ai = 0; ai < 2; ++ai)
#pragma unroll
                    for (int m = 0; m < 4; ++m) { float* rowp = BA + (size_t)(row0 + ai * HALF + m * 16) * 32 + 8 * fq;
                        *(f32x4*)rowp = acc[ai][0][m][0]; *(f32x4*)(rowp + 4) = acc[ai][0][m][1]; }
            }
            return;
        }
        bf16_t* base; int ld, colt, act;
        if (pn < 4) { base = U; ld = 1024; colt = pn * 256; act = 0; }
        else if (pn < 8) { base = SZP; ld = 1024; colt = (pn - 4) * 256; act = 1; }
        else if (pn < 32) { base = QKV; ld = 6144; colt = (pn - 8) * 256; act = 0; }
        else if (pn < 40) { base = SZD; ld = 2048; colt = (pn - 32) * 256; act = 1; }
        else { base = GATES; ld = 4096; colt = (pn - 40) * 256; act = 2; }
        const int col0 = colt + wc * 32 + 8 * fq;
#pragma unroll
        for (int ai = 0; ai < 2; ++ai)
#pragma unroll
            for (int m = 0; m < 4; ++m) { bf16_t* rowp = base + (size_t)(row0 + ai * HALF + m * 16) * ld + col0;
#pragma unroll
                for (int bj = 0; bj < 2; ++bj) { f32x4 v0 = acc[ai][bj][m][0], v1 = acc[ai][bj][m][1];
                    if (act != 0) {
#pragma unroll
                        for (int j = 0; j < 4; ++j) { const float s0 = fast_sigmoid(v0[j]), s1 = fast_sigmoid(v1[j]); v0[j] = act == 1 ? v0[j] * s0 : s0; v1[j] = act == 1 ? v1[j] * s1 : s1; }
                    }
                    *(u32x4*)(rowp + bj * HALF) = pack8(v0, v1); } }
    }
};
struct EpiPoolMix {
    static constexpr bool PERM = true;
    bf16_t* Y; const bf16_t* SZP; const float* scale;
    __device__ __forceinline__ bool reset_after(const Unit&) const { return true; }
    __device__ __forceinline__ void operator()(f32x4 (&acc)[2][2][4][2], const Unit& u, int wr, int wc, int fr, int fq) const {
        const int row0 = u.pm * BM + wr * 64 + fr, col0 = u.pn * BM + wc * 32 + 8 * fq;
#pragma unroll
        for (int bj = 0; bj < 2; ++bj) { const f32x4 s0 = *(const f32x4*)(scale + col0 + bj * HALF), s1 = *(const f32x4*)(scale + col0 + bj * HALF + 4);
#pragma unroll
            for (int ai = 0; ai < 2; ++ai)
#pragma unroll
                for (int m = 0; m < 4; ++m) { const size_t r = (size_t)(row0 + ai * HALF + m * 16);
                    f32x4 z0, z1; unpack8(*(const u32x4*)(SZP + r * 1024 + col0 + bj * HALF), z0, z1);
                    *(u32x4*)(Y + r * YLD + col0 + bj * HALF) = pack8(acc[ai][bj][m][0] * s0 * z0, acc[ai][bj][m][1] * s1 * z1); } }
    }
};
struct EpiMerge {
    static constexpr bool PERM = true;
    const bf16_t* GATES; bf16_t* MG;
    __device__ __forceinline__ bool reset_after(const Unit& u) const { return u.mode != 0; }
    __device__ __forceinline__ void operator()(f32x4 (&acc)[2][2][4][2], const Unit& u, int wr, int wc, int fr, int fq) const {
        const int row0 = u.pm * BM + wr * 64 + fr, col0 = u.pn * BM + wc * 32 + 8 * fq;
#pragma unroll
        for (int ai = 0; ai < 2; ++ai)
#pragma unroll
            for (int m = 0; m < 4; ++m) { const size_t r = (size_t)(row0 + ai * HALF + m * 16);
#pragma unroll
                for (int bj = 0; bj < 2; ++bj) {
                    f32x4 d0, d1; unpack8(*(const u32x4*)(GATES + r * 4096 + 2048 + col0 + bj * HALF), d0, d1);
                    if (u.mode == 0) {
                        f32x4 p0, p1; unpack8(*(const u32x4*)(GATES + r * 4096 + col0 + bj * HALF), p0, p1);
#pragma unroll
                        for (int j = 0; j < 4; ++j) { acc[ai][bj][m][0][j] *= p0[j] / fmaxf(d0[j], 1e-30f); acc[ai][bj][m][1][j] *= p1[j] / fmaxf(d1[j], 1e-30f); }
                    } else {
                        *(u32x4*)(MG + r * DM + col0 + bj * HALF) = pack8(acc[ai][bj][m][0] * d0, acc[ai][bj][m][1] * d1);
                    } } }
    }
};
struct EpiResid {
    static constexpr bool PERM = false;
    const float* x; float* out;
    __device__ __forceinline__ bool reset_after(const Unit&) const { return true; }
    __device__ __forceinline__ void operator()(f32x4 (&acc)[2][2][4][2], const Unit& u, int wr, int wc, int fr, int fq) const {
        const int row0 = u.pm * BM + wr * 64 + fr, col0 = u.pn * BM + wc * 32 + 4 * fq;
#pragma unroll
        for (int ai = 0; ai < 2; ++ai)
#pragma unroll
            for (int m = 0; m < 4; ++m) { const size_t off = (size_t)(row0 + ai * HALF + m * 16) * DM + col0;
#pragma unroll
                for (int bj = 0; bj < 2; ++bj)
#pragma unroll
                    for (int n = 0; n < 2; ++n) *(f32x4*)(out + off + bj * HALF + n * 16) = *(const f32x4*)(x + off + bj * HALF + n * 16) + acc[ai][bj][m][n]; }
    }
};

template <class Epi, class Sched, bool ALIGN_EPI>
__device__ __forceinline__ void gemm_phase(PG8_LAS unsigned char* lds, const Gemm g, const Sched& S, const Epi& E) {
    const int tid = threadIdx.x, wid = __builtin_amdgcn_readfirstlane(tid >> 6), lane = tid & 63, wr = wid >> 2, wc = wid & 3, fr = lane & 15, fq = lane >> 4;
    const int lda = g.lda, ldb = g.ldb;
    unsigned voffA[2], voffB[2];
#pragma unroll
    for (int i = 0; i < 2; ++i) { int R, C; stage_rc(tid * 16 + i * 8192, R, C); const int Rb = Epi::PERM ? ((R & ~31) + perm32(R & 31)) : R;
        voffA[i] = (unsigned)(R * lda + C) * 2u; voffB[i] = (unsigned)(Rb * ldb + C) * 2u; }
    const size_t kstep = (size_t)(BK * 2);
    const size_t hstepA = (size_t)HALF * lda * 2, hstepB = (size_t)HALF * ldb * 2;
    const unsigned ldsw = (unsigned)wid * 1024u;
    const int aoff = lds_byte(wr * 64 + fr, fq * 8), boff = lds_byte(wc * 32 + fr, fq * 8);
#define PG8_SA(b, h) (((b) * 2 + (h)) * HTB)
#define PG8_SB(b, h) ((4 + (b) * 2 + (h)) * HTB)
#define PG8_STAGE(bufoff, gbase, voff) do { _Pragma("unroll") for (int _i = 0; _i < 2; ++_i) \
        __builtin_amdgcn_global_load_lds((const unsigned*)((const char*)(gbase) + (voff)[_i]), (PG8_LAS unsigned*)(lds + (bufoff) + ldsw + _i * 8192), 16, 0, 0); } while (0)
#define PG8_LDA(dst, b, h) do { _Pragma("unroll") for (int m = 0; m < 4; ++m) _Pragma("unroll") for (int k = 0; k < 2; ++k) dst[m][k] = *(const PG8_LAS bf16x8*)(lds + PG8_SA(b, h) + aoff + m * 2048 + k * 1024); } while (0)
#define PG8_LDB(dst, b, h) do { _Pragma("unroll") for (int n = 0; n < 2; ++n) _Pragma("unroll") for (int k = 0; k < 2; ++k) dst[n][k] = *(const PG8_LAS bf16x8*)(lds + PG8_SB(b, h) + boff + n * 2048 + k * 1024); } while (0)
#define PG8_MMA(ai, bj, At, Bt) do { __builtin_amdgcn_s_setprio(1); _Pragma("unroll") for (int m = 0; m < 4; ++m) _Pragma("unroll") for (int n = 0; n < 2; ++n) _Pragma("unroll") for (int k = 0; k < 2; ++k) \
        acc[ai][bj][m][n] = __builtin_amdgcn_mfma_f32_16x16x32_bf16(Bt[n][k], At[m][k], acc[ai][bj][m][n], 0, 0, 0); __builtin_amdgcn_s_setprio(0); } while (0)
#define PG8_WAIT_V(n) asm volatile("s_waitcnt vmcnt(" #n ")" ::: "memory")
#define PG8_WAIT_L(n) asm volatile("s_waitcnt lgkmcnt(" #n ")" ::: "memory")
#define PG8_BAR __builtin_amdgcn_s_barrier()
#define PG8_SCHED __builtin_amdgcn_sched_barrier(0)
#define PG8_UA(u) ((const char*)g.A + ((size_t)(u).pm * BM * lda + (u).aoff) * 2)
#define PG8_UB(u) ((const char*)g.Bt + ((size_t)(u).pn * BM * ldb + (u).boff) * 2)
    Unit cur, nxt; int ui = 0;
    if (!S.next(0, cur)) return;
    f32x4 acc[2][2][4][2];
#pragma unroll
    for (int a = 0; a < 2; ++a)
#pragma unroll
        for (int b = 0; b < 2; ++b)
#pragma unroll
            for (int m = 0; m < 4; ++m)
#pragma unroll
                for (int n = 0; n < 2; ++n) acc[a][b][m][n] = (f32x4){0.f, 0.f, 0.f, 0.f};
    bf16x8 At[4][2], B0[2][2], B1[2][2];
    const char* cA = PG8_UA(cur); const char* cB = PG8_UB(cur);
    PG8_STAGE(PG8_SB(0, 0), cB, voffB); PG8_STAGE(PG8_SB(0, 1), cB + hstepB, voffB); PG8_STAGE(PG8_SA(0, 0), cA, voffA); PG8_STAGE(PG8_SA(0, 1), cA + hstepA, voffA);
    if (wr == 1) PG8_BAR;
    PG8_WAIT_V(2); PG8_BAR;
    PG8_STAGE(PG8_SB(1, 0), cB + kstep, voffB); PG8_STAGE(PG8_SA(1, 0), cA + kstep, voffA); PG8_STAGE(PG8_SB(1, 1), cB + hstepB + kstep, voffB);
    PG8_WAIT_V(6); PG8_BAR;
    for (;;) {
        const bool has_next = S.next(ui + 1, nxt);
        const char* nA = has_next ? PG8_UA(nxt) : cA; const char* nB = has_next ? PG8_UB(nxt) : cB;
        const int nt = cur.nt;
        for (int t = 0; t < nt; t += 2) {
            const bool last = (t == nt - 2);
            const char* a1 = cA + (size_t)(t + 1) * kstep;
            const char* a2 = last ? nA : cA + (size_t)(t + 2) * kstep; const char* b2 = last ? nB : cB + (size_t)(t + 2) * kstep;
            const char* a3 = a2 + kstep; const char* b3 = b2 + kstep;
            PG8_LDB(B0, 0, 0); PG8_LDB(B1, 0, 1); PG8_SCHED; PG8_LDA(At, 0, 0); PG8_STAGE(PG8_SA(1, 1), a1 + hstepA, voffA);
            PG8_WAIT_V(8); PG8_WAIT_L(0); PG8_BAR; PG8_MMA(0, 0, At, B0); PG8_MMA(0, 1, At, B1); PG8_BAR; PG8_SCHED;
            PG8_LDA(At, 0, 1); PG8_STAGE(PG8_SB(0, 0), b2, voffB); PG8_STAGE(PG8_SB(0, 1), b2 + hstepB, voffB); PG8_STAGE(PG8_SA(0, 0), a2, voffA);
            PG8_WAIT_V(8); PG8_WAIT_L(0); PG8_BAR; PG8_MMA(1, 0, At, B0); PG8_MMA(1, 1, At, B1); PG8_BAR; PG8_SCHED;
            PG8_LDB(B0, 1, 0); PG8_LDB(B1, 1, 1); PG8_SCHED; PG8_LDA(At, 1, 0); PG8_STAGE(PG8_SA(0, 1), a2 + hstepA, voffA);
            PG8_WAIT_V(8); PG8_WAIT_L(0); PG8_BAR; PG8_MMA(0, 0, At, B0); PG8_MMA(0, 1, At, B1); PG8_BAR; PG8_SCHED;
            PG8_LDA(At, 1, 1); PG8_STAGE(PG8_SB(1, 0), b3, voffB); PG8_STAGE(PG8_SB(1, 1), b3 + hstepB, voffB); PG8_STAGE(PG8_SA(1, 0), a3, voffA);
            PG8_WAIT_V(8); PG8_WAIT_L(0); PG8_BAR; PG8_MMA(1, 0, At, B0); PG8_MMA(1, 1, At, B1); PG8_BAR; PG8_SCHED;
        }
        if constexpr (ALIGN_EPI) { if (wr == 0) PG8_BAR; }
        E(acc, cur, wr, wc, fr, fq);
        if (!has_next) break;
        if (E.reset_after(cur)) {
#pragma unroll
            for (int a = 0; a < 2; ++a)
#pragma unroll
                for (int b = 0; b < 2; ++b)
#pragma unroll
                    for (int m = 0; m < 4; ++m)
#pragma unroll
                        for (int n = 0; n < 2; ++n) acc[a][b][m][n] = (f32x4){0.f, 0.f, 0.f, 0.f};
        }
        cur = nxt; cA = nA; cB = nB; ++ui;
        if constexpr (ALIGN_EPI) { if (wr == 1) PG8_BAR; }
    }
    PG8_WAIT_V(0);
    if constexpr (!ALIGN_EPI) { if (wr == 0) PG8_BAR; }
    PG8_BAR;
#undef PG8_SA
#undef PG8_SB
#undef PG8_STAGE
#undef PG8_LDA
#undef PG8_LDB
#undef PG8_MMA
#undef PG8_WAIT_V
#undef PG8_WAIT_L
#undef PG8_BAR
#undef PG8_SCHED
#undef PG8_UA
#undef PG8_UB
}
}
#ifndef DUP_MASK
#define DUP_MASK 0
#endif
#ifndef SIMPLE_PREP
#define SIMPLE_PREP 0
#endif
#ifndef SIMPLE_SCAN
#define SIMPLE_SCAN 0
#endif
constexpr int NWAVES = 8;
constexpr int RING_OFF = 0, RING_BYTES = 131072;
constexpr int LDSCTL_OFF = RING_BYTES, MISC_OFF = LDSCTL_OFF + 320;
constexpr int XTRA_OFF = RING_BYTES + 1024;
constexpr int LDS_BYTES = 147456;
constexpr int CW_BAR = 4096;

#define GAS __attribute__((address_space(1)))
#define LAS __attribute__((address_space(3)))
typedef unsigned v4u __attribute__((ext_vector_type(4)));
typedef float f32x4 __attribute__((ext_vector_type(4)));
typedef GAS unsigned gu32;
#define LDS_WAIT() asm volatile("s_waitcnt lgkmcnt(0)" ::: "memory")
#define VM_WAIT() asm volatile("s_waitcnt vmcnt(0)" ::: "memory")
__device__ __forceinline__ unsigned pk2(float lo, float hi) { return (unsigned)f2bf(lo) | ((unsigned)f2bf(hi) << 16); }

#define XB_TMO      128
#define XB_XCNT(j)  (256  + 64 * (j))
#define XB_XSUB(j)  (1280 + 64 * (j))
#define XB_XGEN(j)  (2304 + 64 * (j))
#define XB_TOP      3328
#define XB_TOPGEN   3392
#define XCD_BAR_WORDS 3456
#define XB_SPIN_CAP (1u << 18)
__device__ __forceinline__ unsigned xb_ld(unsigned* p)              { return __hip_atomic_load(p, __ATOMIC_RELAXED, __HIP_MEMORY_SCOPE_AGENT); }
__device__ __forceinline__ unsigned xb_add(unsigned* p, unsigned v) { return __hip_atomic_fetch_add(p, v, __ATOMIC_RELAXED, __HIP_MEMORY_SCOPE_AGENT); }
__device__ __forceinline__ unsigned xb_xcc_id() { return (unsigned)__builtin_amdgcn_s_getreg((3 << 11) | 20) & 0xFu; }
#define XB_SPIN(cond, bar) do { unsigned _sp = 0; while (cond) { __builtin_amdgcn_s_sleep(1); \
    if ((++_sp & 255u) == 0u) { if (xb_ld(&(bar)[XB_TMO])) break; if (_sp > XB_SPIN_CAP) { atomicAdd(&(bar)[XB_TMO], 1u); break; } } } } while (0)
struct XcdBarrier { unsigned* bar; unsigned x; volatile LAS unsigned* st; };
__device__ __forceinline__ XcdBarrier xcd_barrier_post(unsigned* bar, volatile LAS unsigned* st) {
    XcdBarrier b; b.bar = bar; b.x = xb_xcc_id(); b.st = st;
    if (threadIdx.x == 0) (void)xb_add(&bar[XB_XCNT(b.x)], 1u);
    return b;
}
__device__ __forceinline__ void xcd_barrier_complete(unsigned* bar, unsigned x, unsigned& nloc, unsigned& nx) {
    const unsigned G = gridDim.x * gridDim.y * gridDim.z;
    unsigned sum, cnt, mine, sp = 0u;
    for (;;) {
        sum = 0u; cnt = 0u; mine = 0u;
#pragma unroll
        for (unsigned j = 0; j < 16; ++j) { const unsigned c = xb_ld(&bar[XB_XCNT(j)]); sum += c; cnt += (c > 0u) ? 1u : 0u; mine = (j == x) ? c : mine; }
        if (sum == G) break;
        __builtin_amdgcn_s_sleep(1);
        if ((++sp & 255u) == 0u) { if (xb_ld(&bar[XB_TMO])) break; if (sp > XB_SPIN_CAP) { atomicAdd(&bar[XB_TMO], 1u); break; } }
    }
    nloc = mine > 0u ? mine : 1u; nx = cnt > 0u ? cnt : 1u;
}
__device__ __forceinline__ void xcd_barrier(const XcdBarrier& b) {
    asm volatile("s_waitcnt vmcnt(0)" ::: "memory");
    __syncthreads();
    if (threadIdx.x == 0) {
        unsigned* bar = b.bar;
        __builtin_amdgcn_s_waitcnt(0);
        unsigned nloc = b.st[0], nx = b.st[1];
        if (nloc == 0u) { xcd_barrier_complete(bar, b.x, nloc, nx); b.st[0] = nloc; b.st[1] = nx; }
        const unsigned old = xb_add(&bar[XB_XSUB(b.x)], 1u);
        const unsigned gen = old / nloc;
        if (old + 1u == (gen + 1u) * nloc) {
            __builtin_amdgcn_fence(__ATOMIC_RELEASE, "agent");
            asm volatile("s_waitcnt vmcnt(0)" ::: "memory");
            const unsigned og = xb_add(&bar[XB_TOP], 1u);
            const unsigned tg = og / nx;
            if (og + 1u == (tg + 1u) * nx) xb_add(&bar[XB_TOPGEN], 1u);
            else XB_SPIN(xb_ld(&bar[XB_TOPGEN]) == tg, bar);
            __builtin_amdgcn_fence(__ATOMIC_ACQUIRE, "agent");
            xb_add(&bar[XB_XGEN(b.x)], 1u);
            asm volatile("s_waitcnt vmcnt(0)" ::: "memory");
        } else {
            XB_SPIN(xb_ld(&bar[XB_XGEN(b.x)]) == gen, bar);
            __builtin_amdgcn_fence(__ATOMIC_ACQUIRE, "agent");
            asm volatile("s_waitcnt vmcnt(0)" ::: "memory");
        }
    }
    __syncthreads();
}

struct Args { const float* in[14]; float* out; unsigned char* ws; int ph_lo, ph_hi; };

struct Frame {
    LAS unsigned char* lds; int tid, lane, wave, vcu, G;
};

__device__ __forceinline__ void p0_transpose_item(const float* __restrict__ W, int N, int k0, int n0, bf16_t* __restrict__ WT, int ldt, int dn0, int koff, LAS float* scr, int lane) {
#pragma unroll 8
    for (int i = 0; i < 32; ++i) { const int kk = 2 * i + (lane >> 5); scr[kk * 33 + (lane & 31)] = W[(size_t)(k0 + kk) * N + n0 + (lane & 31)]; }
    LDS_WAIT(); asm volatile("" ::: "memory");
    const int c = lane & 7;
#pragma unroll
    for (int j = 0; j < 4; ++j) { const int n = (lane >> 3) + 8 * j; const LAS float* s = scr + (8 * c) * 33 + n;
        v4u o; o.x = pk2(s[0 * 33], s[1 * 33]); o.y = pk2(s[2 * 33], s[3 * 33]); o.z = pk2(s[4 * 33], s[5 * 33]); o.w = pk2(s[6 * 33], s[7 * 33]);
        *(v4u*)(WT + (size_t)(dn0 + n) * ldt + koff + k0 + 8 * c) = o; }
    LDS_WAIT(); asm volatile("" ::: "memory");
}
__device__ __forceinline__ void p0_prologue(Frame& F, const Args& a) {
    unsigned char* ws = a.ws;
    bf16_t *WinT = (bf16_t*)(ws + WS_WINT), *W2T = (bf16_t*)(ws + WS_W2T), *WoT = (bf16_t*)(ws + WS_WOT), *MixT = (bf16_t*)(ws + WS_MIXT), *XN = (bf16_t*)(ws + WS_XN);
    LAS float* scr = (LAS float*)(F.lds + RING_OFF + F.wave * 16384);
    const int gw = F.vcu * NWAVES + F.wave, NGW = F.G * NWAVES;
    constexpr int I_IN = (DM / 64) * (INC / 32), I_PO = (PW / 64) * (DM / 32), I_DN = (DNW / 64) * (DM / 32), I_WO = (DM / 64) * (DM / 32), I_MX = 4 * (PGD / 64) * (PGD / 32);
    constexpr int NITEMS = I_IN + I_PO + I_DN + I_WO + I_MX;
    for (int it = gw; it < NITEMS; it += NGW) {
        int r = it;
        if (r < I_IN) { const int nblk = INC / 32, kb = r / nblk, nb = r % nblk, n0 = 32 * nb;
            const int dn0 = n0 < C_B ? n0 : (n0 < C_GP ? 14336 + (n0 - C_B) : n0 - 32);
            p0_transpose_item(a.in[3], INC, 64 * kb, n0, WinT, DM, dn0, 0, scr, F.lane); continue; } r -= I_IN;
        if (r < I_PO) { const int nblk = DM / 32, kb = r / nblk, nb = r % nblk; p0_transpose_item(a.in[10], DM, 64 * kb, 32 * nb, W2T, YLD, 32 * nb, 0, scr, F.lane); continue; } r -= I_PO;
        if (r < I_DN) { const int nblk = DM / 32, kb = r / nblk, nb = r % nblk; p0_transpose_item(a.in[11], DM, 64 * kb, 32 * nb, W2T, YLD, 32 * nb, 1024, scr, F.lane); continue; } r -= I_DN;
        if (r < I_WO) { const int nblk = DM / 32, kb = r / nblk, nb = r % nblk; p0_transpose_item(a.in[12], DM, 64 * kb, 32 * nb, WoT, DM, 32 * nb, 0, scr, F.lane); continue; } r -= I_WO;
        { const int g = r / 32, rr = r % 32, kb = rr / 8, nb = rr % 8;
          p0_transpose_item(a.in[7] + (size_t)g * PGD * PGD, PGD, 64 * kb, 32 * nb, MixT + (size_t)g * PGD * PGD, PGD, 32 * nb, 0, scr, F.lane); }
    }
    const float* nw = a.in[2];
    for (int r = gw; r < MPAD + (NPAD1 - INC); r += NGW) {
        if (r >= MROWS) { bf16_t* o = r < MPAD ? XN + (size_t)r * DM : WinT + (size_t)(INC + (r - MPAD)) * DM;
#pragma unroll
            for (int j = 0; j < 4; ++j) *(v4u*)(o + 8 * F.lane + 512 * j) = (v4u){0u, 0u, 0u, 0u};
            continue; }
        const float* src = r < MTOK ? a.in[0] + (size_t)r * DM : a.in[1] + (size_t)(r - MTOK) * DM;
        f32x4 v[8]; float s = 0.f;
#pragma unroll
        for (int j = 0; j < 8; ++j) { v[j] = *(const f32x4*)(src + 4 * F.lane + 256 * j); s += (v[j].x * v[j].x + v[j].y * v[j].y) + (v[j].z * v[j].z + v[j].w * v[j].w); }
        const float rs = rsqrtf(wave_sum(s) * (1.f / DM) + EPS);
        unsigned long long* o8 = (unsigned long long*)(XN + (size_t)r * DM) + F.lane;
#pragma unroll
        for (int j = 0; j < 8; ++j) { const f32x4 w = *(const f32x4*)(nw + 4 * F.lane + 256 * j);
            o8[64 * j] = (unsigned long long)pk2(v[j].x * rs * w.x, v[j].y * rs * w.y) | ((unsigned long long)pk2(v[j].z * rs * w.z, v[j].w * rs * w.w) << 32); }
    }
}

template <int WIN>
__device__ __forceinline__ void p2_pool_item(const bf16_t* __restrict__ U, bf16_t* __restrict__ PO, int g, int rb, int c) {
    const int b = rb >> 8, t0 = (rb & 255) * 8, col = g * 256 + c * 8;
    pg8::u32x4 raw[WIN + 7];
#pragma unroll
    for (int j = 0; j < WIN + 7; ++j) { const int t = t0 - (WIN - 1) + j; const int row = t >= 0 ? b * SEQ + t : MTOK + NMETA + t; raw[j] = *(const pg8::u32x4*)(U + (size_t)row * 1024 + col); }
    f32x4 s0 = (f32x4){0.f, 0.f, 0.f, 0.f}, s1 = s0;
#pragma unroll
    for (int j = 0; j < WIN - 1; ++j) { f32x4 x0, x1; pg8::unpack8(raw[j], x0, x1); s0 += x0; s1 += x1; }
    constexpr float inv = 1.f / (float)WIN;
#pragma unroll
    for (int i = 0; i < 8; ++i) { f32x4 x0, x1; pg8::unpack8(raw[WIN - 1 + i], x0, x1); s0 += x0; s1 += x1;
        *(pg8::u32x4*)(PO + (size_t)(b * SEQ + t0 + i) * 1024 + col) = pg8::pack8(s0 * inv - x0, s1 * inv - x1);
        f32x4 y0, y1; pg8::unpack8(raw[i], y0, y1); s0 -= y0; s1 -= y1; }
}
__device__ __forceinline__ void p2_pool(Frame& F, const Args& a) {
    const bf16_t* U = (const bf16_t*)(a.ws + WS_U); bf16_t* PO = (bf16_t*)(a.ws + WS_POOLED);
    const int gw = F.vcu * NWAVES + F.wave, NGW = F.G * NWAVES;
    for (int wi = gw; wi < 4 * 512; wi += NGW) {
        const int g = wi >> 9, rb = (wi & 511) * 2 + (F.lane >> 5), c = F.lane & 31;
        if (g == 0) p2_pool_item<2>(U, PO, 0, rb, c); else if (g == 1) p2_pool_item<4>(U, PO, 1, rb, c); else if (g == 2) p2_pool_item<8>(U, PO, 2, rb, c); else p2_pool_item<16>(U, PO, 3, rb, c);
    }
}
__device__ __forceinline__ void p2_chunk_prep_simple(Frame& F, const Args& a) {
    const bf16_t* QKV = (const bf16_t*)(a.ws + WS_QKV); const float* BA = (const float*)(a.ws + WS_BA);
    const float *conv_w = a.in[4], *A_log = a.in[5], *dt_bias = a.in[6];
    bf16_t *NW = (bf16_t*)(a.ws + WS_CH_NW), *UU = (bf16_t*)(a.ws + WS_CH_U), *QD = (bf16_t*)(a.ws + WS_CH_QD), *KDT = (bf16_t*)(a.ws + WS_CH_KDT), *QK = (bf16_t*)(a.ws + WS_CH_QK);
    float* GL = (float*)(a.ws + WS_CH_GL);
    LAS float* sm = (LAS float*)(F.lds + RING_OFF);
    LAS float *q = sm, *k = q + 8192, *v = k + 8192, *Am = v + 8192, *Tm = Am + 4096;
    LAS float *beta = (LAS float*)(F.lds + XTRA_OFF), *gc = beta + 64;
    const int tid = F.tid, lane = F.lane, wv = F.wave;
    for (int cu = F.vcu; cu < NUNITS; cu += F.G) {
        const int n = cu % NCH, bh = cu / NCH, h = bh % NH, b = bh / NH, p0 = CHUNK * n - PADF;
        for (int idx = tid; idx < 64 * 384; idx += 512) {
            const int i = idx / 384, c3 = idx % 384, which = c3 >> 7, d = c3 & 127, col = which * 2048 + h * HD + d, p = p0 + i;
            float val = 0.f;
            if (p >= 0) { float s = 0.f;
                for (int kk = 0; kk < 4; ++kk) { const int pp = p - 3 + kk; if (pp >= 0) s += conv_w[kk * 6144 + col] * bf2f(QKV[(size_t)ext_row(b, pp) * 6144 + col]); }
                val = siluf_(s); }
            (which == 0 ? q : which == 1 ? k : v)[i * 128 + d] = val;
        }
        if (tid < 64) { const int p = p0 + tid; float be = 0.f, g = 0.f;
            if (p >= 0) { const int r = ext_row(b, p); be = sigmoidf_(BA[(size_t)r * 32 + h]); g = -__expf(A_log[h]) * softplusf_(BA[(size_t)r * 32 + 16 + h] + dt_bias[h]); }
            beta[tid] = be; gc[tid] = g; }
        __syncthreads();
        if (tid == 0) { float s = 0.f; for (int i = 0; i < 64; ++i) { s += gc[i]; gc[i] = s; } }
        for (int r = wv; r < 128; r += 8) {
            LAS float* row = (r < 64 ? q + r * 128 : k + (r - 64) * 128);
            const float a0 = row[lane], a1 = row[lane + 64];
            const float rs = rsqrtf(wave_sum(a0 * a0 + a1 * a1) + EPS) * (r < 64 ? 0.08838834764831845f : 1.f);
            row[lane] = a0 * rs; row[lane + 64] = a1 * rs;
        }
        __syncthreads();
        bf16_t* oQK = QK + (size_t)cu * 4096;
        for (int idx = tid; idx < 4096; idx += 512) {
            const int i = idx >> 6, j = idx & 63; float akk = 0.f, aqk = 0.f;
            if (j <= i) { for (int d = 0; d < 128; ++d) { const float kj = k[j * 128 + d]; akk += k[i * 128 + d] * kj; aqk += q[i * 128 + d] * kj; }
                const float dec = __expf(gc[i] - gc[j]); akk *= beta[i] * dec; aqk *= dec; }
            Am[idx] = j < i ? akk : 0.f; oQK[idx] = f2bf(j <= i ? aqk : 0.f);
        }
        __syncthreads();
        if (tid < 64) { const int c = tid;
            for (int i = 0; i < 64; ++i) { float s = (i == c) ? 1.f : 0.f; for (int j = c; j < i; ++j) s -= Am[i * 64 + j] * Tm[j * 64 + c]; Tm[i * 64 + c] = (i >= c) ? s : 0.f; } }
        __syncthreads();
        bf16_t *oNW = NW + (size_t)cu * 8192, *oU = UU + (size_t)cu * 8192, *oQD = QD + (size_t)cu * 8192, *oKDT = KDT + (size_t)cu * 8192;
        const float gl = gc[63];
        for (int idx = tid; idx < 8192; idx += 512) {
            const int i = idx >> 7, d = idx & 127; float su = 0.f, sw = 0.f;
            for (int j = 0; j <= i; ++j) { const float t = Tm[i * 64 + j] * beta[j]; su += t * v[j * 128 + d]; sw += t * __expf(gc[j]) * k[j * 128 + d]; }
            oU[d * 64 + i] = f2bf(su); oNW[idx] = f2bf(-sw);
            oQD[idx] = f2bf(q[idx] * __expf(gc[i]));
            oKDT[d * 64 + i] = f2bf(k[idx] * __expf(gl - gc[i]));
        }
        if (tid == 0) GL[cu] = __expf(gl);
        __syncthreads();
    }
}

typedef short bf16x8_t __attribute__((ext_vector_type(8)));
typedef unsigned u32x2_t __attribute__((ext_vector_type(2)));
typedef unsigned u32x4_t __attribute__((ext_vector_type(4)));
__device__ __forceinline__ u32x2_t pack4bf(f32x4 v) { u32x2_t r; r.x = pg8::cvt_pk_bf16(v[0], v[1]); r.y = pg8::cvt_pk_bf16(v[2], v[3]); return r; }

constexpr int QS_LD = 272, KT_LD = 144, AM_LD = 68;
constexpr int L_QS = 0, L_KS = 17408, L_KT = 34816, L_VT = 53248, L_AM = 71680, L_TM = 89088, L_TB = 106496, L_TW = 115712, L_XS = 124928;
static_assert(L_XS + 3 * 1152 <= RING_BYTES, "chunk-prep LDS map");
__device__ __forceinline__ void p2_chunk_prep_fast(Frame& F, const Args& a) {
    const bf16_t* QKV = (const bf16_t*)(a.ws + WS_QKV); const float* BA = (const float*)(a.ws + WS_BA);
    const float *conv_w = a.in[4], *A_log = a.in[5], *dt_bias = a.in[6];
    bf16_t *NW = (bf16_t*)(a.ws + WS_CH_NW), *UT = (bf16_t*)(a.ws + WS_CH_U), *QD = (bf16_t*)(a.ws + WS_CH_QD), *KDT = (bf16_t*)(a.ws + WS_CH_KDT), *QK = (bf16_t*)(a.ws + WS_CH_QK);
    float* GL = (float*)(a.ws + WS_CH_GL);
    LAS unsigned char* L = F.lds + RING_OFF;
    LAS float *Am = (LAS float*)(L + L_AM), *Tm = (LAS float*)(L + L_TM);
    LAS float *beta = (LAS float*)(F.lds + XTRA_OFF), *gc = beta + 64;
    const int tid = F.tid, lane = F.lane, w = F.wave, fr = lane & 15, fq = lane >> 4;
    for (int cu = F.vcu; cu < NUNITS; cu += F.G) {
        const int n = cu % NCH, bh = cu / NCH, h = bh % NH, b = bh / NH, p0 = CHUNK * n - PADF;
#pragma unroll 1
        for (int it = 0; it < 6; ++it) {
            const int item = tid + 512 * it, which = it >> 1, i = (item >> 4) & 63, d8 = (item & 15) * 8, col = which * 2048 + h * HD + d8, p = p0 + i;
            float v[8];
#pragma unroll
            for (int j = 0; j < 8; ++j) v[j] = 0.f;
            if (p >= 0) {
#pragma unroll
                for (int kk = 0; kk < 4; ++kk) { const int pp = p - 3 + kk;
                    if (pp >= 0) { pg8::f32x4 x0, x1; pg8::unpack8(*(const pg8::u32x4*)(QKV + (size_t)ext_row(b, pp) * 6144 + col), x0, x1);
                        const f32x4 w0 = *(const f32x4*)(conv_w + kk * 6144 + col), w1 = *(const f32x4*)(conv_w + kk * 6144 + col + 4);
#pragma unroll
                        for (int j = 0; j < 4; ++j) { v[j] += w0[j] * x0[j]; v[4 + j] += w1[j] * x1[j]; } } }
#pragma unroll
                for (int j = 0; j < 8; ++j) v[j] = siluf_(v[j]);
            }
            if (which < 2) { float ss = 0.f;
#pragma unroll
                for (int j = 0; j < 8; ++j) ss += v[j] * v[j];
                ss += __shfl_xor(ss, 1); ss += __shfl_xor(ss, 2); ss += __shfl_xor(ss, 4); ss += __shfl_xor(ss, 8);
                const float rs = rsqrtf(ss + EPS) * (which == 0 ? 0.08838834764831845f : 1.f);
#pragma unroll
                for (int j = 0; j < 8; ++j) v[j] *= rs; }
            const pg8::u32x4 pk = pg8::pack8((f32x4){v[0], v[1], v[2], v[3]}, (f32x4){v[4], v[5], v[6], v[7]});
            if (which < 2) *(LAS pg8::u32x4*)(L + (which == 0 ? L_QS : L_KS) + i * QS_LD + d8 * 2) = pk;
            if (which >= 1) { LAS unsigned char* T = L + (which == 1 ? L_KT : L_VT) + i * 2;
                const unsigned pw[4] = {pk.x, pk.y, pk.z, pk.w};
#pragma unroll
                for (int j = 0; j < 4; ++j) { *(LAS bf16_t*)(T + (d8 + 2 * j) * KT_LD) = (bf16_t)(pw[j] & 0xffffu); *(LAS bf16_t*)(T + (d8 + 2 * j + 1) * KT_LD) = (bf16_t)(pw[j] >> 16); } }
        }
        if (w == 7) {
            const int p = p0 + lane; float be = 0.f, g = 0.f;
            if (p >= 0) { const int r = ext_row(b, p); be = sigmoidf_(BA[(size_t)r * 32 + h]); g = -__expf(A_log[h]) * softplusf_(BA[(size_t)r * 32 + 16 + h] + dt_bias[h]); }
#pragma unroll
            for (int o = 1; o < 64; o <<= 1) { const float t = __shfl_up(g, o); if (lane >= o) g += t; }
            beta[lane] = be; gc[lane] = g;
        }
        __syncthreads();
        const float gl = gc[63];
        {
            const int kind = w >> 2, ti = w & 3;
            bf16x8_t af[4];
#pragma unroll
            for (int ks = 0; ks < 4; ++ks) af[ks] = *(const LAS bf16x8_t*)(L + L_KS + (16 * ti + fr) * QS_LD + (32 * ks + 8 * fq) * 2);
            bf16_t* oQK = QK + (size_t)cu * 4096;
#pragma unroll
            for (int tj = 0; tj < 4; ++tj) {
                if (kind == 0) {
                    if (tj > ti) continue;
                    f32x4 acc = (f32x4){0.f, 0.f, 0.f, 0.f};
#pragma unroll
                    for (int ks = 0; ks < 4; ++ks) acc = __builtin_amdgcn_mfma_f32_16x16x32_bf16(af[ks], *(const LAS bf16x8_t*)(L + L_KS + (16 * tj + fr) * QS_LD + (32 * ks + 8 * fq) * 2), acc, 0, 0, 0);
                    const int j = 16 * tj + fr; const float gj = gc[j];
#pragma unroll
                    for (int r = 0; r < 4; ++r) { const int i = 16 * ti + 4 * fq + r; Am[i * AM_LD + j] = j < i ? acc[r] * beta[i] * __expf(gc[i] - gj) : 0.f; }
                } else {
                    const int i = 16 * tj + fr; u32x2_t o = (u32x2_t){0u, 0u};
                    if (tj >= ti) {
                        f32x4 acc = (f32x4){0.f, 0.f, 0.f, 0.f};
#pragma unroll
                        for (int ks = 0; ks < 4; ++ks) acc = __builtin_amdgcn_mfma_f32_16x16x32_bf16(af[ks], *(const LAS bf16x8_t*)(L + L_QS + (16 * tj + fr) * QS_LD + (32 * ks + 8 * fq) * 2), acc, 0, 0, 0);
                        const float gi = gc[i];
#pragma unroll
                        for (int r = 0; r < 4; ++r) { const int j = 16 * ti + 4 * fq + r; acc[r] = j <= i ? acc[r] * __expf(gi - gc[j]) : 0.f; }
                        o = pack4bf(acc);
                    }
                    *(u32x2_t*)(oQK + i * 64 + 16 * ti + 4 * fq) = o;
                }
            }
        }
        __syncthreads();
        if (w == 0) {
            const int ab = fq, c = fr; float t[16];
#pragma unroll
            for (int r = 0; r < 16; ++r) { float s = (r == c) ? 1.f : 0.f;
#pragma unroll
                for (int m4 = 0; m4 < (r + 3) / 4; ++m4) { const f32x4 av = *(const LAS f32x4*)(Am + (16 * ab + r) * AM_LD + 16 * ab + 4 * m4);
#pragma unroll
                    for (int j = 0; j < 4; ++j) if (4 * m4 + j < r) s -= av[j] * t[4 * m4 + j]; }
                t[r] = s; Tm[(16 * ab + r) * AM_LD + 16 * ab + c] = s; }
        } else {
            bf16_t *oQD = QD + (size_t)cu * 8192, *oKDT = KDT + (size_t)cu * 8192;
            for (int idx = tid - 64; idx < 2048; idx += 448) {
                if (idx < 1024) { const int i = idx >> 4, d8 = (idx & 15) * 8; pg8::f32x4 x0, x1; pg8::unpack8(*(const LAS pg8::u32x4*)(L + L_QS + i * QS_LD + d8 * 2), x0, x1);
                    const float e = __expf(gc[i]); *(pg8::u32x4*)(oQD + i * 128 + d8) = pg8::pack8(x0 * e, x1 * e); }
                else { const int id = idx - 1024, d = id >> 3, i8 = (id & 7) * 8; pg8::f32x4 x0, x1; pg8::unpack8(*(const LAS pg8::u32x4*)(L + L_KT + d * KT_LD + i8 * 2), x0, x1);
#pragma unroll
                    for (int j = 0; j < 4; ++j) { x0[j] *= __expf(gl - gc[i8 + j]); x1[j] *= __expf(gl - gc[i8 + 4 + j]); }
                    *(pg8::u32x4*)(oKDT + d * 64 + i8) = pg8::pack8(x0, x1); }
            }
            if (tid == 64) GL[cu] = __expf(gl);
        }
        __syncthreads();
#pragma unroll
        for (int dd = 1; dd < 4; ++dd) {
            if (w < 4 - dd) {
                const int bb = w, ab = w + dd;
                f32x4 acc = (f32x4){0.f, 0.f, 0.f, 0.f};
                for (int c = bb; c < ab; ++c)
#pragma unroll
                    for (int ks = 0; ks < 4; ++ks) acc = __builtin_amdgcn_mfma_f32_16x16x4f32(Am[(16 * ab + fr) * AM_LD + 16 * c + 4 * ks + fq], Tm[(16 * c + 4 * ks + fq) * AM_LD + 16 * bb + fr], acc, 0, 0, 0);
                LAS float* Xs = (LAS float*)(L + L_XS + w * 1152);
#pragma unroll
                for (int r = 0; r < 4; ++r) Xs[(4 * fq + r) * 17 + fr] = acc[r];
                f32x4 acc2 = (f32x4){0.f, 0.f, 0.f, 0.f};
#pragma unroll
                for (int ks = 0; ks < 4; ++ks) acc2 = __builtin_amdgcn_mfma_f32_16x16x4f32(Tm[(16 * ab + fr) * AM_LD + 16 * ab + 4 * ks + fq], Xs[(4 * ks + fq) * 17 + fr], acc2, 0, 0, 0);
#pragma unroll
                for (int r = 0; r < 4; ++r) Tm[(16 * ab + 4 * fq + r) * AM_LD + 16 * bb + fr] = -acc2[r];
            }
            __syncthreads();
        }
        { const int i = tid >> 3, j8 = (tid & 7) * 8; f32x4 t0 = *(const LAS f32x4*)(Tm + i * AM_LD + j8), t1 = *(const LAS f32x4*)(Tm + i * AM_LD + j8 + 4); f32x4 b0, b1, w0, w1;
#pragma unroll
            for (int j = 0; j < 4; ++j) { const int ja = j8 + j, jb = j8 + 4 + j; const float ba = beta[ja], bb = beta[jb];
                b0[j] = ja <= i ? t0[j] * ba : 0.f; b1[j] = jb <= i ? t1[j] * bb : 0.f; w0[j] = b0[j] * __expf(gc[ja]); w1[j] = b1[j] * __expf(gc[jb]); }
            *(LAS pg8::u32x4*)(L + L_TB + i * KT_LD + j8 * 2) = pg8::pack8(b0, b1); *(LAS pg8::u32x4*)(L + L_TW + i * KT_LD + j8 * 2) = pg8::pack8(w0, w1); }
        __syncthreads();
        {
            bf16_t *oU = UT + (size_t)cu * 8192, *oNW = NW + (size_t)cu * 8192;
            bf16x8_t vf[2], kf[2];
#pragma unroll
            for (int ks = 0; ks < 2; ++ks) { vf[ks] = *(const LAS bf16x8_t*)(L + L_VT + (16 * w + fr) * KT_LD + (32 * ks + 8 * fq) * 2); kf[ks] = *(const LAS bf16x8_t*)(L + L_KT + (16 * w + fr) * KT_LD + (32 * ks + 8 * fq) * 2); }
#pragma unroll
            for (int mi = 0; mi < 4; ++mi) {
                f32x4 au = (f32x4){0.f, 0.f, 0.f, 0.f}, aw = (f32x4){0.f, 0.f, 0.f, 0.f};
#pragma unroll
                for (int ks = 0; ks < 2; ++ks) {
                    au = __builtin_amdgcn_mfma_f32_16x16x32_bf16(*(const LAS bf16x8_t*)(L + L_TB + (16 * mi + fr) * KT_LD + (32 * ks + 8 * fq) * 2), vf[ks], au, 0, 0, 0);
                    aw = __builtin_amdgcn_mfma_f32_16x16x32_bf16(kf[ks], *(const LAS bf16x8_t*)(L + L_TW + (16 * mi + fr) * KT_LD + (32 * ks + 8 * fq) * 2), aw, 0, 0, 0);
                }
                *(u32x2_t*)(oU + (16 * w + fr) * 64 + 16 * mi + 4 * fq) = pack4bf(au);
                *(u32x2_t*)(oNW + (16 * mi + fr) * 128 + 16 * w + 4 * fq) = pack4bf(-aw);
            }
        }
        __syncthreads();
    }
}

__device__ __forceinline__ void p3_scan_simple(Frame& F, const Args& a) {
    const bf16_t *NW = (const bf16_t*)(a.ws + WS_CH_NW), *UU = (const bf16_t*)(a.ws + WS_CH_U), *QD = (const bf16_t*)(a.ws + WS_CH_QD), *KDT = (const bf16_t*)(a.ws + WS_CH_KDT), *QK = (const bf16_t*)(a.ws + WS_CH_QK);
    const float* GL = (const float*)(a.ws + WS_CH_GL); bf16_t* O = (bf16_t*)(a.ws + WS_O);
    LAS float* sm = (LAS float*)(F.lds + RING_OFF);
    LAS float *nw = sm, *qd = sm + 8192, *kd = sm + 16384, *vn = sm + 24576;
    const int tid = F.tid, e = (tid >> 6) * 32 + (tid & 31), half = (tid >> 5) & 1, db = 64 * half; const bool act = tid < 256;
    for (int bh = F.vcu; bh < NB * NH; bh += F.G) {
        const int h = bh % NH, b = bh / NH;
        float S[64];
#pragma unroll
        for (int d = 0; d < 64; ++d) S[d] = 0.f;
        for (int n = 0; n < NCH; ++n) {
            const int cu = bh * NCH + n;
            for (int idx = tid; idx < 8192; idx += 512) { nw[idx] = bf2f(NW[(size_t)cu * 8192 + idx]); qd[idx] = bf2f(QD[(size_t)cu * 8192 + idx]);
                const int d = idx >> 6, i = idx & 63; kd[i * 128 + d] = bf2f(KDT[(size_t)cu * 8192 + idx]); }
            __syncthreads();
            const float gl = GL[cu];
            if (act) for (int i = 0; i < 64; ++i) { float s = 0.f;
#pragma unroll
                for (int d = 0; d < 64; ++d) s += nw[i * 128 + db + d] * S[d];
                s += __shfl_xor(s, 32); s += bf2f(UU[(size_t)cu * 8192 + e * 64 + i]);
                if (half == 0) vn[i * 128 + e] = s; }
            __syncthreads();
            if (act) {
                if (n > 0) for (int i = 0; i < 64; ++i) { float s = 0.f;
#pragma unroll
                    for (int d = 0; d < 64; ++d) s += qd[i * 128 + db + d] * S[d];
                    s += __shfl_xor(s, 32);
                    for (int j = 0; j <= i; ++j) s += bf2f(QK[(size_t)cu * 4096 + i * 64 + j]) * vn[j * 128 + e];
                    if (half == 0) O[(size_t)(b * SEQ + 64 * (n - 1) + i) * DNW + h * HD + e] = f2bf(s); }
#pragma unroll
                for (int d = 0; d < 64; ++d) S[d] *= gl;
                for (int i = 0; i < 64; ++i) { const float vi = vn[i * 128 + e];
#pragma unroll
                    for (int d = 0; d < 64; ++d) S[d] += kd[i * 128 + db + d] * vi; }
            }
            __syncthreads();
        }
    }
}


struct ScanOps { bf16x8_t a[4], x[2], kd[2]; float gl; };
constexpr int ST_LD = 272, VT_LD = 144;
template <int PROBE>
__device__ __forceinline__ void p3_scan_fast(Frame& F, const Args& a) {
    const bf16_t *NW = (const bf16_t*)(a.ws + WS_CH_NW), *UT = (const bf16_t*)(a.ws + WS_CH_U), *QD = (const bf16_t*)(a.ws + WS_CH_QD), *KDT = (const bf16_t*)(a.ws + WS_CH_KDT), *QK = (const bf16_t*)(a.ws + WS_CH_QK);
    const float* GL = (const float*)(a.ws + WS_CH_GL); bf16_t* O = (bf16_t*)(a.ws + (PROBE ? WS_Y : WS_O));
    LAS unsigned char* ST = F.lds + RING_OFF; LAS unsigned char* VT = ST + 32 * ST_LD;
    const int w = F.wave, lane = F.lane, fr = lane & 15, fq = lane >> 4, mt = w & 3; const bool vw = w < 4;
    for (int unit = F.vcu; unit < NB * NH * 4; unit += F.G) {
        const int bh = unit >> 2, s = unit & 3, h = bh % NH, b = bh / NH;
        f32x4 accS[2] = {(f32x4){0.f, 0.f, 0.f, 0.f}, (f32x4){0.f, 0.f, 0.f, 0.f}};
        for (int i = F.tid; i < 32 * ST_LD / 4; i += 512) ((LAS unsigned*)ST)[i] = 0u;
        __syncthreads();
        const bf16_t* Asrc = (vw ? NW : QD) + (16 * mt + fr) * 128 + 8 * fq;
        const bf16_t* Ksrc = KDT + (16 * w + fr) * 64 + 8 * fq;
        const bf16_t* Xsrc = vw ? UT + (32 * s + fr) * 64 + 16 * mt + 8 * (fq >> 1) : QK + (16 * mt + fr) * 64 + 8 * fq;
        const size_t xstride = vw ? 8192 : 4096; const int xstep = vw ? 16 * 64 : 32; const bool hiq = (fq & 1) != 0;
#define SCAN_LOAD(ops, n_) do { const size_t cu_ = (size_t)(bh * NCH + (PROBE != 0 ? 0 : (n_))); \
        _Pragma("unroll") for (int ks = 0; ks < 4; ++ks) (ops).a[ks] = *(const bf16x8_t*)(Asrc + cu_ * 8192 + 32 * ks); \
        _Pragma("unroll") for (int ks = 0; ks < 2; ++ks) (ops).kd[ks] = *(const bf16x8_t*)(Ksrc + cu_ * 8192 + 32 * ks); \
        (ops).x[0] = *(const bf16x8_t*)(Xsrc + cu_ * xstride); (ops).x[1] = *(const bf16x8_t*)(Xsrc + cu_ * xstride + xstep); \
        (ops).gl = GL[cu_]; } while (0)
#define SCAN_STEP(ops, n_) do { \
        f32x4 acc[2]; \
        _Pragma("unroll") for (int n2 = 0; n2 < 2; ++n2) { const unsigned u0_ = hiq ? (unsigned)__builtin_bit_cast(u32x4_t, (ops).x[n2]).z : (unsigned)__builtin_bit_cast(u32x4_t, (ops).x[n2]).x, u1_ = hiq ? (unsigned)__builtin_bit_cast(u32x4_t, (ops).x[n2]).w : (unsigned)__builtin_bit_cast(u32x4_t, (ops).x[n2]).y; \
            acc[n2] = vw ? (f32x4){__uint_as_float(u0_ << 16), __uint_as_float(u0_ & 0xffff0000u), __uint_as_float(u1_ << 16), __uint_as_float(u1_ & 0xffff0000u)} : (f32x4){0.f, 0.f, 0.f, 0.f}; } \
        _Pragma("unroll") for (int ks = 0; ks < 4; ++ks) _Pragma("unroll") for (int n2 = 0; n2 < 2; ++n2) \
            acc[n2] = __builtin_amdgcn_mfma_f32_16x16x32_bf16((ops).a[ks], *(const LAS bf16x8_t*)(ST + (16 * n2 + fr) * ST_LD + (32 * ks + 8 * fq) * 2), acc[n2], 0, 0, 0); \
        if (vw) { _Pragma("unroll") for (int n2 = 0; n2 < 2; ++n2) *(LAS u32x2_t*)(VT + (16 * n2 + fr) * VT_LD + (16 * mt + 4 * fq) * 2) = pack4bf(acc[n2]); } \
        __syncthreads(); \
        bf16x8_t bV[2][2]; \
        _Pragma("unroll") for (int n2 = 0; n2 < 2; ++n2) _Pragma("unroll") for (int ks = 0; ks < 2; ++ks) bV[n2][ks] = *(const LAS bf16x8_t*)(VT + (16 * n2 + fr) * VT_LD + (32 * ks + 8 * fq) * 2); \
        if (!vw) { _Pragma("unroll") for (int n2 = 0; n2 < 2; ++n2) _Pragma("unroll") for (int ks = 0; ks < 2; ++ks) acc[n2] = __builtin_amdgcn_mfma_f32_16x16x32_bf16((ops).x[ks], bV[n2][ks], acc[n2], 0, 0, 0); \
            if ((n_) > 0 && PROBE != 2) { bf16_t* op = O + (size_t)(b * SEQ + 64 * ((n_) - 1) + 16 * mt + 4 * fq) * DNW + h * HD + 32 * s + fr; \
                _Pragma("unroll") for (int n2 = 0; n2 < 2; ++n2) _Pragma("unroll") for (int r = 0; r < 4; ++r) op[(size_t)r * DNW + 16 * n2] = f2bf(acc[n2][r]); } } \
        _Pragma("unroll") for (int n2 = 0; n2 < 2; ++n2) { accS[n2] = accS[n2] * (ops).gl; \
            _Pragma("unroll") for (int ks = 0; ks < 2; ++ks) accS[n2] = __builtin_amdgcn_mfma_f32_16x16x32_bf16((ops).kd[ks], bV[n2][ks], accS[n2], 0, 0, 0); \
            *(LAS u32x2_t*)(ST + (16 * n2 + fr) * ST_LD + (16 * w + 4 * fq) * 2) = pack4bf(accS[n2]); } \
        __syncthreads(); } while (0)
        ScanOps opA, opB, opC;
        SCAN_LOAD(opA, 0); SCAN_LOAD(opB, 1);
        for (int n = 0; n < NCH; n += 3) {
            SCAN_LOAD(opC, n + 2); SCAN_STEP(opA, n);
            SCAN_LOAD(opA, n + 3 < NCH ? n + 3 : NCH - 1); SCAN_STEP(opB, n + 1);
            SCAN_LOAD(opB, n + 4 < NCH ? n + 4 : NCH - 1); SCAN_STEP(opC, n + 2);
        }
#undef SCAN_LOAD
#undef SCAN_STEP
    }
}

__device__ __forceinline__ void p3b_gnorm(Frame& F, const Args& a) {
    const bf16_t *O = (const bf16_t*)(a.ws + WS_O), *SZD = (const bf16_t*)(a.ws + WS_SZD); bf16_t* Y = (bf16_t*)(a.ws + WS_Y); const float* w = a.in[9];
    const int gw = F.vcu * NWAVES + F.wave, NGW = F.G * NWAVES, lane = F.lane;
    const float w0 = w[2 * lane], w1 = w[2 * lane + 1];
    for (int it = gw; it < MTOK * NH; it += NGW) {
        const size_t base = (size_t)(it >> 4) * DNW + (it & 15) * HD + 2 * lane, yb = (size_t)(it >> 4) * YLD + 1024 + (it & 15) * HD + 2 * lane;
        const unsigned ov = *(const unsigned*)(O + base), zv = *(const unsigned*)(SZD + base);
        const float a0 = __uint_as_float(ov << 16), a1 = __uint_as_float(ov & 0xffff0000u);
        const float rs = rsqrtf(wave_sum(a0 * a0 + a1 * a1) * (1.f / HD) + EPS);
        *(unsigned*)(Y + yb) = pk2(a0 * rs * w0 * __uint_as_float(zv << 16), a1 * rs * w1 * __uint_as_float(zv & 0xffff0000u));
    }
}

__device__ __forceinline__ void p6_final(Frame& F, const Args& a) {
    const float* w = a.in[13]; float* out = a.out;
    const int gw = F.vcu * NWAVES + F.wave, NGW = F.G * NWAVES;
    for (int r = gw; r < MTOK; r += NGW) {
        float* row = out + (size_t)r * DM;
        f32x4 v[8]; float s = 0.f;
#pragma unroll
        for (int j = 0; j < 8; ++j) { v[j] = *(const f32x4*)(row + 4 * F.lane + 256 * j); s += (v[j].x * v[j].x + v[j].y * v[j].y) + (v[j].z * v[j].z + v[j].w * v[j].w); }
        const float rs = rsqrtf(wave_sum(s) * (1.f / DM) + EPS);
#pragma unroll
        for (int j = 0; j < 8; ++j) { const f32x4 ww = *(const f32x4*)(w + 4 * F.lane + 256 * j); *(f32x4*)(row + 4 * F.lane + 256 * j) = v[j] * rs * ww; }
    }
}

struct PoolMixOrder {
    int G, c;
    __device__ bool next(int i, pg8::Unit& u) const { const int L = i * G + c; if (L >= 128) return false; u.pm = L >> 2; u.pn = L & 3; u.aoff = (L & 3) * 256; u.boff = 0; u.nt = 4; u.mode = 0; return true; }
};
struct MergeOrder {
    pg8::StaticOrder so;
    __device__ bool next(int i, pg8::Unit& u) const { if (!so.next(i >> 1, u)) return false; if ((i & 1) == 0) { u.nt = 16; u.mode = 0; } else { u.aoff = 1024; u.boff = 1024; u.nt = 32; u.mode = 1; } return true; }
};

constexpr int NPHASE = 8;
__global__ void __launch_bounds__(NWAVES * 64, 2) mega_fwd(Args args) {
    extern __shared__ __attribute__((aligned(16))) unsigned char lds[];
    Frame F;
    F.lds = (LAS unsigned char*)lds;
    F.tid = threadIdx.x; F.lane = F.tid & 63; F.wave = __builtin_amdgcn_readfirstlane(F.tid >> 6);
    F.G = gridDim.x; { const int bx = blockIdx.x; F.vcu = (F.G % 8 == 0) ? (bx % 8) * (F.G / 8) + bx / 8 : bx; }
    unsigned char* ws = args.ws;
    for (int u = F.tid; u < (LDS_BYTES - LDSCTL_OFF) / 4; u += NWAVES * 64) ((LAS unsigned*)(F.lds + LDSCTL_OFF))[u] = 0u;
    __syncthreads();
    const int lo = args.ph_lo, hi = args.ph_hi;
    XcdBarrier bar; bar.bar = (unsigned*)(ws + WS_CTL) + CW_BAR; bar.x = 0; bar.st = nullptr;
    if (hi - lo > 1 || DUP_MASK) bar = xcd_barrier_post((unsigned*)(ws + WS_CTL) + CW_BAR, (volatile LAS unsigned*)(F.lds + MISC_OFF) + 8);
#define DUP(k) ((DUP_MASK >> (k)) & 1)
#define PHASE(k, ...) do { if (lo <= (k) && (k) < hi) { __VA_ARGS__ if (DUP(k)) { xcd_barrier(bar); __VA_ARGS__ } if ((k) + 1 < hi) xcd_barrier(bar); } } while (0)
    PHASE(0, p0_prologue(F, args););
    PHASE(1, {
        pg8::Gemm g{(const bf16_t*)(ws + WS_XN), (const bf16_t*)(ws + WS_WINT), DM, DM}; pg8::StaticOrder S; S.init(MPAD / 256, NPAD1 / 256, DM / 64, F.G, (int)blockIdx.x);
        pg8::EpiProj E{(bf16_t*)(ws + WS_U), (bf16_t*)(ws + WS_SZP), (bf16_t*)(ws + WS_QKV), (bf16_t*)(ws + WS_SZD), (bf16_t*)(ws + WS_GATES), (float*)(ws + WS_BA)};
        pg8::gemm_phase<pg8::EpiProj, pg8::StaticOrder, true>(F.lds + RING_OFF, g, S, E); });
    PHASE(2, p2_pool(F, args); if (SIMPLE_PREP) p2_chunk_prep_simple(F, args); else p2_chunk_prep_fast(F, args););
    #ifndef SCAN_PROBE
#define SCAN_PROBE 0
#endif
    PHASE(3, if (SIMPLE_SCAN) p3_scan_simple(F, args); else { if (SCAN_PROBE) p3_scan_fast<SCAN_PROBE>(F, args); p3_scan_fast<0>(F, args); });
    PHASE(4, {
        p3b_gnorm(F, args);
        pg8::Gemm g{(const bf16_t*)(ws + WS_POOLED), (const bf16_t*)(ws + WS_MIXT), PW, PGD}; PoolMixOrder S{F.G, F.vcu};
        pg8::EpiPoolMix E{(bf16_t*)(ws + WS_Y), (const bf16_t*)(ws + WS_SZP), args.in[8]};
        pg8::gemm_phase<pg8::EpiPoolMix, PoolMixOrder, false>(F.lds + RING_OFF, g, S, E); });
    PHASE(5, {
        pg8::Gemm g{(const bf16_t*)(ws + WS_Y), (const bf16_t*)(ws + WS_W2T), YLD, YLD}; MergeOrder S; S.so.init(MTOK / 256, DM / 256, 0, F.G, (int)blockIdx.x);
        pg8::EpiMerge E{(const bf16_t*)(ws + WS_GATES), (bf16_t*)(ws + WS_MERGED)};
        pg8::gemm_phase<pg8::EpiMerge, MergeOrder, false>(F.lds + RING_OFF, g, S, E); });
    PHASE(6, {
        pg8::Gemm g{(const bf16_t*)(ws + WS_MERGED), (const bf16_t*)(ws + WS_WOT), DM, DM}; pg8::StaticOrder S; S.init(MTOK / 256, DM / 256, DM / 64, F.G, (int)blockIdx.x);
        pg8::EpiResid E{args.in[0], args.out};
        pg8::gemm_phase<pg8::EpiResid, pg8::StaticOrder, false>(F.lds + RING_OFF, g, S, E); });
    PHASE(7, p6_final(F, args););
#undef PHASE
#undef DUP
}
#ifndef MIX
#define MIX 0
#endif
#ifndef NAIVE_MASK
#define NAIVE_MASK 0
#endif
#ifndef FUSE
#define FUSE 1
#endif
extern "C" void kernel_launch(void* const* d_in, const int* in_sizes, int n_in, void* d_out, int out_size, void* d_ws, size_t ws_size, hipStream_t stream) {
    static int grid = 0;
    if (grid == 0) {
        if (n_in != 14 || in_sizes[0] != MTOK * DM || out_size != MTOK * DM || ws_size < WS_END) { fprintf(stderr, "kernel_launch: unexpected shapes / workspace (%zu < %zu); nothing launched\n", ws_size, (size_t)WS_END); grid = -1; return; }
        int dev = 0, cus = 0;
        if (hipGetDevice(&dev) != hipSuccess || hipDeviceGetAttribute(&cus, hipDeviceAttributeMultiprocessorCount, dev) != hipSuccess) { grid = -1; return; }
        if (hipFuncSetAttribute((const void*)mega_fwd, hipFuncAttributeMaxDynamicSharedMemorySize, LDS_BYTES) != hipSuccess) { fprintf(stderr, "kernel_launch: hipFuncSetAttribute failed\n"); grid = -1; return; }
#if MIX
        if (hipFuncSetAttribute((const void*)nv_chunk_prep, hipFuncAttributeMaxDynamicSharedMemorySize, 140 * 1024) != hipSuccess) { grid = -1; return; }
#endif
        (void)hipGetLastError();
        grid = cus;
    }
    if (grid < 0) return;
    if (hipMemsetAsync((char*)d_ws + WS_CTL, 0, CTL_ZERO_BYTES, stream) != hipSuccess) return;
    Args a{};
    for (int i = 0; i < 14; ++i) a.in[i] = (const float*)d_in[i];
    a.out = (float*)d_out; a.ws = (unsigned char*)d_ws;
#if !MIX
    a.ph_lo = 0; a.ph_hi = NPHASE;
    hipLaunchKernelGGL(mega_fwd, dim3(grid), dim3(NWAVES * 64), LDS_BYTES, stream, a);
#else
    const float *x = a.in[0], *meta = a.in[1], *norm_w = a.in[2], *w_in = a.in[3], *conv_w = a.in[4], *A_log = a.in[5], *dt_bias = a.in[6], *pool_mix = a.in[7], *pool_scale = a.in[8],
                *dn_norm_w = a.in[9], *w_pool_out = a.in[10], *w_dn_out = a.in[11], *w_o = a.in[12], *final_norm_w = a.in[13];
    unsigned char* ws = (unsigned char*)d_ws; float* out = (float*)d_out;
    bf16_t *XN = (bf16_t*)(ws + WS_XN), *U = (bf16_t*)(ws + WS_U), *SZP = (bf16_t*)(ws + WS_SZP), *QKV = (bf16_t*)(ws + WS_QKV), *SZD = (bf16_t*)(ws + WS_SZD), *GATES = (bf16_t*)(ws + WS_GATES);
    float* BA = (float*)(ws + WS_BA);
    bf16_t *Y = (bf16_t*)(ws + WS_Y), *PO = (bf16_t*)(ws + WS_POOLED), *O = (bf16_t*)(ws + WS_O), *MG = (bf16_t*)(ws + WS_MERGED);
    bf16_t *cNW = (bf16_t*)(ws + WS_CH_NW), *cU = (bf16_t*)(ws + WS_CH_U), *cQD = (bf16_t*)(ws + WS_CH_QD), *cKDT = (bf16_t*)(ws + WS_CH_KDT), *cQK = (bf16_t*)(ws + WS_CH_QK);
    float* cGL = (float*)(ws + WS_CH_GL);
    int s = 0;
    while (s < NPHASE) {
        if (!((NAIVE_MASK >> s) & 1)) {
            int e = s + 1;
            if (FUSE) while (e < NPHASE && !((NAIVE_MASK >> e) & 1)) ++e;
            a.ph_lo = s; a.ph_hi = e;
            hipLaunchKernelGGL(mega_fwd, dim3(grid), dim3(NWAVES * 64), LDS_BYTES, stream, a);
            s = e; continue;
        }
        switch (s) {
        case 0: nv_prep<<<1024, 256, 0, stream>>>(x, meta, norm_w, XN); break;
        case 1: nv_gemm<EpiProj><<<dim3((INC + 127) / 128, (MROWS + 127) / 128), 256, 0, stream>>>(XN, DM, w_in, INC, MROWS, INC, DM, EpiProj{U, SZP, QKV, SZD, GATES, BA}); break;
        case 2: nv_pool<<<MTOK * PW / 256, 256, 0, stream>>>(U, PO);
                nv_chunk_prep<<<NUNITS, 256, 140 * 1024, stream>>>(QKV, BA, conv_w, A_log, dt_bias, cNW, cU, cQD, cKDT, cQK, cGL); break;
        case 3: nv_chunk_scan<<<NB * NH, 128, 0, stream>>>(cNW, cU, cQD, cKDT, cQK, cGL, O); break;
        case 4: nv_gnorm<<<MTOK * NH / 4, 256, 0, stream>>>(O, SZD, dn_norm_w, Y);
                for (int g = 0; g < 4; ++g)
                    nv_gemm<EpiPool><<<dim3(2, MTOK / 128), 256, 0, stream>>>(PO + g * PGD, PW, pool_mix + (size_t)g * PGD * PGD, PGD, MTOK, PGD, PGD, EpiPool{Y, SZP, pool_scale, g, 0});
                break;
        case 5: nv_gemm<EpiG2a><<<dim3(DM / 128, MTOK / 128), 256, 0, stream>>>(Y, YLD, w_pool_out, DM, MTOK, DM, PW, EpiG2a{out, GATES});
                nv_gemm<EpiG2b><<<dim3(DM / 128, MTOK / 128), 256, 0, stream>>>(Y + 1024, YLD, w_dn_out, DM, MTOK, DM, DNW, EpiG2b{out, GATES, MG}); break;
        case 6: nv_gemm<EpiG3><<<dim3(DM / 128, MTOK / 128), 256, 0, stream>>>(MG, DM, w_o, DM, MTOK, DM, DM, EpiG3{x, out}); break;
        case 7: nv_final<<<MTOK, 256, 0, stream>>>(out, final_norm_w); break;
        }
        ++s;
    }
#endif
}
```

```cpp
#define MIX 0
#include <hip/hip_runtime.h>
#include <cstdint>
#include <cstdio>

typedef unsigned short bf16_t;
__device__ __forceinline__ float bf2f(bf16_t v) { return __uint_as_float(((unsigned)v) << 16); }
__device__ __forceinline__ bf16_t f2bf(float f) { unsigned u = __float_as_uint(f); return (bf16_t)((u + 0x7fffu + ((u >> 16) & 1u)) >> 16); }
__device__ __forceinline__ float sigmoidf_(float x) { return 1.f / (1.f + __expf(-x)); }
__device__ __forceinline__ float siluf_(float x) { return x / (1.f + __expf(-x)); }
__device__ __forceinline__ float softplusf_(float x) { return x > 20.f ? x : log1pf(__expf(x)); }

constexpr int DM = 2048, NB = 4, SEQ = 2048, NMETA = 16, LEXT = SEQ + NMETA;
constexpr int PW = 1024, PGD = 256, NH = 16, HD = 128, DNW = 2048, CHUNK = 64, NCH = 33, PADF = 48;
constexpr int INC = 14368;
constexpr int C_U = 0, C_ZP = 1024, C_Q = 2048, C_ZD = 8192, C_B = 10240, C_GP = 10272;
constexpr int MTOK = NB * SEQ;
constexpr int MROWS = MTOK + NMETA;
constexpr int MPAD = 8448;
constexpr int NPAD1 = 14592;
constexpr int YLD = 3072;
constexpr float EPS = 1e-6f;
constexpr int NUNITS = NB * NH * NCH;

constexpr size_t MiB = 1u << 20;
constexpr size_t WS_CTL = 0, CTL_ZERO_BYTES = 1 * MiB;
constexpr size_t WS_CH = 1 * MiB;
constexpr size_t CH_ARR = (size_t)NUNITS * 8192 * 2;
constexpr size_t WS_CH_NW = WS_CH, WS_CH_U = WS_CH + CH_ARR, WS_CH_QD = WS_CH + 2 * CH_ARR, WS_CH_KDT = WS_CH + 3 * CH_ARR, WS_CH_QK = WS_CH + 4 * CH_ARR;
constexpr size_t WS_CH_GL = WS_CH_QK + (size_t)NUNITS * 4096 * 2;
constexpr size_t WS_WINT = WS_CH;
constexpr size_t WS_XN = WS_CH + 57 * MiB;
constexpr size_t WS_W2T = 150 * MiB;
constexpr size_t WS_WOT = 162 * MiB;
constexpr size_t WS_MIXT = 170 * MiB;
constexpr size_t WS_U = 171 * MiB;
constexpr size_t WS_SZP = WS_U + (size_t)MPAD * 1024 * 2;
constexpr size_t WS_QKV = WS_SZP + (size_t)MPAD * 1024 * 2;
constexpr size_t WS_BA = 303 * MiB;
constexpr size_t WS_O = 204 * MiB, WS_Y = 236 * MiB, WS_MERGED = 204 * MiB;
constexpr size_t WS_SZD = 304 * MiB + 512 * 1024;
constexpr size_t WS_GATES = WS_SZD + (size_t)MPAD * 2048 * 2;
constexpr size_t WS_POOLED = WS_GATES + (size_t)MPAD * 4096 * 2;
constexpr size_t WS_END = WS_POOLED + (size_t)MTOK * 1024 * 2;
static_assert(WS_CH_GL + NUNITS * 4 <= WS_W2T, "chunk arrays");
static_assert(WS_XN + (size_t)MPAD * 2048 * 2 <= WS_W2T, "xn");
static_assert(WS_QKV == 204 * MiB && WS_QKV + (size_t)MPAD * 6144 * 2 <= WS_BA, "qkv");
static_assert(WS_Y + (size_t)MTOK * YLD * 2 <= WS_BA, "y");
static_assert(WS_BA + (size_t)MPAD * 32 * 4 <= WS_SZD, "ba");
static_assert(WS_END <= 449 * MiB, "ws");

__device__ __forceinline__ int ext_row(int b, int p) { return p < NMETA ? MTOK + p : b * SEQ + (p - NMETA); }

__device__ __forceinline__ float wave_sum(float v) {
#pragma unroll
    for (int o = 1; o < 64; o <<= 1) v += __shfl_xor(v, o);
    return v;
}
#if MIX
__global__ void __launch_bounds__(256) nv_prep(const float* __restrict__ x, const float* __restrict__ meta, const float* __restrict__ nw, bf16_t* __restrict__ XN) {
    const int lane = threadIdx.x & 63, gw = (blockIdx.x * 256 + threadIdx.x) >> 6, ngw = gridDim.x * 4;
    for (int r = gw; r < MPAD; r += ngw) {
        bf16_t* o = XN + (size_t)r * DM;
        if (r >= MROWS) { for (int j = lane; j < DM; j += 64) o[j] = 0; continue; }
        const float* src = r < MTOK ? x + (size_t)r * DM : meta + (size_t)(r - MTOK) * DM;
        float v[32]; float s = 0.f;
#pragma unroll
        for (int j = 0; j < 32; ++j) { v[j] = src[lane + 64 * j]; s += v[j] * v[j]; }
        const float rs = rsqrtf(wave_sum(s) * (1.f / DM) + EPS);
#pragma unroll
        for (int j = 0; j < 32; ++j) o[lane + 64 * j] = f2bf(v[j] * rs * nw[lane + 64 * j]);
    }
}

template <class Epi>
__global__ void __launch_bounds__(256) nv_gemm(const bf16_t* __restrict__ A, int lda, const float* __restrict__ W, int ldw, int M, int N, int K, Epi epi) {
    __shared__ __attribute__((aligned(16))) float As[16][132];
    __shared__ __attribute__((aligned(16))) float Bs[16][132];
    const int tid = threadIdx.x, tx = tid & 15, ty = tid >> 4;
    const int m0 = blockIdx.y * 128, n0 = blockIdx.x * 128;
    float acc[8][8];
#pragma unroll
    for (int i = 0; i < 8; ++i)
#pragma unroll
        for (int j = 0; j < 8; ++j) acc[i][j] = 0.f;
    for (int k0 = 0; k0 < K; k0 += 16) {
        {
            const int r = tid >> 1, kc = (tid & 1) * 8, gm = m0 + r;
            uint4 v = make_uint4(0, 0, 0, 0);
            if (gm < M) v = *(const uint4*)(A + (size_t)gm * lda + k0 + kc);
            const unsigned w[4] = {v.x, v.y, v.z, v.w};
#pragma unroll
            for (int j = 0; j < 4; ++j) { As[kc + 2 * j][r] = __uint_as_float(w[j] << 16); As[kc + 2 * j + 1][r] = __uint_as_float(w[j] & 0xffff0000u); }
        }
        {
            const int kk = tid >> 4, nc = (tid & 15) * 8, gn = n0 + nc;
            float4 v0 = make_float4(0, 0, 0, 0), v1 = v0;
            if (gn < N) { const float* p = W + (size_t)(k0 + kk) * ldw + gn; v0 = *(const float4*)p; v1 = *(const float4*)(p + 4); }
            *(float4*)&Bs[kk][nc] = v0; *(float4*)&Bs[kk][nc + 4] = v1;
        }
        __syncthreads();
#pragma unroll
        for (int kk = 0; kk < 16; ++kk) {
            float a[8], b[8];
            *(float4*)&a[0] = *(const float4*)&As[kk][ty * 8]; *(float4*)&a[4] = *(const float4*)&As[kk][ty * 8 + 4];
            *(float4*)&b[0] = *(const float4*)&Bs[kk][tx * 8]; *(float4*)&b[4] = *(const float4*)&Bs[kk][tx * 8 + 4];
#pragma unroll
            for (int i = 0; i < 8; ++i)
#pragma unroll
                for (int j = 0; j < 8; ++j) acc[i][j] += a[i] * b[j];
        }
        __syncthreads();
    }
#pragma unroll
    for (int i = 0; i < 8; ++i)
#pragma unroll
        for (int j = 0; j < 8; ++j) { const int gm = m0 + ty * 8 + i, gn = n0 + tx * 8 + j; if (gm < M && gn < N) epi(gm, gn, acc[i][j]); }
}

struct EpiProj {
    bf16_t *U, *SZP, *QKV, *SZD, *GATES; float* BA;
    __device__ __forceinline__ void operator()(int m, int n, float v) const {
        if (n < C_ZP) U[(size_t)m * 1024 + n] = f2bf(v);
        else if (n < C_Q) SZP[(size_t)m * 1024 + (n - C_ZP)] = f2bf(siluf_(v));
        else if (n < C_ZD) QKV[(size_t)m * 6144 + (n - C_Q)] = f2bf(v);
        else if (n < C_B) SZD[(size_t)m * 2048 + (n - C_ZD)] = f2bf(siluf_(v));
        else if (n < C_GP) BA[(size_t)m * 32 + (n - C_B)] = v;
        else GATES[(size_t)m * 4096 + (n - C_GP)] = f2bf(sigmoidf_(v));
    }
};
struct EpiPool {
    bf16_t* Y; const bf16_t* SZP; const float* scale; int g, pad;
    __device__ __forceinline__ void operator()(int m, int n, float v) const {
        const int c = g * PGD + n; Y[(size_t)m * YLD + c] = f2bf(v * scale[c] * bf2f(SZP[(size_t)m * 1024 + c]));
    }
};
struct EpiG2a { float* T; const bf16_t* GATES; __device__ __forceinline__ void operator()(int m, int n, float v) const { T[(size_t)m * DM + n] = v * bf2f(GATES[(size_t)m * 4096 + n]); } };
struct EpiG2b { const float* T; const bf16_t* GATES; bf16_t* MG; __device__ __forceinline__ void operator()(int m, int n, float v) const { MG[(size_t)m * DM + n] = f2bf(T[(size_t)m * DM + n] + v * bf2f(GATES[(size_t)m * 4096 + 2048 + n])); } };
struct EpiG3 { const float* x; float* out; __device__ __forceinline__ void operator()(int m, int n, float v) const { out[(size_t)m * DM + n] = x[(size_t)m * DM + n] + v; } };

__global__ void __launch_bounds__(256) nv_pool(const bf16_t* __restrict__ U, bf16_t* __restrict__ PO) {
    const int idx = blockIdx.x * 256 + threadIdx.x; if (idx >= MTOK * PW) return;
    const int m = idx >> 10, c = idx & 1023, b = m >> 11, t = m & 2047, p = t + NMETA, win = 2 << (c >> 8);
    float s = 0.f;
    for (int j = 0; j < win; ++j) { const int pp = p - j; if (pp >= 0) s += bf2f(U[(size_t)ext_row(b, pp) * 1024 + c]); }
    const int cnt = (p + 1) < win ? (p + 1) : win;
    PO[idx] = f2bf(s / (float)cnt - bf2f(U[(size_t)m * 1024 + c]));
}

__global__ void __launch_bounds__(256) nv_chunk_prep(const bf16_t* __restrict__ QKV, const float* __restrict__ BA, const float* __restrict__ conv_w, const float* __restrict__ A_log,
                                                     const float* __restrict__ dt_bias, bf16_t* __restrict__ NW, bf16_t* __restrict__ UU, bf16_t* __restrict__ QD, bf16_t* __restrict__ KDT,
                                                     bf16_t* __restrict__ QK, float* __restrict__ GL) {
    extern __shared__ __attribute__((aligned(16))) float sm[];
    float *q = sm, *k = q + 8192, *v = k + 8192, *Am = v + 8192, *Tm = Am + 4096, *beta = Tm + 4096, *gc = beta + 64;
    const int cu = blockIdx.x, n = cu % NCH, bh = cu / NCH, h = bh % NH, b = bh / NH, tid = threadIdx.x, lane = tid & 63, wv = tid >> 6;
    const int p0 = CHUNK * n - PADF;
    for (int idx = tid; idx < 64 * 384; idx += 256) {
        const int i = idx / 384, c3 = idx % 384, which = c3 >> 7, d = c3 & 127, col = which * 2048 + h * HD + d, p = p0 + i;
        float val = 0.f;
        if (p >= 0) { float a = 0.f;
            for (int kk = 0; kk < 4; ++kk) { const int pp = p - 3 + kk; if (pp >= 0) a += conv_w[kk * 6144 + col] * bf2f(QKV[(size_t)ext_row(b, pp) * 6144 + col]); }
            val = siluf_(a); }
        (which == 0 ? q : which == 1 ? k : v)[i * 128 + d] = val;
    }
    if (tid < 64) { const int p = p0 + tid; float be = 0.f, g = 0.f;
        if (p >= 0) { const int r = ext_row(b, p); be = sigmoidf_(BA[(size_t)r * 32 + h]); g = -__expf(A_log[h]) * softplusf_(BA[(size_t)r * 32 + 16 + h] + dt_bias[h]); }
        beta[tid] = be; gc[tid] = g; }
    __syncthreads();
    if (tid == 0) { float s = 0.f; for (int i = 0; i < 64; ++i) { s += gc[i]; gc[i] = s; } }
    for (int r = wv; r < 128; r += 4) {
        float* row = (r < 64 ? q + r * 128 : k + (r - 64) * 128);
        const float a0 = row[lane], a1 = row[lane + 64];
        const float rs = rsqrtf(wave_sum(a0 * a0 + a1 * a1) + EPS) * (r < 64 ? 0.08838834764831845f : 1.f);
        row[lane] = a0 * rs; row[lane + 64] = a1 * rs;
    }
    __syncthreads();
    bf16_t* oQK = QK + (size_t)cu * 4096;
    for (int idx = tid; idx < 4096; idx += 256) {
        const int i = idx >> 6, j = idx & 63; float akk = 0.f, aqk = 0.f;
        if (j <= i) { for (int d = 0; d < 128; ++d) { const float kj = k[j * 128 + d]; akk += k[i * 128 + d] * kj; aqk += q[i * 128 + d] * kj; }
            const float dec = __expf(gc[i] - gc[j]); akk *= beta[i] * dec; aqk *= dec; }
        Am[idx] = j < i ? akk : 0.f; oQK[idx] = f2bf(j <= i ? aqk : 0.f);
    }
    __syncthreads();
    if (tid < 64) { const int c = tid;
        for (int i = 0; i < 64; ++i) { float s = (i == c) ? 1.f : 0.f; for (int j = c; j < i; ++j) s -= Am[i * 64 + j] * Tm[j * 64 + c]; Tm[i * 64 + c] = (i >= c) ? s : 0.f; } }
    __syncthreads();
    bf16_t *oNW = NW + (size_t)cu * 8192, *oU = UU + (size_t)cu * 8192, *oQD = QD + (size_t)cu * 8192, *oKDT = KDT + (size_t)cu * 8192;
    const float gl = gc[63];
    for (int idx = tid; idx < 8192; idx += 256) {
        const int i = idx >> 7, d = idx & 127; float su = 0.f, sw = 0.f;
        for (int j = 0; j <= i; ++j) { const float t = Tm[i * 64 + j] * beta[j]; su += t * v[j * 128 + d]; sw += t * __expf(gc[j]) * k[j * 128 + d]; }
        oU[idx] = f2bf(su); oNW[idx] = f2bf(-sw);
        oQD[idx] = f2bf(q[idx] * __expf(gc[i]));
        oKDT[d * 64 + i] = f2bf(k[idx] * __expf(gl - gc[i]));
    }
    if (tid == 0) GL[cu] = __expf(gl);
}

__global__ void __launch_bounds__(128) nv_chunk_scan(const bf16_t* __restrict__ NW, const bf16_t* __restrict__ UU, const bf16_t* __restrict__ QD, const bf16_t* __restrict__ KDT,
                                                     const bf16_t* __restrict__ QK, const float* __restrict__ GL, bf16_t* __restrict__ O) {
    __shared__ float vn[64][128];
    const int bh = blockIdx.x, h = bh % NH, b = bh / NH, e = threadIdx.x;
    float S[128];
#pragma unroll
    for (int d = 0; d < 128; ++d) S[d] = 0.f;
    for (int n = 0; n < NCH; ++n) {
        const int cu = bh * NCH + n;
        const bf16_t *nw = NW + (size_t)cu * 8192, *uu = UU + (size_t)cu * 8192, *qd = QD + (size_t)cu * 8192, *kdt = KDT + (size_t)cu * 8192, *qk = QK + (size_t)cu * 4096;
        const float gl = GL[cu];
        for (int i = 0; i < 64; ++i) { float a = bf2f(uu[i * 128 + e]);
#pragma unroll
            for (int d = 0; d < 128; ++d) a += bf2f(nw[i * 128 + d]) * S[d];
            vn[i][e] = a; }
        __syncthreads();
        if (n > 0) for (int i = 0; i < 64; ++i) { float a = 0.f;
#pragma unroll
            for (int d = 0; d < 128; ++d) a += bf2f(qd[i * 128 + d]) * S[d];
            for (int j = 0; j <= i; ++j) a += bf2f(qk[i * 64 + j]) * vn[j][e];
            O[(size_t)(b * SEQ + 64 * (n - 1) + i) * DNW + h * HD + e] = f2bf(a); }
#pragma unroll
        for (int d = 0; d < 128; ++d) { float s = S[d] * gl; for (int i = 0; i < 64; ++i) s += bf2f(kdt[d * 64 + i]) * vn[i][e]; S[d] = s; }
        __syncthreads();
    }
}

__global__ void __launch_bounds__(256) nv_gnorm(const bf16_t* __restrict__ O, const bf16_t* __restrict__ SZD, const float* __restrict__ w, bf16_t* __restrict__ Y) {
    const int lane = threadIdx.x & 63, gw = (blockIdx.x * 256 + threadIdx.x) >> 6; if (gw >= MTOK * NH) return;
    const size_t base = (size_t)(gw >> 4) * DNW + (gw & 15) * HD, yb = (size_t)(gw >> 4) * YLD + 1024 + (gw & 15) * HD;
    const float a0 = bf2f(O[base + lane]), a1 = bf2f(O[base + lane + 64]);
    const float rs = rsqrtf(wave_sum(a0 * a0 + a1 * a1) * (1.f / HD) + EPS);
    Y[yb + lane] = f2bf(a0 * rs * w[lane] * bf2f(SZD[base + lane]));
    Y[yb + lane + 64] = f2bf(a1 * rs * w[lane + 64] * bf2f(SZD[base + lane + 64]));
}

__global__ void __launch_bounds__(256) nv_final(float* __restrict__ out, const float* __restrict__ w) {
    __shared__ float red[4];
    float* row = out + (size_t)blockIdx.x * DM; const int tid = threadIdx.x;
    float v[8]; float s = 0.f;
#pragma unroll
    for (int j = 0; j < 8; ++j) { v[j] = row[tid + 256 * j]; s += v[j] * v[j]; }
    s = wave_sum(s); if ((tid & 63) == 0) red[tid >> 6] = s; __syncthreads();
    const float rs = rsqrtf((red[0] + red[1] + red[2] + red[3]) * (1.f / DM) + EPS);
#pragma unroll
    for (int j = 0; j < 8; ++j) row[tid + 256 * j] = v[j] * rs * w[tid + 256 * j];
}

#endif
namespace pg8 {
#define PG8_LAS __attribute__((address_space(3)))
typedef short bf16x8 __attribute__((ext_vector_type(8)));
typedef float f32x4 __attribute__((ext_vector_type(4)));
typedef unsigned u32x4 __attribute__((ext_vector_type(4)));
constexpr int BM = 256, BK = 64, HALF = 128, HTB = HALF * BK * 2  , STAGE_BYTES = 8 * HTB, NXCD = 8, WGM = 8;

__host__ __device__ __forceinline__ int lds_byte(int r, int c) { const int st = (r >> 4) * 2 + (c >> 5), rr = r & 15, cc = c & 31, ob = rr * 64 + cc * 2; return st * 1024 + (ob ^ (((ob >> 9) & 1) << 5)); }
__host__ __device__ __forceinline__ void stage_rc(int b, int& R, int& C) { const int st = b / 1024, sb = b % 1024, swz = sb ^ (((sb >> 9) & 1) << 5); R = (st >> 1) * 16 + swz / 64; C = (st & 1) * 32 + (swz % 64) / 2; }
__host__ __device__ __forceinline__ int perm32(int rho) { const int n = rho >> 4, i = rho & 15; return 8 * (i >> 2) + 4 * n + (i & 3); }

struct Unit { int pm, pn, aoff, boff, nt, mode; };
struct Gemm { const bf16_t* A; const bf16_t* Bt; int lda, ldb; };

struct StaticOrder {
    int nM, nN, nwg, G, c, nt;
    __device__ void init(int nM_, int nN_, int nt_, int G_, int c_) { nM = nM_; nN = nN_; nwg = nM * nN; G = G_; c = c_; nt = nt_; }
    __device__ bool next(int i, Unit& u) const {
        const long L = (long)i * G + c; if (L >= nwg) return false;
        int wgid = (int)L; { const int q = nwg / NXCD, r = nwg % NXCD, xcd = wgid % NXCD, off = wgid / NXCD; wgid = (xcd < r ? xcd * (q + 1) : r * (q + 1) + (xcd - r) * q) + off; }
        const int nig = WGM * nN, gid = wgid / nig, fm = gid * WGM, gsz = (nM - fm) < WGM ? (nM - fm) : WGM;
        u.pm = fm + ((wgid % nig) % gsz); u.pn = (wgid % nig) / gsz; u.aoff = 0; u.boff = 0; u.nt = nt; u.mode = 0; return true;
    }
};

typedef float f32x2_t __attribute__((ext_vector_type(2))); typedef __bf16 bf16x2_t __attribute__((ext_vector_type(2)));
__device__ __forceinline__ unsigned cvt_pk_bf16(float lo, float hi) { f32x2_t v = {lo, hi}; bf16x2_t b = __builtin_convertvector(v, bf16x2_t); return __builtin_bit_cast(unsigned, b); }
__device__ __forceinline__ u32x4 pack8(f32x4 v0, f32x4 v1) { u32x4 w; w.x = cvt_pk_bf16(v0[0], v0[1]); w.y = cvt_pk_bf16(v0[2], v0[3]); w.z = cvt_pk_bf16(v1[0], v1[1]); w.w = cvt_pk_bf16(v1[2], v1[3]); return w; }
__device__ __forceinline__ void unpack8(u32x4 w, f32x4& v0, f32x4& v1) {
    v0 = (f32x4){__uint_as_float(w.x << 16), __uint_as_float(w.x & 0xffff0000u), __uint_as_float(w.y << 16), __uint_as_float(w.y & 0xffff0000u)};
    v1 = (f32x4){__uint_as_float(w.z << 16), __uint_as_float(w.z & 0xffff0000u), __uint_as_float(w.w << 16), __uint_as_float(w.w & 0xffff0000u)};
}
__device__ __forceinline__ float fast_sigmoid(float x) { return __builtin_amdgcn_rcpf(1.f + __builtin_amdgcn_exp2f(-1.4426950408889634f * x)); }

struct EpiProj {
    static constexpr bool PERM = true;
    bf16_t *U, *SZP, *QKV, *SZD, *GATES; float* BA;
    __device__ __forceinline__ bool reset_after(const Unit&) const { return true; }
    __device__ __forceinline__ void operator()(f32x4 (&acc)[2][2][4][2], const Unit& u, int wr, int wc, int fr, int fq) const {
        const int row0 = u.pm * BM + wr * 64 + fr, pn = u.pn;
        if (pn == 56) {
            if (wc == 0) {
#pragma unroll
                for (int ai = 0; ai < 2; ++ai)
#pragma unroll
                    for (int m = 0; m < 4; ++m) { float* rowp = BA + (size_t)(row0 + ai * HALF + m * 16) * 32 + 8 * fq;
                        *(f32x4*)rowp = acc[ai][0][m][0]; *(f32x4*)(rowp + 4) = acc[ai][0][m][1]; }
            }
            return;
        }
        bf16_t* base; int ld, colt, act;
        if (pn < 4) { base = U; ld = 1024; colt = pn * 256; act = 0; }
        else if (pn < 8) { base = SZP; ld = 1024; colt = (pn - 4) * 256; act = 1; }
        else if (pn < 32) { base = QKV; ld = 6144; colt = (pn - 8) * 256; act = 0; }
        else if (pn < 40) { base = SZD; ld = 2048; colt = (pn - 32) * 256; act = 1; }
        else { base = GATES; ld = 4096; colt = (pn - 40) * 256; act = 2; }
        const int col0 = colt + wc * 32 + 8 * fq;
#pragma unroll
        for (int ai = 0; ai < 2; ++ai)
#pragma unroll
            for (int m = 0; m < 4; ++m) { bf16_t* rowp = base + (size_t)(row0 + ai * HALF + m * 16) * ld + col0;
#pragma unroll
                for (int bj = 0; bj < 2; ++bj) { f32x4 v0 = acc[ai][bj][m][0], v1 = acc[ai][bj][m][1];
                    if (act != 0) {
#pragma unroll
                        for (int j = 0; j < 4; ++j) { const float s0 = fast_sigmoid(v0[j]), s1 = fast_sigmoid(v1[j]); v0[j] = act == 1 ? v0[j] * s0 : s0; v1[j] = act == 1 ? v1[j] * s1 : s1; }
                    }
                    *(u32x4*)(rowp + bj * HALF) = pack8(v0, v1); } }
    }
};
struct EpiPoolMix {
    static constexpr bool PERM = true;
    bf16_t* Y; const bf16_t* SZP; const float* scale;
    __device__ __forceinline__ bool reset_after(const Unit&) const { return true; }
    __device__ __forceinline__ void operator()(f32x4 (&acc)[2][2][4][2], const Unit& u, int wr, int wc, int fr, int fq) const {
        const int row0 = u.pm * BM + wr * 64 + fr, col0 = u.pn * BM + wc * 32 + 8 * fq;
#pragma unroll
        for (int bj = 0; bj < 2; ++bj) { const f32x4 s0 = *(const f32x4*)(scale + col0 + bj * HALF), s1 = *(const f32x4*)(scale + col0 + bj * HALF + 4);
#pragma unroll
            for (int ai = 0; ai < 2; ++ai)
#pragma unroll
                for (int m = 0; m < 4; ++m) { const size_t r = (size_t)(row0 + ai * HALF + m * 16);
                    f32x4 z0, z1; unpack8(*(const u32x4*)(SZP + r * 1024 + col0 + bj * HALF), z0, z1);
                    *(u32x4*)(Y + r * YLD + col0 + bj * HALF) = pack8(acc[ai][bj][m][0] * s0 * z0, acc[ai][bj][m][1] * s1 * z1); } }
    }
};
struct EpiMerge {
    static constexpr bool PERM = true;
    const bf16_t* GATES; bf16_t* MG;
    __device__ __forceinline__ bool reset_after(const Unit& u) const { return u.mode != 0; }
    __device__ __forceinline__ void operator()(f32x4 (&acc)[2][2][4][2], const Unit& u, int wr, int wc, int fr, int fq) const {
        const int row0 = u.pm * BM + wr * 64 + fr, col0 = u.pn * BM + wc * 32 + 8 * fq;
#pragma unroll
        for (int ai = 0; ai < 2; ++ai)
#pragma unroll
            for (int m = 0; m < 4; ++m) { const size_t r = (size_t)(row0 + ai * HALF + m * 16);
#pragma unroll
                for (int bj = 0; bj < 2; ++bj) {
                    f32x4 d0, d1; unpack8(*(const u32x4*)(GATES + r * 4096 + 2048 + col0 + bj * HALF), d0, d1);
                    if (u.mode == 0) {
                        f32x4 p0, p1; unpack8(*(const u32x4*)(GATES + r * 4096 + col0 + bj * HALF), p0, p1);
#pragma unroll
                        for (int j = 0; j < 4; ++j) { acc[ai][bj][m][0][j] *= p0[j] / fmaxf(d0[j], 1e-30f); acc[ai][bj][m][1][j] *= p1[j] / fmaxf(d1[j], 1e-30f); }
                    } else {
                        *(u32x4*)(MG + r * DM + col0 + bj * HALF) = pack8(acc[ai][bj][m][0] * d0, acc[ai][bj][m][1] * d1);
                    } } }
    }
};
struct EpiResid {
    static constexpr bool PERM = false;
    const float* x; float* out;
    __device__ __forceinline__ bool reset_after(const Unit&) const { return true; }
    __device__ __forceinline__ void operator()(f32x4 (&acc)[2][2][4][2], const Unit& u, int wr, int wc, int fr, int fq) const {
        const int row0 = u.pm * BM + wr * 64 + fr, col0 = u.pn * BM + wc * 32 + 4 * fq;
#pragma unroll
        for (int ai = 0; ai < 2; ++ai)
#pragma unroll
            for (int m = 0; m < 4; ++m) { const size_t off = (size_t)(row0 + ai * HALF + m * 16) * DM + col0;
#pragma unroll
                for (int bj = 0; bj < 2; ++bj)
#pragma unroll
                    for (int n = 0; n < 2; ++n) *(f32x4*)(out + off + bj * HALF + n * 16) = *(const f32x4*)(x + off + bj * HALF + n * 16) + acc[ai][bj][m][n]; }
    }
};

template <class Epi, class Sched, bool ALIGN_EPI>
__device__ __forceinline__ void gemm_phase(PG8_LAS unsigned char* lds, const Gemm g, const Sched& S, const Epi& E) {
    const int tid = threadIdx.x, wid = __builtin_amdgcn_readfirstlane(tid >> 6), lane = tid & 63, wr = wid >> 2, wc = wid & 3, fr = lane & 15, fq = lane >> 4;
    const int lda = g.lda, ldb = g.ldb;
    unsigned voffA[2], voffB[2];
#pragma unroll
    for (int i = 0; i < 2; ++i) { int R, C; stage_rc(tid * 16 + i * 8192, R, C); const int Rb = Epi::PERM ? ((R & ~31) + perm32(R & 31)) : R;
        voffA[i] = (unsigned)(R * lda + C) * 2u; voffB[i] = (unsigned)(Rb * ldb + C) * 2u; }
    const size_t kstep = (size_t)(BK * 2);
    const size_t hstepA = (size_t)HALF * lda * 2, hstepB = (size_t)HALF * ldb * 2;
    const unsigned ldsw = (unsigned)wid * 1024u;
    const int aoff = lds_byte(wr * 64 + fr, fq * 8), boff = lds_byte(wc * 32 + fr, fq * 8);
#define PG8_SA(b, h) (((b) * 2 + (h)) * HTB)
#define PG8_SB(b, h) ((4 + (b) * 2 + (h)) * HTB)
#define PG8_STAGE(bufoff, gbase, voff) do { _Pragma("unroll") for (int _i = 0; _i < 2; ++_i) \
        __builtin_amdgcn_global_load_lds((const unsigned*)((const char*)(gbase) + (voff)[_i]), (PG8_LAS unsigned*)(lds + (bufoff) + ldsw + _i * 8192), 16, 0, 0); } while (0)
#define PG8_LDA(dst, b, h) do { _Pragma("unroll") for (int m = 0; m < 4; ++m) _Pragma("unroll") for (int k = 0; k < 2; ++k) dst[m][k] = *(const PG8_LAS bf16x8*)(lds + PG8_SA(b, h) + aoff + m * 2048 + k * 1024); } while (0)
#define PG8_LDB(dst, b, h) do { _Pragma("unroll") for (int n = 0; n < 2; ++n) _Pragma("unroll") for (int k = 0; k < 2; ++k) dst[n][k] = *(const PG8_LAS bf16x8*)(lds + PG8_SB(b, h) + boff + n * 2048 + k * 1024); } while (0)
#define PG8_MMA(ai, bj, At, Bt) do { __builtin_amdgcn_s_setprio(1); _Pragma("unroll") for (int m = 0; m < 4; ++m) _Pragma("unroll") for (int n = 0; n < 2; ++n) _Pragma("unroll") for (int k = 0; k < 2; ++k) \
        acc[ai][bj][m][n] = __builtin_amdgcn_mfma_f32_16x16x32_bf16(Bt[n][k], At[m][k], acc[ai][bj][m][n], 0, 0, 0); __builtin_amdgcn_s_setprio(0); } while (0)
#define PG8_WAIT_V(n) asm volatile("s_waitcnt vmcnt(" #n ")" ::: "memory")
#define PG8_WAIT_L(n) asm volatile("s_waitcnt lgkmcnt(" #n ")" ::: "memory")
#define PG8_BAR __builtin_amdgcn_s_barrier()
#define PG8_SCHED __builtin_amdgcn_sched_barrier(0)
#define PG8_UA(u) ((const char*)g.A + ((size_t)(u).pm * BM * lda + (u).aoff) * 2)
#define PG8_UB(u) ((const char*)g.Bt + ((size_t)(u).pn * BM * ldb + (u).boff) * 2)
    Unit cur, nxt; int ui = 0;
    if (!S.next(0, cur)) return;
    f32x4 acc[2][2][4][2];
#pragma unroll
    for (int a = 0; a < 2; ++a)
#pragma unroll
        for (int b = 0; b < 2; ++b)
#pragma unroll
            for (int m = 0; m < 4; ++m)
#pragma unroll
                for (int n = 0; n < 2; ++n) acc[a][b][m][n] = (f32x4){0.f, 0.f, 0.f, 0.f};
    bf16x8 At[4][2], B0[2][2], B1[2][2];
    const char* cA = PG8_UA(cur); const char* cB = PG8_UB(cur);
    PG8_STAGE(PG8_SB(0, 0), cB, voffB); PG8_STAGE(PG8_SB(0, 1), cB + hstepB, voffB); PG8_STAGE(PG8_SA(0, 0), cA, voffA); PG8_STAGE(PG8_SA(0, 1), cA + hstepA, voffA);
    if (wr == 1) PG8_BAR;
    PG8_WAIT_V(2); PG8_BAR;
    PG8_STAGE(PG8_SB(1, 0), cB + kstep, voffB); PG8_STAGE(PG8_SA(1, 0), cA + kstep, voffA); PG8_STAGE(PG8_SB(1, 1), cB + hstepB + kstep, voffB);
    PG8_WAIT_V(6); PG8_BAR;
    for (;;) {
        const bool has_next = S.next(ui + 1, nxt);
        const char* nA = has_next ? PG8_UA(nxt) : cA; const char* nB = has_next ? PG8_UB(nxt) : cB;
        const int nt = cur.nt;
        for (int t = 0; t < nt; t += 2) {
            const bool last = (t == nt - 2);
            const char* a1 = cA + (size_t)(t + 1) * kstep;
            const char* a2 = last ? nA : cA + (size_t)(t + 2) * kstep; const char* b2 = last ? nB : cB + (size_t)(t + 2) * kstep;
            const char* a3 = a2 + kstep; const char* b3 = b2 + kstep;
            PG8_LDB(B0, 0, 0); PG8_LDB(B1, 0, 1); PG8_SCHED; PG8_LDA(At, 0, 0); PG8_STAGE(PG8_SA(1, 1), a1 + hstepA, voffA);
            PG8_WAIT_V(8); PG8_WAIT_L(0); PG8_BAR; PG8_MMA(0, 0, At, B0); PG8_MMA(0, 1, At, B1); PG8_BAR; PG8_SCHED;
            PG8_LDA(At, 0, 1); PG8_STAGE(PG8_SB(0, 0), b2, voffB); PG8_STAGE(PG8_SB(0, 1), b2 + hstepB, voffB); PG8_STAGE(PG8_SA(0, 0), a2, voffA);
            PG8_WAIT_V(8); PG8_WAIT_L(0); PG8_BAR; PG8_MMA(1, 0, At, B0); PG8_MMA(1, 1, At, B1); PG8_BAR; PG8_SCHED;
            PG8_LDB(B0, 1, 0); PG8_LDB(B1, 1, 1); PG8_SCHED; PG8_LDA(At, 1, 0); PG8_STAGE(PG8_SA(0, 1), a2 + hstepA, voffA);
            PG8_WAIT_V(8); PG8_WAIT_L(0); PG8_BAR; PG8_MMA(0, 0, At, B0); PG8_MMA(0, 1, At, B1); PG8_BAR; PG8_SCHED;
            PG8_LDA(At, 1, 1); PG8_STAGE(PG8_SB(1, 0), b3, voffB); PG8_STAGE(PG8_SB(1, 1), b3 + hstepB, voffB); PG8_STAGE(PG8_SA(1, 0), a3, voffA);
            PG8_WAIT_V(8); PG8_WAIT_L(0); PG8_BAR; PG8_MMA(1, 0, At, B0); PG8_MMA(1, 1, At, B1); PG8_BAR; PG8_SCHED;
        }
        if constexpr (ALIGN_EPI) { if (wr == 0) PG8_BAR; }
        E(acc, cur, wr, wc, fr, fq);
        if (!has_next) break;
        if (E.reset_after(cur)) {
#pragma unroll
            for (int a = 0; a < 2; ++a)
#pragma unroll
                for (int b = 0; b < 2; ++b)
#pragma unroll
                    for (int m = 0; m < 4; ++m)
#pragma unroll
                        for (int n = 0; n < 2; ++n) acc[a][b][m][n] = (f32x4){0.f, 0.f, 0.f, 0.f};
        }
        cur = nxt; cA = nA; cB = nB; ++ui;
        if constexpr (ALIGN_EPI) { if (wr == 1) PG8_BAR; }
    }
    PG8_WAIT_V(0);
    if constexpr (!ALIGN_EPI) { if (wr == 0) PG8_BAR; }
    PG8_BAR;
#undef PG8_SA
#undef PG8_SB
#undef PG8_STAGE
#undef PG8_LDA
#undef PG8_LDB
#undef PG8_MMA
#undef PG8_WAIT_V
#undef PG8_WAIT_L
#undef PG8_BAR
#undef PG8_SCHED
#undef PG8_UA
#undef PG8_UB
}
}
#ifndef DUP_MASK
#define DUP_MASK 0
#endif
#ifndef SIMPLE_PREP
#define SIMPLE_PREP 0
#endif
#ifndef SIMPLE_SCAN
#define SIMPLE_SCAN 0
#endif
constexpr int NWAVES = 8;
constexpr int RING_OFF = 0, RING_BYTES = 131072;
constexpr int LDSCTL_OFF = RING_BYTES, MISC_OFF = LDSCTL_OFF + 320;
constexpr int XTRA_OFF = RING_BYTES + 1024;
constexpr int LDS_BYTES = 147456;
constexpr int CW_BAR = 4096;

#define GAS __attribute__((address_space(1)))
#define LAS __attribute__((address_space(3)))
typedef unsigned v4u __attribute__((ext_vector_type(4)));
typedef float f32x4 __attribute__((ext_vector_type(4)));
typedef GAS unsigned gu32;
#define LDS_WAIT() asm volatile("s_waitcnt lgkmcnt(0)" ::: "memory")
#define VM_WAIT() asm volatile("s_waitcnt vmcnt(0)" ::: "memory")
__device__ __forceinline__ unsigned pk2(float lo, float hi) { return (unsigned)f2bf(lo) | ((unsigned)f2bf(hi) << 16); }

#define XB_TMO      128
#define XB_XCNT(j)  (256  + 64 * (j))
#define XB_XSUB(j)  (1280 + 64 * (j))
#define XB_XGEN(j)  (2304 + 64 * (j))
#define XB_TOP      3328
#define XB_TOPGEN   3392
#define XCD_BAR_WORDS 3456
#define XB_SPIN_CAP (1u << 18)
__device__ __forceinline__ unsigned xb_ld(unsigned* p)              { return __hip_atomic_load(p, __ATOMIC_RELAXED, __HIP_MEMORY_SCOPE_AGENT); }
__device__ __forceinline__ unsigned xb_add(unsigned* p, unsigned v) { return __hip_atomic_fetch_add(p, v, __ATOMIC_RELAXED, __HIP_MEMORY_SCOPE_AGENT); }
__device__ __forceinline__ unsigned xb_xcc_id() { return (unsigned)__builtin_amdgcn_s_getreg((3 << 11) | 20) & 0xFu; }
#define XB_SPIN(cond, bar) do { unsigned _sp = 0; while (cond) { __builtin_amdgcn_s_sleep(1); \
    if ((++_sp & 255u) == 0u) { if (xb_ld(&(bar)[XB_TMO])) break; if (_sp > XB_SPIN_CAP) { atomicAdd(&(bar)[XB_TMO], 1u); break; } } } } while (0)
struct XcdBarrier { unsigned* bar; unsigned x; volatile LAS unsigned* st; };
__device__ __forceinline__ XcdBarrier xcd_barrier_post(unsigned* bar, volatile LAS unsigned* st) {
    XcdBarrier b; b.bar = bar; b.x = xb_xcc_id(); b.st = st;
    if (threadIdx.x == 0) (void)xb_add(&bar[XB_XCNT(b.x)], 1u);
    return b;
}
__device__ __forceinline__ void xcd_barrier_complete(unsigned* bar, unsigned x, unsigned& nloc, unsigned& nx) {
    const unsigned G = gridDim.x * gridDim.y * gridDim.z;
    unsigned sum, cnt, mine, sp = 0u;
    for (;;) {
        sum = 0u; cnt = 0u; mine = 0u;
#pragma unroll
        for (unsigned j = 0; j < 16; ++j) { const unsigned c = xb_ld(&bar[XB_XCNT(j)]); sum += c; cnt += (c > 0u) ? 1u : 0u; mine = (j == x) ? c : mine; }
        if (sum == G) break;
        __builtin_amdgcn_s_sleep(1);
        if ((++sp & 255u) == 0u) { if (xb_ld(&bar[XB_TMO])) break; if (sp > XB_SPIN_CAP) { atomicAdd(&bar[XB_TMO], 1u); break; } }
    }
    nloc = mine > 0u ? mine : 1u; nx = cnt > 0u ? cnt : 1u;
}
__device__ __forceinline__ void xcd_barrier(const XcdBarrier& b) {
    asm volatile("s_waitcnt vmcnt(0)" ::: "memory");
    __syncthreads();
    if (threadIdx.x == 0) {
        unsigned* bar = b.bar;
        __builtin_amdgcn_s_waitcnt(0);
        unsigned nloc = b.st[0], nx = b.st[1];
        if (nloc == 0u) { xcd_barrier_complete(bar, b.x, nloc, nx); b.st[0] = nloc; b.st[1] = nx; }
        const unsigned old = xb_add(&bar[XB_XSUB(b.x)], 1u);
        const unsigned gen = old / nloc;
        if (old + 1u == (gen + 1u) * nloc) {
            __builtin_amdgcn_fence(__ATOMIC_RELEASE, "agent");
            asm volatile("s_waitcnt vmcnt(0)" ::: "memory");
            const unsigned og = xb_add(&bar[XB_TOP], 1u);
            const unsigned tg = og / nx;
            if (og + 1u == (tg + 1u) * nx) xb_add(&bar[XB_TOPGEN], 1u);
            else XB_SPIN(xb_ld(&bar[XB_TOPGEN]) == tg, bar);
            __builtin_amdgcn_fence(__ATOMIC_ACQUIRE, "agent");
            xb_add(&bar[XB_XGEN(b.x)], 1u);
            asm volatile("s_waitcnt vmcnt(0)" ::: "memory");
        } else {
            XB_SPIN(xb_ld(&bar[XB_XGEN(b.x)]) == gen, bar);
            __builtin_amdgcn_fence(__ATOMIC_ACQUIRE, "agent");
            asm volatile("s_waitcnt vmcnt(0)" ::: "memory");
        }
    }
    __syncthreads();
}

struct Args { const float* in[14]; float* out; unsigned char* ws; int ph_lo, ph_hi; };

struct Frame {
    LAS unsigned char* lds; int tid, lane, wave, vcu, G;
};

__device__ __forceinline__ void p0_transpose_item(const float* __restrict__ W, int N, int k0, int n0, bf16_t* __restrict__ WT, int ldt, int dn0, int koff, LAS float* scr, int lane) {
#pragma unroll 8
    for (int i = 0; i < 32; ++i) { const int kk = 2 * i + (lane >> 5); scr[kk * 33 + (lane & 31)] = W[(size_t)(k0 + kk) * N + n0 + (lane & 31)]; }
    LDS_WAIT(); asm volatile("" ::: "memory");
    const int c = lane & 7;
#pragma unroll
    for (int j = 0; j < 4; ++j) { const int n = (lane >> 3) + 8 * j; const LAS float* s = scr + (8 * c) * 33 + n;
        v4u o; o.x = pk2(s[0 * 33], s[1 * 33]); o.y = pk2(s[2 * 33], s[3 * 33]); o.z = pk2(s[4 * 33], s[5 * 33]); o.w = pk2(s[6 * 33], s[7 * 33]);
        *(v4u*)(WT + (size_t)(dn0 + n) * ldt + koff + k0 + 8 * c) = o; }
    LDS_WAIT(); asm volatile("" ::: "memory");
}
__device__ __forceinline__ void p0_prologue(Frame& F, const Args& a) {
    unsigned char* ws = a.ws;
    bf16_t *WinT = (bf16_t*)(ws + WS_WINT), *W2T = (bf16_t*)(ws + WS_W2T), *WoT = (bf16_t*)(ws + WS_WOT), *MixT = (bf16_t*)(ws + WS_MIXT), *XN = (bf16_t*)(ws + WS_XN);
    LAS float* scr = (LAS float*)(F.lds + RING_OFF + F.wave * 16384);
    const int gw = F.vcu * NWAVES + F.wave, NGW = F.G * NWAVES;
    constexpr int I_IN = (DM / 64) * (INC / 32), I_PO = (PW / 64) * (DM / 32), I_DN = (DNW / 64) * (DM / 32), I_WO = (DM / 64) * (DM / 32), I_MX = 4 * (PGD / 64) * (PGD / 32);
    constexpr int NITEMS = I_IN + I_PO + I_DN + I_WO + I_MX;
    for (int it = gw; it < NITEMS; it += NGW) {
        int r = it;
        if (r < I_IN) { const int nblk = INC / 32, kb = r / nblk, nb = r % nblk, n0 = 32 * nb;
            const int dn0 = n0 < C_B ? n0 : (n0 < C_GP ? 14336 + (n0 - C_B) : n0 - 32);
            p0_transpose_item(a.in[3], INC, 64 * kb, n0, WinT, DM, dn0, 0, scr, F.lane); continue; } r -= I_IN;
        if (r < I_PO) { const int nblk = DM / 32, kb = r / nblk, nb = r % nblk; p0_transpose_item(a.in[10], DM, 64 * kb, 32 * nb, W2T, YLD, 32 * nb, 0, scr, F.lane); continue; } r -= I_PO;
        if (r < I_DN) { const int nblk = DM / 32, kb = r / nblk, nb = r % nblk; p0_transpose_item(a.in[11], DM, 64 * kb, 32 * nb, W2T, YLD, 32 * nb, 1024, scr, F.lane); continue; } r -= I_DN;
        if (r < I_WO) { const int nblk = DM / 32, kb = r / nblk, nb = r % nblk; p0_transpose_item(a.in[12], DM, 64 * kb, 32 * nb, WoT, DM, 32 * nb, 0, scr, F.lane); continue; } r -= I_WO;
        { const int g = r / 32, rr = r % 32, kb = rr / 8, nb = rr % 8;
          p0_transpose_item(a.in[7] + (size_t)g * PGD * PGD, PGD, 64 * kb, 32 * nb, MixT + (size_t)g * PGD * PGD, PGD, 32 * nb, 0, scr, F.lane); }
    }
    const float* nw = a.in[2];
    for (int r = gw; r < MPAD + (NPAD1 - INC); r += NGW) {
        if (r >= MROWS) { bf16_t* o = r < MPAD ? XN + (size_t)r * DM : WinT + (size_t)(INC + (r - MPAD)) * DM;
#pragma unroll
            for (int j = 0; j < 4; ++j) *(v4u*)(o + 8 * F.lane + 512 * j) = (v4u){0u, 0u, 0u, 0u};
            continue; }
        const float* src = r < MTOK ? a.in[0] + (size_t)r * DM : a.in[1] + (size_t)(r - MTOK) * DM;
        f32x4 v[8]; float s = 0.f;
#pragma unroll
        for (int j = 0; j < 8; ++j) { v[j] = *(const f32x4*)(src + 4 * F.lane + 256 * j); s += (v[j].x * v[j].x + v[j].y * v[j].y) + (v[j].z * v[j].z + v[j].w * v[j].w); }
        const float rs = rsqrtf(wave_sum(s) * (1.f / DM) + EPS);
        unsigned long long* o8 = (unsigned long long*)(XN + (size_t)r * DM) + F.lane;
#pragma unroll
        for (int j = 0; j < 8; ++j) { const f32x4 w = *(const f32x4*)(nw + 4 * F.lane + 256 * j);
            o8[64 * j] = (unsigned long long)pk2(v[j].x * rs * w.x, v[j].y * rs * w.y) | ((unsigned long long)pk2(v[j].z * rs * w.z, v[j].w * rs * w.w) << 32); }
    }
}

template <int WIN>
__device__ __forceinline__ void p2_pool_item(const bf16_t* __restrict__ U, bf16_t* __restrict__ PO, int g, int rb, int c) {
    const int b = rb >> 8, t0 = (rb & 255) * 8, col = g * 256 + c * 8;
    pg8::u32x4 raw[WIN + 7];
#pragma unroll
    for (int j = 0; j < WIN + 7; ++j) { const int t = t0 - (WIN - 1) + j; const int row = t >= 0 ? b * SEQ + t : MTOK + NMETA + t; raw[j] = *(const pg8::u32x4*)(U + (size_t)row * 1024 + col); }
    f32x4 s0 = (f32x4){0.f, 0.f, 0.f, 0.f}, s1 = s0;
#pragma unroll
    for (int j = 0; j < WIN - 1; ++j) { f32x4 x0, x1; pg8::unpack8(raw[j], x0, x1); s0 += x0; s1 += x1; }
    constexpr float inv = 1.f / (float)WIN;
#pragma unroll
    for (int i = 0; i < 8; ++i) { f32x4 x0, x1; pg8::unpack8(raw[WIN - 1 + i], x0, x1); s0 += x0; s1 += x1;
        *(pg8::u32x4*)(PO + (size_t)(b * SEQ + t0 + i) * 1024 + col) = pg8::pack8(s0 * inv - x0, s1 * inv - x1);
        f32x4 y0, y1; pg8::unpack8(raw[i], y0, y1); s0 -= y0; s1 -= y1; }
}
__device__ __forceinline__ void p2_pool(Frame& F, const Args& a) {
    const bf16_t* U = (const bf16_t*)(a.ws + WS_U); bf16_t* PO = (bf16_t*)(a.ws + WS_POOLED);
    const int gw = F.vcu * NWAVES + F.wave, NGW = F.G * NWAVES;
    for (int wi = gw; wi < 4 * 512; wi += NGW) {
        const int g = wi >> 9, rb = (wi & 511) * 2 + (F.lane >> 5), c = F.lane & 31;
        if (g == 0) p2_pool_item<2>(U, PO, 0, rb, c); else if (g == 1) p2_pool_item<4>(U, PO, 1, rb, c); else if (g == 2) p2_pool_item<8>(U, PO, 2, rb, c); else p2_pool_item<16>(U, PO, 3, rb, c);
    }
}
__device__ __forceinline__ void p2_chunk_prep_simple(Frame& F, const Args& a) {
    const bf16_t* QKV = (const bf16_t*)(a.ws + WS_QKV); const float* BA = (const float*)(a.ws + WS_BA);
    const float *conv_w = a.in[4], *A_log = a.in[5], *dt_bias = a.in[6];
    bf16_t *NW = (bf16_t*)(a.ws + WS_CH_NW), *UU = (bf16_t*)(a.ws + WS_CH_U), *QD = (bf16_t*)(a.ws + WS_CH_QD), *KDT = (bf16_t*)(a.ws + WS_CH_KDT), *QK = (bf16_t*)(a.ws + WS_CH_QK);
    float* GL = (float*)(a.ws + WS_CH_GL);
    LAS float* sm = (LAS float*)(F.lds + RING_OFF);
    LAS float *q = sm, *k = q + 8192, *v = k + 8192, *Am = v + 8192, *Tm = Am + 4096;
    LAS float *beta = (LAS float*)(F.lds + XTRA_OFF), *gc = beta + 64;
    const int tid = F.tid, lane = F.lane, wv = F.wave;
    for (int cu = F.vcu; cu < NUNITS; cu += F.G) {
        const int n = cu % NCH, bh = cu / NCH, h = bh % NH, b = bh / NH, p0 = CHUNK * n - PADF;
        for (int idx = tid; idx < 64 * 384; idx += 512) {
            const int i = idx / 384, c3 = idx % 384, which = c3 >> 7, d = c3 & 127, col = which * 2048 + h * HD + d, p = p0 + i;
            float val = 0.f;
            if (p >= 0) { float s = 0.f;
                for (int kk = 0; kk < 4; ++kk) { const int pp = p - 3 + kk; if (pp >= 0) s += conv_w[kk * 6144 + col] * bf2f(QKV[(size_t)ext_row(b, pp) * 6144 + col]); }
                val = siluf_(s); }
            (which == 0 ? q : which == 1 ? k : v)[i * 128 + d] = val;
        }
        if (tid < 64) { const int p = p0 + tid; float be = 0.f, g = 0.f;
            if (p >= 0) { const int r = ext_row(b, p); be = sigmoidf_(BA[(size_t)r * 32 + h]); g = -__expf(A_log[h]) * softplusf_(BA[(size_t)r * 32 + 16 + h] + dt_bias[h]); }
            beta[tid] = be; gc[tid] = g; }
        __syncthreads();
        if (tid == 0) { float s = 0.f; for (int i = 0; i < 64; ++i) { s += gc[i]; gc[i] = s; } }
        for (int r = wv; r < 128; r += 8) {
            LAS float* row = (r < 64 ? q + r * 128 : k + (r - 64) * 128);
            const float a0 = row[lane], a1 = row[lane + 64];
            const float rs = rsqrtf(wave_sum(a0 * a0 + a1 * a1) + EPS) * (r < 64 ? 0.08838834764831845f : 1.f);
            row[lane] = a0 * rs; row[lane + 64] = a1 * rs;
        }
        __syncthreads();
        bf16_t* oQK = QK + (size_t)cu * 4096;
        for (int idx = tid; idx < 4096; idx += 512) {
            const int i = idx >> 6, j = idx & 63; float akk = 0.f, aqk = 0.f;
            if (j <= i) { for (int d = 0; d < 128; ++d) { const float kj = k[j * 128 + d]; akk += k[i * 128 + d] * kj; aqk += q[i * 128 + d] * kj; }
                const float dec = __expf(gc[i] - gc[j]); akk *= beta[i] * dec; aqk *= dec; }
            Am[idx] = j < i ? akk : 0.f; oQK[idx] = f2bf(j <= i ? aqk : 0.f);
        }
        __syncthreads();
        if (tid < 64) { const int c = tid;
            for (int i = 0; i < 64; ++i) { float s = (i == c) ? 1.f : 0.f; for (int j = c; j < i; ++j) s -= Am[i * 64 + j] * Tm[j * 64 + c]; Tm[i * 64 + c] = (i >= c) ? s : 0.f; } }
        __syncthreads();
        bf16_t *oNW = NW + (size_t)cu * 8192, *oU = UU + (size_t)cu * 8192, *oQD = QD + (size_t)cu * 8192, *oKDT = KDT + (size_t)cu * 8192;
        const float gl = gc[63];
        for (int idx = tid; idx < 8192; idx += 512) {
            const int i = idx >> 7, d = idx & 127; float su = 0.f, sw = 0.f;
            for (int j = 0; j <= i; ++j) { const float t = Tm[i * 64 + j] * beta[j]; su += t * v[j * 128 + d]; sw += t * __expf(gc[j]) * k[j * 128 + d]; }
            oU[d * 64 + i] = f2bf(su); oNW[idx] = f2bf(-sw);
            oQD[idx] = f2bf(q[idx] * __expf(gc[i]));
            oKDT[d * 64 + i] = f2bf(k[idx] * __expf(gl - gc[i]));
        }
        if (tid == 0) GL[cu] = __expf(gl);
        __syncthreads();
    }
}

typedef short bf16x8_t __attribute__((ext_vector_type(8)));
typedef unsigned u32x2_t __attribute__((ext_vector_type(2)));
typedef unsigned u32x4_t __attribute__((ext_vector_type(4)));
__device__ __forceinline__ u32x2_t pack4bf(f32x4 v) { u32x2_t r; r.x = pg8::cvt_pk_bf16(v[0], v[1]); r.y = pg8::cvt_pk_bf16(v[2], v[3]); return r; }

constexpr int QS_LD = 272, KT_LD = 144, AM_LD = 68;
constexpr int L_QS = 0, L_KS = 17408, L_KT = 34816, L_VT = 53248, L_AM = 71680, L_TM = 89088, L_TB = 106496, L_TW = 115712, L_XS = 124928;
static_assert(L_XS + 3 * 1152 <= RING_BYTES, "chunk-prep LDS map");
__device__ __forceinline__ int ktoff(int d, int chunk) { return d * KT_LD + ((chunk ^ ((d >> 3) & 7)) << 4); }
struct PrepRaw { pg8::u32x4 x[11]; };
__device__ __forceinline__ void p2_chunk_prep_fast(Frame& F, const Args& a) {
    const bf16_t* QKV = (const bf16_t*)(a.ws + WS_QKV); const float* BA = (const float*)(a.ws + WS_BA);
    const float *conv_w = a.in[4], *A_log = a.in[5], *dt_bias = a.in[6];
    bf16_t *NW = (bf16_t*)(a.ws + WS_CH_NW), *UT = (bf16_t*)(a.ws + WS_CH_U), *QD = (bf16_t*)(a.ws + WS_CH_QD), *KDT = (bf16_t*)(a.ws + WS_CH_KDT), *QK = (bf16_t*)(a.ws + WS_CH_QK);
    float* GL = (float*)(a.ws + WS_CH_GL);
    LAS unsigned char* L = F.lds + RING_OFF;
    LAS float *Am = (LAS float*)(L + L_AM), *Tm = (LAS float*)(L + L_TM);
    LAS float *beta = (LAS float*)(F.lds + XTRA_OFF), *gc = beta + 64;
    const int tid = F.tid, lane = F.lane, w = F.wave, fr = lane & 15, fq = lane >> 4;
    const int which = w >> 1, ib = (4 * w + fq) & 7, d8 = 8 * fr; const bool cvt = w < 6;
    const int u_lo = (33 * F.vcu) / 4, u_hi = F.G == 256 ? (33 * (F.vcu + 1)) / 4 : 0;
#define PREP_LOAD(R, cu_) do { const int n_ = (cu_) % NCH, bh_ = (cu_) / NCH, h_ = bh_ % NH, b_ = bh_ / NH, colx = which * 2048 + h_ * HD + d8; \
        _Pragma("unroll") for (int j = 0; j < 11; ++j) { int pp = CHUNK * n_ - PADF + 8 * ib - 3 + j; pp = pp < 0 ? 0 : pp; (R).x[j] = *(const pg8::u32x4*)(QKV + (size_t)ext_row(b_, pp) * 6144 + colx); } \
        } while (0)
    LAS float* cw = (LAS float*)(F.lds + XTRA_OFF + 1024);
    PrepRaw raw; int hcur = -1;
    if (cvt && u_lo < u_hi) PREP_LOAD(raw, u_lo);
    for (int cu = u_lo; cu < u_hi; ++cu) {
        const int n = cu % NCH, bh = cu / NCH, h = bh % NH, b = bh / NH, p0 = CHUNK * n - PADF;
        if (h != hcur) { hcur = h; for (int i = tid; i < 4 * 384; i += 512) { const int kk = i / 384, c = i % 384; cw[i] = conv_w[kk * 6144 + (c >> 7) * 2048 + h * HD + (c & 127)]; } __syncthreads(); }
        if (cvt) {
            unsigned tr[8][4];
            f32x4 cwr[8];
#pragma unroll
            for (int kk = 0; kk < 4; ++kk) { cwr[2 * kk] = *(const LAS f32x4*)(cw + kk * 384 + which * 128 + d8); cwr[2 * kk + 1] = *(const LAS f32x4*)(cw + kk * 384 + which * 128 + d8 + 4); }
#pragma unroll
            for (int ii = 0; ii < 8; ++ii) {
                float v[8];
#pragma unroll
                for (int j = 0; j < 8; ++j) v[j] = 0.f;
#pragma unroll
                for (int kk = 0; kk < 4; ++kk) { const bool ok = p0 + 8 * ib + ii - 3 + kk >= 0; f32x4 x0, x1; pg8::unpack8(raw.x[ii + kk], x0, x1);
#pragma unroll
                    for (int j = 0; j < 4; ++j) { v[j] += ok ? cwr[2 * kk][j] * x0[j] : 0.f; v[4 + j] += ok ? cwr[2 * kk + 1][j] * x1[j] : 0.f; } }
#pragma unroll
                for (int j = 0; j < 8; ++j) v[j] = v[j] * pg8::fast_sigmoid(v[j]);
                if (which < 2) { float ss = 0.f;
#pragma unroll
                    for (int j = 0; j < 8; ++j) ss += v[j] * v[j];
                    ss += __shfl_xor(ss, 1); ss += __shfl_xor(ss, 2); ss += __shfl_xor(ss, 4); ss += __shfl_xor(ss, 8);
                    const float rs = rsqrtf(ss + EPS) * (which == 0 ? 0.08838834764831845f : 1.f);
#pragma unroll
                    for (int j = 0; j < 8; ++j) v[j] *= rs; }
                const pg8::u32x4 pk = pg8::pack8((f32x4){v[0], v[1], v[2], v[3]}, (f32x4){v[4], v[5], v[6], v[7]});
                if (which < 2) *(LAS pg8::u32x4*)(L + (which == 0 ? L_QS : L_KS) + (8 * ib + ii) * QS_LD + d8 * 2) = pk;
                tr[ii][0] = pk.x; tr[ii][1] = pk.y; tr[ii][2] = pk.z; tr[ii][3] = pk.w;
            }
            if (which >= 1) { LAS unsigned char* T = L + (which == 1 ? L_KT : L_VT);
#pragma unroll
                for (int dj = 0; dj < 8; ++dj) { pg8::u32x4 o;
                    const int q = dj >> 1;
                    if (dj & 1) { o.x = (tr[0][q] >> 16) | (tr[1][q] & 0xffff0000u); o.y = (tr[2][q] >> 16) | (tr[3][q] & 0xffff0000u); o.z = (tr[4][q] >> 16) | (tr[5][q] & 0xffff0000u); o.w = (tr[6][q] >> 16) | (tr[7][q] & 0xffff0000u); }
                    else { o.x = (tr[0][q] & 0xffffu) | (tr[1][q] << 16); o.y = (tr[2][q] & 0xffffu) | (tr[3][q] << 16); o.z = (tr[4][q] & 0xffffu) | (tr[5][q] << 16); o.w = (tr[6][q] & 0xffffu) | (tr[7][q] << 16); }
                    *(LAS pg8::u32x4*)(T + ktoff(d8 + dj, ib)) = o; } }
            if (cu + 1 < u_hi) PREP_LOAD(raw, cu + 1); else PREP_LOAD(raw, cu);
        }
        if (w == 7) {
            const int p = p0 + lane; float be = 0.f, g = 0.f;
            if (p >= 0) { const int r = ext_row(b, p); be = sigmoidf_(BA[(size_t)r * 32 + h]); g = -__expf(A_log[h]) * softplusf_(BA[(size_t)r * 32 + 16 + h] + dt_bias[h]); }
#pragma unroll
            for (int o = 1; o < 64; o <<= 1) { const float t = __shfl_up(g, o); if (lane >= o) g += t; }
            beta[lane] = be; gc[lane] = g;
        }
        __syncthreads();
        const float gl = gc[63];
        {
            const int kind = w >> 2, ti = w & 3;
            bf16x8_t af[4];
#pragma unroll
            for (int ks = 0; ks < 4; ++ks) af[ks] = *(const LAS bf16x8_t*)(L + L_KS + (16 * ti + fr) * QS_LD + (32 * ks + 8 * fq) * 2);
            bf16_t* oQK = QK + (size_t)cu * 4096;
#pragma unroll
            for (int tj = 0; tj < 4; ++tj) {
                if (kind == 0) {
                    if (tj > ti) continue;
                    f32x4 acc = (f32x4){0.f, 0.f, 0.f, 0.f};
#pragma unroll
                    for (int ks = 0; ks < 4; ++ks) acc = __builtin_amdgcn_mfma_f32_16x16x32_bf16(af[ks], *(const LAS bf16x8_t*)(L + L_KS + (16 * tj + fr) * QS_LD + (32 * ks + 8 * fq) * 2), acc, 0, 0, 0);
                    const int j = 16 * tj + fr; const float gj = gc[j];
#pragma unroll
                    for (int r = 0; r < 4; ++r) { const int i = 16 * ti + 4 * fq + r; Am[i * AM_LD + j] = j < i ? acc[r] * beta[i] * __expf(gc[i] - gj) : 0.f; }
                } else {
                    const int i = 16 * tj + fr; u32x2_t o = (u32x2_t){0u, 0u};
                    if (tj >= ti) {
                        f32x4 acc = (f32x4){0.f, 0.f, 0.f, 0.f};
#pragma unroll
                        for (int ks = 0; ks < 4; ++ks) acc = __builtin_amdgcn_mfma_f32_16x16x32_bf16(af[ks], *(const LAS bf16x8_t*)(L + L_QS + (16 * tj + fr) * QS_LD + (32 * ks + 8 * fq) * 2), acc, 0, 0, 0);
                        const float gi = gc[i];
#pragma unroll
                        for (int r = 0; r < 4; ++r) { const int j = 16 * ti + 4 * fq + r; acc[r] = j <= i ? acc[r] * __expf(gi - gc[j]) : 0.f; }
                        o = pack4bf(acc);
                    }
                    *(u32x2_t*)(oQK + i * 64 + 16 * ti + 4 * fq) = o;
                }
            }
        }
        __syncthreads();
        if (w == 0) {
            const int ab = fq, c = fr; float t[16];
#pragma unroll
            for (int r = 0; r < 16; ++r) { float s = (r == c) ? 1.f : 0.f;
#pragma unroll
                for (int m4 = 0; m4 < (r + 3) / 4; ++m4) { const f32x4 av = *(const LAS f32x4*)(Am + (16 * ab + r) * AM_LD + 16 * ab + 4 * m4);
#pragma unroll
                    for (int j = 0; j < 4; ++j) if (4 * m4 + j < r) s -= av[j] * t[4 * m4 + j]; }
                t[r] = s; Tm[(16 * ab + r) * AM_LD + 16 * ab + c] = s; }
        } else {
            bf16_t *oQD = QD + (size_t)cu * 8192, *oKDT = KDT + (size_t)cu * 8192;
            for (int idx = tid - 64; idx < 2048; idx += 448) {
                if (idx < 1024) { const int i = idx >> 4, d8 = (idx & 15) * 8; pg8::f32x4 x0, x1; pg8::unpack8(*(const LAS pg8::u32x4*)(L + L_QS + i * QS_LD + d8 * 2), x0, x1);
                    const float e = __expf(gc[i]); *(pg8::u32x4*)(oQD + i * 128 + d8) = pg8::pack8(x0 * e, x1 * e); }
                else { const int id = idx - 1024, d = id >> 3, i8 = (id & 7) * 8; pg8::f32x4 x0, x1; pg8::unpack8(*(const LAS pg8::u32x4*)(L + L_KT + ktoff(d, i8 >> 3)), x0, x1);
#pragma unroll
                    for (int j = 0; j < 4; ++j) { x0[j] *= __expf(gl - gc[i8 + j]); x1[j] *= __expf(gl - gc[i8 + 4 + j]); }
                    *(pg8::u32x4*)(oKDT + d * 64 + i8) = pg8::pack8(x0, x1); }
            }
            if (tid == 64) GL[cu] = __expf(gl);
        }
        __syncthreads();
#pragma unroll
        for (int dd = 1; dd < 4; ++dd) {
            if (w < 4 - dd) {
                const int bb = w, ab = w + dd;
                f32x4 acc = (f32x4){0.f, 0.f, 0.f, 0.f};
                for (int c = bb; c < ab; ++c)
#pragma unroll
                    for (int ks = 0; ks < 4; ++ks) acc = __builtin_amdgcn_mfma_f32_16x16x4f32(Am[(16 * ab + fr) * AM_LD + 16 * c + 4 * ks + fq], Tm[(16 * c + 4 * ks + fq) * AM_LD + 16 * bb + fr], acc, 0, 0, 0);
                LAS float* Xs = (LAS float*)(L + L_XS + w * 1152);
#pragma unroll
                for (int r = 0; r < 4; ++r) Xs[(4 * fq + r) * 17 + fr] = acc[r];
                f32x4 acc2 = (f32x4){0.f, 0.f, 0.f, 0.f};
#pragma unroll
                for (int ks = 0; ks < 4; ++ks) acc2 = __builtin_amdgcn_mfma_f32_16x16x4f32(Tm[(16 * ab + fr) * AM_LD + 16 * ab + 4 * ks + fq], Xs[(4 * ks + fq) * 17 + fr], acc2, 0, 0, 0);
#pragma unroll
                for (int r = 0; r < 4; ++r) Tm[(16 * ab + 4 * fq + r) * AM_LD + 16 * bb + fr] = -acc2[r];
            }
            __syncthreads();
        }
        { const int i = tid >> 3, j8 = (tid & 7) * 8; f32x4 t0 = *(const LAS f32x4*)(Tm + i * AM_LD + j8), t1 = *(const LAS f32x4*)(Tm + i * AM_LD + j8 + 4); f32x4 b0, b1, w0, w1;
#pragma unroll
            for (int j = 0; j < 4; ++j) { const int ja = j8 + j, jb = j8 + 4 + j; const float ba = beta[ja], bb = beta[jb];
                b0[j] = ja <= i ? t0[j] * ba : 0.f; b1[j] = jb <= i ? t1[j] * bb : 0.f; w0[j] = b0[j] * __expf(gc[ja]); w1[j] = b1[j] * __expf(gc[jb]); }
            *(LAS pg8::u32x4*)(L + L_TB + i * KT_LD + j8 * 2) = pg8::pack8(b0, b1); *(LAS pg8::u32x4*)(L + L_TW + i * KT_LD + j8 * 2) = pg8::pack8(w0, w1); }
        __syncthreads();
        {
            bf16_t *oU = UT + (size_t)cu * 8192, *oNW = NW + (size_t)cu * 8192;
            bf16x8_t vf[2], kf[2];
#pragma unroll
            for (int ks = 0; ks < 2; ++ks) { vf[ks] = *(const LAS bf16x8_t*)(L + L_VT + ktoff(16 * w + fr, 4 * ks + fq)); kf[ks] = *(const LAS bf16x8_t*)(L + L_KT + ktoff(16 * w + fr, 4 * ks + fq)); }
#pragma unroll
            for (int mi = 0; mi < 4; ++mi) {
                f32x4 au = (f32x4){0.f, 0.f, 0.f, 0.f}, aw = (f32x4){0.f, 0.f, 0.f, 0.f};
#pragma unroll
                for (int ks = 0; ks < 2; ++ks) {
                    au = __builtin_amdgcn_mfma_f32_16x16x32_bf16(*(const LAS bf16x8_t*)(L + L_TB + (16 * mi + fr) * KT_LD + (32 * ks + 8 * fq) * 2), vf[ks], au, 0, 0, 0);
                    aw = __builtin_amdgcn_mfma_f32_16x16x32_bf16(kf[ks], *(const LAS bf16x8_t*)(L + L_TW + (16 * mi + fr) * KT_LD + (32 * ks + 8 * fq) * 2), aw, 0, 0, 0);
                }
                *(u32x2_t*)(oU + (16 * w + fr) * 64 + 16 * mi + 4 * fq) = pack4bf(au);
                *(u32x2_t*)(oNW + (16 * mi + fr) * 128 + 16 * w + 4 * fq) = pack4bf(-aw);
            }
        }
        __syncthreads();
    }
#undef PREP_LOAD
}

__device__ __forceinline__ void p3_scan_simple(Frame& F, const Args& a) {
    const bf16_t *NW = (const bf16_t*)(a.ws + WS_CH_NW), *UU = (const bf16_t*)(a.ws + WS_CH_U), *QD = (const bf16_t*)(a.ws + WS_CH_QD), *KDT = (const bf16_t*)(a.ws + WS_CH_KDT), *QK = (const bf16_t*)(a.ws + WS_CH_QK);
    const float* GL = (const float*)(a.ws + WS_CH_GL); bf16_t* O = (bf16_t*)(a.ws + WS_O);
    LAS float* sm = (LAS float*)(F.lds + RING_OFF);
    LAS float *nw = sm, *qd = sm + 8192, *kd = sm + 16384, *vn = sm + 24576;
    const int tid = F.tid, e = (tid >> 6) * 32 + (tid & 31), half = (tid >> 5) & 1, db = 64 * half; const bool act = tid < 256;
    for (int bh = F.vcu; bh < NB * NH; bh += F.G) {
        const int h = bh % NH, b = bh / NH;
        float S[64];
#pragma unroll
        for (int d = 0; d < 64; ++d) S[d] = 0.f;
        for (int n = 0; n < NCH; ++n) {
            const int cu = bh * NCH + n;
            for (int idx = tid; idx < 8192; idx += 512) { nw[idx] = bf2f(NW[(size_t)cu * 8192 + idx]); qd[idx] = bf2f(QD[(size_t)cu * 8192 + idx]);
                const int d = idx >> 6, i = idx & 63; kd[i * 128 + d] = bf2f(KDT[(size_t)cu * 8192 + idx]); }
            __syncthreads();
            const float gl = GL[cu];
            if (act) for (int i = 0; i < 64; ++i) { float s = 0.f;
#pragma unroll
                for (int d = 0; d < 64; ++d) s += nw[i * 128 + db + d] * S[d];
                s += __shfl_xor(s, 32); s += bf2f(UU[(size_t)cu * 8192 + e * 64 + i]);
                if (half == 0) vn[i * 128 + e] = s; }
            __syncthreads();
            if (act) {
                if (n > 0) for (int i = 0; i < 64; ++i) { float s = 0.f;
#pragma unroll
                    for (int d = 0; d < 64; ++d) s += qd[i * 128 + db + d] * S[d];
                    s += __shfl_xor(s, 32);
                    for (int j = 0; j <= i; ++j) s += bf2f(QK[(size_t)cu * 4096 + i * 64 + j]) * vn[j * 128 + e];
                    if (half == 0) O[(size_t)(b * SEQ + 64 * (n - 1) + i) * DNW + h * HD + e] = f2bf(s); }
#pragma unroll
                for (int d = 0; d < 64; ++d) S[d] *= gl;
                for (int i = 0; i < 64; ++i) { const float vi = vn[i * 128 + e];
#pragma unroll
                    for (int d = 0; d < 64; ++d) S[d] += kd[i * 128 + db + d] * vi; }
            }
            __syncthreads();
        }
    }
}


struct ScanOps { bf16x8_t a[4], x[2], kd[2]; float gl; };
constexpr int ST_LD = 272, VT_LD = 144;
template <int PROBE>
__device__ __forceinline__ void p3_scan_fast(Frame& F, const Args& a) {
    const bf16_t *NW = (const bf16_t*)(a.ws + WS_CH_NW), *UT = (const bf16_t*)(a.ws + WS_CH_U), *QD = (const bf16_t*)(a.ws + WS_CH_QD), *KDT = (const bf16_t*)(a.ws + WS_CH_KDT), *QK = (const bf16_t*)(a.ws + WS_CH_QK);
    const float* GL = (const float*)(a.ws + WS_CH_GL); bf16_t* O = (bf16_t*)(a.ws + (PROBE ? WS_Y : WS_O));
    LAS unsigned char* ST = F.lds + RING_OFF; LAS unsigned char* VT = ST + 32 * ST_LD;
    const int w = F.wave, lane = F.lane, fr = lane & 15, fq = lane >> 4, mt = w & 3; const bool vw = w < 4;
    for (int unit = F.vcu; unit < NB * NH * 4; unit += F.G) {
        const int bh = unit >> 2, s = unit & 3, h = bh % NH, b = bh / NH;
        f32x4 accS[2] = {(f32x4){0.f, 0.f, 0.f, 0.f}, (f32x4){0.f, 0.f, 0.f, 0.f}};
        for (int i = F.tid; i < 32 * ST_LD / 4; i += 512) ((LAS unsigned*)ST)[i] = 0u;
        __syncthreads();
        const bf16_t* Asrc = (vw ? NW : QD) + (16 * mt + fr) * 128 + 8 * fq;
        const bf16_t* Ksrc = KDT + (16 * w + fr) * 64 + 8 * fq;
        const bf16_t* Xsrc = vw ? UT + (32 * s + fr) * 64 + 16 * mt + 8 * (fq >> 1) : QK + (16 * mt + fr) * 64 + 8 * fq;
        const size_t xstride = vw ? 8192 : 4096; const int xstep = vw ? 16 * 64 : 32; const bool hiq = (fq & 1) != 0;
#define SCAN_LOAD(ops, n_) do { const size_t cu_ = (size_t)(bh * NCH + (PROBE != 0 ? 0 : (n_))); \
        _Pragma("unroll") for (int ks = 0; ks < 4; ++ks) (ops).a[ks] = *(const bf16x8_t*)(Asrc + cu_ * 8192 + 32 * ks); \
        _Pragma("unroll") for (int ks = 0; ks < 2; ++ks) (ops).kd[ks] = *(const bf16x8_t*)(Ksrc + cu_ * 8192 + 32 * ks); \
        (ops).x[0] = *(const bf16x8_t*)(Xsrc + cu_ * xstride); (ops).x[1] = *(const bf16x8_t*)(Xsrc + cu_ * xstride + xstep); \
        (ops).gl = GL[cu_]; } while (0)
#define SCAN_STEP(ops, n_) do { \
        f32x4 acc[2]; \
        _Pragma("unroll") for (int n2 = 0; n2 < 2; ++n2) { const unsigned u0_ = hiq ? (unsigned)__builtin_bit_cast(u32x4_t, (ops).x[n2]).z : (unsigned)__builtin_bit_cast(u32x4_t, (ops).x[n2]).x, u1_ = hiq ? (unsigned)__builtin_bit_cast(u32x4_t, (ops).x[n2]).w : (unsigned)__builtin_bit_cast(u32x4_t, (ops).x[n2]).y; \
            acc[n2] = vw ? (f32x4){__uint_as_float(u0_ << 16), __uint_as_float(u0_ & 0xffff0000u), __uint_as_float(u1_ << 16), __uint_as_float(u1_ & 0xffff0000u)} : (f32x4){0.f, 0.f, 0.f, 0.f}; } \
        _Pragma("unroll") for (int ks = 0; ks < 4; ++ks) _Pragma("unroll") for (int n2 = 0; n2 < 2; ++n2) \
            acc[n2] = __builtin_amdgcn_mfma_f32_16x16x32_bf16((ops).a[ks], *(const LAS bf16x8_t*)(ST + (16 * n2 + fr) * ST_LD + (32 * ks + 8 * fq) * 2), acc[n2], 0, 0, 0); \
        if (vw) { _Pragma("unroll") for (int n2 = 0; n2 < 2; ++n2) *(LAS u32x2_t*)(VT + (16 * n2 + fr) * VT_LD + (16 * mt + 4 * fq) * 2) = pack4bf(acc[n2]); } \
        __syncthreads(); \
        bf16x8_t bV[2][2]; \
        _Pragma("unroll") for (int n2 = 0; n2 < 2; ++n2) _Pragma("unroll") for (int ks = 0; ks < 2; ++ks) bV[n2][ks] = *(const LAS bf16x8_t*)(VT + (16 * n2 + fr) * VT_LD + (32 * ks + 8 * fq) * 2); \
        if (!vw) { _Pragma("unroll") for (int n2 = 0; n2 < 2; ++n2) _Pragma("unroll") for (int ks = 0; ks < 2; ++ks) acc[n2] = __builtin_amdgcn_mfma_f32_16x16x32_bf16((ops).x[ks], bV[n2][ks], acc[n2], 0, 0, 0); \
            if ((n_) > 0 && PROBE != 2) { bf16_t* op = O + (size_t)(b * SEQ + 64 * ((n_) - 1) + 16 * mt + 4 * fq) * DNW + h * HD + 32 * s + fr; \
                _Pragma("unroll") for (int n2 = 0; n2 < 2; ++n2) _Pragma("unroll") for (int r = 0; r < 4; ++r) op[(size_t)r * DNW + 16 * n2] = f2bf(acc[n2][r]); } } \
        _Pragma("unroll") for (int n2 = 0; n2 < 2; ++n2) { accS[n2] = accS[n2] * (ops).gl; \
            _Pragma("unroll") for (int ks = 0; ks < 2; ++ks) accS[n2] = __builtin_amdgcn_mfma_f32_16x16x32_bf16((ops).kd[ks], bV[n2][ks], accS[n2], 0, 0, 0); \
            *(LAS u32x2_t*)(ST + (16 * n2 + fr) * ST_LD + (16 * w + 4 * fq) * 2) = pack4bf(accS[n2]); } \
        __syncthreads(); } while (0)
        ScanOps opA, opB, opC;
        SCAN_LOAD(opA, 0); SCAN_LOAD(opB, 1);
        for (int n = 0; n < NCH; n += 3) {
            SCAN_LOAD(opC, n + 2); SCAN_STEP(opA, n);
            SCAN_LOAD(opA, n + 3 < NCH ? n + 3 : NCH - 1); SCAN_STEP(opB, n + 1);
            SCAN_LOAD(opB, n + 4 < NCH ? n + 4 : NCH - 1); SCAN_STEP(opC, n + 2);
        }
#undef SCAN_LOAD
#undef SCAN_STEP
    }
}

__device__ __forceinline__ void p3b_gnorm(Frame& F, const Args& a) {
    const bf16_t *O = (const bf16_t*)(a.ws + WS_O), *SZD = (const bf16_t*)(a.ws + WS_SZD); bf16_t* Y = (bf16_t*)(a.ws + WS_Y); const float* w = a.in[9];
    const int gw = F.vcu * NWAVES + F.wave, NGW = F.G * NWAVES, lane = F.lane;
    const float w0 = w[2 * lane], w1 = w[2 * lane + 1];
    for (int it = gw; it < MTOK * NH; it += NGW) {
        const size_t base = (size_t)(it >> 4) * DNW + (it & 15) * HD + 2 * lane, yb = (size_t)(it >> 4) * YLD + 1024 + (it & 15) * HD + 2 * lane;
        const unsigned ov = *(const unsigned*)(O + base), zv = *(const unsigned*)(SZD + base);
        const float a0 = __uint_as_float(ov << 16), a1 = __uint_as_float(ov & 0xffff0000u);
        const float rs = rsqrtf(wave_sum(a0 * a0 + a1 * a1) * (1.f / HD) + EPS);
        *(unsigned*)(Y + yb) = pk2(a0 * rs * w0 * __uint_as_float(zv << 16), a1 * rs * w1 * __uint_as_float(zv & 0xffff0000u));
    }
}

__device__ __forceinline__ void p6_final(Frame& F, const Args& a) {
    const float* w = a.in[13]; float* out = a.out;
    const int gw = F.vcu * NWAVES + F.wave, NGW = F.G * NWAVES;
    for (int r = gw; r < MTOK; r += NGW) {
        float* row = out + (size_t)r * DM;
        f32x4 v[8]; float s = 0.f;
#pragma unroll
        for (int j = 0; j < 8; ++j) { v[j] = *(const f32x4*)(row + 4 * F.lane + 256 * j); s += (v[j].x * v[j].x + v[j].y * v[j].y) + (v[j].z * v[j].z + v[j].w * v[j].w); }
        const float rs = rsqrtf(wave_sum(s) * (1.f / DM) + EPS);
#pragma unroll
        for (int j = 0; j < 8; ++j) { const f32x4 ww = *(const f32x4*)(w + 4 * F.lane + 256 * j); *(f32x4*)(row + 4 * F.lane + 256 * j) = v[j] * rs * ww; }
    }
}

struct PoolMixOrder {
    int G, c;
    __device__ bool next(int i, pg8::Unit& u) const { const int L = i * G + c; if (L >= 128) return false; u.pm = L >> 2; u.pn = L & 3; u.aoff = (L & 3) * 256; u.boff = 0; u.nt = 4; u.mode = 0; return true; }
};
struct MergeOrder {
    pg8::StaticOrder so;
    __device__ bool next(int i, pg8::Unit& u) const { if (!so.next(i >> 1, u)) return false; if ((i & 1) == 0) { u.nt = 16; u.mode = 0; } else { u.aoff = 1024; u.boff = 1024; u.nt = 32; u.mode = 1; } return true; }
};

constexpr int NPHASE = 8;
__global__ void __launch_bounds__(NWAVES * 64, 2) mega_fwd(Args args) {
    extern __shared__ __attribute__((aligned(16))) unsigned char lds[];
    Frame F;
    F.lds = (LAS unsigned char*)lds;
    F.tid = threadIdx.x; F.lane = F.tid & 63; F.wave = __builtin_amdgcn_readfirstlane(F.tid >> 6);
    F.G = gridDim.x; { const int bx = blockIdx.x; F.vcu = (F.G % 8 == 0) ? (bx % 8) * (F.G / 8) + bx / 8 : bx; }
    unsigned char* ws = args.ws;
    for (int u = F.tid; u < (LDS_BYTES - LDSCTL_OFF) / 4; u += NWAVES * 64) ((LAS unsigned*)(F.lds + LDSCTL_OFF))[u] = 0u;
    __syncthreads();
    const int lo = args.ph_lo, hi = args.ph_hi;
    XcdBarrier bar; bar.bar = (unsigned*)(ws + WS_CTL) + CW_BAR; bar.x = 0; bar.st = nullptr;
    if (hi - lo > 1 || DUP_MASK) bar = xcd_barrier_post((unsigned*)(ws + WS_CTL) + CW_BAR, (volatile LAS unsigned*)(F.lds + MISC_OFF) + 8);
#define DUP(k) ((DUP_MASK >> (k)) & 1)
#define PHASE(k, ...) do { if (lo <= (k) && (k) < hi) { __VA_ARGS__ if (DUP(k)) { xcd_barrier(bar); __VA_ARGS__ } if ((k) + 1 < hi) xcd_barrier(bar); } } while (0)
    PHASE(0, p0_prologue(F, args););
    PHASE(1, {
        pg8::Gemm g{(const bf16_t*)(ws + WS_XN), (const bf16_t*)(ws + WS_WINT), DM, DM}; pg8::StaticOrder S; S.init(MPAD / 256, NPAD1 / 256, DM / 64, F.G, (int)blockIdx.x);
        pg8::EpiProj E{(bf16_t*)(ws + WS_U), (bf16_t*)(ws + WS_SZP), (bf16_t*)(ws + WS_QKV), (bf16_t*)(ws + WS_SZD), (bf16_t*)(ws + WS_GATES), (float*)(ws + WS_BA)};
        pg8::gemm_phase<pg8::EpiProj, pg8::StaticOrder, true>(F.lds + RING_OFF, g, S, E); });
    PHASE(2, p2_pool(F, args); if (SIMPLE_PREP) p2_chunk_prep_simple(F, args); else p2_chunk_prep_fast(F, args););
    #ifndef SCAN_PROBE
#define SCAN_PROBE 0
#endif
    PHASE(3, if (SIMPLE_SCAN) p3_scan_simple(F, args); else { if (SCAN_PROBE) p3_scan_fast<SCAN_PROBE>(F, args); p3_scan_fast<0>(F, args); });
    PHASE(4, {
        p3b_gnorm(F, args);
        pg8::Gemm g{(const bf16_t*)(ws + WS_POOLED), (const bf16_t*)(ws + WS_MIXT), PW, PGD}; PoolMixOrder S{F.G, F.vcu};
        pg8::EpiPoolMix E{(bf16_t*)(ws + WS_Y), (const bf16_t*)(ws + WS_SZP), args.in[8]};
        pg8::gemm_phase<pg8::EpiPoolMix, PoolMixOrder, false>(F.lds + RING_OFF, g, S, E); });
    PHASE(5, {
        pg8::Gemm g{(const bf16_t*)(ws + WS_Y), (const bf16_t*)(ws + WS_W2T), YLD, YLD}; MergeOrder S; S.so.init(MTOK / 256, DM / 256, 0, F.G, (int)blockIdx.x);
        pg8::EpiMerge E{(const bf16_t*)(ws + WS_GATES), (bf16_t*)(ws + WS_MERGED)};
        pg8::gemm_phase<pg8::EpiMerge, MergeOrder, false>(F.lds + RING_OFF, g, S, E); });
    PHASE(6, {
        pg8::Gemm g{(const bf16_t*)(ws + WS_MERGED), (const bf16_t*)(ws + WS_WOT), DM, DM}; pg8::StaticOrder S; S.init(MTOK / 256, DM / 256, DM / 64, F.G, (int)blockIdx.x);
        pg8::EpiResid E{args.in[0], args.out};
        pg8::gemm_phase<pg8::EpiResid, pg8::StaticOrder, false>(F.lds + RING_OFF, g, S, E); });
    PHASE(7, p6_final(F, args););
#undef PHASE
#undef DUP
}
#ifndef MIX
#define MIX 0
#endif
#ifndef NAIVE_MASK
#define NAIVE_MASK 0
#endif
#ifndef FUSE
#define FUSE 1
#endif
extern "C" void kernel_launch(void* const* d_in, const int* in_sizes, int n_in, void* d_out, int out_size, void* d_ws, size_t ws_size, hipStream_t stream) {
    static int grid = 0;
    if (grid == 0) {
        if (n_in != 14 || in_sizes[0] != MTOK * DM || out_size != MTOK * DM || ws_size < WS_END) { fprintf(stderr, "kernel_launch: unexpected shapes / workspace (%zu < %zu); nothing launched\n", ws_size, (size_t)WS_END); grid = -1; return; }
        int dev = 0, cus = 0;
        if (hipGetDevice(&dev) != hipSuccess || hipDeviceGetAttribute(&cus, hipDeviceAttributeMultiprocessorCount, dev) != hipSuccess) { grid = -1; return; }
        if (hipFuncSetAttribute((const void*)mega_fwd, hipFuncAttributeMaxDynamicSharedMemorySize, LDS_BYTES) != hipSuccess) { fprintf(stderr, "kernel_launch: hipFuncSetAttribute failed\n"); grid = -1; return; }
#if MIX
        if (hipFuncSetAttribute((const void*)nv_chunk_prep, hipFuncAttributeMaxDynamicSharedMemorySize, 140 * 1024) != hipSuccess) { grid = -1; return; }
#endif
        (void)hipGetLastError();
        grid = cus;
    }
    if (grid < 0) return;
    if (hipMemsetAsync((char*)d_ws + WS_CTL, 0, CTL_ZERO_BYTES, stream) != hipSuccess) return;
    Args a{};
    for (int i = 0; i < 14; ++i) a.in[i] = (const float*)d_in[i];
    a.out = (float*)d_out; a.ws = (unsigned char*)d_ws;
#if !MIX
    a.ph_lo = 0; a.ph_hi = NPHASE;
    hipLaunchKernelGGL(mega_fwd, dim3(grid), dim3(NWAVES * 64), LDS_BYTES, stream, a);
#else
    const float *x = a.in[0], *meta = a.in[1], *norm_w = a.in[2], *w_in = a.in[3], *conv_w = a.in[4], *A_log = a.in[5], *dt_bias = a.in[6], *pool_mix = a.in[7], *pool_scale = a.in[8],
                *dn_norm_w = a.in[9], *w_pool_out = a.in[10], *w_dn_out = a.in[11], *w_o = a.in[12], *final_norm_w = a.in[13];
    unsigned char* ws = (unsigned char*)d_ws; float* out = (float*)d_out;
    bf16_t *XN = (bf16_t*)(ws + WS_XN), *U = (bf16_t*)(ws + WS_U), *SZP = (bf16_t*)(ws + WS_SZP), *QKV = (bf16_t*)(ws + WS_QKV), *SZD = (bf16_t*)(ws + WS_SZD), *GATES = (bf16_t*)(ws + WS_GATES);
    float* BA = (float*)(ws + WS_BA);
    bf16_t *Y = (bf16_t*)(ws + WS_Y), *PO = (bf16_t*)(ws + WS_POOLED), *O = (bf16_t*)(ws + WS_O), *MG = (bf16_t*)(ws + WS_MERGED);
    bf16_t *cNW = (bf16_t*)(ws + WS_CH_NW), *cU = (bf16_t*)(ws + WS_CH_U), *cQD = (bf16_t*)(ws + WS_CH_QD), *cKDT = (bf16_t*)(ws + WS_CH_KDT), *cQK = (bf16_t*)(ws + WS_CH_QK);
    float* cGL = (float*)(ws + WS_CH_GL);
    int s = 0;
    while (s < NPHASE) {
        if (!((NAIVE_MASK >> s) & 1)) {
            int e = s + 1;
            if (FUSE) while (e < NPHASE && !((NAIVE_MASK >> e) & 1)) ++e;
            a.ph_lo = s; a.ph_hi = e;
            hipLaunchKernelGGL(mega_fwd, dim3(grid), dim3(NWAVES * 64), LDS_BYTES, stream, a);
            s = e; continue;
        }
        switch (s) {
        case 0: nv_prep<<<1024, 256, 0, stream>>>(x, meta, norm_w, XN); break;
        case 1: nv_gemm<EpiProj><<<dim3((INC + 127) / 128, (MROWS + 127) / 128), 256, 0, stream>>>(XN, DM, w_in, INC, MROWS, INC, DM, EpiProj{U, SZP, QKV, SZD, GATES, BA}); break;
        case 2: nv_pool<<<MTOK * PW / 256, 256, 0, stream>>>(U, PO);
                nv_chunk_prep<<<NUNITS, 256, 140 * 1024, stream>>>(QKV, BA, conv_w, A_log, dt_bias, cNW, cU, cQD, cKDT, cQK, cGL); break;
        case 3: nv_chunk_scan<<<NB * NH, 128, 0, stream>>>(cNW, cU, cQD, cKDT, cQK, cGL, O); break;
        case 4: nv_gnorm<<<MTOK * NH / 4, 256, 0, stream>>>(O, SZD, dn_norm_w, Y);
                for (int g = 0; g < 4; ++g)
                    nv_gemm<EpiPool><<<dim3(2, MTOK / 128), 256, 0, stream>>>(PO + g * PGD, PW, pool_mix + (size_t)g * PGD * PGD, PGD, MTOK, PGD, PGD, EpiPool{Y, SZP, pool_scale, g, 0});
                break;
        case 5: nv_gemm<EpiG2a><<<dim3(DM / 128, MTOK / 128), 256, 0, stream>>>(Y, YLD, w_pool_out, DM, MTOK, DM, PW, EpiG2a{out, GATES});
                nv_gemm<EpiG2b><<<dim3(DM / 128, MTOK / 128), 256, 0, stream>>>(Y + 1024, YLD, w_dn_out, DM, MTOK, DM, DNW, EpiG2b{out, GATES, MG}); break;
        case 6: nv_gemm<EpiG3><<<dim3(DM / 128, MTOK / 128), 256, 0, stream>>>(MG, DM, w_o, DM, MTOK, DM, DM, EpiG3{x, out}); break;
        case 7: nv_final<<<MTOK, 256, 0, stream>>>(out, final_norm_w); break;
        }
        ++s;
    }
#endif
}
```

```cpp
#define MIX 0
#include <hip/hip_runtime.h>
#include <cstdint>
#include <cstdio>

typedef unsigned short bf16_t;
__device__ __forceinline__ float bf2f(bf16_t v) { return __uint_as_float(((unsigned)v) << 16); }
__device__ __forceinline__ bf16_t f2bf(float f) { unsigned u = __float_as_uint(f); return (bf16_t)((u + 0x7fffu + ((u >> 16) & 1u)) >> 16); }
__device__ __forceinline__ float sigmoidf_(float x) { return 1.f / (1.f + __expf(-x)); }
__device__ __forceinline__ float siluf_(float x) { return x / (1.f + __expf(-x)); }
__device__ __forceinline__ float softplusf_(float x) { return x > 20.f ? x : log1pf(__expf(x)); }

constexpr int DM = 2048, NB = 4, SEQ = 2048, NMETA = 16, LEXT = SEQ + NMETA;
constexpr int PW = 1024, PGD = 256, NH = 16, HD = 128, DNW = 2048, CHUNK = 64, NCH = 33, PADF = 48;
constexpr int INC = 14368;
constexpr int C_U = 0, C_ZP = 1024, C_Q = 2048, C_ZD = 8192, C_B = 10240, C_GP = 10272;
constexpr int MTOK = NB * SEQ;
constexpr int MROWS = MTOK + NMETA;
constexpr int MPAD = 8448;
constexpr int NPAD1 = 14592;
constexpr int YLD = 3072;
constexpr float EPS = 1e-6f;
constexpr int NUNITS = NB * NH * NCH;

constexpr size_t MiB = 1u << 20;
constexpr size_t WS_CTL = 0, CTL_ZERO_BYTES = 1 * MiB;
constexpr size_t WS_CH = 1 * MiB;
constexpr size_t CH_ARR = (size_t)NUNITS * 8192 * 2;
constexpr size_t WS_CH_NW = WS_CH, WS_CH_U = WS_CH + CH_ARR, WS_CH_QD = WS_CH + 2 * CH_ARR, WS_CH_KDT = WS_CH + 3 * CH_ARR, WS_CH_QK = WS_CH + 4 * CH_ARR;
constexpr size_t WS_CH_GL = WS_CH_QK + (size_t)NUNITS * 4096 * 2;
constexpr size_t WS_WINT = WS_CH;
constexpr size_t WS_XN = WS_CH + 57 * MiB;
constexpr size_t WS_W2T = 150 * MiB;
constexpr size_t WS_WOT = 162 * MiB;
constexpr size_t WS_MIXT = 170 * MiB;
constexpr size_t WS_U = 171 * MiB;
constexpr size_t WS_SZP = WS_U + (size_t)MPAD * 1024 * 2;
constexpr size_t WS_QKV = WS_SZP + (size_t)MPAD * 1024 * 2;
constexpr size_t WS_BA = 303 * MiB;
constexpr size_t WS_O = 204 * MiB, WS_Y = 236 * MiB, WS_MERGED = 204 * MiB;
constexpr size_t WS_SZD = 304 * MiB + 512 * 1024;
constexpr size_t WS_GATES = WS_SZD + (size_t)MPAD * 2048 * 2;
constexpr size_t WS_POOLED = WS_GATES + (size_t)MPAD * 4096 * 2;
constexpr size_t WS_END = WS_POOLED + (size_t)MTOK * 1024 * 2;
static_assert(WS_CH_GL + NUNITS * 4 <= WS_W2T, "chunk arrays");
static_assert(WS_XN + (size_t)MPAD * 2048 * 2 <= WS_W2T, "xn");
static_assert(WS_QKV == 204 * MiB && WS_QKV + (size_t)MPAD * 6144 * 2 <= WS_BA, "qkv");
static_assert(WS_Y + (size_t)MTOK * YLD * 2 <= WS_BA, "y");
static_assert(WS_BA + (size_t)MPAD * 32 * 4 <= WS_SZD, "ba");
static_assert(WS_END <= 449 * MiB, "ws");

__device__ __forceinline__ int ext_row(int b, int p) { return p < NMETA ? MTOK + p : b * SEQ + (p - NMETA); }

__device__ __forceinline__ float wave_sum(float v) {
#pragma unroll
    for (int o = 1; o < 64; o <<= 1) v += __shfl_xor(v, o);
    return v;
}
#if MIX
__global__ void __launch_bounds__(256) nv_prep(const float* __restrict__ x, const float* __restrict__ meta, const float* __restrict__ nw, bf16_t* __restrict__ XN) {
    const int lane = threadIdx.x & 63, gw = (blockIdx.x * 256 + threadIdx.x) >> 6, ngw = gridDim.x * 4;
    for (int r = gw; r < MPAD; r += ngw) {
        bf16_t* o = XN + (size_t)r * DM;
        if (r >= MROWS) { for (int j = lane; j < DM; j += 64) o[j] = 0; continue; }
        const float* src = r < MTOK ? x + (size_t)r * DM : meta + (size_t)(r - MTOK) * DM;
        float v[32]; float s = 0.f;
#pragma unroll
        for (int j = 0; j < 32; ++j) { v[j] = src[lane + 64 * j]; s += v[j] * v[j]; }
        const float rs = rsqrtf(wave_sum(s) * (1.f / DM) + EPS);
#pragma unroll
        for (int j = 0; j < 32; ++j) o[lane + 64 * j] = f2bf(v[j] * rs * nw[lane + 64 * j]);
    }
}

template <class Epi>
__global__ void __launch_bounds__(256) nv_gemm(const bf16_t* __restrict__ A, int lda, const float* __restrict__ W, int ldw, int M, int N, int K, Epi epi) {
    __shared__ __attribute__((aligned(16))) float As[16][132];
    __shared__ __attribute__((aligned(16))) float Bs[16][132];
    const int tid = threadIdx.x, tx = tid & 15, ty = tid >> 4;
    const int m0 = blockIdx.y * 128, n0 = blockIdx.x * 128;
    float acc[8][8];
#pragma unroll
    for (int i = 0; i < 8; ++i)
#pragma unroll
        for (int j = 0; j < 8; ++j) acc[i][j] = 0.f;
    for (int k0 = 0; k0 < K; k0 += 16) {
        {
            const int r = tid >> 1, kc = (tid & 1) * 8, gm = m0 + r;
            uint4 v = make_uint4(0, 0, 0, 0);
            if (gm < M) v = *(const uint4*)(A + (size_t)gm * lda + k0 + kc);
            const unsigned w[4] = {v.x, v.y, v.z, v.w};
#pragma unroll
            for (int j = 0; j < 4; ++j) { As[kc + 2 * j][r] = __uint_as_float(w[j] << 16); As[kc + 2 * j + 1][r] = __uint_as_float(w[j] & 0xffff0000u); }
        }
        {
            const int kk = tid >> 4, nc = (tid & 15) * 8, gn = n0 + nc;
            float4 v0 = make_float4(0, 0, 0, 0), v1 = v0;
            if (gn < N) { const float* p = W + (size_t)(k0 + kk) * ldw + gn; v0 = *(const float4*)p; v1 = *(const float4*)(p + 4); }
            *(float4*)&Bs[kk][nc] = v0; *(float4*)&Bs[kk][nc + 4] = v1;
        }
        __syncthreads();
#pragma unroll
        for (int kk = 0; kk < 16; ++kk) {
            float a[8], b[8];
            *(float4*)&a[0] = *(const float4*)&As[kk][ty * 8]; *(float4*)&a[4] = *(const float4*)&As[kk][ty * 8 + 4];
            *(float4*)&b[0] = *(const float4*)&Bs[kk][tx * 8]; *(float4*)&b[4] = *(const float4*)&Bs[kk][tx * 8 + 4];
#pragma unroll
            for (int i = 0; i < 8; ++i)
#pragma unroll
                for (int j = 0; j < 8; ++j) acc[i][j] += a[i] * b[j];
        }
        __syncthreads();
    }
#pragma unroll
    for (int i = 0; i < 8; ++i)
#pragma unroll
        for (int j = 0; j < 8; ++j) { const int gm = m0 + ty * 8 + i, gn = n0 + tx * 8 + j; if (gm < M && gn < N) epi(gm, gn, acc[i][j]); }
}

struct EpiProj {
    bf16_t *U, *SZP, *QKV, *SZD, *GATES; float* BA;
    __device__ __forceinline__ void operator()(int m, int n, float v) const {
        if (n < C_ZP) U[(size_t)m * 1024 + n] = f2bf(v);
        else if (n < C_Q) SZP[(size_t)m * 1024 + (n - C_ZP)] = f2bf(siluf_(v));
        else if (n < C_ZD) QKV[(size_t)m * 6144 + (n - C_Q)] = f2bf(v);
        else if (n < C_B) SZD[(size_t)m * 2048 + (n - C_ZD)] = f2bf(siluf_(v));
        else if (n < C_GP) BA[(size_t)m * 32 + (n - C_B)] = v;
        else GATES[(size_t)m * 4096 + (n - C_GP)] = f2bf(sigmoidf_(v));
    }
};
struct EpiPool {
    bf16_t* Y; const bf16_t* SZP; const float* scale; int g, pad;
    __device__ __forceinline__ void operator()(int m, int n, float v) const {
        const int c = g * PGD + n; Y[(size_t)m * YLD + c] = f2bf(v * scale[c] * bf2f(SZP[(size_t)m * 1024 + c]));
    }
};
struct EpiG2a { float* T; const bf16_t* GATES; __device__ __forceinline__ void operator()(int m, int n, float v) const { T[(size_t)m * DM + n] = v * bf2f(GATES[(size_t)m * 4096 + n]); } };
struct EpiG2b { const float* T; const bf16_t* GATES; bf16_t* MG; __device__ __forceinline__ void operator()(int m, int n, float v) const { MG[(size_t)m * DM + n] = f2bf(T[(size_t)m * DM + n] + v * bf2f(GATES[(size_t)m * 4096 + 2048 + n])); } };
struct EpiG3 { const float* x; float* out; __device__ __forceinline__ void operator()(int m, int n, float v) const { out[(size_t)m * DM + n] = x[(size_t)m * DM + n] + v; } };

__global__ void __launch_bounds__(256) nv_pool(const bf16_t* __restrict__ U, bf16_t* __restrict__ PO) {
    const int idx = blockIdx.x * 256 + threadIdx.x; if (idx >= MTOK * PW) return;
    const int m = idx >> 10, c = idx & 1023, b = m >> 11, t = m & 2047, p = t + NMETA, win = 2 << (c >> 8);
    float s = 0.f;
    for (int j = 0; j < win; ++j) { const int pp = p - j; if (pp >= 0) s += bf2f(U[(size_t)ext_row(b, pp) * 1024 + c]); }
    const int cnt = (p + 1) < win ? (p + 1) : win;
    PO[idx] = f2bf(s / (float)cnt - bf2f(U[(size_t)m * 1024 + c]));
}

__global__ void __launch_bounds__(256) nv_chunk_prep(const bf16_t* __restrict__ QKV, const float* __restrict__ BA, const float* __restrict__ conv_w, const float* __restrict__ A_log,
                                                     const float* __restrict__ dt_bias, bf16_t* __restrict__ NW, bf16_t* __restrict__ UU, bf16_t* __restrict__ QD, bf16_t* __restrict__ KDT,
                                                     bf16_t* __restrict__ QK, float* __restrict__ GL) {
    extern __shared__ __attribute__((aligned(16))) float sm[];
    float *q = sm, *k = q + 8192, *v = k + 8192, *Am = v + 8192, *Tm = Am + 4096, *beta = Tm + 4096, *gc = beta + 64;
    const int cu = blockIdx.x, n = cu % NCH, bh = cu / NCH, h = bh % NH, b = bh / NH, tid = threadIdx.x, lane = tid & 63, wv = tid >> 6;
    const int p0 = CHUNK * n - PADF;
    for (int idx = tid; idx < 64 * 384; idx += 256) {
        const int i = idx / 384, c3 = idx % 384, which = c3 >> 7, d = c3 & 127, col = which * 2048 + h * HD + d, p = p0 + i;
        float val = 0.f;
        if (p >= 0) { float a = 0.f;
            for (int kk = 0; kk < 4; ++kk) { const int pp = p - 3 + kk; if (pp >= 0) a += conv_w[kk * 6144 + col] * bf2f(QKV[(size_t)ext_row(b, pp) * 6144 + col]); }
            val = siluf_(a); }
        (which == 0 ? q : which == 1 ? k : v)[i * 128 + d] = val;
    }
    if (tid < 64) { const int p = p0 + tid; float be = 0.f, g = 0.f;
        if (p >= 0) { const int r = ext_row(b, p); be = sigmoidf_(BA[(size_t)r * 32 + h]); g = -__expf(A_log[h]) * softplusf_(BA[(size_t)r * 32 + 16 + h] + dt_bias[h]); }
        beta[tid] = be; gc[tid] = g; }
    __syncthreads();
    if (tid == 0) { float s = 0.f; for (int i = 0; i < 64; ++i) { s += gc[i]; gc[i] = s; } }
    for (int r = wv; r < 128; r += 4) {
        float* row = (r < 64 ? q + r * 128 : k + (r - 64) * 128);
        const float a0 = row[lane], a1 = row[lane + 64];
        const float rs = rsqrtf(wave_sum(a0 * a0 + a1 * a1) + EPS) * (r < 64 ? 0.08838834764831845f : 1.f);
        row[lane] = a0 * rs; row[lane + 64] = a1 * rs;
    }
    __syncthreads();
    bf16_t* oQK = QK + (size_t)cu * 4096;
    for (int idx = tid; idx < 4096; idx += 256) {
        const int i = idx >> 6, j = idx & 63; float akk = 0.f, aqk = 0.f;
        if (j <= i) { for (int d = 0; d < 128; ++d) { const float kj = k[j * 128 + d]; akk += k[i * 128 + d] * kj; aqk += q[i * 128 + d] * kj; }
            const float dec = __expf(gc[i] - gc[j]); akk *= beta[i] * dec; aqk *= dec; }
        Am[idx] = j < i ? akk : 0.f; oQK[idx] = f2bf(j <= i ? aqk : 0.f);
    }
    __syncthreads();
    if (tid < 64) { const int c = tid;
        for (int i = 0; i < 64; ++i) { float s = (i == c) ? 1.f : 0.f; for (int j = c; j < i; ++j) s -= Am[i * 64 + j] * Tm[j * 64 + c]; Tm[i * 64 + c] = (i >= c) ? s : 0.f; } }
    __syncthreads();
    bf16_t *oNW = NW + (size_t)cu * 8192, *oU = UU + (size_t)cu * 8192, *oQD = QD + (size_t)cu * 8192, *oKDT = KDT + (size_t)cu * 8192;
    const float gl = gc[63];
    for (int idx = tid; idx < 8192; idx += 256) {
        const int i = idx >> 7, d = idx & 127; float su = 0.f, sw = 0.f;
        for (int j = 0; j <= i; ++j) { const float t = Tm[i * 64 + j] * beta[j]; su += t * v[j * 128 + d]; sw += t * __expf(gc[j]) * k[j * 128 + d]; }
        oU[idx] = f2bf(su); oNW[idx] = f2bf(-sw);
        oQD[idx] = f2bf(q[idx] * __expf(gc[i]));
        oKDT[d * 64 + i] = f2bf(k[idx] * __expf(gl - gc[i]));
    }
    if (tid == 0) GL[cu] = __expf(gl);
}

__global__ void __launch_bounds__(128) nv_chunk_scan(const bf16_t* __restrict__ NW, const bf16_t* __restrict__ UU, const bf16_t* __restrict__ QD, const bf16_t* __restrict__ KDT,
                                                     const bf16_t* __restrict__ QK, const float* __restrict__ GL, bf16_t* __restrict__ O) {
    __shared__ float vn[64][128];
    const int bh = blockIdx.x, h = bh % NH, b = bh / NH, e = threadIdx.x;
    float S[128];
#pragma unroll
    for (int d = 0; d < 128; ++d) S[d] = 0.f;
    for (int n = 0; n < NCH; ++n) {
        const int cu = bh * NCH + n;
        const bf16_t *nw = NW + (size_t)cu * 8192, *uu = UU + (size_t)cu * 8192, *qd = QD + (size_t)cu * 8192, *kdt = KDT + (size_t)cu * 8192, *qk = QK + (size_t)cu * 4096;
        const float gl = GL[cu];
        for (int i = 0; i < 64; ++i) { float a = bf2f(uu[i * 128 + e]);
#pragma unroll
            for (int d = 0; d < 128; ++d) a += bf2f(nw[i * 128 + d]) * S[d];
            vn[i][e] = a; }
        __syncthreads();
        if (n > 0) for (int i = 0; i < 64; ++i) { float a = 0.f;
#pragma unroll
            for (int d = 0; d < 128; ++d) a += bf2f(qd[i * 128 + d]) * S[d];
            for (int j = 0; j <= i; ++j) a += bf2f(qk[i * 64 + j]) * vn[j][e];
            O[(size_t)(b * SEQ + 64 * (n - 1) + i) * DNW + h * HD + e] = f2bf(a); }
#pragma unroll
        for (int d = 0; d < 128; ++d) { float s = S[d] * gl; for (int i = 0; i < 64; ++i) s += bf2f(kdt[d * 64 + i]) * vn[i][e]; S[d] = s; }
        __syncthreads();
    }
}

__global__ void __launch_bounds__(256) nv_gnorm(const bf16_t* __restrict__ O, const bf16_t* __restrict__ SZD, const float* __restrict__ w, bf16_t* __restrict__ Y) {
    const int lane = threadIdx.x & 63, gw = (blockIdx.x * 256 + threadIdx.x) >> 6; if (gw >= MTOK * NH) return;
    const size_t base = (size_t)(gw >> 4) * DNW + (gw & 15) * HD, yb = (size_t)(gw >> 4) * YLD + 1024 + (gw & 15) * HD;
    const float a0 = bf2f(O[base + lane]), a1 = bf2f(O[base + lane + 64]);
    const float rs = rsqrtf(wave_sum(a0 * a0 + a1 * a1) * (1.f / HD) + EPS);
    Y[yb + lane] = f2bf(a0 * rs * w[lane] * bf2f(SZD[base + lane]));
    Y[yb + lane + 64] = f2bf(a1 * rs * w[lane + 64] * bf2f(SZD[base + lane + 64]));
}

__global__ void __launch_bounds__(256) nv_final(float* __restrict__ out, const float* __restrict__ w) {
    __shared__ float red[4];
    float* row = out + (size_t)blockIdx.x * DM; const int tid = threadIdx.x;
    float v[8]; float s = 0.f;
#pragma unroll
    for (int j = 0; j < 8; ++j) { v[j] = row[tid + 256 * j]; s += v[j] * v[j]; }
    s = wave_sum(s); if ((tid & 63) == 0) red[tid >> 6] = s; __syncthreads();
    const float rs = rsqrtf((red[0] + red[1] + red[2] + red[3]) * (1.f / DM) + EPS);
#pragma unroll
    for (int j = 0; j < 8; ++j) row[tid + 256 * j] = v[j] * rs * w[tid + 256 * j];
}

#endif
namespace pg8 {
#define PG8_LAS __attribute__((address_space(3)))
typedef short bf16x8 __attribute__((ext_vector_type(8)));
typedef float f32x4 __attribute__((ext_vector_type(4)));
typedef unsigned u32x4 __attribute__((ext_vector_type(4)));
constexpr int BM = 256, BK = 64, HALF = 128, HTB = HALF * BK * 2  , STAGE_BYTES = 8 * HTB, NXCD = 8, WGM = 8;

__host__ __device__ __forceinline__ int lds_byte(int r, int c) { const int st = (r >> 4) * 2 + (c >> 5), rr = r & 15, cc = c & 31, ob = rr * 64 + cc * 2; return st * 1024 + (ob ^ (((ob >> 9) & 1) << 5)); }
__host__ __device__ __forceinline__ void stage_rc(int b, int& R, int& C) { const int st = b / 1024, sb = b % 1024, swz = sb ^ (((sb >> 9) & 1) << 5); R = (st >> 1) * 16 + swz / 64; C = (st & 1) * 32 + (swz % 64) / 2; }
__host__ __device__ __forceinline__ int perm32(int rho) { const int n = rho >> 4, i = rho & 15; return 8 * (i >> 2) + 4 * n + (i & 3); }

struct Unit { int pm, pn, aoff, boff, nt, mode; };
struct Gemm { const bf16_t* A; const bf16_t* Bt; int lda, ldb; };

struct StaticOrder {
    int nM, nN, nwg, G, c, nt;
    __device__ void init(int nM_, int nN_, int nt_, int G_, int c_) { nM = nM_; nN = nN_; nwg = nM * nN; G = G_; c = c_; nt = nt_; }
    __device__ bool next(int i, Unit& u) const {
        const long L = (long)i * G + c; if (L >= nwg) return false;
        int wgid = (int)L; { const int q = nwg / NXCD, r = nwg % NXCD, xcd = wgid % NXCD, off = wgid / NXCD; wgid = (xcd < r ? xcd * (q + 1) : r * (q + 1) + (xcd - r) * q) + off; }
        const int nig = WGM * nN, gid = wgid / nig, fm = gid * WGM, gsz = (nM - fm) < WGM ? (nM - fm) : WGM;
        u.pm = fm + ((wgid % nig) % gsz); u.pn = (wgid % nig) / gsz; u.aoff = 0; u.boff = 0; u.nt = nt; u.mode = 0; return true;
    }
};

typedef float f32x2_t __attribute__((ext_vector_type(2))); typedef __bf16 bf16x2_t __attribute__((ext_vector_type(2)));
__device__ __forceinline__ unsigned cvt_pk_bf16(float lo, float hi) { f32x2_t v = {lo, hi}; bf16x2_t b = __builtin_convertvector(v, bf16x2_t); return __builtin_bit_cast(unsigned, b); }
__device__ __forceinline__ u32x4 pack8(f32x4 v0, f32x4 v1) { u32x4 w; w.x = cvt_pk_bf16(v0[0], v0[1]); w.y = cvt_pk_bf16(v0[2], v0[3]); w.z = cvt_pk_bf16(v1[0], v1[1]); w.w = cvt_pk_bf16(v1[2], v1[3]); return w; }
__device__ __forceinline__ void unpack8(u32x4 w, f32x4& v0, f32x4& v1) {
    v0 = (f32x4){__uint_as_float(w.x << 16), __uint_as_float(w.x & 0xffff0000u), __uint_as_float(w.y << 16), __uint_as_float(w.y & 0xffff0000u)};
    v1 = (f32x4){__uint_as_float(w.z << 16), __uint_as_float(w.z & 0xffff0000u), __uint_as_float(w.w << 16), __uint_as_float(w.w & 0xffff0000u)};
}
__device__ __forceinline__ float fast_sigmoid(float x) { return __builtin_amdgcn_rcpf(1.f + __builtin_amdgcn_exp2f(-1.4426950408889634f * x)); }

struct EpiProj {
    static constexpr bool PERM = true;
    bf16_t *U, *SZP, *QKV, *SZD, *GATES; float* BA;
    __device__ __forceinline__ bool reset_after(const Unit&) const { return true; }
    __device__ __forceinline__ void operator()(f32x4 (&acc)[2][2][4][2], const Unit& u, int wr, int wc, int fr, int fq) const {
        const int row0 = u.pm * BM + wr * 64 + fr, pn = u.pn;
        if (pn == 56) {
            if (wc == 0) {
#pragma unroll
                for (int ai = 0; ai < 2; ++ai)
#pragma unroll
                    for (int m = 0; m < 4; ++m) { float* rowp = BA + (size_t)(row0 + ai * HALF + m * 16) * 32 + 8 * fq;
                        *(f32x4*)rowp = acc[ai][0][m][0]; *(f32x4*)(rowp + 4) = acc[ai][0][m][1]; }
            }
            return;
        }
        bf16_t* base; int ld, colt, act;
        if (pn < 4) { base = U; ld = 1024; colt = pn * 256; act = 0; }
        else if (pn < 8) { base = SZP; ld = 1024; colt = (pn - 4) * 256; act = 1; }
        else if (pn < 32) { base = QKV; ld = 6144; colt = (pn - 8) * 256; act = 0; }
        else if (pn < 40) { base = SZD; ld = 2048; colt = (pn - 32) * 256; act = 1; }
        else { base = GATES; ld = 4096; colt = (pn - 40) * 256; act = 2; }
        const int col0 = colt + wc * 32 + 8 * fq;
#pragma unroll
        for (int ai = 0; ai < 2; ++ai)
#pragma unroll
            for (int m = 0; m < 4; ++m) { bf16_t* rowp = base + (size_t)(row0 + ai * HALF + m * 16) * ld + col0;
#pragma unroll
                for (int bj = 0; bj < 2; ++bj) { f32x4 v0 = acc[ai][bj][m][0], v1 = acc[ai][bj][m][1];
                    if (act != 0) {
#pragma unroll
                        for (int j = 0; j < 4; ++j) { const float s0 = fast_sigmoid(v0[j]), s1 = fast_sigmoid(v1[j]); v0[j] = act == 1 ? v0[j] * s0 : s0; v1[j] = act == 1 ? v1[j] * s1 : s1; }
                    }
                    *(u32x4*)(rowp + bj * HALF) = pack8(v0, v1); } }
    }
};
struct EpiPoolMix {
    static constexpr bool PERM = true;
    bf16_t* Y; const bf16_t* SZP; const float* scale;
    __device__ __forceinline__ bool reset_after(const Unit&) const { return true; }
    __device__ __forceinline__ void operator()(f32x4 (&acc)[2][2][4][2], const Unit& u, int wr, int wc, int fr, int fq) const {
        const int row0 = u.pm * BM + wr * 64 + fr, col0 = u.pn * BM + wc * 32 + 8 * fq;
#pragma unroll
        for (int bj = 0; bj < 2; ++bj) { const f32x4 s0 = *(const f32x4*)(scale + col0 + bj * HALF), s1 = *(const f32x4*)(scale + col0 + bj * HALF + 4);
#pragma unroll
            for (int ai = 0; ai < 2; ++ai)
#pragma unroll
                for (int m = 0; m < 4; ++m) { const size_t r = (size_t)(row0 + ai * HALF + m * 16);
                    f32x4 z0, z1; unpack8(*(const u32x4*)(SZP + r * 1024 + col0 + bj * HALF), z0, z1);
                    *(u32x4*)(Y + r * YLD + col0 + bj * HALF) = pack8(acc[ai][bj][m][0] * s0 * z0, acc[ai][bj][m][1] * s1 * z1); } }
    }
};
struct EpiMerge {
    static constexpr bool PERM = true;
    const bf16_t* GATES; bf16_t* MG;
    __device__ __forceinline__ bool reset_after(const Unit& u) const { return u.mode != 0; }
    __device__ __forceinline__ void operator()(f32x4 (&acc)[2][2][4][2], const Unit& u, int wr, int wc, int fr, int fq) const {
        const int row0 = u.pm * BM + wr * 64 + fr, col0 = u.pn * BM + wc * 32 + 8 * fq;
#pragma unroll
        for (int ai = 0; ai < 2; ++ai)
#pragma unroll
            for (int m = 0; m < 4; ++m) { const size_t r = (size_t)(row0 + ai * HALF + m * 16);
#pragma unroll
                for (int bj = 0; bj < 2; ++bj) {
                    f32x4 d0, d1; unpack8(*(const u32x4*)(GATES + r * 4096 + 2048 + col0 + bj * HALF), d0, d1);
                    if (u.mode == 0) {
                        f32x4 p0, p1; unpack8(*(const u32x4*)(GATES + r * 4096 + col0 + bj * HALF), p0, p1);
#pragma unroll
                        for (int j = 0; j < 4; ++j) { acc[ai][bj][m][0][j] *= p0[j] / fmaxf(d0[j], 1e-30f); acc[ai][bj][m][1][j] *= p1[j] / fmaxf(d1[j], 1e-30f); }
                    } else {
                        *(u32x4*)(MG + r * DM + col0 + bj * HALF) = pack8(acc[ai][bj][m][0] * d0, acc[ai][bj][m][1] * d1);
                    } } }
    }
};
struct EpiResid {
    static constexpr bool PERM = false;
    const float* x; float* out;
    __device__ __forceinline__ bool reset_after(const Unit&) const { return true; }
    __device__ __forceinline__ void operator()(f32x4 (&acc)[2][2][4][2], const Unit& u, int wr, int wc, int fr, int fq) const {
        const int row0 = u.pm * BM + wr * 64 + fr, col0 = u.pn * BM + wc * 32 + 4 * fq;
#pragma unroll
        for (int ai = 0; ai < 2; ++ai)
#pragma unroll
            for (int m = 0; m < 4; ++m) { const size_t off = (size_t)(row0 + ai * HALF + m * 16) * DM + col0;
#pragma unroll
                for (int bj = 0; bj < 2; ++bj)
#pragma unroll
                    for (int n = 0; n < 2; ++n) *(f32x4*)(out + off + bj * HALF + n * 16) = *(const f32x4*)(x + off + bj * HALF + n * 16) + acc[ai][bj][m][n]; }
    }
};

template <class Epi, class Sched, bool ALIGN_EPI>
__device__ __forceinline__ void gemm_phase(PG8_LAS unsigned char* lds, const Gemm g, const Sched& S, const Epi& E) {
    const int tid = threadIdx.x, wid = __builtin_amdgcn_readfirstlane(tid >> 6), lane = tid & 63, wr = wid >> 2, wc = wid & 3, fr = lane & 15, fq = lane >> 4;
    const int lda = g.lda, ldb = g.ldb;
    unsigned voffA[2], voffB[2];
#pragma unroll
    for (int i = 0; i < 2; ++i) { int R, C; stage_rc(tid * 16 + i * 8192, R, C); const int Rb = Epi::PERM ? ((R & ~31) + perm32(R & 31)) : R;
        voffA[i] = (unsigned)(R * lda + C) * 2u; voffB[i] = (unsigned)(Rb * ldb + C) * 2u; }
    const size_t kstep = (size_t)(BK * 2);
    const size_t hstepA = (size_t)HALF * lda * 2, hstepB = (size_t)HALF * ldb * 2;
    const unsigned ldsw = (unsigned)wid * 1024u;
    const int aoff = lds_byte(wr * 64 + fr, fq * 8), boff = lds_byte(wc * 32 + fr, fq * 8);
#define PG8_SA(b, h) (((b) * 2 + (h)) * HTB)
#define PG8_SB(b, h) ((4 + (b) * 2 + (h)) * HTB)
#define PG8_STAGE(bufoff, gbase, voff) do { _Pragma("unroll") for (int _i = 0; _i < 2; ++_i) \
        __builtin_amdgcn_global_load_lds((const unsigned*)((const char*)(gbase) + (voff)[_i]), (PG8_LAS unsigned*)(lds + (bufoff) + ldsw + _i * 8192), 16, 0, 0); } while (0)
#define PG8_LDA(dst, b, h) do { _Pragma("unroll") for (int m = 0; m < 4; ++m) _Pragma("unroll") for (int k = 0; k < 2; ++k) dst[m][k] = *(const PG8_LAS bf16x8*)(lds + PG8_SA(b, h) + aoff + m * 2048 + k * 1024); } while (0)
#define PG8_LDB(dst, b, h) do { _Pragma("unroll") for (int n = 0; n < 2; ++n) _Pragma("unroll") for (int k = 0; k < 2; ++k) dst[n][k] = *(const PG8_LAS bf16x8*)(lds + PG8_SB(b, h) + boff + n * 2048 + k * 1024); } while (0)
#define PG8_MMA(ai, bj, At, Bt) do { __builtin_amdgcn_s_setprio(1); _Pragma("unroll") for (int m = 0; m < 4; ++m) _Pragma("unroll") for (int n = 0; n < 2; ++n) _Pragma("unroll") for (int k = 0; k < 2; ++k) \
        acc[ai][bj][m][n] = __builtin_amdgcn_mfma_f32_16x16x32_bf16(Bt[n][k], At[m][k], acc[ai][bj][m][n], 0, 0, 0); __builtin_amdgcn_s_setprio(0); } while (0)
#define PG8_WAIT_V(n) asm volatile("s_waitcnt vmcnt(" #n ")" ::: "memory")
#define PG8_WAIT_L(n) asm volatile("s_waitcnt lgkmcnt(" #n ")" ::: "memory")
#define PG8_BAR __builtin_amdgcn_s_barrier()
#define PG8_SCHED __builtin_amdgcn_sched_barrier(0)
#define PG8_UA(u) ((const char*)g.A + ((size_t)(u).pm * BM * lda + (u).aoff) * 2)
#define PG8_UB(u) ((const char*)g.Bt + ((size_t)(u).pn * BM * ldb + (u).boff) * 2)
    Unit cur, nxt; int ui = 0;
    if (!S.next(0, cur)) return;
    f32x4 acc[2][2][4][2];
#pragma unroll
    for (int a = 0; a < 2; ++a)
#pragma unroll
        for (int b = 0; b < 2; ++b)
#pragma unroll
            for (int m = 0; m < 4; ++m)
#pragma unroll
                for (int n = 0; n < 2; ++n) acc[a][b][m][n] = (f32x4){0.f, 0.f, 0.f, 0.f};
    bf16x8 At[4][2], B0[2][2], B1[2][2];
    const char* cA = PG8_UA(cur); const char* cB = PG8_UB(cur);
    PG8_STAGE(PG8_SB(0, 0), cB, voffB); PG8_STAGE(PG8_SB(0, 1), cB + hstepB, voffB); PG8_STAGE(PG8_SA(0, 0), cA, voffA); PG8_STAGE(PG8_SA(0, 1), cA + hstepA, voffA);
    if (wr == 1) PG8_BAR;
    PG8_WAIT_V(2); PG8_BAR;
    PG8_STAGE(PG8_SB(1, 0), cB + kstep, voffB); PG8_STAGE(PG8_SA(1, 0), cA + kstep, voffA); PG8_STAGE(PG8_SB(1, 1), cB + hstepB + kstep, voffB);
    PG8_WAIT_V(6); PG8_BAR;
    for (;;) {
        const bool has_next = S.next(ui + 1, nxt);
        const char* nA = has_next ? PG8_UA(nxt) : cA; const char* nB = has_next ? PG8_UB(nxt) : cB;
        const int nt = cur.nt;
        for (int t = 0; t < nt; t += 2) {
            const bool last = (t == nt - 2);
            const char* a1 = cA + (size_t)(t + 1) * kstep;
            const char* a2 = last ? nA : cA + (size_t)(t + 2) * kstep; const char* b2 = last ? nB : cB + (size_t)(t + 2) * kstep;
            const char* a3 = a2 + kstep; const char* b3 = b2 + kstep;
            PG8_LDB(B0, 0, 0); PG8_LDB(B1, 0, 1); PG8_SCHED; PG8_LDA(At, 0, 0); PG8_STAGE(PG8_SA(1, 1), a1 + hstepA, voffA);
            PG8_WAIT_V(8); PG8_WAIT_L(0); PG8_BAR; PG8_MMA(0, 0, At, B0); PG8_MMA(0, 1, At, B1); PG8_BAR; PG8_SCHED;
            PG8_LDA(At, 0, 1); PG8_STAGE(PG8_SB(0, 0), b2, voffB); PG8_STAGE(PG8_SB(0, 1), b2 + hstepB, voffB); PG8_STAGE(PG8_SA(0, 0), a2, voffA);
            PG8_WAIT_V(8); PG8_WAIT_L(0); PG8_BAR; PG8_MMA(1, 0, At, B0); PG8_MMA(1, 1, At, B1); PG8_BAR; PG8_SCHED;
            PG8_LDB(B0, 1, 0); PG8_LDB(B1, 1, 1); PG8_SCHED; PG8_LDA(At, 1, 0); PG8_STAGE(PG8_SA(0, 1), a2 + hstepA, voffA);
            PG8_WAIT_V(8); PG8_WAIT_L(0); PG8_BAR; PG8_MMA(0, 0, At, B0); PG8_MMA(0, 1, At, B1); PG8_BAR; PG8_SCHED;
            PG8_LDA(At, 1, 1); PG8_STAGE(PG8_SB(1, 0), b3, voffB); PG8_STAGE(PG8_SB(1, 1), b3 + hstepB, voffB); PG8_STAGE(PG8_SA(1, 0), a3, voffA);
            PG8_WAIT_V(8); PG8_WAIT_L(0); PG8_BAR; PG8_MMA(1, 0, At, B0); PG8_MMA(1, 1, At, B1); PG8_BAR; PG8_SCHED;
        }
        if constexpr (ALIGN_EPI) { if (wr == 0) PG8_BAR; }
        E(acc, cur, wr, wc, fr, fq);
        if (!has_next) break;
        if (E.reset_after(cur)) {
#pragma unroll
            for (int a = 0; a < 2; ++a)
#pragma unroll
                for (int b = 0; b < 2; ++b)
#pragma unroll
                    for (int m = 0; m < 4; ++m)
#pragma unroll
                        for (int n = 0; n < 2; ++n) acc[a][b][m][n] = (f32x4){0.f, 0.f, 0.f, 0.f};
        }
        cur = nxt; cA = nA; cB = nB; ++ui;
        if constexpr (ALIGN_EPI) { if (wr == 1) PG8_BAR; }
    }
    PG8_WAIT_V(0);
    if constexpr (!ALIGN_EPI) { if (wr == 0) PG8_BAR; }
    PG8_BAR;
#undef PG8_SA
#undef PG8_SB
#undef PG8_STAGE
#undef PG8_LDA
#undef PG8_LDB
#undef PG8_MMA
#undef PG8_WAIT_V
#undef PG8_WAIT_L
#undef PG8_BAR
#undef PG8_SCHED
#undef PG8_UA
#undef PG8_UB
}
}
#ifndef DUP_MASK
#define DUP_MASK 0
#endif
#ifndef SIMPLE_PREP
#define SIMPLE_PREP 0
#endif
#ifndef SIMPLE_SCAN
#define SIMPLE_SCAN 0
#endif
constexpr int NWAVES = 8;
constexpr int RING_OFF = 0, RING_BYTES = 131072;
constexpr int LDSCTL_OFF = RING_BYTES, MISC_OFF = LDSCTL_OFF + 320;
constexpr int XTRA_OFF = RING_BYTES + 1024;
constexpr int LDS_BYTES = 147456;
constexpr int CW_BAR = 4096;

#define GAS __attribute__((address_space(1)))
#define LAS __attribute__((address_space(3)))
typedef unsigned v4u __attribute__((ext_vector_type(4)));
typedef float f32x4 __attribute__((ext_vector_type(4)));
typedef GAS unsigned gu32;
#define LDS_WAIT() asm volatile("s_waitcnt lgkmcnt(0)" ::: "memory")
#define VM_WAIT() asm volatile("s_waitcnt vmcnt(0)" ::: "memory")
__device__ __forceinline__ unsigned pk2(float lo, float hi) { return (unsigned)f2bf(lo) | ((unsigned)f2bf(hi) << 16); }

#define XB_TMO      128
#define XB_XCNT(j)  (256  + 64 * (j))
#define XB_XSUB(j)  (1280 + 64 * (j))
#define XB_XGEN(j)  (2304 + 64 * (j))
#define XB_TOP      3328
#define XB_TOPGEN   3392
#define XCD_BAR_WORDS 3456
#define XB_SPIN_CAP (1u << 18)
__device__ __forceinline__ unsigned xb_ld(unsigned* p)              { return __hip_atomic_load(p, __ATOMIC_RELAXED, __HIP_MEMORY_SCOPE_AGENT); }
__device__ __forceinline__ unsigned xb_add(unsigned* p, unsigned v) { return __hip_atomic_fetch_add(p, v, __ATOMIC_RELAXED, __HIP_MEMORY_SCOPE_AGENT); }
__device__ __forceinline__ unsigned xb_xcc_id() { return (unsigned)__builtin_amdgcn_s_getreg((3 << 11) | 20) & 0xFu; }
#define XB_SPIN(cond, bar) do { unsigned _sp = 0; while (cond) { __builtin_amdgcn_s_sleep(1); \
    if ((++_sp & 255u) == 0u) { if (xb_ld(&(bar)[XB_TMO])) break; if (_sp > XB_SPIN_CAP) { atomicAdd(&(bar)[XB_TMO], 1u); break; } } } } while (0)
struct XcdBarrier { unsigned* bar; unsigned x; volatile LAS unsigned* st; };
__device__ __forceinline__ XcdBarrier xcd_barrier_post(unsigned* bar, volatile LAS unsigned* st) {
    XcdBarrier b; b.bar = bar; b.x = xb_xcc_id(); b.st = st;
    if (threadIdx.x == 0) (void)xb_add(&bar[XB_XCNT(b.x)], 1u);
    return b;
}
__device__ __forceinline__ void xcd_barrier_complete(unsigned* bar, unsigned x, unsigned& nloc, unsigned& nx) {
    const unsigned G = gridDim.x * gridDim.y * gridDim.z;
    unsigned sum, cnt, mine, sp = 0u;
    for (;;) {
        sum = 0u; cnt = 0u; mine = 0u;
#pragma unroll
        for (unsigned j = 0; j < 16; ++j) { const unsigned c = xb_ld(&bar[XB_XCNT(j)]); sum += c; cnt += (c > 0u) ? 1u : 0u; mine = (j == x) ? c : mine; }
        if (sum == G) break;
        __builtin_amdgcn_s_sleep(1);
        if ((++sp & 255u) == 0u) { if (xb_ld(&bar[XB_TMO])) break; if (sp > XB_SPIN_CAP) { atomicAdd(&bar[XB_TMO], 1u); break; } }
    }
    nloc = mine > 0u ? mine : 1u; nx = cnt > 0u ? cnt : 1u;
}
__device__ __forceinline__ void xcd_barrier(const XcdBarrier& b) {
    asm volatile("s_waitcnt vmcnt(0)" ::: "memory");
    __syncthreads();
    if (threadIdx.x == 0) {
        unsigned* bar = b.bar;
        __builtin_amdgcn_s_waitcnt(0);
        unsigned nloc = b.st[0], nx = b.st[1];
        if (nloc == 0u) { xcd_barrier_complete(bar, b.x, nloc, nx); b.st[0] = nloc; b.st[1] = nx; }
        const unsigned old = xb_add(&bar[XB_XSUB(b.x)], 1u);
        const unsigned gen = old / nloc;
        if (old + 1u == (gen + 1u) * nloc) {
            __builtin_amdgcn_fence(__ATOMIC_RELEASE, "agent");
            asm volatile("s_waitcnt vmcnt(0)" ::: "memory");
            const unsigned og = xb_add(&bar[XB_TOP], 1u);
            const unsigned tg = og / nx;
            if (og + 1u == (tg + 1u) * nx) xb_add(&bar[XB_TOPGEN], 1u);
            else XB_SPIN(xb_ld(&bar[XB_TOPGEN]) == tg, bar);
            __builtin_amdgcn_fence(__ATOMIC_ACQUIRE, "agent");
            xb_add(&bar[XB_XGEN(b.x)], 1u);
            asm volatile("s_waitcnt vmcnt(0)" ::: "memory");
        } else {
            XB_SPIN(xb_ld(&bar[XB_XGEN(b.x)]) == gen, bar);
            __builtin_amdgcn_fence(__ATOMIC_ACQUIRE, "agent");
            asm volatile("s_waitcnt vmcnt(0)" ::: "memory");
        }
    }
    __syncthreads();
}

struct Args { const float* in[14]; float* out; unsigned char* ws; int ph_lo, ph_hi; };

struct Frame {
    LAS unsigned char* lds; int tid, lane, wave, vcu, G;
};

__device__ __forceinline__ void p0_transpose_item(const float* __restrict__ W, int N, int k0, int n0, bf16_t* __restrict__ WT, int ldt, int dn0, int koff, LAS float* scr, int lane) {
#pragma unroll 8
    for (int i = 0; i < 32; ++i) { const int kk = 2 * i + (lane >> 5); scr[kk * 33 + (lane & 31)] = W[(size_t)(k0 + kk) * N + n0 + (lane & 31)]; }
    LDS_WAIT(); asm volatile("" ::: "memory");
    const int c = lane & 7;
#pragma unroll
    for (int j = 0; j < 4; ++j) { const int n = (lane >> 3) + 8 * j; const LAS float* s = scr + (8 * c) * 33 + n;
        v4u o; o.x = pk2(s[0 * 33], s[1 * 33]); o.y = pk2(s[2 * 33], s[3 * 33]); o.z = pk2(s[4 * 33], s[5 * 33]); o.w = pk2(s[6 * 33], s[7 * 33]);
        *(v4u*)(WT + (size_t)(dn0 + n) * ldt + koff + k0 + 8 * c) = o; }
    LDS_WAIT(); asm volatile("" ::: "memory");
}
__device__ __forceinline__ void p0_prologue(Frame& F, const Args& a) {
    unsigned char* ws = a.ws;
    bf16_t *WinT = (bf16_t*)(ws + WS_WINT), *W2T = (bf16_t*)(ws + WS_W2T), *WoT = (bf16_t*)(ws + WS_WOT), *MixT = (bf16_t*)(ws + WS_MIXT), *XN = (bf16_t*)(ws + WS_XN);
    LAS float* scr = (LAS float*)(F.lds + RING_OFF + F.wave * 16384);
    const int gw = F.vcu * NWAVES + F.wave, NGW = F.G * NWAVES;
    constexpr int I_IN = (DM / 64) * (INC / 32), I_PO = (PW / 64) * (DM / 32), I_DN = (DNW / 64) * (DM / 32), I_WO = (DM / 64) * (DM / 32), I_MX = 4 * (PGD / 64) * (PGD / 32);
    constexpr int NITEMS = I_IN + I_PO + I_DN + I_WO + I_MX;
    for (int it = gw; it < NITEMS; it += NGW) {
        int r = it;
        if (r < I_IN) { const int nblk = INC / 32, kb = r / nblk, nb = r % nblk, n0 = 32 * nb;
            const int dn0 = n0 < C_B ? n0 : (n0 < C_GP ? 14336 + (n0 - C_B) : n0 - 32);
            p0_transpose_item(a.in[3], INC, 64 * kb, n0, WinT, DM, dn0, 0, scr, F.lane); continue; } r -= I_IN;
        if (r < I_PO) { const int nblk = DM / 32, kb = r / nblk, nb = r % nblk; p0_transpose_item(a.in[10], DM, 64 * kb, 32 * nb, W2T, YLD, 32 * nb, 0, scr, F.lane); continue; } r -= I_PO;
        if (r < I_DN) { const int nblk = DM / 32, kb = r / nblk, nb = r % nblk; p0_transpose_item(a.in[11], DM, 64 * kb, 32 * nb, W2T, YLD, 32 * nb, 1024, scr, F.lane); continue; } r -= I_DN;
        if (r < I_WO) { const int nblk = DM / 32, kb = r / nblk, nb = r % nblk; p0_transpose_item(a.in[12], DM, 64 * kb, 32 * nb, WoT, DM, 32 * nb, 0, scr, F.lane); continue; } r -= I_WO;
        { const int g = r / 32, rr = r % 32, kb = rr / 8, nb = rr % 8;
          p0_transpose_item(a.in[7] + (size_t)g * PGD * PGD, PGD, 64 * kb, 32 * nb, MixT + (size_t)g * PGD * PGD, PGD, 32 * nb, 0, scr, F.lane); }
    }
    const float* nw = a.in[2];
    for (int r = gw; r < MPAD + (NPAD1 - INC); r += NGW) {
        if (r >= MROWS) { bf16_t* o = r < MPAD ? XN + (size_t)r * DM : WinT + (size_t)(INC + (r - MPAD)) * DM;
#pragma unroll
            for (int j = 0; j < 4; ++j) *(v4u*)(o + 8 * F.lane + 512 * j) = (v4u){0u, 0u, 0u, 0u};
            continue; }
        const float* src = r < MTOK ? a.in[0] + (size_t)r * DM : a.in[1] + (size_t)(r - MTOK) * DM;
        f32x4 v[8]; float s = 0.f;
#pragma unroll
        for (int j = 0; j < 8; ++j) { v[j] = *(const f32x4*)(src + 4 * F.lane + 256 * j); s += (v[j].x * v[j].x + v[j].y * v[j].y) + (v[j].z * v[j].z + v[j].w * v[j].w); }
        const float rs = rsqrtf(wave_sum(s) * (1.f / DM) + EPS);
        unsigned long long* o8 = (unsigned long long*)(XN + (size_t)r * DM) + F.lane;
#pragma unroll
        for (int j = 0; j < 8; ++j) { const f32x4 w = *(const f32x4*)(nw + 4 * F.lane + 256 * j);
            o8[64 * j] = (unsigned long long)pk2(v[j].x * rs * w.x, v[j].y * rs * w.y) | ((unsigned long long)pk2(v[j].z * rs * w.z, v[j].w * rs * w.w) << 32); }
    }
}

template <int WIN>
__device__ __forceinline__ void p2_pool_item(const bf16_t* __restrict__ U, bf16_t* __restrict__ PO, int g, int rb, int c) {
    const int b = rb >> 8, t0 = (rb & 255) * 8, col = g * 256 + c * 8;
    pg8::u32x4 raw[WIN + 7];
#pragma unroll
    for (int j = 0; j < WIN + 7; ++j) { const int t = t0 - (WIN - 1) + j; const int row = t >= 0 ? b * SEQ + t : MTOK + NMETA + t; raw[j] = *(const pg8::u32x4*)(U + (size_t)row * 1024 + col); }
    f32x4 s0 = (f32x4){0.f, 0.f, 0.f, 0.f}, s1 = s0;
#pragma unroll
    for (int j = 0; j < WIN - 1; ++j) { f32x4 x0, x1; pg8::unpack8(raw[j], x0, x1); s0 += x0; s1 += x1; }
    constexpr float inv = 1.f / (float)WIN;
#pragma unroll
    for (int i = 0; i < 8; ++i) { f32x4 x0, x1; pg8::unpack8(raw[WIN - 1 + i], x0, x1); s0 += x0; s1 += x1;
        *(pg8::u32x4*)(PO + (size_t)(b * SEQ + t0 + i) * 1024 + col) = pg8::pack8(s0 * inv - x0, s1 * inv - x1);
        f32x4 y0, y1; pg8::unpack8(raw[i], y0, y1); s0 -= y0; s1 -= y1; }
}
__device__ __forceinline__ void p2_pool(Frame& F, const Args& a) {
    const bf16_t* U = (const bf16_t*)(a.ws + WS_U); bf16_t* PO = (bf16_t*)(a.ws + WS_POOLED);
    const int gw = F.vcu * NWAVES + F.wave, NGW = F.G * NWAVES;
    for (int wi = gw; wi < 4 * 512; wi += NGW) {
        const int g = wi >> 9, rb = (wi & 511) * 2 + (F.lane >> 5), c = F.lane & 31;
        if (g == 0) p2_pool_item<2>(U, PO, 0, rb, c); else if (g == 1) p2_pool_item<4>(U, PO, 1, rb, c); else if (g == 2) p2_pool_item<8>(U, PO, 2, rb, c); else p2_pool_item<16>(U, PO, 3, rb, c);
    }
}
__device__ __forceinline__ void p2_chunk_prep_simple(Frame& F, const Args& a) {
    const bf16_t* QKV = (const bf16_t*)(a.ws + WS_QKV); const float* BA = (const float*)(a.ws + WS_BA);
    const float *conv_w = a.in[4], *A_log = a.in[5], *dt_bias = a.in[6];
    bf16_t *NW = (bf16_t*)(a.ws + WS_CH_NW), *UU = (bf16_t*)(a.ws + WS_CH_U), *QD = (bf16_t*)(a.ws + WS_CH_QD), *KDT = (bf16_t*)(a.ws + WS_CH_KDT), *QK = (bf16_t*)(a.ws + WS_CH_QK);
    float* GL = (float*)(a.ws + WS_CH_GL);
    LAS float* sm = (LAS float*)(F.lds + RING_OFF);
    LAS float *q = sm, *k = q + 8192, *v = k + 8192, *Am = v + 8192, *Tm = Am + 4096;
    LAS float *beta = (LAS float*)(F.lds + XTRA_OFF), *gc = beta + 64;
    const int tid = F.tid, lane = F.lane, wv = F.wave;
    for (int cu = F.vcu; cu < NUNITS; cu += F.G) {
        const int n = cu % NCH, bh = cu / NCH, h = bh % NH, b = bh / NH, p0 = CHUNK * n - PADF;
        for (int idx = tid; idx < 64 * 384; idx += 512) {
            const int i = idx / 384, c3 = idx % 384, which = c3 >> 7, d = c3 & 127, col = which * 2048 + h * HD + d, p = p0 + i;
            float val = 0.f;
            if (p >= 0) { float s = 0.f;
                for (int kk = 0; kk < 4; ++kk) { const int pp = p - 3 + kk; if (pp >= 0) s += conv_w[kk * 6144 + col] * bf2f(QKV[(size_t)ext_row(b, pp) * 6144 + col]); }
                val = siluf_(s); }
            (which == 0 ? q : which == 1 ? k : v)[i * 128 + d] = val;
        }
        if (tid < 64) { const int p = p0 + tid; float be = 0.f, g = 0.f;
            if (p >= 0) { const int r = ext_row(b, p); be = sigmoidf_(BA[(size_t)r * 32 + h]); g = -__expf(A_log[h]) * softplusf_(BA[(size_t)r * 32 + 16 + h] + dt_bias[h]); }
            beta[tid] = be; gc[tid] = g; }
        __syncthreads();
        if (tid == 0) { float s = 0.f; for (int i = 0; i < 64; ++i) { s += gc[i]; gc[i] = s; } }
        for (int r = wv; r < 128; r += 8) {
            LAS float* row = (r < 64 ? q + r * 128 : k + (r - 64) * 128);
            const float a0 = row[lane], a1 = row[lane + 64];
            const float rs = rsqrtf(wave_sum(a0 * a0 + a1 * a1) + EPS) * (r < 64 ? 0.08838834764831845f : 1.f);
            row[lane] = a0 * rs; row[lane + 64] = a1 * rs;
        }
        __syncthreads();
        bf16_t* oQK = QK + (size_t)cu * 4096;
        for (int idx = tid; idx < 4096; idx += 512) {
            const int i = idx >> 6, j = idx & 63; float akk = 0.f, aqk = 0.f;
            if (j <= i) { for (int d = 0; d < 128; ++d) { const float kj = k[j * 128 + d]; akk += k[i * 128 + d] * kj; aqk += q[i * 128 + d] * kj; }
                const float dec = __expf(gc[i] - gc[j]); akk *= beta[i] * dec; aqk *= dec; }
            Am[idx] = j < i ? akk : 0.f; oQK[idx] = f2bf(j <= i ? aqk : 0.f);
        }
        __syncthreads();
        if (tid < 64) { const int c = tid;
            for (int i = 0; i < 64; ++i) { float s = (i == c) ? 1.f : 0.f; for (int j = c; j < i; ++j) s -= Am[i * 64 + j] * Tm[j * 64 + c]; Tm[i * 64 + c] = (i >= c) ? s : 0.f; } }
        __syncthreads();
        bf16_t *oNW = NW + (size_t)cu * 8192, *oU = UU + (size_t)cu * 8192, *oQD = QD + (size_t)cu * 8192, *oKDT = KDT + (size_t)cu * 8192;
        const float gl = gc[63];
        for (int idx = tid; idx < 8192; idx += 512) {
            const int i = idx >> 7, d = idx & 127; float su = 0.f, sw = 0.f;
            for (int j = 0; j <= i; ++j) { const float t = Tm[i * 64 + j] * beta[j]; su += t * v[j * 128 + d]; sw += t * __expf(gc[j]) * k[j * 128 + d]; }
            oU[d * 64 + i] = f2bf(su); oNW[idx] = f2bf(-sw);
            oQD[idx] = f2bf(q[idx] * __expf(gc[i]));
            oKDT[d * 64 + i] = f2bf(k[idx] * __expf(gl - gc[i]));
        }
        if (tid == 0) GL[cu] = __expf(gl);
        __syncthreads();
    }
}

typedef short bf16x8_t __attribute__((ext_vector_type(8)));
typedef unsigned u32x2_t __attribute__((ext_vector_type(2)));
typedef unsigned u32x4_t __attribute__((ext_vector_type(4)));
__device__ __forceinline__ u32x2_t pack4bf(f32x4 v) { u32x2_t r; r.x = pg8::cvt_pk_bf16(v[0], v[1]); r.y = pg8::cvt_pk_bf16(v[2], v[3]); return r; }

constexpr int QS_LD = 272, KT_LD = 144, AM_LD = 68;
constexpr int L_QS = 0, L_KS = 17408, L_KT = 34816, L_VT = 53248, L_AM = 71680, L_TM = 89088, L_TB = 106496, L_TW = 115712, L_XS = 124928;
static_assert(L_XS + 3 * 1152 <= RING_BYTES, "chunk-prep LDS map");
__device__ __forceinline__ int ktoff(int d, int chunk) { return d * KT_LD + ((chunk ^ ((d >> 3) & 7)) << 4); }
struct PrepRaw { pg8::u32x4 x[11]; float pb, pa; };
__device__ __forceinline__ void p2_chunk_prep_fast(Frame& F, const Args& a) {
    const bf16_t* QKV = (const bf16_t*)(a.ws + WS_QKV); const float* BA = (const float*)(a.ws + WS_BA);
    const float *conv_w = a.in[4], *A_log = a.in[5], *dt_bias = a.in[6];
    bf16_t *NW = (bf16_t*)(a.ws + WS_CH_NW), *UT = (bf16_t*)(a.ws + WS_CH_U), *QD = (bf16_t*)(a.ws + WS_CH_QD), *KDT = (bf16_t*)(a.ws + WS_CH_KDT), *QK = (bf16_t*)(a.ws + WS_CH_QK);
    float* GL = (float*)(a.ws + WS_CH_GL);
    LAS unsigned char* L = F.lds + RING_OFF;
    LAS float *Am = (LAS float*)(L + L_AM), *Tm = (LAS float*)(L + L_TM);
    LAS float *beta = (LAS float*)(F.lds + XTRA_OFF), *gc = beta + 64;
    const int tid = F.tid, lane = F.lane, w = F.wave, fr = lane & 15, fq = lane >> 4;
    const int which = w >> 1, ib = (4 * w + fq) & 7, d8 = 8 * fr; const bool cvt = w < 6;
    const int u_lo = (33 * F.vcu) / 4, u_hi = F.G == 256 ? (33 * (F.vcu + 1)) / 4 : 0;
#define PREP_LOAD(R, cu_) do { const int n_ = (cu_) % NCH, bh_ = (cu_) / NCH, h_ = bh_ % NH, b_ = bh_ / NH, colx = (which < 3 ? which : 2) * 2048 + h_ * HD + d8; \
        _Pragma("unroll") for (int j = 0; j < 11; ++j) { int pp = CHUNK * n_ - PADF + 8 * ib - 3 + j; pp = pp < 0 ? 0 : pp; (R).x[j] = *(const pg8::u32x4*)(QKV + (size_t)ext_row(b_, pp) * 6144 + colx); } \
        { int pl = CHUNK * n_ - PADF + lane; pl = pl < 0 ? 0 : pl; const float* bp = BA + (size_t)ext_row(b_, pl) * 32 + h_; (R).pb = bp[0]; (R).pa = bp[16]; } } while (0)
    LAS float* cw = (LAS float*)(F.lds + XTRA_OFF + 1024);
    PrepRaw raw; int hcur = -1;
    if (u_lo < u_hi) PREP_LOAD(raw, u_lo);
    for (int cu = u_lo; cu < u_hi; ++cu) {
        const int n = cu % NCH, bh = cu / NCH, h = bh % NH, b = bh / NH, p0 = CHUNK * n - PADF;
        if (h != hcur) { hcur = h; for (int i = tid; i < 4 * 384; i += 512) { const int kk = i / 384, c = i % 384; cw[i] = conv_w[kk * 6144 + (c >> 7) * 2048 + h * HD + (c & 127)]; } __syncthreads(); }
        if (cvt) {
            unsigned tr[8][4];
            f32x4 cwr[8];
#pragma unroll
            for (int kk = 0; kk < 4; ++kk) { cwr[2 * kk] = *(const LAS f32x4*)(cw + kk * 384 + which * 128 + d8); cwr[2 * kk + 1] = *(const LAS f32x4*)(cw + kk * 384 + which * 128 + d8 + 4); }
#pragma unroll
            for (int ii = 0; ii < 8; ++ii) {
                float v[8];
#pragma unroll
                for (int j = 0; j < 8; ++j) v[j] = 0.f;
#pragma unroll
                for (int kk = 0; kk < 4; ++kk) { const bool ok = p0 + 8 * ib + ii - 3 + kk >= 0; f32x4 x0, x1; pg8::unpack8(raw.x[ii + kk], x0, x1);
#pragma unroll
                    for (int j = 0; j < 4; ++j) { v[j] += ok ? cwr[2 * kk][j] * x0[j] : 0.f; v[4 + j] += ok ? cwr[2 * kk + 1][j] * x1[j] : 0.f; } }
#pragma unroll
                for (int j = 0; j < 8; ++j) v[j] = v[j] * pg8::fast_sigmoid(v[j]);
                if (which < 2) { float ss = 0.f;
#pragma unroll
                    for (int j = 0; j < 8; ++j) ss += v[j] * v[j];
                    ss += __shfl_xor(ss, 1); ss += __shfl_xor(ss, 2); ss += __shfl_xor(ss, 4); ss += __shfl_xor(ss, 8);
                    const float rs = rsqrtf(ss + EPS) * (which == 0 ? 0.08838834764831845f : 1.f);
#pragma unroll
                    for (int j = 0; j < 8; ++j) v[j] *= rs; }
                const pg8::u32x4 pk = pg8::pack8((f32x4){v[0], v[1], v[2], v[3]}, (f32x4){v[4], v[5], v[6], v[7]});
                if (which < 2) *(LAS pg8::u32x4*)(L + (which == 0 ? L_QS : L_KS) + (8 * ib + ii) * QS_LD + d8 * 2) = pk;
                tr[ii][0] = pk.x; tr[ii][1] = pk.y; tr[ii][2] = pk.z; tr[ii][3] = pk.w;
            }
            if (which >= 1) { LAS unsigned char* T = L + (which == 1 ? L_KT : L_VT);
#pragma unroll
                for (int dj = 0; dj < 8; ++dj) { pg8::u32x4 o;
                    const int q = dj >> 1;
                    if (dj & 1) { o.x = (tr[0][q] >> 16) | (tr[1][q] & 0xffff0000u); o.y = (tr[2][q] >> 16) | (tr[3][q] & 0xffff0000u); o.z = (tr[4][q] >> 16) | (tr[5][q] & 0xffff0000u); o.w = (tr[6][q] >> 16) | (tr[7][q] & 0xffff0000u); }
                    else { o.x = (tr[0][q] & 0xffffu) | (tr[1][q] << 16); o.y = (tr[2][q] & 0xffffu) | (tr[3][q] << 16); o.z = (tr[4][q] & 0xffffu) | (tr[5][q] << 16); o.w = (tr[6][q] & 0xffffu) | (tr[7][q] << 16); }
                    *(LAS pg8::u32x4*)(T + ktoff(d8 + dj, ib)) = o; } }
        }
        if (w == 7) {
            const int p = p0 + lane; float be = 0.f, g = 0.f;
            if (p >= 0) { be = sigmoidf_(raw.pb); g = -__expf(A_log[h]) * softplusf_(raw.pa + dt_bias[h]); }
#pragma unroll
            for (int o = 1; o < 64; o <<= 1) { const float t = __shfl_up(g, o); if (lane >= o) g += t; }
            beta[lane] = be; gc[lane] = g;
        }
        __syncthreads();
        PREP_LOAD(raw, cu + 1 < u_hi ? cu + 1 : cu);
        const float gl = gc[63];
        {
            const int kind = w >> 2, ti = w & 3;
            bf16x8_t af[4];
#pragma unroll
            for (int ks = 0; ks < 4; ++ks) af[ks] = *(const LAS bf16x8_t*)(L + L_KS + (16 * ti + fr) * QS_LD + (32 * ks + 8 * fq) * 2);
            bf16_t* oQK = QK + (size_t)cu * 4096;
#pragma unroll
            for (int tj = 0; tj < 4; ++tj) {
                if (kind == 0) {
                    if (tj > ti) continue;
                    f32x4 acc = (f32x4){0.f, 0.f, 0.f, 0.f};
#pragma unroll
                    for (int ks = 0; ks < 4; ++ks) acc = __builtin_amdgcn_mfma_f32_16x16x32_bf16(af[ks], *(const LAS bf16x8_t*)(L + L_KS + (16 * tj + fr) * QS_LD + (32 * ks + 8 * fq) * 2), acc, 0, 0, 0);
                    const int j = 16 * tj + fr; const float gj = gc[j];
#pragma unroll
                    for (int r = 0; r < 4; ++r) { const int i = 16 * ti + 4 * fq + r; Am[i * AM_LD + j] = j < i ? acc[r] * beta[i] * __expf(gc[i] - gj) : 0.f; }
                } else {
                    const int i = 16 * tj + fr; u32x2_t o = (u32x2_t){0u, 0u};
                    if (tj >= ti) {
                        f32x4 acc = (f32x4){0.f, 0.f, 0.f, 0.f};
#pragma unroll
                        for (int ks = 0; ks < 4; ++ks) acc = __builtin_amdgcn_mfma_f32_16x16x32_bf16(af[ks], *(const LAS bf16x8_t*)(L + L_QS + (16 * tj + fr) * QS_LD + (32 * ks + 8 * fq) * 2), acc, 0, 0, 0);
                        const float gi = gc[i];
#pragma unroll
                        for (int r = 0; r < 4; ++r) { const int j = 16 * ti + 4 * fq + r; acc[r] = j <= i ? acc[r] * __expf(gi - gc[j]) : 0.f; }
                        o = pack4bf(acc);
                    }
                    *(u32x2_t*)(oQK + i * 64 + 16 * ti + 4 * fq) = o;
                }
            }
        }
        __syncthreads();
        if (w == 0) {
            const int ab = fq, c = fr; float t[16];
#pragma unroll
            for (int r = 0; r < 16; ++r) { float s = (r == c) ? 1.f : 0.f;
#pragma unroll
                for (int m4 = 0; m4 < (r + 3) / 4; ++m4) { const f32x4 av = *(const LAS f32x4*)(Am + (16 * ab + r) * AM_LD + 16 * ab + 4 * m4);
#pragma unroll
                    for (int j = 0; j < 4; ++j) if (4 * m4 + j < r) s -= av[j] * t[4 * m4 + j]; }
                t[r] = s; Tm[(16 * ab + r) * AM_LD + 16 * ab + c] = s; }
        } else {
            bf16_t *oQD = QD + (size_t)cu * 8192, *oKDT = KDT + (size_t)cu * 8192;
            for (int idx = tid - 64; idx < 2048; idx += 448) {
                if (idx < 1024) { const int i = idx >> 4, d8 = (idx & 15) * 8; pg8::f32x4 x0, x1; pg8::unpack8(*(const LAS pg8::u32x4*)(L + L_QS + i * QS_LD + d8 * 2), x0, x1);
                    const float e = __expf(gc[i]); *(pg8::u32x4*)(oQD + i * 128 + d8) = pg8::pack8(x0 * e, x1 * e); }
                else { const int id = idx - 1024, d = id >> 3, i8 = (id & 7) * 8; pg8::f32x4 x0, x1; pg8::unpack8(*(const LAS pg8::u32x4*)(L + L_KT + ktoff(d, i8 >> 3)), x0, x1);
#pragma unroll
                    for (int j = 0; j < 4; ++j) { x0[j] *= __expf(gl - gc[i8 + j]); x1[j] *= __expf(gl - gc[i8 + 4 + j]); }
                    *(pg8::u32x4*)(oKDT + d * 64 + i8) = pg8::pack8(x0, x1); }
            }
            if (tid == 64) GL[cu] = __expf(gl);
        }
        __syncthreads();
#pragma unroll
        for (int dd = 1; dd < 4; ++dd) {
            if (w < 4 - dd) {
                const int bb = w, ab = w + dd;
                f32x4 acc = (f32x4){0.f, 0.f, 0.f, 0.f};
                for (int c = bb; c < ab; ++c)
#pragma unroll
                    for (int ks = 0; ks < 4; ++ks) acc = __builtin_amdgcn_mfma_f32_16x16x4f32(Am[(16 * ab + fr) * AM_LD + 16 * c + 4 * ks + fq], Tm[(16 * c + 4 * ks + fq) * AM_LD + 16 * bb + fr], acc, 0, 0, 0);
                LAS float* Xs = (LAS float*)(L + L_XS + w * 1152);
#pragma unroll
                for (int r = 0; r < 4; ++r) Xs[(4 * fq + r) * 17 + fr] = acc[r];
                f32x4 acc2 = (f32x4){0.f, 0.f, 0.f, 0.f};
#pragma unroll
                for (int ks = 0; ks < 4; ++ks) acc2 = __builtin_amdgcn_mfma_f32_16x16x4f32(Tm[(16 * ab + fr) * AM_LD + 16 * ab + 4 * ks + fq], Xs[(4 * ks + fq) * 17 + fr], acc2, 0, 0, 0);
#pragma unroll
                for (int r = 0; r < 4; ++r) Tm[(16 * ab + 4 * fq + r) * AM_LD + 16 * bb + fr] = -acc2[r];
            }
            __syncthreads();
        }
        { const int i = tid >> 3, j8 = (tid & 7) * 8; f32x4 t0 = *(const LAS f32x4*)(Tm + i * AM_LD + j8), t1 = *(const LAS f32x4*)(Tm + i * AM_LD + j8 + 4); f32x4 b0, b1, w0, w1;
#pragma unroll
            for (int j = 0; j < 4; ++j) { const int ja = j8 + j, jb = j8 + 4 + j; const float ba = beta[ja], bb = beta[jb];
                b0[j] = ja <= i ? t0[j] * ba : 0.f; b1[j] = jb <= i ? t1[j] * bb : 0.f; w0[j] = b0[j] * __expf(gc[ja]); w1[j] = b1[j] * __expf(gc[jb]); }
            *(LAS pg8::u32x4*)(L + L_TB + i * KT_LD + j8 * 2) = pg8::pack8(b0, b1); *(LAS pg8::u32x4*)(L + L_TW + i * KT_LD + j8 * 2) = pg8::pack8(w0, w1); }
        __syncthreads();
        {
            bf16_t *oU = UT + (size_t)cu * 8192, *oNW = NW + (size_t)cu * 8192;
            bf16x8_t vf[2], kf[2];
#pragma unroll
            for (int ks = 0; ks < 2; ++ks) { vf[ks] = *(const LAS bf16x8_t*)(L + L_VT + ktoff(16 * w + fr, 4 * ks + fq)); kf[ks] = *(const LAS bf16x8_t*)(L + L_KT + ktoff(16 * w + fr, 4 * ks + fq)); }
#pragma unroll
            for (int mi = 0; mi < 4; ++mi) {
                f32x4 au = (f32x4){0.f, 0.f, 0.f, 0.f}, aw = (f32x4){0.f, 0.f, 0.f, 0.f};
#pragma unroll
                for (int ks = 0; ks < 2; ++ks) {
                    au = __builtin_amdgcn_mfma_f32_16x16x32_bf16(*(const LAS bf16x8_t*)(L + L_TB + (16 * mi + fr) * KT_LD + (32 * ks + 8 * fq) * 2), vf[ks], au, 0, 0, 0);
                    aw = __builtin_amdgcn_mfma_f32_16x16x32_bf16(kf[ks], *(const LAS bf16x8_t*)(L + L_TW + (16 * mi + fr) * KT_LD + (32 * ks + 8 * fq) * 2), aw, 0, 0, 0);
                }
                *(u32x2_t*)(oU + (16 * w + fr) * 64 + 16 * mi + 4 * fq) = pack4bf(au);
                *(u32x2_t*)(oNW + (16 * mi + fr) * 128 + 16 * w + 4 * fq) = pack4bf(-aw);
            }
        }
        __syncthreads();
    }
#undef PREP_LOAD
}

__device__ __forceinline__ void p3_scan_simple(Frame& F, const Args& a) {
    const bf16_t *NW = (const bf16_t*)(a.ws + WS_CH_NW), *UU = (const bf16_t*)(a.ws + WS_CH_U), *QD = (const bf16_t*)(a.ws + WS_CH_QD), *KDT = (const bf16_t*)(a.ws + WS_CH_KDT), *QK = (const bf16_t*)(a.ws + WS_CH_QK);
    const float* GL = (const float*)(a.ws + WS_CH_GL); bf16_t* O = (bf16_t*)(a.ws + WS_O);
    LAS float* sm = (LAS float*)(F.lds + RING_OFF);
    LAS float *nw = sm, *qd = sm + 8192, *kd = sm + 16384, *vn = sm + 24576;
    const int tid = F.tid, e = (tid >> 6) * 32 + (tid & 31), half = (tid >> 5) & 1, db = 64 * half; const bool act = tid < 256;
    for (int bh = F.vcu; bh < NB * NH; bh += F.G) {
        const int h = bh % NH, b = bh / NH;
        float S[64];
#pragma unroll
        for (int d = 0; d < 64; ++d) S[d] = 0.f;
        for (int n = 0; n < NCH; ++n) {
            const int cu = bh * NCH + n;
            for (int idx = tid; idx < 8192; idx += 512) { nw[idx] = bf2f(NW[(size_t)cu * 8192 + idx]); qd[idx] = bf2f(QD[(size_t)cu * 8192 + idx]);
                const int d = idx >> 6, i = idx & 63; kd[i * 128 + d] = bf2f(KDT[(size_t)cu * 8192 + idx]); }
            __syncthreads();
            const float gl = GL[cu];
            if (act) for (int i = 0; i < 64; ++i) { float s = 0.f;
#pragma unroll
                for (int d = 0; d < 64; ++d) s += nw[i * 128 + db + d] * S[d];
                s += __shfl_xor(s, 32); s += bf2f(UU[(size_t)cu * 8192 + e * 64 + i]);
                if (half == 0) vn[i * 128 + e] = s; }
            __syncthreads();
            if (act) {
                if (n > 0) for (int i = 0; i < 64; ++i) { float s = 0.f;
#pragma unroll
                    for (int d = 0; d < 64; ++d) s += qd[i * 128 + db + d] * S[d];
                    s += __shfl_xor(s, 32);
                    for (int j = 0; j <= i; ++j) s += bf2f(QK[(size_t)cu * 4096 + i * 64 + j]) * vn[j * 128 + e];
                    if (half == 0) O[(size_t)(b * SEQ + 64 * (n - 1) + i) * DNW + h * HD + e] = f2bf(s); }
#pragma unroll
                for (int d = 0; d < 64; ++d) S[d] *= gl;
                for (int i = 0; i < 64; ++i) { const float vi = vn[i * 128 + e];
#pragma unroll
                    for (int d = 0; d < 64; ++d) S[d] += kd[i * 128 + db + d] * vi; }
            }
            __syncthreads();
        }
    }
}


struct ScanOps { bf16x8_t a[4], x[2], kd[2]; float gl; };
constexpr int ST_LD = 272, VT_LD = 144;
template <int PROBE>
__device__ __forceinline__ void p3_scan_fast(Frame& F, const Args& a) {
    const bf16_t *NW = (const bf16_t*)(a.ws + WS_CH_NW), *UT = (const bf16_t*)(a.ws + WS_CH_U), *QD = (const bf16_t*)(a.ws + WS_CH_QD), *KDT = (const bf16_t*)(a.ws + WS_CH_KDT), *QK = (const bf16_t*)(a.ws + WS_CH_QK);
    const float* GL = (const float*)(a.ws + WS_CH_GL); bf16_t* O = (bf16_t*)(a.ws + (PROBE ? WS_Y : WS_O));
    LAS unsigned char* ST = F.lds + RING_OFF; LAS unsigned char* VT = ST + 32 * ST_LD;
    const int w = F.wave, lane = F.lane, fr = lane & 15, fq = lane >> 4, mt = w & 3; const bool vw = w < 4;
    for (int unit = F.vcu; unit < NB * NH * 4; unit += F.G) {
        const int bh = unit >> 2, s = unit & 3, h = bh % NH, b = bh / NH;
        f32x4 accS[2] = {(f32x4){0.f, 0.f, 0.f, 0.f}, (f32x4){0.f, 0.f, 0.f, 0.f}};
        for (int i = F.tid; i < 32 * ST_LD / 4; i += 512) ((LAS unsigned*)ST)[i] = 0u;
        __syncthreads();
        const bf16_t* Asrc = (vw ? NW : QD) + (16 * mt + fr) * 128 + 8 * fq;
        const bf16_t* Ksrc = KDT + (16 * w + fr) * 64 + 8 * fq;
        const bf16_t* Xsrc = vw ? UT + (32 * s + fr) * 64 + 16 * mt + 8 * (fq >> 1) : QK + (16 * mt + fr) * 64 + 8 * fq;
        const size_t xstride = vw ? 8192 : 4096; const int xstep = vw ? 16 * 64 : 32; const bool hiq = (fq & 1) != 0;
#define SCAN_LOAD(ops, n_) do { const size_t cu_ = (size_t)(bh * NCH + (PROBE != 0 ? 0 : (n_))); \
        _Pragma("unroll") for (int ks = 0; ks < 4; ++ks) (ops).a[ks] = *(const bf16x8_t*)(Asrc + cu_ * 8192 + 32 * ks); \
        _Pragma("unroll") for (int ks = 0; ks < 2; ++ks) (ops).kd[ks] = *(const bf16x8_t*)(Ksrc + cu_ * 8192 + 32 * ks); \
        (ops).x[0] = *(const bf16x8_t*)(Xsrc + cu_ * xstride); (ops).x[1] = *(const bf16x8_t*)(Xsrc + cu_ * xstride + xstep); \
        (ops).gl = GL[cu_]; } while (0)
#define SCAN_STEP(ops, n_) do { \
        f32x4 acc[2]; \
        _Pragma("unroll") for (int n2 = 0; n2 < 2; ++n2) { const unsigned u0_ = hiq ? (unsigned)__builtin_bit_cast(u32x4_t, (ops).x[n2]).z : (unsigned)__builtin_bit_cast(u32x4_t, (ops).x[n2]).x, u1_ = hiq ? (unsigned)__builtin_bit_cast(u32x4_t, (ops).x[n2]).w : (unsigned)__builtin_bit_cast(u32x4_t, (ops).x[n2]).y; \
            acc[n2] = vw ? (f32x4){__uint_as_float(u0_ << 16), __uint_as_float(u0_ & 0xffff0000u), __uint_as_float(u1_ << 16), __uint_as_float(u1_ & 0xffff0000u)} : (f32x4){0.f, 0.f, 0.f, 0.f}; } \
        _Pragma("unroll") for (int ks = 0; ks < 4; ++ks) _Pragma("unroll") for (int n2 = 0; n2 < 2; ++n2) \
            acc[n2] = __builtin_amdgcn_mfma_f32_16x16x32_bf16((ops).a[ks], *(const LAS bf16x8_t*)(ST + (16 * n2 + fr) * ST_LD + (32 * ks + 8 * fq) * 2), acc[n2], 0, 0, 0); \
        if (vw) { _Pragma("unroll") for (int n2 = 0; n2 < 2; ++n2) *(LAS u32x2_t*)(VT + (16 * n2 + fr) * VT_LD + (16 * mt + 4 * fq) * 2) = pack4bf(acc[n2]); } \
        __syncthreads(); \
        bf16x8_t bV[2][2]; \
        _Pragma("unroll") for (int n2 = 0; n2 < 2; ++n2) _Pragma("unroll") for (int ks = 0; ks < 2; ++ks) bV[n2][ks] = *(const LAS bf16x8_t*)(VT + (16 * n2 + fr) * VT_LD + (32 * ks + 8 * fq) * 2); \
        if (!vw) { _Pragma("unroll") for (int n2 = 0; n2 < 2; ++n2) _Pragma("unroll") for (int ks = 0; ks < 2; ++ks) acc[n2] = __builtin_amdgcn_mfma_f32_16x16x32_bf16((ops).x[ks], bV[n2][ks], acc[n2], 0, 0, 0); \
            if ((n_) > 0 && PROBE != 2) { bf16_t* op = O + (size_t)(b * SEQ + 64 * ((n_) - 1) + 16 * mt + 4 * fq) * DNW + h * HD + 32 * s + fr; \
                _Pragma("unroll") for (int n2 = 0; n2 < 2; ++n2) _Pragma("unroll") for (int r = 0; r < 4; ++r) op[(size_t)r * DNW + 16 * n2] = f2bf(acc[n2][r]); } } \
        _Pragma("unroll") for (int n2 = 0; n2 < 2; ++n2) { accS[n2] = accS[n2] * (ops).gl; \
            _Pragma("unroll") for (int ks = 0; ks < 2; ++ks) accS[n2] = __builtin_amdgcn_mfma_f32_16x16x32_bf16((ops).kd[ks], bV[n2][ks], accS[n2], 0, 0, 0); \
            *(LAS u32x2_t*)(ST + (16 * n2 + fr) * ST_LD + (16 * w + 4 * fq) * 2) = pack4bf(accS[n2]); } \
        __syncthreads(); } while (0)
        ScanOps opA, opB, opC;
        SCAN_LOAD(opA, 0); SCAN_LOAD(opB, 1);
        for (int n = 0; n < NCH; n += 3) {
            SCAN_LOAD(opC, n + 2); SCAN_STEP(opA, n);
            SCAN_LOAD(opA, n + 3 < NCH ? n + 3 : NCH - 1); SCAN_STEP(opB, n + 1);
            SCAN_LOAD(opB, n + 4 < NCH ? n + 4 : NCH - 1); SCAN_STEP(opC, n + 2);
        }
#undef SCAN_LOAD
#undef SCAN_STEP
    }
}

__device__ __forceinline__ void p3b_gnorm(Frame& F, const Args& a) {
    const bf16_t *O = (const bf16_t*)(a.ws + WS_O), *SZD = (const bf16_t*)(a.ws + WS_SZD); bf16_t* Y = (bf16_t*)(a.ws + WS_Y); const float* w = a.in[9];
    const int gw = F.vcu * NWAVES + F.wave, NGW = F.G * NWAVES, lane = F.lane;
    const float w0 = w[2 * lane], w1 = w[2 * lane + 1];
    for (int it = gw; it < MTOK * NH; it += NGW) {
        const size_t base = (size_t)(it >> 4) * DNW + (it & 15) * HD + 2 * lane, yb = (size_t)(it >> 4) * YLD + 1024 + (it & 15) * HD + 2 * lane;
        const unsigned ov = *(const unsigned*)(O + base), zv = *(const unsigned*)(SZD + base);
        const float a0 = __uint_as_float(ov << 16), a1 = __uint_as_float(ov & 0xffff0000u);
        const float rs = rsqrtf(wave_sum(a0 * a0 + a1 * a1) * (1.f / HD) + EPS);
        *(unsigned*)(Y + yb) = pk2(a0 * rs * w0 * __uint_as_float(zv << 16), a1 * rs * w1 * __uint_as_float(zv & 0xffff0000u));
    }
}

__device__ __forceinline__ void p6_final(Frame& F, const Args& a) {
    const float* w = a.in[13]; float* out = a.out;
    const int gw = F.vcu * NWAVES + F.wave, NGW = F.G * NWAVES;
    for (int r = gw; r < MTOK; r += NGW) {
        float* row = out + (size_t)r * DM;
        f32x4 v[8]; float s = 0.f;
#pragma unroll
        for (int j = 0; j < 8; ++j) { v[j] = *(const f32x4*)(row + 4 * F.lane + 256 * j); s += (v[j].x * v[j].x + v[j].y * v[j].y) + (v[j].z * v[j].z + v[j].w * v[j].w); }
        const float rs = rsqrtf(wave_sum(s) * (1.f / DM) + EPS);
#pragma unroll
        for (int j = 0; j < 8; ++j) { const f32x4 ww = *(const f32x4*)(w + 4 * F.lane + 256 * j); *(f32x4*)(row + 4 * F.lane + 256 * j) = v[j] * rs * ww; }
    }
}

struct PoolMixOrder {
    int G, c;
    __device__ bool next(int i, pg8::Unit& u) const { const int L = i * G + c; if (L >= 128) return false; u.pm = L >> 2; u.pn = L & 3; u.aoff = (L & 3) * 256; u.boff = 0; u.nt = 4; u.mode = 0; return true; }
};
struct MergeOrder {
    pg8::StaticOrder so;
    __device__ bool next(int i, pg8::Unit& u) const { if (!so.next(i >> 1, u)) return false; if ((i & 1) == 0) { u.nt = 16; u.mode = 0; } else { u.aoff = 1024; u.boff = 1024; u.nt = 32; u.mode = 1; } return true; }
};

constexpr int NPHASE = 8;
__global__ void __launch_bounds__(NWAVES * 64, 2) mega_fwd(Args args) {
    extern __shared__ __attribute__((aligned(16))) unsigned char lds[];
    Frame F;
    F.lds = (LAS unsigned char*)lds;
    F.tid = threadIdx.x; F.lane = F.tid & 63; F.wave = __builtin_amdgcn_readfirstlane(F.tid >> 6);
    F.G = gridDim.x; { const int bx = blockIdx.x; F.vcu = (F.G % 8 == 0) ? (bx % 8) * (F.G / 8) + bx / 8 : bx; }
    unsigned char* ws = args.ws;
    for (int u = F.tid; u < (LDS_BYTES - LDSCTL_OFF) / 4; u += NWAVES * 64) ((LAS unsigned*)(F.lds + LDSCTL_OFF))[u] = 0u;
    __syncthreads();
    const int lo = args.ph_lo, hi = args.ph_hi;
    XcdBarrier bar; bar.bar = (unsigned*)(ws + WS_CTL) + CW_BAR; bar.x = 0; bar.st = nullptr;
    if (hi - lo > 1 || DUP_MASK) bar = xcd_barrier_post((unsigned*)(ws + WS_CTL) + CW_BAR, (volatile LAS unsigned*)(F.lds + MISC_OFF) + 8);
#define DUP(k) ((DUP_MASK >> (k)) & 1)
#define PHASE(k, ...) do { if (lo <= (k) && (k) < hi) { __VA_ARGS__ if (DUP(k)) { xcd_barrier(bar); __VA_ARGS__ } if ((k) + 1 < hi) xcd_barrier(bar); } } while (0)
    PHASE(0, p0_prologue(F, args););
    PHASE(1, {
        pg8::Gemm g{(const bf16_t*)(ws + WS_XN), (const bf16_t*)(ws + WS_WINT), DM, DM}; pg8::StaticOrder S; S.init(MPAD / 256, NPAD1 / 256, DM / 64, F.G, (int)blockIdx.x);
        pg8::EpiProj E{(bf16_t*)(ws + WS_U), (bf16_t*)(ws + WS_SZP), (bf16_t*)(ws + WS_QKV), (bf16_t*)(ws + WS_SZD), (bf16_t*)(ws + WS_GATES), (float*)(ws + WS_BA)};
        pg8::gemm_phase<pg8::EpiProj, pg8::StaticOrder, true>(F.lds + RING_OFF, g, S, E); });
    PHASE(2, p2_pool(F, args); if (SIMPLE_PREP) p2_chunk_prep_simple(F, args); else p2_chunk_prep_fast(F, args););
    #ifndef SCAN_PROBE
#define SCAN_PROBE 0
#endif
    PHASE(3, if (SIMPLE_SCAN) p3_scan_simple(F, args); else { if (SCAN_PROBE) p3_scan_fast<SCAN_PROBE>(F, args); p3_scan_fast<0>(F, args); });
    PHASE(4, {
        p3b_gnorm(F, args);
        pg8::Gemm g{(const bf16_t*)(ws + WS_POOLED), (const bf16_t*)(ws + WS_MIXT), PW, PGD}; PoolMixOrder S{F.G, F.vcu};
        pg8::EpiPoolMix E{(bf16_t*)(ws + WS_Y), (const bf16_t*)(ws + WS_SZP), args.in[8]};
        pg8::gemm_phase<pg8::EpiPoolMix, PoolMixOrder, false>(F.lds + RING_OFF, g, S, E); });
    PHASE(5, {
        pg8::Gemm g{(const bf16_t*)(ws + WS_Y), (const bf16_t*)(ws + WS_W2T), YLD, YLD}; MergeOrder S; S.so.init(MTOK / 256, DM / 256, 0, F.G, (int)blockIdx.x);
        pg8::EpiMerge E{(const bf16_t*)(ws + WS_GATES), (bf16_t*)(ws + WS_MERGED)};
        pg8::gemm_phase<pg8::EpiMerge, MergeOrder, false>(F.lds + RING_OFF, g, S, E); });
    PHASE(6, {
        pg8::Gemm g{(const bf16_t*)(ws + WS_MERGED), (const bf16_t*)(ws + WS_WOT), DM, DM}; pg8::StaticOrder S; S.init(MTOK / 256, DM / 256, DM / 64, F.G, (int)blockIdx.x);
        pg8::EpiResid E{args.in[0], args.out};
        pg8::gemm_phase<pg8::EpiResid, pg8::StaticOrder, false>(F.lds + RING_OFF, g, S, E); });
    PHASE(7, p6_final(F, args););
#undef PHASE
#undef DUP
}
#ifndef MIX
#define MIX 0
#endif
#ifndef NAIVE_MASK
#define NAIVE_MASK 0
#endif
#ifndef FUSE
#define FUSE 1
#endif
extern "C" void kernel_launch(void* const* d_in, const int* in_sizes, int n_in, void* d_out, int out_size, void* d_ws, size_t ws_size, hipStream_t stream) {
    static int grid = 0;
    if (grid == 0) {
        if (n_in != 14 || in_sizes[0] != MTOK * DM || out_size != MTOK * DM || ws_size < WS_END) { fprintf(stderr, "kernel_launch: unexpected shapes / workspace (%zu < %zu); nothing launched\n", ws_size, (size_t)WS_END); grid = -1; return; }
        int dev = 0, cus = 0;
        if (hipGetDevice(&dev) != hipSuccess || hipDeviceGetAttribute(&cus, hipDeviceAttributeMultiprocessorCount, dev) != hipSuccess) { grid = -1; return; }
        if (hipFuncSetAttribute((const void*)mega_fwd, hipFuncAttributeMaxDynamicSharedMemorySize, LDS_BYTES) != hipSuccess) { fprintf(stderr, "kernel_launch: hipFuncSetAttribute failed\n"); grid = -1; return; }
#if MIX
        if (hipFuncSetAttribute((const void*)nv_chunk_prep, hipFuncAttributeMaxDynamicSharedMemorySize, 140 * 1024) != hipSuccess) { grid = -1; return; }
#endif
        (void)hipGetLastError();
        grid = cus;
    }
    if (grid < 0) return;
    if (hipMemsetAsync((char*)d_ws + WS_CTL, 0, CTL_ZERO_BYTES, stream) != hipSuccess) return;
    Args a{};
    for (int i = 0; i < 14; ++i) a.in[i] = (const float*)d_in[i];
    a.out = (float*)d_out; a.ws = (unsigned char*)d_ws;
#if !MIX
    a.ph_lo = 0; a.ph_hi = NPHASE;
    hipLaunchKernelGGL(mega_fwd, dim3(grid), dim3(NWAVES * 64), LDS_BYTES, stream, a);
#else
    const float *x = a.in[0], *meta = a.in[1], *norm_w = a.in[2], *w_in = a.in[3], *conv_w = a.in[4], *A_log = a.in[5], *dt_bias = a.in[6], *pool_mix = a.in[7], *pool_scale = a.in[8],
                *dn_norm_w = a.in[9], *w_pool_out = a.in[10], *w_dn_out = a.in[11], *w_o = a.in[12], *final_norm_w = a.in[13];
    unsigned char* ws = (unsigned char*)d_ws; float* out = (float*)d_out;
    bf16_t *XN = (bf16_t*)(ws + WS_XN), *U = (bf16_t*)(ws + WS_U), *SZP = (bf16_t*)(ws + WS_SZP), *QKV = (bf16_t*)(ws + WS_QKV), *SZD = (bf16_t*)(ws + WS_SZD), *GATES = (bf16_t*)(ws + WS_GATES);
    float* BA = (float*)(ws + WS_BA);
    bf16_t *Y = (bf16_t*)(ws + WS_Y), *PO = (bf16_t*)(ws + WS_POOLED), *O = (bf16_t*)(ws + WS_O), *MG = (bf16_t*)(ws + WS_MERGED);
    bf16_t *cNW = (bf16_t*)(ws + WS_CH_NW), *cU = (bf16_t*)(ws + WS_CH_U), *cQD = (bf16_t*)(ws + WS_CH_QD), *cKDT = (bf16_t*)(ws + WS_CH_KDT), *cQK = (bf16_t*)(ws + WS_CH_QK);
    float* cGL = (float*)(ws + WS_CH_GL);
    int s = 0;
    while (s < NPHASE) {
        if (!((NAIVE_MASK >> s) & 1)) {
            int e = s + 1;
            if (FUSE) while (e < NPHASE && !((NAIVE_MASK >> e) & 1)) ++e;
            a.ph_lo = s; a.ph_hi = e;
            hipLaunchKernelGGL(mega_fwd, dim3(grid), dim3(NWAVES * 64), LDS_BYTES, stream, a);
            s = e; continue;
        }
        switch (s) {
        case 0: nv_prep<<<1024, 256, 0, stream>>>(x, meta, norm_w, XN); break;
        case 1: nv_gemm<EpiProj><<<dim3((INC + 127) / 128, (MROWS + 127) / 128), 256, 0, stream>>>(XN, DM, w_in, INC, MROWS, INC, DM, EpiProj{U, SZP, QKV, SZD, GATES, BA}); break;
        case 2: nv_pool<<<MTOK * PW / 256, 256, 0, stream>>>(U, PO);
                nv_chunk_prep<<<NUNITS, 256, 140 * 1024, stream>>>(QKV, BA, conv_w, A_log, dt_bias, cNW, cU, cQD, cKDT, cQK, cGL); break;
        case 3: nv_chunk_scan<<<NB * NH, 128, 0, stream>>>(cNW, cU, cQD, cKDT, cQK, cGL, O); break;
        case 4: nv_gnorm<<<MTOK * NH / 4, 256, 0, stream>>>(O, SZD, dn_norm_w, Y);
                for (int g = 0; g < 4; ++g)
                    nv_gemm<EpiPool><<<dim3(2, MTOK / 128), 256, 0, stream>>>(PO + g * PGD, PW, pool_mix + (size_t)g * PGD * PGD, PGD, MTOK, PGD, PGD, EpiPool{Y, SZP, pool_scale, g, 0});
                break;
        case 5: nv_gemm<EpiG2a><<<dim3(DM / 128, MTOK / 128), 256, 0, stream>>>(Y, YLD, w_pool_out, DM, MTOK, DM, PW, EpiG2a{out, GATES});
                nv_gemm<EpiG2b><<<dim3(DM / 128, MTOK / 128), 256, 0, stream>>>(Y + 1024, YLD, w_dn_out, DM, MTOK, DM, DNW, EpiG2b{out, GATES, MG}); break;
        case 6: nv_gemm<EpiG3><<<dim3(DM / 128, MTOK / 128), 256, 0, stream>>>(MG, DM, w_o, DM, MTOK, DM, DM, EpiG3{x, out}); break;
        case 7: nv_final<<<MTOK, 256, 0, stream>>>(out, final_norm_w); break;
        }
        ++s;
    }
#endif
}
```

```cpp
#define MIX 0
#include <hip/hip_runtime.h>
#include <cstdint>
#include <cstdio>

typedef unsigned short bf16_t;
__device__ __forceinline__ float bf2f(bf16_t v) { return __uint_as_float(((unsigned)v) << 16); }
__device__ __forceinline__ bf16_t f2bf(float f) { unsigned u = __float_as_uint(f); return (bf16_t)((u + 0x7fffu + ((u >> 16) & 1u)) >> 16); }
__device__ __forceinline__ float sigmoidf_(float x) { return 1.f / (1.f + __expf(-x)); }
__device__ __forceinline__ float siluf_(float x) { return x / (1.f + __expf(-x)); }
__device__ __forceinline__ float softplusf_(float x) { return x > 20.f ? x : log1pf(__expf(x)); }

constexpr int DM = 2048, NB = 4, SEQ = 2048, NMETA = 16, LEXT = SEQ + NMETA;
constexpr int PW = 1024, PGD = 256, NH = 16, HD = 128, DNW = 2048, CHUNK = 64, NCH = 33, PADF = 48;
constexpr int INC = 14368;
constexpr int C_U = 0, C_ZP = 1024, C_Q = 2048, C_ZD = 8192, C_B = 10240, C_GP = 10272;
constexpr int MTOK = NB * SEQ;
constexpr int MROWS = MTOK + NMETA;
constexpr int MPAD = 8448;
constexpr int NPAD1 = 14592;
constexpr int YLD = 3072;
constexpr float EPS = 1e-6f;
constexpr int NUNITS = NB * NH * NCH;

constexpr size_t MiB = 1u << 20;
constexpr size_t WS_CTL = 0, CTL_ZERO_BYTES = 1 * MiB;
constexpr size_t WS_CH = 1 * MiB;
constexpr size_t CH_ARR = (size_t)NUNITS * 8192 * 2;
constexpr size_t WS_CH_NW = WS_CH, WS_CH_U = WS_CH + CH_ARR, WS_CH_QD = WS_CH + 2 * CH_ARR, WS_CH_KDT = WS_CH + 3 * CH_ARR, WS_CH_QK = WS_CH + 4 * CH_ARR;
constexpr size_t WS_CH_GL = WS_CH_QK + (size_t)NUNITS * 4096 * 2;
constexpr size_t WS_WINT = WS_CH;
constexpr size_t WS_XN = WS_CH + 57 * MiB;
constexpr size_t WS_W2T = 150 * MiB;
constexpr size_t WS_WOT = 162 * MiB;
constexpr size_t WS_MIXT = 170 * MiB;
constexpr size_t WS_U = 171 * MiB;
constexpr size_t WS_SZP = WS_U + (size_t)MPAD * 1024 * 2;
constexpr size_t WS_QKV = WS_SZP + (size_t)MPAD * 1024 * 2;
constexpr size_t WS_BA = 303 * MiB;
constexpr size_t WS_O = 204 * MiB, WS_Y = 236 * MiB, WS_MERGED = 204 * MiB;
constexpr size_t WS_SZD = 304 * MiB + 512 * 1024;
constexpr size_t WS_GATES = WS_SZD + (size_t)MPAD * 2048 * 2;
constexpr size_t WS_POOLED = WS_GATES + (size_t)MPAD * 4096 * 2;
constexpr size_t WS_END = WS_POOLED + (size_t)MTOK * 1024 * 2;
static_assert(WS_CH_GL + NUNITS * 4 <= WS_W2T, "chunk arrays");
static_assert(WS_XN + (size_t)MPAD * 2048 * 2 <= WS_W2T, "xn");
static_assert(WS_QKV == 204 * MiB && WS_QKV + (size_t)MPAD * 6144 * 2 <= WS_BA, "qkv");
static_assert(WS_Y + (size_t)MTOK * YLD * 2 <= WS_BA, "y");
static_assert(WS_BA + (size_t)MPAD * 32 * 4 <= WS_SZD, "ba");
static_assert(WS_END <= 449 * MiB, "ws");

__device__ __forceinline__ int ext_row(int b, int p) { return p < NMETA ? MTOK + p : b * SEQ + (p - NMETA); }

__device__ __forceinline__ float wave_sum(float v) {
#pragma unroll
    for (int o = 1; o < 64; o <<= 1) v += __shfl_xor(v, o);
    return v;
}
#if MIX
__global__ void __launch_bounds__(256) nv_prep(const float* __restrict__ x, const float* __restrict__ meta, const float* __restrict__ nw, bf16_t* __restrict__ XN) {
    const int lane = threadIdx.x & 63, gw = (blockIdx.x * 256 + threadIdx.x) >> 6, ngw = gridDim.x * 4;
    for (int r = gw; r < MPAD; r += ngw) {
        bf16_t* o = XN + (size_t)r * DM;
        if (r >= MROWS) { for (int j = lane; j < DM; j += 64) o[j] = 0; continue; }
        const float* src = r < MTOK ? x + (size_t)r * DM : meta + (size_t)(r - MTOK) * DM;
        float v[32]; float s = 0.f;
#pragma unroll
        for (int j = 0; j < 32; ++j) { v[j] = src[lane + 64 * j]; s += v[j] * v[j]; }
        const float rs = rsqrtf(wave_sum(s) * (1.f / DM) + EPS);
#pragma unroll
        for (int j = 0; j < 32; ++j) o[lane + 64 * j] = f2bf(v[j] * rs * nw[lane + 64 * j]);
    }
}

template <class Epi>
__global__ void __launch_bounds__(256) nv_gemm(const bf16_t* __restrict__ A, int lda, const float* __restrict__ W, int ldw, int M, int N, int K, Epi epi) {
    __shared__ __attribute__((aligned(16))) float As[16][132];
    __shared__ __attribute__((aligned(16))) float Bs[16][132];
    const int tid = threadIdx.x, tx = tid & 15, ty = tid >> 4;
    const int m0 = blockIdx.y * 128, n0 = blockIdx.x * 128;
    float acc[8][8];
#pragma unroll
    for (int i = 0; i < 8; ++i)
#pragma unroll
        for (int j = 0; j < 8; ++j) acc[i][j] = 0.f;
    for (int k0 = 0; k0 < K; k0 += 16) {
        {
            const int r = tid >> 1, kc = (tid & 1) * 8, gm = m0 + r;
            uint4 v = make_uint4(0, 0, 0, 0);
            if (gm < M) v = *(const uint4*)(A + (size_t)gm * lda + k0 + kc);
            const unsigned w[4] = {v.x, v.y, v.z, v.w};
#pragma unroll
            for (int j = 0; j < 4; ++j) { As[kc + 2 * j][r] = __uint_as_float(w[j] << 16); As[kc + 2 * j + 1][r] = __uint_as_float(w[j] & 0xffff0000u); }
        }
        {
            const int kk = tid >> 4, nc = (tid & 15) * 8, gn = n0 + nc;
            float4 v0 = make_float4(0, 0, 0, 0), v1 = v0;
            if (gn < N) { const float* p = W + (size_t)(k0 + kk) * ldw + gn; v0 = *(const float4*)p; v1 = *(const float4*)(p + 4); }
            *(float4*)&Bs[kk][nc] = v0; *(float4*)&Bs[kk][nc + 4] = v1;
        }
        __syncthreads();
#pragma unroll
        for (int kk = 0; kk < 16; ++kk) {
            float a[8], b[8];
            *(float4*)&a[0] = *(const float4*)&As[kk][ty * 8]; *(float4*)&a[4] = *(const float4*)&As[kk][ty * 8 + 4];
            *(float4*)&b[0] = *(const float4*)&Bs[kk][tx * 8]; *(float4*)&b[4] = *(const float4*)&Bs[kk][tx * 8 + 4];
#pragma unroll
            for (int i = 0; i < 8; ++i)
#pragma unroll
                for (int j = 0; j < 8; ++j) acc[i][j] += a[i] * b[j];
        }
        __syncthreads();
    }
#pragma unroll
    for (int i = 0; i < 8; ++i)
#pragma unroll
        for (int j = 0; j < 8; ++j) { const int gm = m0 + ty * 8 + i, gn = n0 + tx * 8 + j; if (gm < M && gn < N) epi(gm, gn, acc[i][j]); }
}

struct EpiProj {
    bf16_t *U, *SZP, *QKV, *SZD, *GATES; float* BA;
    __device__ __forceinline__ void operator()(int m, int n, float v) const {
        if (n < C_ZP) U[(size_t)m * 1024 + n] = f2bf(v);
        else if (n < C_Q) SZP[(size_t)m * 1024 + (n - C_ZP)] = f2bf(siluf_(v));
        else if (n < C_ZD) QKV[(size_t)m * 6144 + (n - C_Q)] = f2bf(v);
        else if (n < C_B) SZD[(size_t)m * 2048 + (n - C_ZD)] = f2bf(siluf_(v));
        else if (n < C_GP) BA[(size_t)m * 32 + (n - C_B)] = v;
        else GATES[(size_t)m * 4096 + (n - C_GP)] = f2bf(sigmoidf_(v));
    }
};
struct EpiPool {
    bf16_t* Y; const bf16_t* SZP; const float* scale; int g, pad;
    __device__ __forceinline__ void operator()(int m, int n, float v) const {
        const int c = g * PGD + n; Y[(size_t)m * YLD + c] = f2bf(v * scale[c] * bf2f(SZP[(size_t)m * 1024 + c]));
    }
};
struct EpiG2a { float* T; const bf16_t* GATES; __device__ __forceinline__ void operator()(int m, int n, float v) const { T[(size_t)m * DM + n] = v * bf2f(GATES[(size_t)m * 4096 + n]); } };
struct EpiG2b { const float* T; const bf16_t* GATES; bf16_t* MG; __device__ __forceinline__ void operator()(int m, int n, float v) const { MG[(size_t)m * DM + n] = f2bf(T[(size_t)m * DM + n] + v * bf2f(GATES[(size_t)m * 4096 + 2048 + n])); } };
struct EpiG3 { const float* x; float* out; __device__ __forceinline__ void operator()(int m, int n, float v) const { out[(size_t)m * DM + n] = x[(size_t)m * DM + n] + v; } };

__global__ void __launch_bounds__(256) nv_pool(const bf16_t* __restrict__ U, bf16_t* __restrict__ PO) {
    const int idx = blockIdx.x * 256 + threadIdx.x; if (idx >= MTOK * PW) return;
    const int m = idx >> 10, c = idx & 1023, b = m >> 11, t = m & 2047, p = t + NMETA, win = 2 << (c >> 8);
    float s = 0.f;
    for (int j = 0; j < win; ++j) { const int pp = p - j; if (pp >= 0) s += bf2f(U[(size_t)ext_row(b, pp) * 1024 + c]); }
    const int cnt = (p + 1) < win ? (p + 1) : win;
    PO[idx] = f2bf(s / (float)cnt - bf2f(U[(size_t)m * 1024 + c]));
}

__global__ void __launch_bounds__(256) nv_chunk_prep(const bf16_t* __restrict__ QKV, const float* __restrict__ BA, const float* __restrict__ conv_w, const float* __restrict__ A_log,
                                                     const float* __restrict__ dt_bias, bf16_t* __restrict__ NW, bf16_t* __restrict__ UU, bf16_t* __restrict__ QD, bf16_t* __restrict__ KDT,
                                                     bf16_t* __restrict__ QK, float* __restrict__ GL) {
    extern __shared__ __attribute__((aligned(16))) float sm[];
    float *q = sm, *k = q + 8192, *v = k + 8192, *Am = v + 8192, *Tm = Am + 4096, *beta = Tm + 4096, *gc = beta + 64;
    const int cu = blockIdx.x, n = cu % NCH, bh = cu / NCH, h = bh % NH, b = bh / NH, tid = threadIdx.x, lane = tid & 63, wv = tid >> 6;
    const int p0 = CHUNK * n - PADF;
    for (int idx = tid; idx < 64 * 384; idx += 256) {
        const int i = idx / 384, c3 = idx % 384, which = c3 >> 7, d = c3 & 127, col = which * 2048 + h * HD + d, p = p0 + i;
        float val = 0.f;
        if (p >= 0) { float a = 0.f;
            for (int kk = 0; kk < 4; ++kk) { const int pp = p - 3 + kk; if (pp >= 0) a += conv_w[kk * 6144 + col] * bf2f(QKV[(size_t)ext_row(b, pp) * 6144 + col]); }
            val = siluf_(a); }
        (which == 0 ? q : which == 1 ? k : v)[i * 128 + d] = val;
    }
    if (tid < 64) { const int p = p0 + tid; float be = 0.f, g = 0.f;
        if (p >= 0) { const int r = ext_row(b, p); be = sigmoidf_(BA[(size_t)r * 32 + h]); g = -__expf(A_log[h]) * softplusf_(BA[(size_t)r * 32 + 16 + h] + dt_bias[h]); }
        beta[tid] = be; gc[tid] = g; }
    __syncthreads();
    if (tid == 0) { float s = 0.f; for (int i = 0; i < 64; ++i) { s += gc[i]; gc[i] = s; } }
    for (int r = wv; r < 128; r += 4) {
        float* row = (r < 64 ? q + r * 128 : k + (r - 64) * 128);
        const float a0 = row[lane], a1 = row[lane + 64];
        const float rs = rsqrtf(wave_sum(a0 * a0 + a1 * a1) + EPS) * (r < 64 ? 0.08838834764831845f : 1.f);
        row[lane] = a0 * rs; row[lane + 64] = a1 * rs;
    }
    __syncthreads();
    bf16_t* oQK = QK + (size_t)cu * 4096;
    for (int idx = tid; idx < 4096; idx += 256) {
        const int i = idx >> 6, j = idx & 63; float akk = 0.f, aqk = 0.f;
        if (j <= i) { for (int d = 0; d < 128; ++d) { const float kj = k[j * 128 + d]; akk += k[i * 128 + d] * kj; aqk += q[i * 128 + d] * kj; }
            const float dec = __expf(gc[i] - gc[j]); akk *= beta[i] * dec; aqk *= dec; }
        Am[idx] = j < i ? akk : 0.f; oQK[idx] = f2bf(j <= i ? aqk : 0.f);
    }
    __syncthreads();
    if (tid < 64) { const int c = tid;
        for (int i = 0; i < 64; ++i) { float s = (i == c) ? 1.f : 0.f; for (int j = c; j < i; ++j) s -= Am[i * 64 + j] * Tm[j * 64 + c]; Tm[i * 64 + c] = (i >= c) ? s : 0.f; } }
    __syncthreads();
    bf16_t *oNW = NW + (size_t)cu * 8192, *oU = UU + (size_t)cu * 8192, *oQD = QD + (size_t)cu * 8192, *oKDT = KDT + (size_t)cu * 8192;
    const float gl = gc[63];
    for (int idx = tid; idx < 8192; idx += 256) {
        const int i = idx >> 7, d = idx & 127; float su = 0.f, sw = 0.f;
        for (int j = 0; j <= i; ++j) { const float t = Tm[i * 64 + j] * beta[j]; su += t * v[j * 128 + d]; sw += t * __expf(gc[j]) * k[j * 128 + d]; }
        oU[idx] = f2bf(su); oNW[idx] = f2bf(-sw);
        oQD[idx] = f2bf(q[idx] * __expf(gc[i]));
        oKDT[d * 64 + i] = f2bf(k[idx] * __expf(gl - gc[i]));
    }
    if (tid == 0) GL[cu] = __expf(gl);
}

__global__ void __launch_bounds__(128) nv_chunk_scan(const bf16_t* __restrict__ NW, const bf16_t* __restrict__ UU, const bf16_t* __restrict__ QD, const bf16_t* __restrict__ KDT,
                                                     const bf16_t* __restrict__ QK, const float* __restrict__ GL, bf16_t* __restrict__ O) {
    __shared__ float vn[64][128];
    const int bh = blockIdx.x, h = bh % NH, b = bh / NH, e = threadIdx.x;
    float S[128];
#pragma unroll
    for (int d = 0; d < 128; ++d) S[d] = 0.f;
    for (int n = 0; n < NCH; ++n) {
        const int cu = bh * NCH + n;
        const bf16_t *nw = NW + (size_t)cu * 8192, *uu = UU + (size_t)cu * 8192, *qd = QD + (size_t)cu * 8192, *kdt = KDT + (size_t)cu * 8192, *qk = QK + (size_t)cu * 4096;
        const float gl = GL[cu];
        for (int i = 0; i < 64; ++i) { float a = bf2f(uu[i * 128 + e]);
#pragma unroll
            for (int d = 0; d < 128; ++d) a += bf2f(nw[i * 128 + d]) * S[d];
            vn[i][e] = a; }
        __syncthreads();
        if (n > 0) for (int i = 0; i < 64; ++i) { float a = 0.f;
#pragma unroll
            for (int d = 0; d < 128; ++d) a += bf2f(qd[i * 128 + d]) * S[d];
            for (int j = 0; j <= i; ++j) a += bf2f(qk[i * 64 + j]) * vn[j][e];
            O[(size_t)(b * SEQ + 64 * (n - 1) + i) * DNW + h * HD + e] = f2bf(a); }
#pragma unroll
        for (int d = 0; d < 128; ++d) { float s = S[d] * gl; for (int i = 0; i < 64; ++i) s += bf2f(kdt[d * 64 + i]) * vn[i][e]; S[d] = s; }
        __syncthreads();
    }
}

__global__ void __launch_bounds__(256) nv_gnorm(const bf16_t* __restrict__ O, const bf16_t* __restrict__ SZD, const float* __restrict__ w, bf16_t* __restrict__ Y) {
    const int lane = threadIdx.x & 63, gw = (blockIdx.x * 256 + threadIdx.x) >> 6; if (gw >= MTOK * NH) return;
    const size_t base = (size_t)(gw >> 4) * DNW + (gw & 15) * HD, yb = (size_t)(gw >> 4) * YLD + 1024 + (gw & 15) * HD;
    const float a0 = bf2f(O[base + lane]), a1 = bf2f(O[base + lane + 64]);
    const float rs = rsqrtf(wave_sum(a0 * a0 + a1 * a1) * (1.f / HD) + EPS);
    Y[yb + lane] = f2bf(a0 * rs * w[lane] * bf2f(SZD[base + lane]));
    Y[yb + lane + 64] = f2bf(a1 * rs * w[lane + 64] * bf2f(SZD[base + lane + 64]));
}

__global__ void __launch_bounds__(256) nv_final(float* __restrict__ out, const float* __restrict__ w) {
    __shared__ float red[4];
    float* row = out + (size_t)blockIdx.x * DM; const int tid = threadIdx.x;
    float v[8]; float s = 0.f;
#pragma unroll
    for (int j = 0; j < 8; ++j) { v[j] = row[tid + 256 * j]; s += v[j] * v[j]; }
    s = wave_sum(s); if ((tid & 63) == 0) red[tid >> 6] = s; __syncthreads();
    const float rs = rsqrtf((red[0] + red[1] + red[2] + red[3]) * (1.f / DM) + EPS);
#pragma unroll
    for (int j = 0; j < 8; ++j) row[tid + 256 * j] = v[j] * rs * w[tid + 256 * j];
}

#endif
namespace pg8 {
#define PG8_LAS __attribute__((address_space(3)))
typedef short bf16x8 __attribute__((ext_vector_type(8)));
typedef float f32x4 __attribute__((ext_vector_type(4)));
typedef unsigned u32x4 __attribute__((ext_vector_type(4)));
constexpr int BM = 256, BK = 64, HALF = 128, HTB = HALF * BK * 2  , STAGE_BYTES = 8 * HTB, NXCD = 8, WGM = 8;

__host__ __device__ __forceinline__ int lds_byte(int r, int c) { const int st = (r >> 4) * 2 + (c >> 5), rr = r & 15, cc = c & 31, ob = rr * 64 + cc * 2; return st * 1024 + (ob ^ (((ob >> 9) & 1) << 5)); }
__host__ __device__ __forceinline__ void stage_rc(int b, int& R, int& C) { const int st = b / 1024, sb = b % 1024, swz = sb ^ (((sb >> 9) & 1) << 5); R = (st >> 1) * 16 + swz / 64; C = (st & 1) * 32 + (swz % 64) / 2; }
__host__ __device__ __forceinline__ int perm32(int rho) { const int n = rho >> 4, i = rho & 15; return 8 * (i >> 2) + 4 * n + (i & 3); }

struct Unit { int pm, pn, aoff, boff, nt, mode; };
struct Gemm { const bf16_t* A; const bf16_t* Bt; int lda, ldb; };

struct StaticOrder {
    int nM, nN, nwg, G, c, nt;
    __device__ void init(int nM_, int nN_, int nt_, int G_, int c_) { nM = nM_; nN = nN_; nwg = nM * nN; G = G_; c = c_; nt = nt_; }
    __device__ bool next(int i, Unit& u) const {
        const long L = (long)i * G + c; if (L >= nwg) return false;
        int wgid = (int)L; { const int q = nwg / NXCD, r = nwg % NXCD, xcd = wgid % NXCD, off = wgid / NXCD; wgid = (xcd < r ? xcd * (q + 1) : r * (q + 1) + (xcd - r) * q) + off; }
        const int nig = WGM * nN, gid = wgid / nig, fm = gid * WGM, gsz = (nM - fm) < WGM ? (nM - fm) : WGM;
        u.pm = fm + ((wgid % nig) % gsz); u.pn = (wgid % nig) / gsz; u.aoff = 0; u.boff = 0; u.nt = nt; u.mode = 0; return true;
    }
};

typedef float f32x2_t __attribute__((ext_vector_type(2))); typedef __bf16 bf16x2_t __attribute__((ext_vector_type(2)));
__device__ __forceinline__ unsigned cvt_pk_bf16(float lo, float hi) { f32x2_t v = {lo, hi}; bf16x2_t b = __builtin_convertvector(v, bf16x2_t); return __builtin_bit_cast(unsigned, b); }
__device__ __forceinline__ u32x4 pack8(f32x4 v0, f32x4 v1) { u32x4 w; w.x = cvt_pk_bf16(v0[0], v0[1]); w.y = cvt_pk_bf16(v0[2], v0[3]); w.z = cvt_pk_bf16(v1[0], v1[1]); w.w = cvt_pk_bf16(v1[2], v1[3]); return w; }
__device__ __forceinline__ void unpack8(u32x4 w, f32x4& v0, f32x4& v1) {
    v0 = (f32x4){__uint_as_float(w.x << 16), __uint_as_float(w.x & 0xffff0000u), __uint_as_float(w.y << 16), __uint_as_float(w.y & 0xffff0000u)};
    v1 = (f32x4){__uint_as_float(w.z << 16), __uint_as_float(w.z & 0xffff0000u), __uint_as_float(w.w << 16), __uint_as_float(w.w & 0xffff0000u)};
}
__device__ __forceinline__ float fast_sigmoid(float x) { return __builtin_amdgcn_rcpf(1.f + __builtin_amdgcn_exp2f(-1.4426950408889634f * x)); }

struct EpiProj {
    static constexpr bool PERM = true;
    bf16_t *U, *SZP, *QKV, *SZD, *GATES; float* BA;
    __device__ __forceinline__ bool reset_after(const Unit&) const { return true; }
    __device__ __forceinline__ void operator()(f32x4 (&acc)[2][2][4][2], const Unit& u, int wr, int wc, int fr, int fq) const {
        const int row0 = u.pm * BM + wr * 64 + fr, pn = u.pn;
        if (pn == 56) {
            if (wc == 0) {
#pragma unroll
                for (int ai = 0; ai < 2; ++ai)
#pragma unroll
                    for (int m = 0; m < 4; ++m) { float* rowp = BA + (size_t)(row0 + ai * HALF + m * 16) * 32 + 8 * fq;
                        *(f32x4*)rowp = acc[ai][0][m][0]; *(f32x4*)(rowp + 4) = acc[ai][0][m][1]; }
            }
            return;
        }
        bf16_t* base; int ld, colt, act;
        if (pn < 4) { base = U; ld = 1024; colt = pn * 256; act = 0; }
        else if (pn < 8) { base = SZP; ld = 1024; colt = (pn - 4) * 256; act = 1; }
        else if (pn < 32) { base = QKV; ld = 6144; colt = (pn - 8) * 256; act = 0; }
        else if (pn < 40) { base = SZD; ld = 2048; colt = (pn - 32) * 256; act = 1; }
        else { base = GATES; ld = 4096; colt = (pn - 40) * 256; act = 2; }
        const int col0 = colt + wc * 32 + 8 * fq;
#pragma unroll
        for (int ai = 0; ai < 2; ++ai)
#pragma unroll
            for (int m = 0; m < 4; ++m) { bf16_t* rowp = base + (size_t)(row0 + ai * HALF + m * 16) * ld + col0;
#pragma unroll
                for (int bj = 0; bj < 2; ++bj) { f32x4 v0 = acc[ai][bj][m][0], v1 = acc[ai][bj][m][1];
                    if (act != 0) {
#pragma unroll
                        for (int j = 0; j < 4; ++j) { const float s0 = fast_sigmoid(v0[j]), s1 = fast_sigmoid(v1[j]); v0[j] = act == 1 ? v0[j] * s0 : s0; v1[j] = act == 1 ? v1[j] * s1 : s1; }
                    }
                    *(u32x4*)(rowp + bj * HALF) = pack8(v0, v1); } }
    }
};
struct EpiPoolMix {
    static constexpr bool PERM = true;
    bf16_t* Y; const bf16_t* SZP; const float* scale;
    __device__ __forceinline__ bool reset_after(const Unit&) const { return true; }
    __device__ __forceinline__ void operator()(f32x4 (&acc)[2][2][4][2], const Unit& u, int wr, int wc, int fr, int fq) const {
        const int row0 = u.pm * BM + wr * 64 + fr, col0 = u.pn * BM + wc * 32 + 8 * fq;
#pragma unroll
        for (int bj = 0; bj < 2; ++bj) { const f32x4 s0 = *(const f32x4*)(scale + col0 + bj * HALF), s1 = *(const f32x4*)(scale + col0 + bj * HALF + 4);
#pragma unroll
            for (int ai = 0; ai < 2; ++ai)
#pragma unroll
                for (int m = 0; m < 4; ++m) { const size_t r = (size_t)(row0 + ai * HALF + m * 16);
                    f32x4 z0, z1; unpack8(*(const u32x4*)(SZP + r * 1024 + col0 + bj * HALF), z0, z1);
                    *(u32x4*)(Y + r * YLD + col0 + bj * HALF) = pack8(acc[ai][bj][m][0] * s0 * z0, acc[ai][bj][m][1] * s1 * z1); } }
    }
};
struct EpiMerge {
    static constexpr bool PERM = true;
    const bf16_t* GATES; bf16_t* MG;
    __device__ __forceinline__ bool reset_after(const Unit& u) const { return u.mode != 0; }
    __device__ __forceinline__ void operator()(f32x4 (&acc)[2][2][4][2], const Unit& u, int wr, int wc, int fr, int fq) const {
        const int row0 = u.pm * BM + wr * 64 + fr, col0 = u.pn * BM + wc * 32 + 8 * fq;
#pragma unroll
        for (int ai = 0; ai < 2; ++ai)
#pragma unroll
            for (int m = 0; m < 4; ++m) { const size_t r = (size_t)(row0 + ai * HALF + m * 16);
#pragma unroll
                for (int bj = 0; bj < 2; ++bj) {
                    f32x4 d0, d1; unpack8(*(const u32x4*)(GATES + r * 4096 + 2048 + col0 + bj * HALF), d0, d1);
                    if (u.mode == 0) {
                        f32x4 p0, p1; unpack8(*(const u32x4*)(GATES + r * 4096 + col0 + bj * HALF), p0, p1);
#pragma unroll
                        for (int j = 0; j < 4; ++j) { acc[ai][bj][m][0][j] *= p0[j] / fmaxf(d0[j], 1e-30f); acc[ai][bj][m][1][j] *= p1[j] / fmaxf(d1[j], 1e-30f); }
                    } else {
                        *(u32x4*)(MG + r * DM + col0 + bj * HALF) = pack8(acc[ai][bj][m][0] * d0, acc[ai][bj][m][1] * d1);
                    } } }
    }
};
struct EpiResid {
    static constexpr bool PERM = false;
    const float* x; float* out;
    __device__ __forceinline__ bool reset_after(const Unit&) const { return true; }
    __device__ __forceinline__ void operator()(f32x4 (&acc)[2][2][4][2], const Unit& u, int wr, int wc, int fr, int fq) const {
        const int row0 = u.pm * BM + wr * 64 + fr, col0 = u.pn * BM + wc * 32 + 4 * fq;
#pragma unroll
        for (int ai = 0; ai < 2; ++ai)
#pragma unroll
            for (int m = 0; m < 4; ++m) { const size_t off = (size_t)(row0 + ai * HALF + m * 16) * DM + col0;
#pragma unroll
                for (int bj = 0; bj < 2; ++bj)
#pragma unroll
                    for (int n = 0; n < 2; ++n) *(f32x4*)(out + off + bj * HALF + n * 16) = *(const f32x4*)(x + off + bj * HALF + n * 16) + acc[ai][bj][m][n]; }
    }
};

template <class Epi, class Sched, bool ALIGN_EPI>
__device__ __forceinline__ void gemm_phase(PG8_LAS unsigned char* lds, const Gemm g, const Sched& S, const Epi& E) {
    const int tid = threadIdx.x, wid = __builtin_amdgcn_readfirstlane(tid >> 6), lane = tid & 63, wr = wid >> 2, wc = wid & 3, fr = lane & 15, fq = lane >> 4;
    const int lda = g.lda, ldb = g.ldb;
    unsigned voffA[2], voffB[2];
#pragma unroll
    for (int i = 0; i < 2; ++i) { int R, C; stage_rc(tid * 16 + i * 8192, R, C); const int Rb = Epi::PERM ? ((R & ~31) + perm32(R & 31)) : R;
        voffA[i] = (unsigned)(R * lda + C) * 2u; voffB[i] = (unsigned)(Rb * ldb + C) * 2u; }
    const size_t kstep = (size_t)(BK * 2);
    const size_t hstepA = (size_t)HALF * lda * 2, hstepB = (size_t)HALF * ldb * 2;
    const unsigned ldsw = (unsigned)wid * 1024u;
    const int aoff = lds_byte(wr * 64 + fr, fq * 8), boff = lds_byte(wc * 32 + fr, fq * 8);
#define PG8_SA(b, h) (((b) * 2 + (h)) * HTB)
#define PG8_SB(b, h) ((4 + (b) * 2 + (h)) * HTB)
#define PG8_STAGE(bufoff, gbase, voff) do { _Pragma("unroll") for (int _i = 0; _i < 2; ++_i) \
        __builtin_amdgcn_global_load_lds((const unsigned*)((const char*)(gbase) + (voff)[_i]), (PG8_LAS unsigned*)(lds + (bufoff) + ldsw + _i * 8192), 16, 0, 0); } while (0)
#define PG8_LDA(dst, b, h) do { _Pragma("unroll") for (int m = 0; m < 4; ++m) _Pragma("unroll") for (int k = 0; k < 2; ++k) dst[m][k] = *(const PG8_LAS bf16x8*)(lds + PG8_SA(b, h) + aoff + m * 2048 + k * 1024); } while (0)
#define PG8_LDB(dst, b, h) do { _Pragma("unroll") for (int n = 0; n < 2; ++n) _Pragma("unroll") for (int k = 0; k < 2; ++k) dst[n][k] = *(const PG8_LAS bf16x8*)(lds + PG8_SB(b, h) + boff + n * 2048 + k * 1024); } while (0)
#define PG8_MMA(ai, bj, At, Bt) do { __builtin_amdgcn_s_setprio(1); _Pragma("unroll") for (int m = 0; m < 4; ++m) _Pragma("unroll") for (int n = 0; n < 2; ++n) _Pragma("unroll") for (int k = 0; k < 2; ++k) \
        acc[ai][bj][m][n] = __builtin_amdgcn_mfma_f32_16x16x32_bf16(Bt[n][k], At[m][k], acc[ai][bj][m][n], 0, 0, 0); __builtin_amdgcn_s_setprio(0); } while (0)
#define PG8_WAIT_V(n) asm volatile("s_waitcnt vmcnt(" #n ")" ::: "memory")
#define PG8_WAIT_L(n) asm volatile("s_waitcnt lgkmcnt(" #n ")" ::: "memory")
#define PG8_BAR __builtin_amdgcn_s_barrier()
#define PG8_SCHED __builtin_amdgcn_sched_barrier(0)
#define PG8_UA(u) ((const char*)g.A + ((size_t)(u).pm * BM * lda + (u).aoff) * 2)
#define PG8_UB(u) ((const char*)g.Bt + ((size_t)(u).pn * BM * ldb + (u).boff) * 2)
    Unit cur, nxt; int ui = 0;
    if (!S.next(0, cur)) return;
    f32x4 acc[2][2][4][2];
#pragma unroll
    for (int a = 0; a < 2; ++a)
#pragma unroll
        for (int b = 0; b < 2; ++b)
#pragma unroll
            for (int m = 0; m < 4; ++m)
#pragma unroll
                for (int n = 0; n < 2; ++n) acc[a][b][m][n] = (f32x4){0.f, 0.f, 0.f, 0.f};
    bf16x8 At[4][2], B0[2][2], B1[2][2];
    const char* cA = PG8_UA(cur); const char* cB = PG8_UB(cur);
    PG8_STAGE(PG8_SB(0, 0), cB, voffB); PG8_STAGE(PG8_SB(0, 1), cB + hstepB, voffB); PG8_STAGE(PG8_SA(0, 0), cA, voffA); PG8_STAGE(PG8_SA(0, 1), cA + hstepA, voffA);
    if (wr == 1) PG8_BAR;
    PG8_WAIT_V(2); PG8_BAR;
    PG8_STAGE(PG8_SB(1, 0), cB + kstep, voffB); PG8_STAGE(PG8_SA(1, 0), cA + kstep, voffA); PG8_STAGE(PG8_SB(1, 1), cB + hstepB + kstep, voffB);
    PG8_WAIT_V(6); PG8_BAR;
    for (;;) {
        const bool has_next = S.next(ui + 1, nxt);
        const char* nA = has_next ? PG8_UA(nxt) : cA; const char* nB = has_next ? PG8_UB(nxt) : cB;
        const int nt = cur.nt;
        for (int t = 0; t < nt; t += 2) {
            const bool last = (t == nt - 2);
            const char* a1 = cA + (size_t)(t + 1) * kstep;
            const char* a2 = last ? nA : cA + (size_t)(t + 2) * kstep; const char* b2 = last ? nB : cB + (size_t)(t + 2) * kstep;
            const char* a3 = a2 + kstep; const char* b3 = b2 + kstep;
            PG8_LDB(B0, 0, 0); PG8_LDB(B1, 0, 1); PG8_SCHED; PG8_LDA(At, 0, 0); PG8_STAGE(PG8_SA(1, 1), a1 + hstepA, voffA);
            PG8_WAIT_V(8); PG8_WAIT_L(0); PG8_BAR; PG8_MMA(0, 0, At, B0); PG8_MMA(0, 1, At, B1); PG8_BAR; PG8_SCHED;
            PG8_LDA(At, 0, 1); PG8_STAGE(PG8_SB(0, 0), b2, voffB); PG8_STAGE(PG8_SB(0, 1), b2 + hstepB, voffB); PG8_STAGE(PG8_SA(0, 0), a2, voffA);
            PG8_WAIT_V(8); PG8_WAIT_L(0); PG8_BAR; PG8_MMA(1, 0, At, B0); PG8_MMA(1, 1, At, B1); PG8_BAR; PG8_SCHED;
            PG8_LDB(B0, 1, 0); PG8_LDB(B1, 1, 1); PG8_SCHED; PG8_LDA(At, 1, 0); PG8_STAGE(PG8_SA(0, 1), a2 + hstepA, voffA);
            PG8_WAIT_V(8); PG8_WAIT_L(0); PG8_BAR; PG8_MMA(0, 0, At, B0); PG8_MMA(0, 1, At, B1); PG8_BAR; PG8_SCHED;
            PG8_LDA(At, 1, 1); PG8_STAGE(PG8_SB(1, 0), b3, voffB); PG8_STAGE(PG8_SB(1, 1), b3 + hstepB, voffB); PG8_STAGE(PG8_SA(1, 0), a3, voffA);
            PG8_WAIT_V(8); PG8_WAIT_L(0); PG8_BAR; PG8_MMA(1, 0, At, B0); PG8_MMA(1, 1, At, B1); PG8_BAR; PG8_SCHED;
        }
        if constexpr (ALIGN_EPI) { if (wr == 0) PG8_BAR; }
        E(acc, cur, wr, wc, fr, fq);
        if (!has_next) break;
        if (E.reset_after(cur)) {
#pragma unroll
            for (int a = 0; a < 2; ++a)
#pragma unroll
                for (int b = 0; b < 2; ++b)
#pragma unroll
                    for (int m = 0; m < 4; ++m)
#pragma unroll
                        for (int n = 0; n < 2; ++n) acc[a][b][m][n] = (f32x4){0.f, 0.f, 0.f, 0.f};
        }
        cur = nxt; cA = nA; cB = nB; ++ui;
        if constexpr (ALIGN_EPI) { if (wr == 1) PG8_BAR; }
    }
    PG8_WAIT_V(0);
    if constexpr (!ALIGN_EPI) { if (wr == 0) PG8_BAR; }
    PG8_BAR;
#undef PG8_SA
#undef PG8_SB
#undef PG8_STAGE
#undef PG8_LDA
#undef PG8_LDB
#undef PG8_MMA
#undef PG8_WAIT_V
#undef PG8_WAIT_L
#undef PG8_BAR
#undef PG8_SCHED
#undef PG8_UA
#undef PG8_UB
}
}
#ifndef DUP_MASK
#define DUP_MASK 0
#endif
#ifndef SIMPLE_PREP
#define SIMPLE_PREP 0
#endif
#ifndef PREP_PROBE
#define PREP_PROBE 0
#endif
#ifndef SIMPLE_SCAN
#define SIMPLE_SCAN 0
#endif
constexpr int NWAVES = 8;
constexpr int RING_OFF = 0, RING_BYTES = 131072;
constexpr int LDSCTL_OFF = RING_BYTES, MISC_OFF = LDSCTL_OFF + 320;
constexpr int XTRA_OFF = RING_BYTES + 1024;
constexpr int LDS_BYTES = 147456;
constexpr int CW_BAR = 4096;

#define GAS __attribute__((address_space(1)))
#define LAS __attribute__((address_space(3)))
typedef unsigned v4u __attribute__((ext_vector_type(4)));
typedef float f32x4 __attribute__((ext_vector_type(4)));
typedef GAS unsigned gu32;
#define LDS_WAIT() asm volatile("s_waitcnt lgkmcnt(0)" ::: "memory")
#define VM_WAIT() asm volatile("s_waitcnt vmcnt(0)" ::: "memory")
__device__ __forceinline__ unsigned pk2(float lo, float hi) { return (unsigned)f2bf(lo) | ((unsigned)f2bf(hi) << 16); }

#define XB_TMO      128
#define XB_XCNT(j)  (256  + 64 * (j))
#define XB_XSUB(j)  (1280 + 64 * (j))
#define XB_XGEN(j)  (2304 + 64 * (j))
#define XB_TOP      3328
#define XB_TOPGEN   3392
#define XCD_BAR_WORDS 3456
#define XB_SPIN_CAP (1u << 18)
__device__ __forceinline__ unsigned xb_ld(unsigned* p)              { return __hip_atomic_load(p, __ATOMIC_RELAXED, __HIP_MEMORY_SCOPE_AGENT); }
__device__ __forceinline__ unsigned xb_add(unsigned* p, unsigned v) { return __hip_atomic_fetch_add(p, v, __ATOMIC_RELAXED, __HIP_MEMORY_SCOPE_AGENT); }
__device__ __forceinline__ unsigned xb_xcc_id() { return (unsigned)__builtin_amdgcn_s_getreg((3 << 11) | 20) & 0xFu; }
#define XB_SPIN(cond, bar) do { unsigned _sp = 0; while (cond) { __builtin_amdgcn_s_sleep(1); \
    if ((++_sp & 255u) == 0u) { if (xb_ld(&(bar)[XB_TMO])) break; if (_sp > XB_SPIN_CAP) { atomicAdd(&(bar)[XB_TMO], 1u); break; } } } } while (0)
struct XcdBarrier { unsigned* bar; unsigned x; volatile LAS unsigned* st; };
__device__ __forceinline__ XcdBarrier xcd_barrier_post(unsigned* bar, volatile LAS unsigned* st) {
    XcdBarrier b; b.bar = bar; b.x = xb_xcc_id(); b.st = st;
    if (threadIdx.x == 0) (void)xb_add(&bar[XB_XCNT(b.x)], 1u);
    return b;
}
__device__ __forceinline__ void xcd_barrier_complete(unsigned* bar, unsigned x, unsigned& nloc, unsigned& nx) {
    const unsigned G = gridDim.x * gridDim.y * gridDim.z;
    unsigned sum, cnt, mine, sp = 0u;
    for (;;) {
        sum = 0u; cnt = 0u; mine = 0u;
#pragma unroll
        for (unsigned j = 0; j < 16; ++j) { const unsigned c = xb_ld(&bar[XB_XCNT(j)]); sum += c; cnt += (c > 0u) ? 1u : 0u; mine = (j == x) ? c : mine; }
        if (sum == G) break;
        __builtin_amdgcn_s_sleep(1);
        if ((++sp & 255u) == 0u) { if (xb_ld(&bar[XB_TMO])) break; if (sp > XB_SPIN_CAP) { atomicAdd(&bar[XB_TMO], 1u); break; } }
    }
    nloc = mine > 0u ? mine : 1u; nx = cnt > 0u ? cnt : 1u;
}
__device__ __forceinline__ void xcd_barrier(const XcdBarrier& b) {
    asm volatile("s_waitcnt vmcnt(0)" ::: "memory");
    __syncthreads();
    if (threadIdx.x == 0) {
        unsigned* bar = b.bar;
        __builtin_amdgcn_s_waitcnt(0);
        unsigned nloc = b.st[0], nx = b.st[1];
        if (nloc == 0u) { xcd_barrier_complete(bar, b.x, nloc, nx); b.st[0] = nloc; b.st[1] = nx; }
        const unsigned old = xb_add(&bar[XB_XSUB(b.x)], 1u);
        const unsigned gen = old / nloc;
        if (old + 1u == (gen + 1u) * nloc) {
            __builtin_amdgcn_fence(__ATOMIC_RELEASE, "agent");
            asm volatile("s_waitcnt vmcnt(0)" ::: "memory");
            const unsigned og = xb_add(&bar[XB_TOP], 1u);
            const unsigned tg = og / nx;
            if (og + 1u == (tg + 1u) * nx) xb_add(&bar[XB_TOPGEN], 1u);
            else XB_SPIN(xb_ld(&bar[XB_TOPGEN]) == tg, bar);
            __builtin_amdgcn_fence(__ATOMIC_ACQUIRE, "agent");
            xb_add(&bar[XB_XGEN(b.x)], 1u);
            asm volatile("s_waitcnt vmcnt(0)" ::: "memory");
        } else {
            XB_SPIN(xb_ld(&bar[XB_XGEN(b.x)]) == gen, bar);
            __builtin_amdgcn_fence(__ATOMIC_ACQUIRE, "agent");
            asm volatile("s_waitcnt vmcnt(0)" ::: "memory");
        }
    }
    __syncthreads();
}

struct Args { const float* in[14]; float* out; unsigned char* ws; int ph_lo, ph_hi; };

struct Frame {
    LAS unsigned char* lds; int tid, lane, wave, vcu, G;
};

__device__ __forceinline__ void p0_transpose_item(const float* __restrict__ W, int N, int k0, int n0, bf16_t* __restrict__ WT, int ldt, int dn0, int koff, LAS float* scr, int lane) {
#pragma unroll 8
    for (int i = 0; i < 32; ++i) { const int kk = 2 * i + (lane >> 5); scr[kk * 33 + (lane & 31)] = W[(size_t)(k0 + kk) * N + n0 + (lane & 31)]; }
    LDS_WAIT(); asm volatile("" ::: "memory");
    const int c = lane & 7;
#pragma unroll
    for (int j = 0; j < 4; ++j) { const int n = (lane >> 3) + 8 * j; const LAS float* s = scr + (8 * c) * 33 + n;
        v4u o; o.x = pk2(s[0 * 33], s[1 * 33]); o.y = pk2(s[2 * 33], s[3 * 33]); o.z = pk2(s[4 * 33], s[5 * 33]); o.w = pk2(s[6 * 33], s[7 * 33]);
        *(v4u*)(WT + (size_t)(dn0 + n) * ldt + koff + k0 + 8 * c) = o; }
    LDS_WAIT(); asm volatile("" ::: "memory");
}
__device__ __forceinline__ void p0_prologue(Frame& F, const Args& a) {
    unsigned char* ws = a.ws;
    bf16_t *WinT = (bf16_t*)(ws + WS_WINT), *W2T = (bf16_t*)(ws + WS_W2T), *WoT = (bf16_t*)(ws + WS_WOT), *MixT = (bf16_t*)(ws + WS_MIXT), *XN = (bf16_t*)(ws + WS_XN);
    LAS float* scr = (LAS float*)(F.lds + RING_OFF + F.wave * 16384);
    const int gw = F.vcu * NWAVES + F.wave, NGW = F.G * NWAVES;
    constexpr int I_IN = (DM / 64) * (INC / 32), I_PO = (PW / 64) * (DM / 32), I_DN = (DNW / 64) * (DM / 32), I_WO = (DM / 64) * (DM / 32), I_MX = 4 * (PGD / 64) * (PGD / 32);
    constexpr int NITEMS = I_IN + I_PO + I_DN + I_WO + I_MX;
    for (int it = gw; it < NITEMS; it += NGW) {
        int r = it;
        if (r < I_IN) { const int nblk = INC / 32, kb = r / nblk, nb = r % nblk, n0 = 32 * nb;
            const int dn0 = n0 < C_B ? n0 : (n0 < C_GP ? 14336 + (n0 - C_B) : n0 - 32);
            p0_transpose_item(a.in[3], INC, 64 * kb, n0, WinT, DM, dn0, 0, scr, F.lane); continue; } r -= I_IN;
        if (r < I_PO) { const int nblk = DM / 32, kb = r / nblk, nb = r % nblk; p0_transpose_item(a.in[10], DM, 64 * kb, 32 * nb, W2T, YLD, 32 * nb, 0, scr, F.lane); continue; } r -= I_PO;
        if (r < I_DN) { const int nblk = DM / 32, kb = r / nblk, nb = r % nblk; p0_transpose_item(a.in[11], DM, 64 * kb, 32 * nb, W2T, YLD, 32 * nb, 1024, scr, F.lane); continue; } r -= I_DN;
        if (r < I_WO) { const int nblk = DM / 32, kb = r / nblk, nb = r % nblk; p0_transpose_item(a.in[12], DM, 64 * kb, 32 * nb, WoT, DM, 32 * nb, 0, scr, F.lane); continue; } r -= I_WO;
        { const int g = r / 32, rr = r % 32, kb = rr / 8, nb = rr % 8;
          p0_transpose_item(a.in[7] + (size_t)g * PGD * PGD, PGD, 64 * kb, 32 * nb, MixT + (size_t)g * PGD * PGD, PGD, 32 * nb, 0, scr, F.lane); }
    }
    const float* nw = a.in[2];
    for (int r = gw; r < MPAD + (NPAD1 - INC); r += NGW) {
        if (r >= MROWS) { bf16_t* o = r < MPAD ? XN + (size_t)r * DM : WinT + (size_t)(INC + (r - MPAD)) * DM;
#pragma unroll
            for (int j = 0; j < 4; ++j) *(v4u*)(o + 8 * F.lane + 512 * j) = (v4u){0u, 0u, 0u, 0u};
            continue; }
        const float* src = r < MTOK ? a.in[0] + (size_t)r * DM : a.in[1] + (size_t)(r - MTOK) * DM;
        f32x4 v[8]; float s = 0.f;
#pragma unroll
        for (int j = 0; j < 8; ++j) { v[j] = *(const f32x4*)(src + 4 * F.lane + 256 * j); s += (v[j].x * v[j].x + v[j].y * v[j].y) + (v[j].z * v[j].z + v[j].w * v[j].w); }
        const float rs = rsqrtf(wave_sum(s) * (1.f / DM) + EPS);
        unsigned long long* o8 = (unsigned long long*)(XN + (size_t)r * DM) + F.lane;
#pragma unroll
        for (int j = 0; j < 8; ++j) { const f32x4 w = *(const f32x4*)(nw + 4 * F.lane + 256 * j);
            o8[64 * j] = (unsigned long long)pk2(v[j].x * rs * w.x, v[j].y * rs * w.y) | ((unsigned long long)pk2(v[j].z * rs * w.z, v[j].w * rs * w.w) << 32); }
    }
}

template <int WIN>
__device__ __forceinline__ void p2_pool_item(const bf16_t* __restrict__ U, bf16_t* __restrict__ PO, int g, int rb, int c) {
    const int b = rb >> 8, t0 = (rb & 255) * 8, col = g * 256 + c * 8;
    pg8::u32x4 raw[WIN + 7];
#pragma unroll
    for (int j = 0; j < WIN + 7; ++j) { const int t = t0 - (WIN - 1) + j; const int row = t >= 0 ? b * SEQ + t : MTOK + NMETA + t; raw[j] = *(const pg8::u32x4*)(U + (size_t)row * 1024 + col); }
    f32x4 s0 = (f32x4){0.f, 0.f, 0.f, 0.f}, s1 = s0;
#pragma unroll
    for (int j = 0; j < WIN - 1; ++j) { f32x4 x0, x1; pg8::unpack8(raw[j], x0, x1); s0 += x0; s1 += x1; }
    constexpr float inv = 1.f / (float)WIN;
#pragma unroll
    for (int i = 0; i < 8; ++i) { f32x4 x0, x1; pg8::unpack8(raw[WIN - 1 + i], x0, x1); s0 += x0; s1 += x1;
        *(pg8::u32x4*)(PO + (size_t)(b * SEQ + t0 + i) * 1024 + col) = pg8::pack8(s0 * inv - x0, s1 * inv - x1);
        f32x4 y0, y1; pg8::unpack8(raw[i], y0, y1); s0 -= y0; s1 -= y1; }
}
__device__ __forceinline__ void p2_pool(Frame& F, const Args& a) {
    const bf16_t* U = (const bf16_t*)(a.ws + WS_U); bf16_t* PO = (bf16_t*)(a.ws + WS_POOLED);
    const int gw = F.vcu * NWAVES + F.wave, NGW = F.G * NWAVES;
    for (int wi = gw; wi < 4 * 512; wi += NGW) {
        const int g = wi >> 9, rb = (wi & 511) * 2 + (F.lane >> 5), c = F.lane & 31;
        if (g == 0) p2_pool_item<2>(U, PO, 0, rb, c); else if (g == 1) p2_pool_item<4>(U, PO, 1, rb, c); else if (g == 2) p2_pool_item<8>(U, PO, 2, rb, c); else p2_pool_item<16>(U, PO, 3, rb, c);
    }
}
__device__ __forceinline__ void p2_chunk_prep_simple(Frame& F, const Args& a) {
    const bf16_t* QKV = (const bf16_t*)(a.ws + WS_QKV); const float* BA = (const float*)(a.ws + WS_BA);
    const float *conv_w = a.in[4], *A_log = a.in[5], *dt_bias = a.in[6];
    bf16_t *NW = (bf16_t*)(a.ws + WS_CH_NW), *UU = (bf16_t*)(a.ws + WS_CH_U), *QD = (bf16_t*)(a.ws + WS_CH_QD), *KDT = (bf16_t*)(a.ws + WS_CH_KDT), *QK = (bf16_t*)(a.ws + WS_CH_QK);
    float* GL = (float*)(a.ws + WS_CH_GL);
    LAS float* sm = (LAS float*)(F.lds + RING_OFF);
    LAS float *q = sm, *k = q + 8192, *v = k + 8192, *Am = v + 8192, *Tm = Am + 4096;
    LAS float *beta = (LAS float*)(F.lds + XTRA_OFF), *gc = beta + 64;
    const int tid = F.tid, lane = F.lane, wv = F.wave;
    for (int cu = F.vcu; cu < NUNITS; cu += F.G) {
        const int n = cu % NCH, bh = cu / NCH, h = bh % NH, b = bh / NH, p0 = CHUNK * n - PADF;
        for (int idx = tid; idx < 64 * 384; idx += 512) {
            const int i = idx / 384, c3 = idx % 384, which = c3 >> 7, d = c3 & 127, col = which * 2048 + h * HD + d, p = p0 + i;
            float val = 0.f;
            if (p >= 0) { float s = 0.f;
                for (int kk = 0; kk < 4; ++kk) { const int pp = p - 3 + kk; if (pp >= 0) s += conv_w[kk * 6144 + col] * bf2f(QKV[(size_t)ext_row(b, pp) * 6144 + col]); }
                val = siluf_(s); }
            (which == 0 ? q : which == 1 ? k : v)[i * 128 + d] = val;
        }
        if (tid < 64) { const int p = p0 + tid; float be = 0.f, g = 0.f;
            if (p >= 0) { const int r = ext_row(b, p); be = sigmoidf_(BA[(size_t)r * 32 + h]); g = -__expf(A_log[h]) * softplusf_(BA[(size_t)r * 32 + 16 + h] + dt_bias[h]); }
            beta[tid] = be; gc[tid] = g; }
        __syncthreads();
        if (tid == 0) { float s = 0.f; for (int i = 0; i < 64; ++i) { s += gc[i]; gc[i] = s; } }
        for (int r = wv; r < 128; r += 8) {
            LAS float* row = (r < 64 ? q + r * 128 : k + (r - 64) * 128);
            const float a0 = row[lane], a1 = row[lane + 64];
            const float rs = rsqrtf(wave_sum(a0 * a0 + a1 * a1) + EPS) * (r < 64 ? 0.08838834764831845f : 1.f);
            row[lane] = a0 * rs; row[lane + 64] = a1 * rs;
        }
        __syncthreads();
        bf16_t* oQK = QK + (size_t)cu * 4096;
        for (int idx = tid; idx < 4096; idx += 512) {
            const int i = idx >> 6, j = idx & 63; float akk = 0.f, aqk = 0.f;
            if (j <= i) { for (int d = 0; d < 128; ++d) { const float kj = k[j * 128 + d]; akk += k[i * 128 + d] * kj; aqk += q[i * 128 + d] * kj; }
                const float dec = __expf(gc[i] - gc[j]); akk *= beta[i] * dec; aqk *= dec; }
            Am[idx] = j < i ? akk : 0.f; oQK[idx] = f2bf(j <= i ? aqk : 0.f);
        }
        __syncthreads();
        if (tid < 64) { const int c = tid;
            for (int i = 0; i < 64; ++i) { float s = (i == c) ? 1.f : 0.f; for (int j = c; j < i; ++j) s -= Am[i * 64 + j] * Tm[j * 64 + c]; Tm[i * 64 + c] = (i >= c) ? s : 0.f; } }
        __syncthreads();
        bf16_t *oNW = NW + (size_t)cu * 8192, *oU = UU + (size_t)cu * 8192, *oQD = QD + (size_t)cu * 8192, *oKDT = KDT + (size_t)cu * 8192;
        const float gl = gc[63];
        for (int idx = tid; idx < 8192; idx += 512) {
            const int i = idx >> 7, d = idx & 127; float su = 0.f, sw = 0.f;
            for (int j = 0; j <= i; ++j) { const float t = Tm[i * 64 + j] * beta[j]; su += t * v[j * 128 + d]; sw += t * __expf(gc[j]) * k[j * 128 + d]; }
            oU[d * 64 + i] = f2bf(su); oNW[idx] = f2bf(-sw);
            oQD[idx] = f2bf(q[idx] * __expf(gc[i]));
            oKDT[d * 64 + i] = f2bf(k[idx] * __expf(gl - gc[i]));
        }
        if (tid == 0) GL[cu] = __expf(gl);
        __syncthreads();
    }
}

typedef short bf16x8_t __attribute__((ext_vector_type(8)));
typedef unsigned u32x2_t __attribute__((ext_vector_type(2)));
typedef unsigned u32x4_t __attribute__((ext_vector_type(4)));
__device__ __forceinline__ u32x2_t pack4bf(f32x4 v) { u32x2_t r; r.x = pg8::cvt_pk_bf16(v[0], v[1]); r.y = pg8::cvt_pk_bf16(v[2], v[3]); return r; }

constexpr int QS_LD = 272, KT_LD = 144, AM_LD = 68;
constexpr int L_QS = 0, L_KS = 17408, L_KT = 34816, L_VT = 53248, L_AM = 71680, L_TM = 89088, L_TB = 106496, L_TW = 115712, L_XS = 124928;
static_assert(L_XS + 3 * 1152 <= RING_BYTES, "chunk-prep LDS map");
__device__ __forceinline__ int ktoff(int d, int chunk) { return d * KT_LD + ((chunk ^ ((d >> 3) & 7)) << 4); }
struct PrepRaw { pg8::u32x4 x[11]; float pb, pa; };
template <int SKIP>
__device__ __forceinline__ void p2_chunk_prep_fast(Frame& F, const Args& a) {
    const bf16_t* QKV = (const bf16_t*)(a.ws + WS_QKV); const float* BA = (const float*)(a.ws + WS_BA);
    const float *conv_w = a.in[4], *A_log = a.in[5], *dt_bias = a.in[6];
    bf16_t *NW = (bf16_t*)(a.ws + WS_CH_NW), *UT = (bf16_t*)(a.ws + WS_CH_U), *QD = (bf16_t*)(a.ws + WS_CH_QD), *KDT = (bf16_t*)(a.ws + WS_CH_KDT), *QK = (bf16_t*)(a.ws + WS_CH_QK);
    float* GL = (float*)(a.ws + WS_CH_GL);
    LAS unsigned char* L = F.lds + RING_OFF;
    LAS float *Am = (LAS float*)(L + L_AM), *Tm = (LAS float*)(L + L_TM);
    LAS float *beta = (LAS float*)(F.lds + XTRA_OFF), *gc = beta + 64;
    const int w = F.wave;
    const int which = w >> 1; const bool cvt = w < 6;
    const int u_lo = (33 * F.vcu) / 4, u_hi = F.G == 256 ? (33 * (F.vcu + 1)) / 4 : 0;
#define PREP_LOAD(R, cu_) do { const int n_ = (cu_) % NCH, bh_ = (cu_) / NCH, h_ = bh_ % NH, b_ = bh_ / NH, colx = (which < 3 ? which : 2) * 2048 + h_ * HD + d8; \
        _Pragma("unroll") for (int j = 0; j < 11; ++j) { int pp = CHUNK * n_ - PADF + 8 * ib - 3 + j; pp = pp < 0 ? 0 : pp; (R).x[j] = *(const pg8::u32x4*)(QKV + (size_t)ext_row(b_, pp) * 6144 + colx); } \
        { int pl = CHUNK * n_ - PADF + lane; pl = pl < 0 ? 0 : pl; const float* bp = BA + (size_t)ext_row(b_, pl) * 32 + h_; (R).pb = bp[0]; (R).pa = bp[16]; } } while (0)
    LAS float* cw = (LAS float*)(F.lds + XTRA_OFF + 1024);
    PrepRaw raw; int hcur = -1;
    { const int lane = F.lane, fr = lane & 15, fq = lane >> 4, ib = (4 * w + fq) & 7, d8 = 8 * fr; if (u_lo < u_hi) PREP_LOAD(raw, u_lo); }
    for (int cu = u_lo; cu < u_hi; ++cu) {
        int lane = F.lane; asm volatile("" : "+v"(lane));
        const int fr = lane & 15, fq = lane >> 4, tid = w * 64 + lane, ib = (4 * w + fq) & 7, d8 = 8 * fr;
        const int n = cu % NCH, bh = cu / NCH, h = bh % NH, b = bh / NH, p0 = CHUNK * n - PADF;
        if (h != hcur) { hcur = h; for (int i = tid; i < 4 * 384; i += 512) { const int kk = i / 384, c = i % 384; cw[i] = conv_w[kk * 6144 + (c >> 7) * 2048 + h * HD + (c & 127)]; } __syncthreads(); }
        if (cvt && !(SKIP & 1)) {
            if (n == 0) {
#pragma unroll
                for (int j = 0; j < 11; ++j) { const bool ok = p0 + 8 * ib - 3 + j >= 0; raw.x[j].x = ok ? raw.x[j].x : 0u; raw.x[j].y = ok ? raw.x[j].y : 0u; raw.x[j].z = ok ? raw.x[j].z : 0u; raw.x[j].w = ok ? raw.x[j].w : 0u; } }
            f32x4 cwr[8];
#pragma unroll
            for (int kk = 0; kk < 4; ++kk) { cwr[2 * kk] = *(const LAS f32x4*)(cw + kk * 384 + which * 128 + d8); cwr[2 * kk + 1] = *(const LAS f32x4*)(cw + kk * 384 + which * 128 + d8 + 4); }
#pragma unroll
            for (int hb = 0; hb < 2; ++hb) {
                unsigned tr[4][4];
#pragma unroll
                for (int i4 = 0; i4 < 4; ++i4) { const int ii = 4 * hb + i4;
                    float v[8];
#pragma unroll
                    for (int j = 0; j < 8; ++j) v[j] = 0.f;
#pragma unroll
                    for (int kk = 0; kk < 4; ++kk) { f32x4 x0, x1; pg8::unpack8(raw.x[ii + kk], x0, x1);
#pragma unroll
                        for (int j = 0; j < 4; ++j) { v[j] += cwr[2 * kk][j] * x0[j]; v[4 + j] += cwr[2 * kk + 1][j] * x1[j]; } }
#pragma unroll
                    for (int j = 0; j < 8; ++j) v[j] = v[j] * pg8::fast_sigmoid(v[j]);
                    if (which < 2) { float ss = 0.f;
#pragma unroll
                        for (int j = 0; j < 8; ++j) ss += v[j] * v[j];
                        ss += __shfl_xor(ss, 1); ss += __shfl_xor(ss, 2); ss += __shfl_xor(ss, 4); ss += __shfl_xor(ss, 8);
                        const float rs = rsqrtf(ss + EPS) * (which == 0 ? 0.08838834764831845f : 1.f);
#pragma unroll
                        for (int j = 0; j < 8; ++j) v[j] *= rs; }
                    const pg8::u32x4 pk = pg8::pack8((f32x4){v[0], v[1], v[2], v[3]}, (f32x4){v[4], v[5], v[6], v[7]});
                    if (which < 2) *(LAS pg8::u32x4*)(L + (which == 0 ? L_QS : L_KS) + (8 * ib + ii) * QS_LD + d8 * 2) = pk;
                    tr[i4][0] = pk.x; tr[i4][1] = pk.y; tr[i4][2] = pk.z; tr[i4][3] = pk.w;
                }
                if (which >= 1) { LAS unsigned char* T = L + (which == 1 ? L_KT : L_VT) + 8 * hb;
#pragma unroll
                    for (int dj = 0; dj < 8; ++dj) { u32x2_t o; const int q = dj >> 1;
                        if (dj & 1) { o.x = (tr[0][q] >> 16) | (tr[1][q] & 0xffff0000u); o.y = (tr[2][q] >> 16) | (tr[3][q] & 0xffff0000u); }
                        else { o.x = (tr[0][q] & 0xffffu) | (tr[1][q] << 16); o.y = (tr[2][q] & 0xffffu) | (tr[3][q] << 16); }
                        *(LAS u32x2_t*)(T + ktoff(d8 + dj, ib)) = o; } }
            }
        }
        if (w == 7) {
            const int p = p0 + lane; float be = 0.f, g = 0.f;
            if (p >= 0) { be = sigmoidf_(raw.pb); g = -__expf(A_log[h]) * softplusf_(raw.pa + dt_bias[h]); }
#pragma unroll
            for (int o = 1; o < 64; o <<= 1) { const float t = __shfl_up(g, o); if (lane >= o) g += t; }
            beta[lane] = be; gc[lane] = g;
        }
        __syncthreads();
        PREP_LOAD(raw, cu + 1 < u_hi ? cu + 1 : cu);
        const float gl = gc[63];
        if (!(SKIP & 2)) {
            const int kind = w >> 2, ti = w & 3;
            bf16x8_t af[4];
#pragma unroll
            for (int ks = 0; ks < 4; ++ks) af[ks] = *(const LAS bf16x8_t*)(L + L_KS + (16 * ti + fr) * QS_LD + (32 * ks + 8 * fq) * 2);
            bf16_t* oQK = QK + (size_t)cu * 4096;
#pragma unroll
            for (int tj = 0; tj < 4; ++tj) {
                if (kind == 0) {
                    if (tj > ti) continue;
                    f32x4 acc = (f32x4){0.f, 0.f, 0.f, 0.f};
#pragma unroll
                    for (int ks = 0; ks < 4; ++ks) acc = __builtin_amdgcn_mfma_f32_16x16x32_bf16(af[ks], *(const LAS bf16x8_t*)(L + L_KS + (16 * tj + fr) * QS_LD + (32 * ks + 8 * fq) * 2), acc, 0, 0, 0);
                    const int j = 16 * tj + fr; const float gj = gc[j]; const f32x4 gi4 = *(const LAS f32x4*)(gc + 16 * ti + 4 * fq), bi4 = *(const LAS f32x4*)(beta + 16 * ti + 4 * fq);
#pragma unroll
                    for (int r = 0; r < 4; ++r) { const int i = 16 * ti + 4 * fq + r; const float m = (tj < ti || fr < 4 * fq + r) ? 1.f : 0.f; Am[i * AM_LD + j] = acc[r] * bi4[r] * __expf(fminf(gi4[r] - gj, 0.f)) * m; }
                } else {
                    const int i = 16 * tj + fr; u32x2_t o = (u32x2_t){0u, 0u};
                    if (tj >= ti) {
                        f32x4 acc = (f32x4){0.f, 0.f, 0.f, 0.f};
#pragma unroll
                        for (int ks = 0; ks < 4; ++ks) acc = __builtin_amdgcn_mfma_f32_16x16x32_bf16(af[ks], *(const LAS bf16x8_t*)(L + L_QS + (16 * tj + fr) * QS_LD + (32 * ks + 8 * fq) * 2), acc, 0, 0, 0);
                        const float gi = gc[i]; const f32x4 gj4 = *(const LAS f32x4*)(gc + 16 * ti + 4 * fq);
#pragma unroll
                        for (int r = 0; r < 4; ++r) { const float m = (tj > ti || 4 * fq + r <= fr) ? 1.f : 0.f; acc[r] = acc[r] * __expf(fminf(gi - gj4[r], 0.f)) * m; }
                        o = pack4bf(acc);
                    }
                    *(u32x2_t*)(oQK + i * 64 + 16 * ti + 4 * fq) = o;
                }
            }
        }
        __syncthreads();
        if (SKIP & 4) {} else if (w == 0) {
            const int ab = fq, c = fr; float t[16];
#pragma unroll
            for (int r = 0; r < 16; ++r) { float s = (r == c) ? 1.f : 0.f;
#pragma unroll
                for (int m4 = 0; m4 < (r + 3) / 4; ++m4) { const f32x4 av = *(const LAS f32x4*)(Am + (16 * ab + r) * AM_LD + 16 * ab + 4 * m4);
#pragma unroll
                    for (int j = 0; j < 4; ++j) if (4 * m4 + j < r) s -= av[j] * t[4 * m4 + j]; }
                t[r] = s; Tm[(16 * ab + r) * AM_LD + 16 * ab + c] = s; }
        } else {
            bf16_t *oQD = QD + (size_t)cu * 8192, *oKDT = KDT + (size_t)cu * 8192;
            for (int idx = tid - 64; idx < 2048; idx += 448) {
                if (idx < 1024) { const int i = idx >> 4, d8 = (idx & 15) * 8; pg8::f32x4 x0, x1; pg8::unpack8(*(const LAS pg8::u32x4*)(L + L_QS + i * QS_LD + d8 * 2), x0, x1);
                    const float e = __expf(gc[i]); *(pg8::u32x4*)(oQD + i * 128 + d8) = pg8::pack8(x0 * e, x1 * e); }
                else { const int id = idx - 1024, d = id >> 3, i8 = (id & 7) * 8; pg8::f32x4 x0, x1; pg8::unpack8(*(const LAS pg8::u32x4*)(L + L_KT + ktoff(d, i8 >> 3)), x0, x1);
#pragma unroll
                    for (int j = 0; j < 4; ++j) { x0[j] *= __expf(gl - gc[i8 + j]); x1[j] *= __expf(gl - gc[i8 + 4 + j]); }
                    *(pg8::u32x4*)(oKDT + d * 64 + i8) = pg8::pack8(x0, x1); }
            }
            if (tid == 64) GL[cu] = __expf(gl);
        }
        __syncthreads();
#pragma unroll
        for (int dd = 1; dd < 4; ++dd) {
            if (w < 4 - dd && !(SKIP & 8)) {
                const int bb = w, ab = w + dd;
                f32x4 acc = (f32x4){0.f, 0.f, 0.f, 0.f};
                for (int c = bb; c < ab; ++c)
#pragma unroll
                    for (int ks = 0; ks < 4; ++ks) acc = __builtin_amdgcn_mfma_f32_16x16x4f32(Am[(16 * ab + fr) * AM_LD + 16 * c + 4 * ks + fq], Tm[(16 * c + 4 * ks + fq) * AM_LD + 16 * bb + fr], acc, 0, 0, 0);
                LAS float* Xs = (LAS float*)(L + L_XS + w * 1152);
#pragma unroll
                for (int r = 0; r < 4; ++r) Xs[(4 * fq + r) * 17 + fr] = acc[r];
                f32x4 acc2 = (f32x4){0.f, 0.f, 0.f, 0.f};
#pragma unroll
                for (int ks = 0; ks < 4; ++ks) acc2 = __builtin_amdgcn_mfma_f32_16x16x4f32(Tm[(16 * ab + fr) * AM_LD + 16 * ab + 4 * ks + fq], Xs[(4 * ks + fq) * 17 + fr], acc2, 0, 0, 0);
#pragma unroll
                for (int r = 0; r < 4; ++r) Tm[(16 * ab + 4 * fq + r) * AM_LD + 16 * bb + fr] = -acc2[r];
            }
            __syncthreads();
        }
        if (!(SKIP & 16)) { const int i = tid >> 3, j8 = (tid & 7) * 8; f32x4 t0 = *(const LAS f32x4*)(Tm + i * AM_LD + j8), t1 = *(const LAS f32x4*)(Tm + i * AM_LD + j8 + 4); f32x4 b0, b1, w0, w1;
#pragma unroll
            for (int j = 0; j < 4; ++j) { const int ja = j8 + j, jb = j8 + 4 + j; const float ba = beta[ja], bb = beta[jb];
                b0[j] = ja <= i ? t0[j] * ba : 0.f; b1[j] = jb <= i ? t1[j] * bb : 0.f; w0[j] = b0[j] * __expf(gc[ja]); w1[j] = b1[j] * __expf(gc[jb]); }
            *(LAS pg8::u32x4*)(L + L_TB + i * KT_LD + j8 * 2) = pg8::pack8(b0, b1); *(LAS pg8::u32x4*)(L + L_TW + i * KT_LD + j8 * 2) = pg8::pack8(w0, w1); }
        __syncthreads();
        if (!(SKIP & 16)) {
            bf16_t *oU = UT + (size_t)cu * 8192, *oNW = NW + (size_t)cu * 8192;
            bf16x8_t vf[2], kf[2];
#pragma unroll
            for (int ks = 0; ks < 2; ++ks) { vf[ks] = *(const LAS bf16x8_t*)(L + L_VT + ktoff(16 * w + fr, 4 * ks + fq)); kf[ks] = *(const LAS bf16x8_t*)(L + L_KT + ktoff(16 * w + fr, 4 * ks + fq)); }
#pragma unroll
            for (int mi = 0; mi < 4; ++mi) {
                f32x4 au = (f32x4){0.f, 0.f, 0.f, 0.f}, aw = (f32x4){0.f, 0.f, 0.f, 0.f};
#pragma unroll
                for (int ks = 0; ks < 2; ++ks) {
                    au = __builtin_amdgcn_mfma_f32_16x16x32_bf16(*(const LAS bf16x8_t*)(L + L_TB + (16 * mi + fr) * KT_LD + (32 * ks + 8 * fq) * 2), vf[ks], au, 0, 0, 0);
                    aw = __builtin_amdgcn_mfma_f32_16x16x32_bf16(kf[ks], *(const LAS bf16x8_t*)(L + L_TW + (16 * mi + fr) * KT_LD + (32 * ks + 8 * fq) * 2), aw, 0, 0, 0);
                }
                *(u32x2_t*)(oU + (16 * w + fr) * 64 + 16 * mi + 4 * fq) = pack4bf(au);
                *(u32x2_t*)(oNW + (16 * mi + fr) * 128 + 16 * w + 4 * fq) = pack4bf(-aw);
            }
        }
        __syncthreads();
    }
#undef PREP_LOAD
}

__device__ __forceinline__ void p3_scan_simple(Frame& F, const Args& a) {
    const bf16_t *NW = (const bf16_t*)(a.ws + WS_CH_NW), *UU = (const bf16_t*)(a.ws + WS_CH_U), *QD = (const bf16_t*)(a.ws + WS_CH_QD), *KDT = (const bf16_t*)(a.ws + WS_CH_KDT), *QK = (const bf16_t*)(a.ws + WS_CH_QK);
    const float* GL = (const float*)(a.ws + WS_CH_GL); bf16_t* O = (bf16_t*)(a.ws + WS_O);
    LAS float* sm = (LAS float*)(F.lds + RING_OFF);
    LAS float *nw = sm, *qd = sm + 8192, *kd = sm + 16384, *vn = sm + 24576;
    const int tid = F.tid, e = (tid >> 6) * 32 + (tid & 31), half = (tid >> 5) & 1, db = 64 * half; const bool act = tid < 256;
    for (int bh = F.vcu; bh < NB * NH; bh += F.G) {
        const int h = bh % NH, b = bh / NH;
        float S[64];
#pragma unroll
        for (int d = 0; d < 64; ++d) S[d] = 0.f;
        for (int n = 0; n < NCH; ++n) {
            const int cu = bh * NCH + n;
            for (int idx = tid; idx < 8192; idx += 512) { nw[idx] = bf2f(NW[(size_t)cu * 8192 + idx]); qd[idx] = bf2f(QD[(size_t)cu * 8192 + idx]);
                const int d = idx >> 6, i = idx & 63; kd[i * 128 + d] = bf2f(KDT[(size_t)cu * 8192 + idx]); }
            __syncthreads();
            const float gl = GL[cu];
            if (act) for (int i = 0; i < 64; ++i) { float s = 0.f;
#pragma unroll
                for (int d = 0; d < 64; ++d) s += nw[i * 128 + db + d] * S[d];
                s += __shfl_xor(s, 32); s += bf2f(UU[(size_t)cu * 8192 + e * 64 + i]);
                if (half == 0) vn[i * 128 + e] = s; }
            __syncthreads();
            if (act) {
                if (n > 0) for (int i = 0; i < 64; ++i) { float s = 0.f;
#pragma unroll
                    for (int d = 0; d < 64; ++d) s += qd[i * 128 + db + d] * S[d];
                    s += __shfl_xor(s, 32);
                    for (int j = 0; j <= i; ++j) s += bf2f(QK[(size_t)cu * 4096 + i * 64 + j]) * vn[j * 128 + e];
                    if (half == 0) O[(size_t)(b * SEQ + 64 * (n - 1) + i) * DNW + h * HD + e] = f2bf(s); }
#pragma unroll
                for (int d = 0; d < 64; ++d) S[d] *= gl;
                for (int i = 0; i < 64; ++i) { const float vi = vn[i * 128 + e];
#pragma unroll
                    for (int d = 0; d < 64; ++d) S[d] += kd[i * 128 + db + d] * vi; }
            }
            __syncthreads();
        }
    }
}


struct ScanOps { bf16x8_t a[4], x[2], kd[2]; float gl; };
constexpr int ST_LD = 272, VT_LD = 144;
template <int PROBE>
__device__ __forceinline__ void p3_scan_fast(Frame& F, const Args& a) {
    const bf16_t *NW = (const bf16_t*)(a.ws + WS_CH_NW), *UT = (const bf16_t*)(a.ws + WS_CH_U), *QD = (const bf16_t*)(a.ws + WS_CH_QD), *KDT = (const bf16_t*)(a.ws + WS_CH_KDT), *QK = (const bf16_t*)(a.ws + WS_CH_QK);
    const float* GL = (const float*)(a.ws + WS_CH_GL); bf16_t* O = (bf16_t*)(a.ws + (PROBE ? WS_Y : WS_O));
    LAS unsigned char* ST = F.lds + RING_OFF; LAS unsigned char* VT = ST + 32 * ST_LD;
    const int w = F.wave, lane = F.lane, fr = lane & 15, fq = lane >> 4, mt = w & 3; const bool vw = w < 4;
    for (int unit = F.vcu; unit < NB * NH * 4; unit += F.G) {
        const int bh = unit >> 2, s = unit & 3, h = bh % NH, b = bh / NH;
        f32x4 accS[2] = {(f32x4){0.f, 0.f, 0.f, 0.f}, (f32x4){0.f, 0.f, 0.f, 0.f}};
        for (int i = F.tid; i < 32 * ST_LD / 4; i += 512) ((LAS unsigned*)ST)[i] = 0u;
        __syncthreads();
        const bf16_t* Asrc = (vw ? NW : QD) + (16 * mt + fr) * 128 + 8 * fq;
        const bf16_t* Ksrc = KDT + (16 * w + fr) * 64 + 8 * fq;
        const bf16_t* Xsrc = vw ? UT + (32 * s + fr) * 64 + 16 * mt + 8 * (fq >> 1) : QK + (16 * mt + fr) * 64 + 8 * fq;
        const size_t xstride = vw ? 8192 : 4096; const int xstep = vw ? 16 * 64 : 32; const bool hiq = (fq & 1) != 0;
#define SCAN_LOAD(ops, n_) do { const size_t cu_ = (size_t)(bh * NCH + (PROBE != 0 ? 0 : (n_))); \
        _Pragma("unroll") for (int ks = 0; ks < 4; ++ks) (ops).a[ks] = *(const bf16x8_t*)(Asrc + cu_ * 8192 + 32 * ks); \
        _Pragma("unroll") for (int ks = 0; ks < 2; ++ks) (ops).kd[ks] = *(const bf16x8_t*)(Ksrc + cu_ * 8192 + 32 * ks); \
        (ops).x[0] = *(const bf16x8_t*)(Xsrc + cu_ * xstride); (ops).x[1] = *(const bf16x8_t*)(Xsrc + cu_ * xstride + xstep); \
        (ops).gl = GL[cu_]; } while (0)
#define SCAN_STEP(ops, n_) do { \
        f32x4 acc[2]; \
        _Pragma("unroll") for (int n2 = 0; n2 < 2; ++n2) { const unsigned u0_ = hiq ? (unsigned)__builtin_bit_cast(u32x4_t, (ops).x[n2]).z : (unsigned)__builtin_bit_cast(u32x4_t, (ops).x[n2]).x, u1_ = hiq ? (unsigned)__builtin_bit_cast(u32x4_t, (ops).x[n2]).w : (unsigned)__builtin_bit_cast(u32x4_t, (ops).x[n2]).y; \
            acc[n2] = vw ? (f32x4){__uint_as_float(u0_ << 16), __uint_as_float(u0_ & 0xffff0000u), __uint_as_float(u1_ << 16), __uint_as_float(u1_ & 0xffff0000u)} : (f32x4){0.f, 0.f, 0.f, 0.f}; } \
        _Pragma("unroll") for (int ks = 0; ks < 4; ++ks) _Pragma("unroll") for (int n2 = 0; n2 < 2; ++n2) \
            acc[n2] = __builtin_amdgcn_mfma_f32_16x16x32_bf16((ops).a[ks], *(const LAS bf16x8_t*)(ST + (16 * n2 + fr) * ST_LD + (32 * ks + 8 * fq) * 2), acc[n2], 0, 0, 0); \
        if (vw) { _Pragma("unroll") for (int n2 = 0; n2 < 2; ++n2) *(LAS u32x2_t*)(VT + (16 * n2 + fr) * VT_LD + (16 * mt + 4 * fq) * 2) = pack4bf(acc[n2]); } \
        __syncthreads(); \
        bf16x8_t bV[2][2]; \
        _Pragma("unroll") for (int n2 = 0; n2 < 2; ++n2) _Pragma("unroll") for (int ks = 0; ks < 2; ++ks) bV[n2][ks] = *(const LAS bf16x8_t*)(VT + (16 * n2 + fr) * VT_LD + (32 * ks + 8 * fq) * 2); \
        if (!vw) { _Pragma("unroll") for (int n2 = 0; n2 < 2; ++n2) _Pragma("unroll") for (int ks = 0; ks < 2; ++ks) acc[n2] = __builtin_amdgcn_mfma_f32_16x16x32_bf16((ops).x[ks], bV[n2][ks], acc[n2], 0, 0, 0); \
            if ((n_) > 0 && PROBE != 2) { bf16_t* op = O + (size_t)(b * SEQ + 64 * ((n_) - 1) + 16 * mt + 4 * fq) * DNW + h * HD + 32 * s + fr; \
                _Pragma("unroll") for (int n2 = 0; n2 < 2; ++n2) _Pragma("unroll") for (int r = 0; r < 4; ++r) op[(size_t)r * DNW + 16 * n2] = f2bf(acc[n2][r]); } } \
        _Pragma("unroll") for (int n2 = 0; n2 < 2; ++n2) { accS[n2] = accS[n2] * (ops).gl; \
            _Pragma("unroll") for (int ks = 0; ks < 2; ++ks) accS[n2] = __builtin_amdgcn_mfma_f32_16x16x32_bf16((ops).kd[ks], bV[n2][ks], accS[n2], 0, 0, 0); \
            *(LAS u32x2_t*)(ST + (16 * n2 + fr) * ST_LD + (16 * w + 4 * fq) * 2) = pack4bf(accS[n2]); } \
        __syncthreads(); } while (0)
        ScanOps opA, opB, opC;
        SCAN_LOAD(opA, 0); SCAN_LOAD(opB, 1);
        for (int n = 0; n < NCH; n += 3) {
            SCAN_LOAD(opC, n + 2); SCAN_STEP(opA, n);
            SCAN_LOAD(opA, n + 3 < NCH ? n + 3 : NCH - 1); SCAN_STEP(opB, n + 1);
            SCAN_LOAD(opB, n + 4 < NCH ? n + 4 : NCH - 1); SCAN_STEP(opC, n + 2);
        }
#undef SCAN_LOAD
#undef SCAN_STEP
    }
}

__device__ __forceinline__ void p3b_gnorm(Frame& F, const Args& a) {
    const bf16_t *O = (const bf16_t*)(a.ws + WS_O), *SZD = (const bf16_t*)(a.ws + WS_SZD); bf16_t* Y = (bf16_t*)(a.ws + WS_Y); const float* w = a.in[9];
    const int gw = F.vcu * NWAVES + F.wave, NGW = F.G * NWAVES, lane = F.lane;
    const float w0 = w[2 * lane], w1 = w[2 * lane + 1];
    for (int it = gw; it < MTOK * NH; it += NGW) {
        const size_t base = (size_t)(it >> 4) * DNW + (it & 15) * HD + 2 * lane, yb = (size_t)(it >> 4) * YLD + 1024 + (it & 15) * HD + 2 * lane;
        const unsigned ov = *(const unsigned*)(O + base), zv = *(const unsigned*)(SZD + base);
        const float a0 = __uint_as_float(ov << 16), a1 = __uint_as_float(ov & 0xffff0000u);
        const float rs = rsqrtf(wave_sum(a0 * a0 + a1 * a1) * (1.f / HD) + EPS);
        *(unsigned*)(Y + yb) = pk2(a0 * rs * w0 * __uint_as_float(zv << 16), a1 * rs * w1 * __uint_as_float(zv & 0xffff0000u));
    }
}

__device__ __forceinline__ void p6_final(Frame& F, const Args& a) {
    const float* w = a.in[13]; float* out = a.out;
    const int gw = F.vcu * NWAVES + F.wave, NGW = F.G * NWAVES;
    for (int r = gw; r < MTOK; r += NGW) {
        float* row = out + (size_t)r * DM;
        f32x4 v[8]; float s = 0.f;
#pragma unroll
        for (int j = 0; j < 8; ++j) { v[j] = *(const f32x4*)(row + 4 * F.lane + 256 * j); s += (v[j].x * v[j].x + v[j].y * v[j].y) + (v[j].z * v[j].z + v[j].w * v[j].w); }
        const float rs = rsqrtf(wave_sum(s) * (1.f / DM) + EPS);
#pragma unroll
        for (int j = 0; j < 8; ++j) { const f32x4 ww = *(const f32x4*)(w + 4 * F.lane + 256 * j); *(f32x4*)(row + 4 * F.lane + 256 * j) = v[j] * rs * ww; }
    }
}

struct PoolMixOrder {
    int G, c;
    __device__ bool next(int i, pg8::Unit& u) const { const int L = i * G + c; if (L >= 128) return false; u.pm = L >> 2; u.pn = L & 3; u.aoff = (L & 3) * 256; u.boff = 0; u.nt = 4; u.mode = 0; return true; }
};
struct MergeOrder {
    pg8::StaticOrder so;
    __device__ bool next(int i, pg8::Unit& u) const { if (!so.next(i >> 1, u)) return false; if ((i & 1) == 0) { u.nt = 16; u.mode = 0; } else { u.aoff = 1024; u.boff = 1024; u.nt = 32; u.mode = 1; } return true; }
};

constexpr int NPHASE = 8;
__global__ void __launch_bounds__(NWAVES * 64, 2) mega_fwd(Args args) {
    extern __shared__ __attribute__((aligned(16))) unsigned char lds[];
    Frame F;
    F.lds = (LAS unsigned char*)lds;
    F.tid = threadIdx.x; F.lane = F.tid & 63; F.wave = __builtin_amdgcn_readfirstlane(F.tid >> 6);
    F.G = gridDim.x; { const int bx = blockIdx.x; F.vcu = (F.G % 8 == 0) ? (bx % 8) * (F.G / 8) + bx / 8 : bx; }
    unsigned char* ws = args.ws;
    for (int u = F.tid; u < (LDS_BYTES - LDSCTL_OFF) / 4; u += NWAVES * 64) ((LAS unsigned*)(F.lds + LDSCTL_OFF))[u] = 0u;
    __syncthreads();
    const int lo = args.ph_lo, hi = args.ph_hi;
    XcdBarrier bar; bar.bar = (unsigned*)(ws + WS_CTL) + CW_BAR; bar.x = 0; bar.st = nullptr;
    if (hi - lo > 1 || DUP_MASK) bar = xcd_barrier_post((unsigned*)(ws + WS_CTL) + CW_BAR, (volatile LAS unsigned*)(F.lds + MISC_OFF) + 8);
#define DUP(k) ((DUP_MASK >> (k)) & 1)
#define PHASE(k, ...) do { if (lo <= (k) && (k) < hi) { __VA_ARGS__ if (DUP(k)) { xcd_barrier(bar); __VA_ARGS__ } if ((k) + 1 < hi) xcd_barrier(bar); } } while (0)
    PHASE(0, p0_prologue(F, args););
    PHASE(1, {
        pg8::Gemm g{(const bf16_t*)(ws + WS_XN), (const bf16_t*)(ws + WS_WINT), DM, DM}; pg8::StaticOrder S; S.init(MPAD / 256, NPAD1 / 256, DM / 64, F.G, (int)blockIdx.x);
        pg8::EpiProj E{(bf16_t*)(ws + WS_U), (bf16_t*)(ws + WS_SZP), (bf16_t*)(ws + WS_QKV), (bf16_t*)(ws + WS_SZD), (bf16_t*)(ws + WS_GATES), (float*)(ws + WS_BA)};
        pg8::gemm_phase<pg8::EpiProj, pg8::StaticOrder, true>(F.lds + RING_OFF, g, S, E); });
    PHASE(2, p2_pool(F, args); if (SIMPLE_PREP) p2_chunk_prep_simple(F, args); else { if (PREP_PROBE) p2_chunk_prep_fast<PREP_PROBE>(F, args); p2_chunk_prep_fast<0>(F, args); });
    #ifndef SCAN_PROBE
#define SCAN_PROBE 0
#endif
    PHASE(3, if (SIMPLE_SCAN) p3_scan_simple(F, args); else { if (SCAN_PROBE) p3_scan_fast<SCAN_PROBE>(F, args); p3_scan_fast<0>(F, args); });
    PHASE(4, {
        p3b_gnorm(F, args);
        pg8::Gemm g{(const bf16_t*)(ws + WS_POOLED), (const bf16_t*)(ws + WS_MIXT), PW, PGD}; PoolMixOrder S{F.G, F.vcu};
        pg8::EpiPoolMix E{(bf16_t*)(ws + WS_Y), (const bf16_t*)(ws + WS_SZP), args.in[8]};
        pg8::gemm_phase<pg8::EpiPoolMix, PoolMixOrder, false>(F.lds + RING_OFF, g, S, E); });
    PHASE(5, {
        pg8::Gemm g{(const bf16_t*)(ws + WS_Y), (const bf16_t*)(ws + WS_W2T), YLD, YLD}; MergeOrder S; S.so.init(MTOK / 256, DM / 256, 0, F.G, (int)blockIdx.x);
        pg8::EpiMerge E{(const bf16_t*)(ws + WS_GATES), (bf16_t*)(ws + WS_MERGED)};
        pg8::gemm_phase<pg8::EpiMerge, MergeOrder, false>(F.lds + RING_OFF, g, S, E); });
    PHASE(6, {
        pg8::Gemm g{(const bf16_t*)(ws + WS_MERGED), (const bf16_t*)(ws + WS_WOT), DM, DM}; pg8::StaticOrder S; S.init(MTOK / 256, DM / 256, DM / 64, F.G, (int)blockIdx.x);
        pg8::EpiResid E{args.in[0], args.out};
        pg8::gemm_phase<pg8::EpiResid, pg8::StaticOrder, false>(F.lds + RING_OFF, g, S, E); });
    PHASE(7, p6_final(F, args););
#undef PHASE
#undef DUP
}
#ifndef MIX
#define MIX 0
#endif
#ifndef NAIVE_MASK
#define NAIVE_MASK 0
#endif
#ifndef FUSE
#define FUSE 1
#endif
extern "C" void kernel_launch(void* const* d_in, const int* in_sizes, int n_in, void* d_out, int out_size, void* d_ws, size_t ws_size, hipStream_t stream) {
    static int grid = 0;
    if (grid == 0) {
        if (n_in != 14 || in_sizes[0] != MTOK * DM || out_size != MTOK * DM || ws_size < WS_END) { fprintf(stderr, "kernel_launch: unexpected shapes / workspace (%zu < %zu); nothing launched\n", ws_size, (size_t)WS_END); grid = -1; return; }
        int dev = 0, cus = 0;
        if (hipGetDevice(&dev) != hipSuccess || hipDeviceGetAttribute(&cus, hipDeviceAttributeMultiprocessorCount, dev) != hipSuccess) { grid = -1; return; }
        if (hipFuncSetAttribute((const void*)mega_fwd, hipFuncAttributeMaxDynamicSharedMemorySize, LDS_BYTES) != hipSuccess) { fprintf(stderr, "kernel_launch: hipFuncSetAttribute failed\n"); grid = -1; return; }
#if MIX
        if (hipFuncSetAttribute((const void*)nv_chunk_prep, hipFuncAttributeMaxDynamicSharedMemorySize, 140 * 1024) != hipSuccess) { grid = -1; return; }
#endif
        (void)hipGetLastError();
        grid = cus;
    }
    if (grid < 0) return;
    if (hipMemsetAsync((char*)d_ws + WS_CTL, 0, CTL_ZERO_BYTES, stream) != hipSuccess) return;
    Args a{};
    for (int i = 0; i < 14; ++i) a.in[i] = (const float*)d_in[i];
    a.out = (float*)d_out; a.ws = (unsigned char*)d_ws;
#if !MIX
    a.ph_lo = 0; a.ph_hi = NPHASE;
    hipLaunchKernelGGL(mega_fwd, dim3(grid), dim3(NWAVES * 64), LDS_BYTES, stream, a);
#else
    const float *x = a.in[0], *meta = a.in[1], *norm_w = a.in[2], *w_in = a.in[3], *conv_w = a.in[4], *A_log = a.in[5], *dt_bias = a.in[6], *pool_mix = a.in[7], *pool_scale = a.in[8],
                *dn_norm_w = a.in[9], *w_pool_out = a.in[10], *w_dn_out = a.in[11], *w_o = a.in[12], *final_norm_w = a.in[13];
    unsigned char* ws = (unsigned char*)d_ws; float* out = (float*)d_out;
    bf16_t *XN = (bf16_t*)(ws + WS_XN), *U = (bf16_t*)(ws + WS_U), *SZP = (bf16_t*)(ws + WS_SZP), *QKV = (bf16_t*)(ws + WS_QKV), *SZD = (bf16_t*)(ws + WS_SZD), *GATES = (bf16_t*)(ws + WS_GATES);
    float* BA = (float*)(ws + WS_BA);
    bf16_t *Y = (bf16_t*)(ws + WS_Y), *PO = (bf16_t*)(ws + WS_POOLED), *O = (bf16_t*)(ws + WS_O), *MG = (bf16_t*)(ws + WS_MERGED);
    bf16_t *cNW = (bf16_t*)(ws + WS_CH_NW), *cU = (bf16_t*)(ws + WS_CH_U), *cQD = (bf16_t*)(ws + WS_CH_QD), *cKDT = (bf16_t*)(ws + WS_CH_KDT), *cQK = (bf16_t*)(ws + WS_CH_QK);
    float* cGL = (float*)(ws + WS_CH_GL);
    int s = 0;
    while (s < NPHASE) {
        if (!((NAIVE_MASK >> s) & 1)) {
            int e = s + 1;
            if (FUSE) while (e < NPHASE && !((NAIVE_MASK >> e) & 1)) ++e;
            a.ph_lo = s; a.ph_hi = e;
            hipLaunchKernelGGL(mega_fwd, dim3(grid), dim3(NWAVES * 64), LDS_BYTES, stream, a);
            s = e; continue;
        }
        switch (s) {
        case 0: nv_prep<<<1024, 256, 0, stream>>>(x, meta, norm_w, XN); break;
        case 1: nv_gemm<EpiProj><<<dim3((INC + 127) / 128, (MROWS + 127) / 128), 256, 0, stream>>>(XN, DM, w_in, INC, MROWS, INC, DM, EpiProj{U, SZP, QKV, SZD, GATES, BA}); break;
        case 2: nv_pool<<<MTOK * PW / 256, 256, 0, stream>>>(U, PO);
                nv_chunk_prep<<<NUNITS, 256, 140 * 1024, stream>>>(QKV, BA, conv_w, A_log, dt_bias, cNW, cU, cQD, cKDT, cQK, cGL); break;
        case 3: nv_chunk_scan<<<NB * NH, 128, 0, stream>>>(cNW, cU, cQD, cKDT, cQK, cGL, O); break;
        case 4: nv_gnorm<<<MTOK * NH / 4, 256, 0, stream>>>(O, SZD, dn_norm_w, Y);
                for (int g = 0; g < 4; ++g)
                    nv_gemm<EpiPool><<<dim3(2, MTOK / 128), 256, 0, stream>>>(PO + g * PGD, PW, pool_mix + (size_t)g * PGD * PGD, PGD, MTOK, PGD, PGD, EpiPool{Y, SZP, pool_scale, g, 0});
                break;
        case 5: nv_gemm<EpiG2a><<<dim3(DM / 128, MTOK / 128), 256, 0, stream>>>(Y, YLD, w_pool_out, DM, MTOK, DM, PW, EpiG2a{out, GATES});
                nv_gemm<EpiG2b><<<dim3(DM / 128, MTOK / 128), 256, 0, stream>>>(Y + 1024, YLD, w_dn_out, DM, MTOK, DM, DNW, EpiG2b{out, GATES, MG}); break;
        case 6: nv_gemm<EpiG3><<<dim3(DM / 128, MTOK / 128), 256, 0, stream>>>(MG, DM, w_o, DM, MTOK, DM, DM, EpiG3{x, out}); break;
        case 7: nv_final<<<MTOK, 256, 0, stream>>>(out, final_norm_w); break;
        }
        ++s;
    }
#endif
}
```

```cpp
#define MIX 0
#include <hip/hip_runtime.h>
#include <cstdint>
#include <cstdio>

typedef unsigned short bf16_t;
__device__ __forceinline__ float bf2f(bf16_t v) { return __uint_as_float(((unsigned)v) << 16); }
__device__ __forceinline__ bf16_t f2bf(float f) { unsigned u = __float_as_uint(f); return (bf16_t)((u + 0x7fffu + ((u >> 16) & 1u)) >> 16); }
__device__ __forceinline__ float sigmoidf_(float x) { return 1.f / (1.f + __expf(-x)); }
__device__ __forceinline__ float siluf_(float x) { return x / (1.f + __expf(-x)); }
__device__ __forceinline__ float softplusf_(float x) { return x > 20.f ? x : log1pf(__expf(x)); }

constexpr int DM = 2048, NB = 4, SEQ = 2048, NMETA = 16, LEXT = SEQ + NMETA;
constexpr int PW = 1024, PGD = 256, NH = 16, HD = 128, DNW = 2048, CHUNK = 64, NCH = 33, PADF = 48;
constexpr int INC = 14368;
constexpr int C_U = 0, C_ZP = 1024, C_Q = 2048, C_ZD = 8192, C_B = 10240, C_GP = 10272;
constexpr int MTOK = NB * SEQ;
constexpr int MROWS = MTOK + NMETA;
constexpr int MPAD = 8448;
constexpr int NPAD1 = 14592;
constexpr int YLD = 3072;
constexpr float EPS = 1e-6f;
constexpr int NUNITS = NB * NH * NCH;

constexpr size_t MiB = 1u << 20;
constexpr size_t WS_CTL = 0, CTL_ZERO_BYTES = 1 * MiB;
constexpr size_t WS_CH = 1 * MiB;
constexpr size_t CH_ARR = (size_t)NUNITS * 8192 * 2;
constexpr size_t WS_CH_NW = WS_CH, WS_CH_U = WS_CH + CH_ARR, WS_CH_QD = WS_CH + 2 * CH_ARR, WS_CH_KDT = WS_CH + 3 * CH_ARR, WS_CH_QK = WS_CH + 4 * CH_ARR;
constexpr size_t WS_CH_GL = WS_CH_QK + (size_t)NUNITS * 4096 * 2;
constexpr size_t WS_WINT = WS_CH;
constexpr size_t WS_XN = WS_CH + 57 * MiB;
constexpr size_t WS_W2T = 150 * MiB;
constexpr size_t WS_WOT = 162 * MiB;
constexpr size_t WS_MIXT = 170 * MiB;
constexpr size_t WS_U = 171 * MiB;
constexpr size_t WS_SZP = WS_U + (size_t)MPAD * 1024 * 2;
constexpr size_t WS_QKV = WS_SZP + (size_t)MPAD * 1024 * 2;
constexpr size_t WS_BA = 303 * MiB;
constexpr size_t WS_O = 204 * MiB, WS_Y = 236 * MiB, WS_MERGED = 204 * MiB;
constexpr size_t WS_SZD = 304 * MiB + 512 * 1024;
constexpr size_t WS_GATES = WS_SZD + (size_t)MPAD * 2048 * 2;
constexpr size_t WS_POOLED = WS_GATES + (size_t)MPAD * 4096 * 2;
constexpr size_t WS_END = WS_POOLED + (size_t)MTOK * 1024 * 2;
static_assert(WS_CH_GL + NUNITS * 4 <= WS_W2T, "chunk arrays");
static_assert(WS_XN + (size_t)MPAD * 2048 * 2 <= WS_W2T, "xn");
static_assert(WS_QKV == 204 * MiB && WS_QKV + (size_t)MPAD * 6144 * 2 <= WS_BA, "qkv");
static_assert(WS_Y + (size_t)MTOK * YLD * 2 <= WS_BA, "y");
static_assert(WS_BA + (size_t)MPAD * 32 * 4 <= WS_SZD, "ba");
static_assert(WS_END <= 449 * MiB, "ws");

__device__ __forceinline__ int ext_row(int b, int p) { return p < NMETA ? MTOK + p : b * SEQ + (p - NMETA); }

__device__ __forceinline__ float wave_sum(float v) {
#pragma unroll
    for (int o = 1; o < 64; o <<= 1) v += __shfl_xor(v, o);
    return v;
}
#if MIX
__global__ void __launch_bounds__(256) nv_prep(const float* __restrict__ x, const float* __restrict__ meta, const float* __restrict__ nw, bf16_t* __restrict__ XN) {
    const int lane = threadIdx.x & 63, gw = (blockIdx.x * 256 + threadIdx.x) >> 6, ngw = gridDim.x * 4;
    for (int r = gw; r < MPAD; r += ngw) {
        bf16_t* o = XN + (size_t)r * DM;
        if (r >= MROWS) { for (int j = lane; j < DM; j += 64) o[j] = 0; continue; }
        const float* src = r < MTOK ? x + (size_t)r * DM : meta + (size_t)(r - MTOK) * DM;
        float v[32]; float s = 0.f;
#pragma unroll
        for (int j = 0; j < 32; ++j) { v[j] = src[lane + 64 * j]; s += v[j] * v[j]; }
        const float rs = rsqrtf(wave_sum(s) * (1.f / DM) + EPS);
#pragma unroll
        for (int j = 0; j < 32; ++j) o[lane + 64 * j] = f2bf(v[j] * rs * nw[lane + 64 * j]);
    }
}

template <class Epi>
__global__ void __launch_bounds__(256) nv_gemm(const bf16_t* __restrict__ A, int lda, const float* __restrict__ W, int ldw, int M, int N, int K, Epi epi) {
    __shared__ __attribute__((aligned(16))) float As[16][132];
    __shared__ __attribute__((aligned(16))) float Bs[16][132];
    const int tid = threadIdx.x, tx = tid & 15, ty = tid >> 4;
    const int m0 = blockIdx.y * 128, n0 = blockIdx.x * 128;
    float acc[8][8];
#pragma unroll
    for (int i = 0; i < 8; ++i)
#pragma unroll
        for (int j = 0; j < 8; ++j) acc[i][j] = 0.f;
    for (int k0 = 0; k0 < K; k0 += 16) {
        {
            const int r = tid >> 1, kc = (tid & 1) * 8, gm = m0 + r;
            uint4 v = make_uint4(0, 0, 0, 0);
            if (gm < M) v = *(const uint4*)(A + (size_t)gm * lda + k0 + kc);
            const unsigned w[4] = {v.x, v.y, v.z, v.w};
#pragma unroll
            for (int j = 0; j < 4; ++j) { As[kc + 2 * j][r] = __uint_as_float(w[j] << 16); As[kc + 2 * j + 1][r] = __uint_as_float(w[j] & 0xffff0000u); }
        }
        {
            const int kk = tid >> 4, nc = (tid & 15) * 8, gn = n0 + nc;
            float4 v0 = make_float4(0, 0, 0, 0), v1 = v0;
            if (gn < N) { const float* p = W + (size_t)(k0 + kk) * ldw + gn; v0 = *(const float4*)p; v1 = *(const float4*)(p + 4); }
            *(float4*)&Bs[kk][nc] = v0; *(float4*)&Bs[kk][nc + 4] = v1;
        }
        __syncthreads();
#pragma unroll
        for (int kk = 0; kk < 16; ++kk) {
            float a[8], b[8];
            *(float4*)&a[0] = *(const float4*)&As[kk][ty * 8]; *(float4*)&a[4] = *(const float4*)&As[kk][ty * 8 + 4];
            *(float4*)&b[0] = *(const float4*)&Bs[kk][tx * 8]; *(float4*)&b[4] = *(const float4*)&Bs[kk][tx * 8 + 4];
#pragma unroll
            for (int i = 0; i < 8; ++i)
#pragma unroll
                for (int j = 0; j < 8; ++j) acc[i][j] += a[i] * b[j];
        }
        __syncthreads();
    }
#pragma unroll
    for (int i = 0; i < 8; ++i)
#pragma unroll
        for (int j = 0; j < 8; ++j) { const int gm = m0 + ty * 8 + i, gn = n0 + tx * 8 + j; if (gm < M && gn < N) epi(gm, gn, acc[i][j]); }
}

struct EpiProj {
    bf16_t *U, *SZP, *QKV, *SZD, *GATES; float* BA;
    __device__ __forceinline__ void operator()(int m, int n, float v) const {
        if (n < C_ZP) U[(size_t)m * 1024 + n] = f2bf(v);
        else if (n < C_Q) SZP[(size_t)m * 1024 + (n - C_ZP)] = f2bf(siluf_(v));
        else if (n < C_ZD) QKV[(size_t)m * 6144 + (n - C_Q)] = f2bf(v);
        else if (n < C_B) SZD[(size_t)m * 2048 + (n - C_ZD)] = f2bf(siluf_(v));
        else if (n < C_GP) BA[(size_t)m * 32 + (n - C_B)] = v;
        else GATES[(size_t)m * 4096 + (n - C_GP)] = f2bf(sigmoidf_(v));
    }
};
struct EpiPool {
    bf16_t* Y; const bf16_t* SZP; const float* scale; int g, pad;
    __device__ __forceinline__ void operator()(int m, int n, float v) const {
        const int c = g * PGD + n; Y[(size_t)m * YLD + c] = f2bf(v * scale[c] * bf2f(SZP[(size_t)m * 1024 + c]));
    }
};
struct EpiG2a { float* T; const bf16_t* GATES; __device__ __forceinline__ void operator()(int m, int n, float v) const { T[(size_t)m * DM + n] = v * bf2f(GATES[(size_t)m * 4096 + n]); } };
struct EpiG2b { const float* T; const bf16_t* GATES; bf16_t* MG; __device__ __forceinline__ void operator()(int m, int n, float v) const { MG[(size_t)m * DM + n] = f2bf(T[(size_t)m * DM + n] + v * bf2f(GATES[(size_t)m * 4096 + 2048 + n])); } };
struct EpiG3 { const float* x; float* out; __device__ __forceinline__ void operator()(int m, int n, float v) const { out[(size_t)m * DM + n] = x[(size_t)m * DM + n] + v; } };

__global__ void __launch_bounds__(256) nv_pool(const bf16_t* __restrict__ U, bf16_t* __restrict__ PO) {
    const int idx = blockIdx.x * 256 + threadIdx.x; if (idx >= MTOK * PW) return;
    const int m = idx >> 10, c = idx & 1023, b = m >> 11, t = m & 2047, p = t + NMETA, win = 2 << (c >> 8);
    float s = 0.f;
    for (int j = 0; j < win; ++j) { const int pp = p - j; if (pp >= 0) s += bf2f(U[(size_t)ext_row(b, pp) * 1024 + c]); }
    const int cnt = (p + 1) < win ? (p + 1) : win;
    PO[idx] = f2bf(s / (float)cnt - bf2f(U[(size_t)m * 1024 + c]));
}

__global__ void __launch_bounds__(256) nv_chunk_prep(const bf16_t* __restrict__ QKV, const float* __restrict__ BA, const float* __restrict__ conv_w, const float* __restrict__ A_log,
                                                     const float* __restrict__ dt_bias, bf16_t* __restrict__ NW, bf16_t* __restrict__ UU, bf16_t* __restrict__ QD, bf16_t* __restrict__ KDT,
                                                     bf16_t* __restrict__ QK, float* __restrict__ GL) {
    extern __shared__ __attribute__((aligned(16))) float sm[];
    float *q = sm, *k = q + 8192, *v = k + 8192, *Am = v + 8192, *Tm = Am + 4096, *beta = Tm + 4096, *gc = beta + 64;
    const int cu = blockIdx.x, n = cu % NCH, bh = cu / NCH, h = bh % NH, b = bh / NH, tid = threadIdx.x, lane = tid & 63, wv = tid >> 6;
    const int p0 = CHUNK * n - PADF;
    for (int idx = tid; idx < 64 * 384; idx += 256) {
        const int i = idx / 384, c3 = idx % 384, which = c3 >> 7, d = c3 & 127, col = which * 2048 + h * HD + d, p = p0 + i;
        float val = 0.f;
        if (p >= 0) { float a = 0.f;
            for (int kk = 0; kk < 4; ++kk) { const int pp = p - 3 + kk; if (pp >= 0) a += conv_w[kk * 6144 + col] * bf2f(QKV[(size_t)ext_row(b, pp) * 6144 + col]); }
            val = siluf_(a); }
        (which == 0 ? q : which == 1 ? k : v)[i * 128 + d] = val;
    }
    if (tid < 64) { const int p = p0 + tid; float be = 0.f, g = 0.f;
        if (p >= 0) { const int r = ext_row(b, p); be = sigmoidf_(BA[(size_t)r * 32 + h]); g = -__expf(A_log[h]) * softplusf_(BA[(size_t)r * 32 + 16 + h] + dt_bias[h]); }
        beta[tid] = be; gc[tid] = g; }
    __syncthreads();
    if (tid == 0) { float s = 0.f; for (int i = 0; i < 64; ++i) { s += gc[i]; gc[i] = s; } }
    for (int r = wv; r < 128; r += 4) {
        float* row = (r < 64 ? q + r * 128 : k + (r - 64) * 128);
        const float a0 = row[lane], a1 = row[lane + 64];
        const float rs = rsqrtf(wave_sum(a0 * a0 + a1 * a1) + EPS) * (r < 64 ? 0.08838834764831845f : 1.f);
        row[lane] = a0 * rs; row[lane + 64] = a1 * rs;
    }
    __syncthreads();
    bf16_t* oQK = QK + (size_t)cu * 4096;
    for (int idx = tid; idx < 4096; idx += 256) {
        const int i = idx >> 6, j = idx & 63; float akk = 0.f, aqk = 0.f;
        if (j <= i) { for (int d = 0; d < 128; ++d) { const float kj = k[j * 128 + d]; akk += k[i * 128 + d] * kj; aqk += q[i * 128 + d] * kj; }
            const float dec = __expf(gc[i] - gc[j]); akk *= beta[i] * dec; aqk *= dec; }
        Am[idx] = j < i ? akk : 0.f; oQK[idx] = f2bf(j <= i ? aqk : 0.f);
    }
    __syncthreads();
    if (tid < 64) { const int c = tid;
        for (int i = 0; i < 64; ++i) { float s = (i == c) ? 1.f : 0.f; for (int j = c; j < i; ++j) s -= Am[i * 64 + j] * Tm[j * 64 + c]; Tm[i * 64 + c] = (i >= c) ? s : 0.f; } }
    __syncthreads();
    bf16_t *oNW = NW + (size_t)cu * 8192, *oU = UU + (size_t)cu * 8192, *oQD = QD + (size_t)cu * 8192, *oKDT = KDT + (size_t)cu * 8192;
    const float gl = gc[63];
    for (int idx = tid; idx < 8192; idx += 256) {
        const int i = idx >> 7, d = idx & 127; float su = 0.f, sw = 0.f;
        for (int j = 0; j <= i; ++j) { const float t = Tm[i * 64 + j] * beta[j]; su += t * v[j * 128 + d]; sw += t * __expf(gc[j]) * k[j * 128 + d]; }
        oU[idx] = f2bf(su); oNW[idx] = f2bf(-sw);
        oQD[idx] = f2bf(q[idx] * __expf(gc[i]));
        oKDT[d * 64 + i] = f2bf(k[idx] * __expf(gl - gc[i]));
    }
    if (tid == 0) GL[cu] = __expf(gl);
}

__global__ void __launch_bounds__(128) nv_chunk_scan(const bf16_t* __restrict__ NW, const bf16_t* __restrict__ UU, const bf16_t* __restrict__ QD, const bf16_t* __restrict__ KDT,
                                                     const bf16_t* __restrict__ QK, const float* __restrict__ GL, bf16_t* __restrict__ O) {
    __shared__ float vn[64][128];
    const int bh = blockIdx.x, h = bh % NH, b = bh / NH, e = threadIdx.x;
    float S[128];
#pragma unroll
    for (int d = 0; d < 128; ++d) S[d] = 0.f;
    for (int n = 0; n < NCH; ++n) {
        const int cu = bh * NCH + n;
        const bf16_t *nw = NW + (size_t)cu * 8192, *uu = UU + (size_t)cu * 8192, *qd = QD + (size_t)cu * 8192, *kdt = KDT + (size_t)cu * 8192, *qk = QK + (size_t)cu * 4096;
        const float gl = GL[cu];
        for (int i = 0; i < 64; ++i) { float a = bf2f(uu[i * 128 + e]);
#pragma unroll
            for (int d = 0; d < 128; ++d) a += bf2f(nw[i * 128 + d]) * S[d];
            vn[i][e] = a; }
        __syncthreads();
        if (n > 0) for (int i = 0; i < 64; ++i) { float a = 0.f;
#pragma unroll
            for (int d = 0; d < 128; ++d) a += bf2f(qd[i * 128 + d]) * S[d];
            for (int j = 0; j <= i; ++j) a += bf2f(qk[i * 64 + j]) * vn[j][e];
            O[(size_t)(b * SEQ + 64 * (n - 1) + i) * DNW + h * HD + e] = f2bf(a); }
#pragma unroll
        for (int d = 0; d < 128; ++d) { float s = S[d] * gl; for (int i = 0; i < 64; ++i) s += bf2f(kdt[d * 64 + i]) * vn[i][e]; S[d] = s; }
        __syncthreads();
    }
}

__global__ void __launch_bounds__(256) nv_gnorm(const bf16_t* __restrict__ O, const bf16_t* __restrict__ SZD, const float* __restrict__ w, bf16_t* __restrict__ Y) {
    const int lane = threadIdx.x & 63, gw = (blockIdx.x * 256 + threadIdx.x) >> 6; if (gw >= MTOK * NH) return;
    const size_t base = (size_t)(gw >> 4) * DNW + (gw & 15) * HD, yb = (size_t)(gw >> 4) * YLD + 1024 + (gw & 15) * HD;
    const float a0 = bf2f(O[base + lane]), a1 = bf2f(O[base + lane + 64]);
    const float rs = rsqrtf(wave_sum(a0 * a0 + a1 * a1) * (1.f / HD) + EPS);
    Y[yb + lane] = f2bf(a0 * rs * w[lane] * bf2f(SZD[base + lane]));
    Y[yb + lane + 64] = f2bf(a1 * rs * w[lane + 64] * bf2f(SZD[base + lane + 64]));
}

__global__ void __launch_bounds__(256) nv_final(float* __restrict__ out, const float* __restrict__ w) {
    __shared__ float red[4];
    float* row = out + (size_t)blockIdx.x * DM; const int tid = threadIdx.x;
    float v[8]; float s = 0.f;
#pragma unroll
    for (int j = 0; j < 8; ++j) { v[j] = row[tid + 256 * j]; s += v[j] * v[j]; }
    s = wave_sum(s); if ((tid & 63) == 0) red[tid >> 6] = s; __syncthreads();
    const float rs = rsqrtf((red[0] + red[1] + red[2] + red[3]) * (1.f / DM) + EPS);
#pragma unroll
    for (int j = 0; j < 8; ++j) row[tid + 256 * j] = v[j] * rs * w[tid + 256 * j];
}

#endif
namespace pg8 {
#define PG8_LAS __attribute__((address_space(3)))
typedef short bf16x8 __attribute__((ext_vector_type(8)));
typedef float f32x4 __attribute__((ext_vector_type(4)));
typedef unsigned u32x4 __attribute__((ext_vector_type(4)));
constexpr int BM = 256, BK = 64, HALF = 128, HTB = HALF * BK * 2  , STAGE_BYTES = 8 * HTB, NXCD = 8, WGM = 8;

__host__ __device__ __forceinline__ int lds_byte(int r, int c) { const int st = (r >> 4) * 2 + (c >> 5), rr = r & 15, cc = c & 31, ob = rr * 64 + cc * 2; return st * 1024 + (ob ^ (((ob >> 9) & 1) << 5)); }
__host__ __device__ __forceinline__ void stage_rc(int b, int& R, int& C) { const int st = b / 1024, sb = b % 1024, swz = sb ^ (((sb >> 9) & 1) << 5); R = (st >> 1) * 16 + swz / 64; C = (st & 1) * 32 + (swz % 64) / 2; }
__host__ __device__ __forceinline__ int perm32(int rho) { const int n = rho >> 4, i = rho & 15; return 8 * (i >> 2) + 4 * n + (i & 3); }

struct Unit { int pm, pn, aoff, boff, nt, mode; };
struct Gemm { const bf16_t* A; const bf16_t* Bt; int lda, ldb; };

struct StaticOrder {
    int nM, nN, nwg, G, c, nt;
    __device__ void init(int nM_, int nN_, int nt_, int G_, int c_) { nM = nM_; nN = nN_; nwg = nM * nN; G = G_; c = c_; nt = nt_; }
    __device__ bool next(int i, Unit& u) const {
        const long L = (long)i * G + c; if (L >= nwg) return false;
        int wgid = (int)L; { const int q = nwg / NXCD, r = nwg % NXCD, xcd = wgid % NXCD, off = wgid / NXCD; wgid = (xcd < r ? xcd * (q + 1) : r * (q + 1) + (xcd - r) * q) + off; }
        const int nig = WGM * nN, gid = wgid / nig, fm = gid * WGM, gsz = (nM - fm) < WGM ? (nM - fm) : WGM;
        u.pm = fm + ((wgid % nig) % gsz); u.pn = (wgid % nig) / gsz; u.aoff = 0; u.boff = 0; u.nt = nt; u.mode = 0; return true;
    }
};

typedef float f32x2_t __attribute__((ext_vector_type(2))); typedef __bf16 bf16x2_t __attribute__((ext_vector_type(2)));
__device__ __forceinline__ unsigned cvt_pk_bf16(float lo, float hi) { f32x2_t v = {lo, hi}; bf16x2_t b = __builtin_convertvector(v, bf16x2_t); return __builtin_bit_cast(unsigned, b); }
__device__ __forceinline__ u32x4 pack8(f32x4 v0, f32x4 v1) { u32x4 w; w.x = cvt_pk_bf16(v0[0], v0[1]); w.y = cvt_pk_bf16(v0[2], v0[3]); w.z = cvt_pk_bf16(v1[0], v1[1]); w.w = cvt_pk_bf16(v1[2], v1[3]); return w; }
__device__ __forceinline__ void unpack8(u32x4 w, f32x4& v0, f32x4& v1) {
    v0 = (f32x4){__uint_as_float(w.x << 16), __uint_as_float(w.x & 0xffff0000u), __uint_as_float(w.y << 16), __uint_as_float(w.y & 0xffff0000u)};
    v1 = (f32x4){__uint_as_float(w.z << 16), __uint_as_float(w.z & 0xffff0000u), __uint_as_float(w.w << 16), __uint_as_float(w.w & 0xffff0000u)};
}
__device__ __forceinline__ float fast_sigmoid(float x) { return __builtin_amdgcn_rcpf(1.f + __builtin_amdgcn_exp2f(-1.4426950408889634f * x)); }

struct EpiProj {
    static constexpr bool PERM = true;
    bf16_t *U, *SZP, *QKV, *SZD, *GATES; float* BA;
    __device__ __forceinline__ bool reset_after(const Unit&) const { return true; }
    __device__ __forceinline__ void operator()(f32x4 (&acc)[2][2][4][2], const Unit& u, int wr, int wc, int fr, int fq) const {
        const int row0 = u.pm * BM + wr * 64 + fr, pn = u.pn;
        if (pn == 56) {
            if (wc == 0) {
#pragma unroll
                for (int ai = 0; ai < 2; ++ai)
#pragma unroll
                    for (int m = 0; m < 4; ++m) { float* rowp = BA + (size_t)(row0 + ai * HALF + m * 16) * 32 + 8 * fq;
                        *(f32x4*)rowp = acc[ai][0][m][0]; *(f32x4*)(rowp + 4) = acc[ai][0][m][1]; }
            }
            return;
        }
        bf16_t* base; int ld, colt, act;
        if (pn < 4) { base = U; ld = 1024; colt = pn * 256; act = 0; }
        else if (pn < 8) { base = SZP; ld = 1024; colt = (pn - 4) * 256; act = 1; }
        else if (pn < 32) { base = QKV; ld = 6144; colt = (pn - 8) * 256; act = 0; }
        else if (pn < 40) { base = SZD; ld = 2048; colt = (pn - 32) * 256; act = 1; }
        else { base = GATES; ld = 4096; colt = (pn - 40) * 256; act = 2; }
        const int col0 = colt + wc * 32 + 8 * fq;
#pragma unroll
        for (int ai = 0; ai < 2; ++ai)
#pragma unroll
            for (int m = 0; m < 4; ++m) { bf16_t* rowp = base + (size_t)(row0 + ai * HALF + m * 16) * ld + col0;
#pragma unroll
                for (int bj = 0; bj < 2; ++bj) { f32x4 v0 = acc[ai][bj][m][0], v1 = acc[ai][bj][m][1];
                    if (act != 0) {
#pragma unroll
                        for (int j = 0; j < 4; ++j) { const float s0 = fast_sigmoid(v0[j]), s1 = fast_sigmoid(v1[j]); v0[j] = act == 1 ? v0[j] * s0 : s0; v1[j] = act == 1 ? v1[j] * s1 : s1; }
                    }
                    *(u32x4*)(rowp + bj * HALF) = pack8(v0, v1); } }
    }
};
struct EpiPoolMix {
    static constexpr bool PERM = true;
    bf16_t* Y; const bf16_t* SZP; const float* scale;
    __device__ __forceinline__ bool reset_after(const Unit&) const { return true; }
    __device__ __forceinline__ void operator()(f32x4 (&acc)[2][2][4][2], const Unit& u, int wr, int wc, int fr, int fq) const {
        const int row0 = u.pm * BM + wr * 64 + fr, col0 = u.pn * BM + wc * 32 + 8 * fq;
#pragma unroll
        for (int bj = 0; bj < 2; ++bj) { const f32x4 s0 = *(const f32x4*)(scale + col0 + bj * HALF), s1 = *(const f32x4*)(scale + col0 + bj * HALF + 4);
#pragma unroll
            for (int ai = 0; ai < 2; ++ai)
#pragma unroll
                for (int m = 0; m < 4; ++m) { const size_t r = (size_t)(row0 + ai * HALF + m * 16);
                    f32x4 z0, z1; unpack8(*(const u32x4*)(SZP + r * 1024 + col0 + bj * HALF), z0, z1);
                    *(u32x4*)(Y + r * YLD + col0 + bj * HALF) = pack8(acc[ai][bj][m][0] * s0 * z0, acc[ai][bj][m][1] * s1 * z1); } }
    }
};
struct EpiMerge {
    static constexpr bool PERM = true;
    const bf16_t* GATES; bf16_t* MG;
    __device__ __forceinline__ bool reset_after(const Unit& u) const { return u.mode != 0; }
    __device__ __forceinline__ void operator()(f32x4 (&acc)[2][2][4][2], const Unit& u, int wr, int wc, int fr, int fq) const {
        const int row0 = u.pm * BM + wr * 64 + fr, col0 = u.pn * BM + wc * 32 + 8 * fq;
#pragma unroll
        for (int ai = 0; ai < 2; ++ai)
#pragma unroll
            for (int m = 0; m < 4; ++m) { const size_t r = (size_t)(row0 + ai * HALF + m * 16);
#pragma unroll
                for (int bj = 0; bj < 2; ++bj) {
                    f32x4 d0, d1; unpack8(*(const u32x4*)(GATES + r * 4096 + 2048 + col0 + bj * HALF), d0, d1);
                    if (u.mode == 0) {
                        f32x4 p0, p1; unpack8(*(const u32x4*)(GATES + r * 4096 + col0 + bj * HALF), p0, p1);
#pragma unroll
                        for (int j = 0; j < 4; ++j) { acc[ai][bj][m][0][j] *= p0[j] / fmaxf(d0[j], 1e-30f); acc[ai][bj][m][1][j] *= p1[j] / fmaxf(d1[j], 1e-30f); }
                    } else {
                        *(u32x4*)(MG + r * DM + col0 + bj * HALF) = pack8(acc[ai][bj][m][0] * d0, acc[ai][bj][m][1] * d1);
                    } } }
    }
};
struct EpiResid {
    static constexpr bool PERM = false;
    const float* x; float* out;
    __device__ __forceinline__ bool reset_after(const Unit&) const { return true; }
    __device__ __forceinline__ void operator()(f32x4 (&acc)[2][2][4][2], const Unit& u, int wr, int wc, int fr, int fq) const {
        const int row0 = u.pm * BM + wr * 64 + fr, col0 = u.pn * BM + wc * 32 + 4 * fq;
#pragma unroll
        for (int ai = 0; ai < 2; ++ai)
#pragma unroll
            for (int m = 0; m < 4; ++m) { const size_t off = (size_t)(row0 + ai * HALF + m * 16) * DM + col0;
#pragma unroll
                for (int bj = 0; bj < 2; ++bj)
#pragma unroll
                    for (int n = 0; n < 2; ++n) *(f32x4*)(out + off + bj * HALF + n * 16) = *(const f32x4*)(x + off + bj * HALF + n * 16) + acc[ai][bj][m][n]; }
    }
};

template <class Epi, class Sched, bool ALIGN_EPI>
__device__ __forceinline__ void gemm_phase(PG8_LAS unsigned char* lds, const Gemm g, const Sched& S, const Epi& E) {
    const int tid = threadIdx.x, wid = __builtin_amdgcn_readfirstlane(tid >> 6), lane = tid & 63, wr = wid >> 2, wc = wid & 3, fr = lane & 15, fq = lane >> 4;
    const int lda = g.lda, ldb = g.ldb;
    unsigned voffA[2], voffB[2];
#pragma unroll
    for (int i = 0; i < 2; ++i) { int R, C; stage_rc(tid * 16 + i * 8192, R, C); const int Rb = Epi::PERM ? ((R & ~31) + perm32(R & 31)) : R;
        voffA[i] = (unsigned)(R * lda + C) * 2u; voffB[i] = (unsigned)(Rb * ldb + C) * 2u; }
    const size_t kstep = (size_t)(BK * 2);
    const size_t hstepA = (size_t)HALF * lda * 2, hstepB = (size_t)HALF * ldb * 2;
    const unsigned ldsw = (unsigned)wid * 1024u;
    const int aoff = lds_byte(wr * 64 + fr, fq * 8), boff = lds_byte(wc * 32 + fr, fq * 8);
#define PG8_SA(b, h) (((b) * 2 + (h)) * HTB)
#define PG8_SB(b, h) ((4 + (b) * 2 + (h)) * HTB)
#define PG8_STAGE(bufoff, gbase, voff) do { _Pragma("unroll") for (int _i = 0; _i < 2; ++_i) \
        __builtin_amdgcn_global_load_lds((const unsigned*)((const char*)(gbase) + (voff)[_i]), (PG8_LAS unsigned*)(lds + (bufoff) + ldsw + _i * 8192), 16, 0, 0); } while (0)
#define PG8_LDA(dst, b, h) do { _Pragma("unroll") for (int m = 0; m < 4; ++m) _Pragma("unroll") for (int k = 0; k < 2; ++k) dst[m][k] = *(const PG8_LAS bf16x8*)(lds + PG8_SA(b, h) + aoff + m * 2048 + k * 1024); } while (0)
#define PG8_LDB(dst, b, h) do { _Pragma("unroll") for (int n = 0; n < 2; ++n) _Pragma("unroll") for (int k = 0; k < 2; ++k) dst[n][k] = *(const PG8_LAS bf16x8*)(lds + PG8_SB(b, h) + boff + n * 2048 + k * 1024); } while (0)
#define PG8_MMA(ai, bj, At, Bt) do { __builtin_amdgcn_s_setprio(1); _Pragma("unroll") for (int m = 0; m < 4; ++m) _Pragma("unroll") for (int n = 0; n < 2; ++n) _Pragma("unroll") for (int k = 0; k < 2; ++k) \
        acc[ai][bj][m][n] = __builtin_amdgcn_mfma_f32_16x16x32_bf16(Bt[n][k], At[m][k], acc[ai][bj][m][n], 0, 0, 0); __builtin_amdgcn_s_setprio(0); } while (0)
#define PG8_WAIT_V(n) asm volatile("s_waitcnt vmcnt(" #n ")" ::: "memory")
#define PG8_WAIT_L(n) asm volatile("s_waitcnt lgkmcnt(" #n ")" ::: "memory")
#define PG8_BAR __builtin_amdgcn_s_barrier()
#define PG8_SCHED __builtin_amdgcn_sched_barrier(0)
#define PG8_UA(u) ((const char*)g.A + ((size_t)(u).pm * BM * lda + (u).aoff) * 2)
#define PG8_UB(u) ((const char*)g.Bt + ((size_t)(u).pn * BM * ldb + (u).boff) * 2)
    Unit cur, nxt; int ui = 0;
    if (!S.next(0, cur)) return;
    f32x4 acc[2][2][4][2];
#pragma unroll
    for (int a = 0; a < 2; ++a)
#pragma unroll
        for (int b = 0; b < 2; ++b)
#pragma unroll
            for (int m = 0; m < 4; ++m)
#pragma unroll
                for (int n = 0; n < 2; ++n) acc[a][b][m][n] = (f32x4){0.f, 0.f, 0.f, 0.f};
    bf16x8 At[4][2], B0[2][2], B1[2][2];
    const char* cA = PG8_UA(cur); const char* cB = PG8_UB(cur);
    PG8_STAGE(PG8_SB(0, 0), cB, voffB); PG8_STAGE(PG8_SB(0, 1), cB + hstepB, voffB); PG8_STAGE(PG8_SA(0, 0), cA, voffA); PG8_STAGE(PG8_SA(0, 1), cA + hstepA, voffA);
    if (wr == 1) PG8_BAR;
    PG8_WAIT_V(2); PG8_BAR;
    PG8_STAGE(PG8_SB(1, 0), cB + kstep, voffB); PG8_STAGE(PG8_SA(1, 0), cA + kstep, voffA); PG8_STAGE(PG8_SB(1, 1), cB + hstepB + kstep, voffB);
    PG8_WAIT_V(6); PG8_BAR;
    for (;;) {
        const bool has_next = S.next(ui + 1, nxt);
        const char* nA = has_next ? PG8_UA(nxt) : cA; const char* nB = has_next ? PG8_UB(nxt) : cB;
        const int nt = cur.nt;
        for (int t = 0; t < nt; t += 2) {
            const bool last = (t == nt - 2);
            const char* a1 = cA + (size_t)(t + 1) * kstep;
            const char* a2 = last ? nA : cA + (size_t)(t + 2) * kstep; const char* b2 = last ? nB : cB + (size_t)(t + 2) * kstep;
            const char* a3 = a2 + kstep; const char* b3 = b2 + kstep;
            PG8_LDB(B0, 0, 0); PG8_LDB(B1, 0, 1); PG8_SCHED; PG8_LDA(At, 0, 0); PG8_STAGE(PG8_SA(1, 1), a1 + hstepA, voffA);
            PG8_WAIT_V(8); PG8_WAIT_L(0); PG8_BAR; PG8_MMA(0, 0, At, B0); PG8_MMA(0, 1, At, B1); PG8_BAR; PG8_SCHED;
            PG8_LDA(At, 0, 1); PG8_STAGE(PG8_SB(0, 0), b2, voffB); PG8_STAGE(PG8_SB(0, 1), b2 + hstepB, voffB); PG8_STAGE(PG8_SA(0, 0), a2, voffA);
            PG8_WAIT_V(8); PG8_WAIT_L(0); PG8_BAR; PG8_MMA(1, 0, At, B0); PG8_MMA(1, 1, At, B1); PG8_BAR; PG8_SCHED;
            PG8_LDB(B0, 1, 0); PG8_LDB(B1, 1, 1); PG8_SCHED; PG8_LDA(At, 1, 0); PG8_STAGE(PG8_SA(0, 1), a2 + hstepA, voffA);
            PG8_WAIT_V(8); PG8_WAIT_L(0); PG8_BAR; PG8_MMA(0, 0, At, B0); PG8_MMA(0, 1, At, B1); PG8_BAR; PG8_SCHED;
            PG8_LDA(At, 1, 1); PG8_STAGE(PG8_SB(1, 0), b3, voffB); PG8_STAGE(PG8_SB(1, 1), b3 + hstepB, voffB); PG8_STAGE(PG8_SA(1, 0), a3, voffA);
            PG8_WAIT_V(8); PG8_WAIT_L(0); PG8_BAR; PG8_MMA(1, 0, At, B0); PG8_MMA(1, 1, At, B1); PG8_BAR; PG8_SCHED;
        }
        if constexpr (ALIGN_EPI) { if (wr == 0) PG8_BAR; }
        E(acc, cur, wr, wc, fr, fq);
        if (!has_next) break;
        if (E.reset_after(cur)) {
#pragma unroll
            for (int a = 0; a < 2; ++a)
#pragma unroll
                for (int b = 0; b < 2; ++b)
#pragma unroll
                    for (int m = 0; m < 4; ++m)
#pragma unroll
                        for (int n = 0; n < 2; ++n) acc[a][b][m][n] = (f32x4){0.f, 0.f, 0.f, 0.f};
        }
        cur = nxt; cA = nA; cB = nB; ++ui;
        if constexpr (ALIGN_EPI) { if (wr == 1) PG8_BAR; }
    }
    PG8_WAIT_V(0);
    if constexpr (!ALIGN_EPI) { if (wr == 0) PG8_BAR; }
    PG8_BAR;
#undef PG8_SA
#undef PG8_SB
#undef PG8_STAGE
#undef PG8_LDA
#undef PG8_LDB
#undef PG8_MMA
#undef PG8_WAIT_V
#undef PG8_WAIT_L
#undef PG8_BAR
#undef PG8_SCHED
#undef PG8_UA
#undef PG8_UB
}
}
#ifndef DUP_MASK
#define DUP_MASK 0
#endif
#ifndef SIMPLE_PREP
#define SIMPLE_PREP 0
#endif
#ifndef PREP_PROBE
#define PREP_PROBE 0
#endif
#ifndef SIMPLE_SCAN
#define SIMPLE_SCAN 0
#endif
constexpr int NWAVES = 8;
constexpr int RING_OFF = 0, RING_BYTES = 131072;
constexpr int LDSCTL_OFF = RING_BYTES, MISC_OFF = LDSCTL_OFF + 320;
constexpr int XTRA_OFF = RING_BYTES + 1024;
constexpr int LDS_BYTES = 147456;
constexpr int CW_BAR = 4096;

#define GAS __attribute__((address_space(1)))
#define LAS __attribute__((address_space(3)))
typedef unsigned v4u __attribute__((ext_vector_type(4)));
typedef float f32x4 __attribute__((ext_vector_type(4)));
typedef GAS unsigned gu32;
#define LDS_WAIT() asm volatile("s_waitcnt lgkmcnt(0)" ::: "memory")
#define VM_WAIT() asm volatile("s_waitcnt vmcnt(0)" ::: "memory")
__device__ __forceinline__ unsigned pk2(float lo, float hi) { return (unsigned)f2bf(lo) | ((unsigned)f2bf(hi) << 16); }

#define XB_TMO      128
#define XB_XCNT(j)  (256  + 64 * (j))
#define XB_XSUB(j)  (1280 + 64 * (j))
#define XB_XGEN(j)  (2304 + 64 * (j))
#define XB_TOP      3328
#define XB_TOPGEN   3392
#define XCD_BAR_WORDS 3456
#define XB_SPIN_CAP (1u << 18)
__device__ __forceinline__ unsigned xb_ld(unsigned* p)              { return __hip_atomic_load(p, __ATOMIC_RELAXED, __HIP_MEMORY_SCOPE_AGENT); }
__device__ __forceinline__ unsigned xb_add(unsigned* p, unsigned v) { return __hip_atomic_fetch_add(p, v, __ATOMIC_RELAXED, __HIP_MEMORY_SCOPE_AGENT); }
__device__ __forceinline__ unsigned xb_xcc_id() { return (unsigned)__builtin_amdgcn_s_getreg((3 << 11) | 20) & 0xFu; }
#define XB_SPIN(cond, bar) do { unsigned _sp = 0; while (cond) { __builtin_amdgcn_s_sleep(1); \
    if ((++_sp & 255u) == 0u) { if (xb_ld(&(bar)[XB_TMO])) break; if (_sp > XB_SPIN_CAP) { atomicAdd(&(bar)[XB_TMO], 1u); break; } } } } while (0)
struct XcdBarrier { unsigned* bar; unsigned x; volatile LAS unsigned* st; };
__device__ __forceinline__ XcdBarrier xcd_barrier_post(unsigned* bar, volatile LAS unsigned* st) {
    XcdBarrier b; b.bar = bar; b.x = xb_xcc_id(); b.st = st;
    if (threadIdx.x == 0) (void)xb_add(&bar[XB_XCNT(b.x)], 1u);
    return b;
}
__device__ __forceinline__ void xcd_barrier_complete(unsigned* bar, unsigned x, unsigned& nloc, unsigned& nx) {
    const unsigned G = gridDim.x * gridDim.y * gridDim.z;
    unsigned sum, cnt, mine, sp = 0u;
    for (;;) {
        sum = 0u; cnt = 0u; mine = 0u;
#pragma unroll
        for (unsigned j = 0; j < 16; ++j) { const unsigned c = xb_ld(&bar[XB_XCNT(j)]); sum += c; cnt += (c > 0u) ? 1u : 0u; mine = (j == x) ? c : mine; }
        if (sum == G) break;
        __builtin_amdgcn_s_sleep(1);
        if ((++sp & 255u) == 0u) { if (xb_ld(&bar[XB_TMO])) break; if (sp > XB_SPIN_CAP) { atomicAdd(&bar[XB_TMO], 1u); break; } }
    }
    nloc = mine > 0u ? mine : 1u; nx = cnt > 0u ? cnt : 1u;
}
__device__ __forceinline__ void xcd_barrier(const XcdBarrier& b) {
    asm volatile("s_waitcnt vmcnt(0)" ::: "memory");
    __syncthreads();
    if (threadIdx.x == 0) {
        unsigned* bar = b.bar;
        __builtin_amdgcn_s_waitcnt(0);
        unsigned nloc = b.st[0], nx = b.st[1];
        if (nloc == 0u) { xcd_barrier_complete(bar, b.x, nloc, nx); b.st[0] = nloc; b.st[1] = nx; }
        const unsigned old = xb_add(&bar[XB_XSUB(b.x)], 1u);
        const unsigned gen = old / nloc;
        if (old + 1u == (gen + 1u) * nloc) {
            __builtin_amdgcn_fence(__ATOMIC_RELEASE, "agent");
            asm volatile("s_waitcnt vmcnt(0)" ::: "memory");
            const unsigned og = xb_add(&bar[XB_TOP], 1u);
            const unsigned tg = og / nx;
            if (og + 1u == (tg + 1u) * nx) xb_add(&bar[XB_TOPGEN], 1u);
            else XB_SPIN(xb_ld(&bar[XB_TOPGEN]) == tg, bar);
            __builtin_amdgcn_fence(__ATOMIC_ACQUIRE, "agent");
            xb_add(&bar[XB_XGEN(b.x)], 1u);
            asm volatile("s_waitcnt vmcnt(0)" ::: "memory");
        } else {
            XB_SPIN(xb_ld(&bar[XB_XGEN(b.x)]) == gen, bar);
            __builtin_amdgcn_fence(__ATOMIC_ACQUIRE, "agent");
            asm volatile("s_waitcnt vmcnt(0)" ::: "memory");
        }
    }
    __syncthreads();
}

struct Args { const float* in[14]; float* out; unsigned char* ws; int ph_lo, ph_hi; };

struct Frame {
    LAS unsigned char* lds; int tid, lane, wave, vcu, G;
};

__device__ __forceinline__ void p0_transpose_item(const float* __restrict__ W, int N, int k0, int n0, bf16_t* __restrict__ WT, int ldt, int dn0, int koff, LAS float* scr, int lane) {
#pragma unroll 8
    for (int i = 0; i < 32; ++i) { const int kk = 2 * i + (lane >> 5); scr[kk * 33 + (lane & 31)] = W[(size_t)(k0 + kk) * N + n0 + (lane & 31)]; }
    LDS_WAIT(); asm volatile("" ::: "memory");
    const int c = lane & 7;
#pragma unroll
    for (int j = 0; j < 4; ++j) { const int n = (lane >> 3) + 8 * j; const LAS float* s = scr + (8 * c) * 33 + n;
        v4u o; o.x = pk2(s[0 * 33], s[1 * 33]); o.y = pk2(s[2 * 33], s[3 * 33]); o.z = pk2(s[4 * 33], s[5 * 33]); o.w = pk2(s[6 * 33], s[7 * 33]);
        *(v4u*)(WT + (size_t)(dn0 + n) * ldt + koff + k0 + 8 * c) = o; }
    LDS_WAIT(); asm volatile("" ::: "memory");
}
__device__ __forceinline__ void p0_prologue(Frame& F, const Args& a) {
    unsigned char* ws = a.ws;
    bf16_t *WinT = (bf16_t*)(ws + WS_WINT), *W2T = (bf16_t*)(ws + WS_W2T), *WoT = (bf16_t*)(ws + WS_WOT), *MixT = (bf16_t*)(ws + WS_MIXT), *XN = (bf16_t*)(ws + WS_XN);
    LAS float* scr = (LAS float*)(F.lds + RING_OFF + F.wave * 16384);
    const int gw = F.vcu * NWAVES + F.wave, NGW = F.G * NWAVES;
    constexpr int I_IN = (DM / 64) * (INC / 32), I_PO = (PW / 64) * (DM / 32), I_DN = (DNW / 64) * (DM / 32), I_WO = (DM / 64) * (DM / 32), I_MX = 4 * (PGD / 64) * (PGD / 32);
    constexpr int NITEMS = I_IN + I_PO + I_DN + I_WO + I_MX;
    for (int it = gw; it < NITEMS; it += NGW) {
        int r = it;
        if (r < I_IN) { const int nblk = INC / 32, kb = r / nblk, nb = r % nblk, n0 = 32 * nb;
            const int dn0 = n0 < C_B ? n0 : (n0 < C_GP ? 14336 + (n0 - C_B) : n0 - 32);
            p0_transpose_item(a.in[3], INC, 64 * kb, n0, WinT, DM, dn0, 0, scr, F.lane); continue; } r -= I_IN;
        if (r < I_PO) { const int nblk = DM / 32, kb = r / nblk, nb = r % nblk; p0_transpose_item(a.in[10], DM, 64 * kb, 32 * nb, W2T, YLD, 32 * nb, 0, scr, F.lane); continue; } r -= I_PO;
        if (r < I_DN) { const int nblk = DM / 32, kb = r / nblk, nb = r % nblk; p0_transpose_item(a.in[11], DM, 64 * kb, 32 * nb, W2T, YLD, 32 * nb, 1024, scr, F.lane); continue; } r -= I_DN;
        if (r < I_WO) { const int nblk = DM / 32, kb = r / nblk, nb = r % nblk; p0_transpose_item(a.in[12], DM, 64 * kb, 32 * nb, WoT, DM, 32 * nb, 0, scr, F.lane); continue; } r -= I_WO;
        { const int g = r / 32, rr = r % 32, kb = rr / 8, nb = rr % 8;
          p0_transpose_item(a.in[7] + (size_t)g * PGD * PGD, PGD, 64 * kb, 32 * nb, MixT + (size_t)g * PGD * PGD, PGD, 32 * nb, 0, scr, F.lane); }
    }
    const float* nw = a.in[2];
    for (int r = gw; r < MPAD + (NPAD1 - INC); r += NGW) {
        if (r >= MROWS) { bf16_t* o = r < MPAD ? XN + (size_t)r * DM : WinT + (size_t)(INC + (r - MPAD)) * DM;
#pragma unroll
            for (int j = 0; j < 4; ++j) *(v4u*)(o + 8 * F.lane + 512 * j) = (v4u){0u, 0u, 0u, 0u};
            continue; }
        const float* src = r < MTOK ? a.in[0] + (size_t)r * DM : a.in[1] + (size_t)(r - MTOK) * DM;
        f32x4 v[8]; float s = 0.f;
#pragma unroll
        for (int j = 0; j < 8; ++j) { v[j] = *(const f32x4*)(src + 4 * F.lane + 256 * j); s += (v[j].x * v[j].x + v[j].y * v[j].y) + (v[j].z * v[j].z + v[j].w * v[j].w); }
        const float rs = rsqrtf(wave_sum(s) * (1.f / DM) + EPS);
        unsigned long long* o8 = (unsigned long long*)(XN + (size_t)r * DM) + F.lane;
#pragma unroll
        for (int j = 0; j < 8; ++j) { const f32x4 w = *(const f32x4*)(nw + 4 * F.lane + 256 * j);
            o8[64 * j] = (unsigned long long)pk2(v[j].x * rs * w.x, v[j].y * rs * w.y) | ((unsigned long long)pk2(v[j].z * rs * w.z, v[j].w * rs * w.w) << 32); }
    }
}

template <int WIN>
__device__ __forceinline__ void p2_pool_item(const bf16_t* __restrict__ U, bf16_t* __restrict__ PO, int g, int rb, int c) {
    const int b = rb >> 8, t0 = (rb & 255) * 8, col = g * 256 + c * 8;
    pg8::u32x4 raw[WIN + 7];
#pragma unroll
    for (int j = 0; j < WIN + 7; ++j) { const int t = t0 - (WIN - 1) + j; const int row = t >= 0 ? b * SEQ + t : MTOK + NMETA + t; raw[j] = *(const pg8::u32x4*)(U + (size_t)row * 1024 + col); }
    f32x4 s0 = (f32x4){0.f, 0.f, 0.f, 0.f}, s1 = s0;
#pragma unroll
    for (int j = 0; j < WIN - 1; ++j) { f32x4 x0, x1; pg8::unpack8(raw[j], x0, x1); s0 += x0; s1 += x1; }
    constexpr float inv = 1.f / (float)WIN;
#pragma unroll
    for (int i = 0; i < 8; ++i) { f32x4 x0, x1; pg8::unpack8(raw[WIN - 1 + i], x0, x1); s0 += x0; s1 += x1;
        *(pg8::u32x4*)(PO + (size_t)(b * SEQ + t0 + i) * 1024 + col) = pg8::pack8(s0 * inv - x0, s1 * inv - x1);
        f32x4 y0, y1; pg8::unpack8(raw[i], y0, y1); s0 -= y0; s1 -= y1; }
}
__device__ __forceinline__ void p2_pool(Frame& F, const Args& a) {
    const bf16_t* U = (const bf16_t*)(a.ws + WS_U); bf16_t* PO = (bf16_t*)(a.ws + WS_POOLED);
    const int gw = F.vcu * NWAVES + F.wave, NGW = F.G * NWAVES;
    for (int wi = gw; wi < 4 * 512; wi += NGW) {
        const int g = wi >> 9, rb = (wi & 511) * 2 + (F.lane >> 5), c = F.lane & 31;
        if (g == 0) p2_pool_item<2>(U, PO, 0, rb, c); else if (g == 1) p2_pool_item<4>(U, PO, 1, rb, c); else if (g == 2) p2_pool_item<8>(U, PO, 2, rb, c); else p2_pool_item<16>(U, PO, 3, rb, c);
    }
}
__device__ __forceinline__ void p2_chunk_prep_simple(Frame& F, const Args& a) {
    const bf16_t* QKV = (const bf16_t*)(a.ws + WS_QKV); const float* BA = (const float*)(a.ws + WS_BA);
    const float *conv_w = a.in[4], *A_log = a.in[5], *dt_bias = a.in[6];
    bf16_t *NW = (bf16_t*)(a.ws + WS_CH_NW), *UU = (bf16_t*)(a.ws + WS_CH_U), *QD = (bf16_t*)(a.ws + WS_CH_QD), *KDT = (bf16_t*)(a.ws + WS_CH_KDT), *QK = (bf16_t*)(a.ws + WS_CH_QK);
    float* GL = (float*)(a.ws + WS_CH_GL);
    LAS float* sm = (LAS float*)(F.lds + RING_OFF);
    LAS float *q = sm, *k = q + 8192, *v = k + 8192, *Am = v + 8192, *Tm = Am + 4096;
    LAS float *beta = (LAS float*)(F.lds + XTRA_OFF), *gc = beta + 64;
    const int tid = F.tid, lane = F.lane, wv = F.wave;
    for (int cu = F.vcu; cu < NUNITS; cu += F.G) {
        const int n = cu % NCH, bh = cu / NCH, h = bh % NH, b = bh / NH, p0 = CHUNK * n - PADF;
        for (int idx = tid; idx < 64 * 384; idx += 512) {
            const int i = idx / 384, c3 = idx % 384, which = c3 >> 7, d = c3 & 127, col = which * 2048 + h * HD + d, p = p0 + i;
            float val = 0.f;
            if (p >= 0) { float s = 0.f;
                for (int kk = 0; kk < 4; ++kk) { const int pp = p - 3 + kk; if (pp >= 0) s += conv_w[kk * 6144 + col] * bf2f(QKV[(size_t)ext_row(b, pp) * 6144 + col]); }
                val = siluf_(s); }
            (which == 0 ? q : which == 1 ? k : v)[i * 128 + d] = val;
        }
        if (tid < 64) { const int p = p0 + tid; float be = 0.f, g = 0.f;
            if (p >= 0) { const int r = ext_row(b, p); be = sigmoidf_(BA[(size_t)r * 32 + h]); g = -__expf(A_log[h]) * softplusf_(BA[(size_t)r * 32 + 16 + h] + dt_bias[h]); }
            beta[tid] = be; gc[tid] = g; }
        __syncthreads();
        if (tid == 0) { float s = 0.f; for (int i = 0; i < 64; ++i) { s += gc[i]; gc[i] = s; } }
        for (int r = wv; r < 128; r += 8) {
            LAS float* row = (r < 64 ? q + r * 128 : k + (r - 64) * 128);
            const float a0 = row[lane], a1 = row[lane + 64];
            const float rs = rsqrtf(wave_sum(a0 * a0 + a1 * a1) + EPS) * (r < 64 ? 0.08838834764831845f : 1.f);
            row[lane] = a0 * rs; row[lane + 64] = a1 * rs;
        }
        __syncthreads();
        bf16_t* oQK = QK + (size_t)cu * 4096;
        for (int idx = tid; idx < 4096; idx += 512) {
            const int i = idx >> 6, j = idx & 63; float akk = 0.f, aqk = 0.f;
            if (j <= i) { for (int d = 0; d < 128; ++d) { const float kj = k[j * 128 + d]; akk += k[i * 128 + d] * kj; aqk += q[i * 128 + d] * kj; }
                const float dec = __expf(gc[i] - gc[j]); akk *= beta[i] * dec; aqk *= dec; }
            Am[idx] = j < i ? akk : 0.f; oQK[idx] = f2bf(j <= i ? aqk : 0.f);
        }
        __syncthreads();
        if (tid < 64) { const int c = tid;
            for (int i = 0; i < 64; ++i) { float s = (i == c) ? 1.f : 0.f; for (int j = c; j < i; ++j) s -= Am[i * 64 + j] * Tm[j * 64 + c]; Tm[i * 64 + c] = (i >= c) ? s : 0.f; } }
        __syncthreads();
        bf16_t *oNW = NW + (size_t)cu * 8192, *oU = UU + (size_t)cu * 8192, *oQD = QD + (size_t)cu * 8192, *oKDT = KDT + (size_t)cu * 8192;
        const float gl = gc[63];
        for (int idx = tid; idx < 8192; idx += 512) {
            const int i = idx >> 7, d = idx & 127; float su = 0.f, sw = 0.f;
            for (int j = 0; j <= i; ++j) { const float t = Tm[i * 64 + j] * beta[j]; su += t * v[j * 128 + d]; sw += t * __expf(gc[j]) * k[j * 128 + d]; }
            oU[d * 64 + i] = f2bf(su); oNW[idx] = f2bf(-sw);
            oQD[idx] = f2bf(q[idx] * __expf(gc[i]));
            oKDT[d * 64 + i] = f2bf(k[idx] * __expf(gl - gc[i]));
        }
        if (tid == 0) GL[cu] = __expf(gl);
        __syncthreads();
    }
}

typedef short bf16x8_t __attribute__((ext_vector_type(8)));
typedef unsigned u32x2_t __attribute__((ext_vector_type(2)));
typedef unsigned u32x4_t __attribute__((ext_vector_type(4)));
__device__ __forceinline__ u32x2_t pack4bf(f32x4 v) { u32x2_t r; r.x = pg8::cvt_pk_bf16(v[0], v[1]); r.y = pg8::cvt_pk_bf16(v[2], v[3]); return r; }

constexpr int QS_LD = 272, KT_LD = 144, AM_LD = 68;
constexpr int L_QS = 0, L_KS = 17408, L_KT = 34816, L_VT = 53248, L_AM = 71680, L_TM = 89088, L_TB = 106496, L_TW = 115712, L_XS = 124928;
static_assert(L_XS + 3 * 1152 <= RING_BYTES, "chunk-prep LDS map");
__device__ __forceinline__ int ktoff(int d, int chunk) { return d * KT_LD + ((chunk ^ ((d >> 3) & 7)) << 4); }
struct PrepRaw { pg8::u32x4 x[11]; float pb, pa; };
template <int SKIP>
__device__ __forceinline__ void p2_chunk_prep_fast(Frame& F, const Args& a) {
    const bf16_t* QKV = (const bf16_t*)(a.ws + WS_QKV); const float* BA = (const float*)(a.ws + WS_BA);
    const float *conv_w = a.in[4], *A_log = a.in[5], *dt_bias = a.in[6];
    bf16_t *NW = (bf16_t*)(a.ws + WS_CH_NW), *UT = (bf16_t*)(a.ws + WS_CH_U), *QD = (bf16_t*)(a.ws + WS_CH_QD), *KDT = (bf16_t*)(a.ws + WS_CH_KDT), *QK = (bf16_t*)(a.ws + WS_CH_QK);
    float* GL = (float*)(a.ws + WS_CH_GL);
    LAS unsigned char* L = F.lds + RING_OFF;
    LAS float *Am = (LAS float*)(L + L_AM), *Tm = (LAS float*)(L + L_TM);
    LAS float *beta = (LAS float*)(F.lds + XTRA_OFF), *gc = beta + 64;
    const int w = F.wave;
    const int which = w >> 1; const bool cvt = w < 6;
    const int u_lo = (33 * F.vcu) / 4, u_hi = F.G == 256 ? (33 * (F.vcu + 1)) / 4 : 0;
#define PREP_LOAD(R, cu_) do { const int n_ = (cu_) % NCH, bh_ = (cu_) / NCH, h_ = bh_ % NH, b_ = bh_ / NH, colx = (which < 3 ? which : 2) * 2048 + h_ * HD + d8; \
        _Pragma("unroll") for (int j = 0; j < 11; ++j) { int pp = CHUNK * n_ - PADF + 8 * ib - 3 + j; pp = pp < 0 ? 0 : pp; (R).x[j] = *(const pg8::u32x4*)(QKV + (size_t)ext_row(b_, pp) * 6144 + colx); } \
        { int pl = CHUNK * n_ - PADF + lane; pl = pl < 0 ? 0 : pl; const float* bp = BA + (size_t)ext_row(b_, pl) * 32 + h_; (R).pb = bp[0]; (R).pa = bp[16]; } } while (0)
    LAS float* cw = (LAS float*)(F.lds + XTRA_OFF + 1024);
    PrepRaw raw; int hcur = -1;
    { const int lane = F.lane, fr = lane & 15, fq = lane >> 4, ib = (4 * w + fq) & 7, d8 = 8 * fr; if (u_lo < u_hi) PREP_LOAD(raw, u_lo); }
    for (int cu = u_lo; cu < u_hi; ++cu) {
        int lane = F.lane; asm volatile("" : "+v"(lane));
        const int fr = lane & 15, fq = lane >> 4, tid = w * 64 + lane, ib = (4 * w + fq) & 7, d8 = 8 * fr;
        const int n = cu % NCH, bh = cu / NCH, h = bh % NH, b = bh / NH, p0 = CHUNK * n - PADF;
        if (h != hcur) { hcur = h; for (int i = tid; i < 4 * 384; i += 512) { const int kk = i / 384, c = i % 384; cw[i] = conv_w[kk * 6144 + (c >> 7) * 2048 + h * HD + (c & 127)]; } __syncthreads(); }
        if (cvt && !(SKIP & 1)) {
            if (n == 0) {
#pragma unroll
                for (int j = 0; j < 11; ++j) { const bool ok = p0 + 8 * ib - 3 + j >= 0; raw.x[j].x = ok ? raw.x[j].x : 0u; raw.x[j].y = ok ? raw.x[j].y : 0u; raw.x[j].z = ok ? raw.x[j].z : 0u; raw.x[j].w = ok ? raw.x[j].w : 0u; } }
            f32x4 cwr[8];
#pragma unroll
            for (int kk = 0; kk < 4; ++kk) { cwr[2 * kk] = *(const LAS f32x4*)(cw + kk * 384 + which * 128 + d8); cwr[2 * kk + 1] = *(const LAS f32x4*)(cw + kk * 384 + which * 128 + d8 + 4); }
#pragma unroll
            for (int hb = 0; hb < 2; ++hb) {
                unsigned tr[4][4];
#pragma unroll
                for (int i4 = 0; i4 < 4; ++i4) { const int ii = 4 * hb + i4;
                    float v[8];
#pragma unroll
                    for (int j = 0; j < 8; ++j) v[j] = 0.f;
#pragma unroll
                    for (int kk = 0; kk < 4; ++kk) { f32x4 x0, x1; pg8::unpack8(raw.x[ii + kk], x0, x1);
#pragma unroll
                        for (int j = 0; j < 4; ++j) { v[j] += cwr[2 * kk][j] * x0[j]; v[4 + j] += cwr[2 * kk + 1][j] * x1[j]; } }
#pragma unroll
                    for (int j = 0; j < 8; ++j) v[j] = v[j] * pg8::fast_sigmoid(v[j]);
                    if (which < 2) { float ss = 0.f;
#pragma unroll
                        for (int j = 0; j < 8; ++j) ss += v[j] * v[j];
                        ss += __shfl_xor(ss, 1); ss += __shfl_xor(ss, 2); ss += __shfl_xor(ss, 4); ss += __shfl_xor(ss, 8);
                        const float rs = rsqrtf(ss + EPS) * (which == 0 ? 0.08838834764831845f : 1.f);
#pragma unroll
                        for (int j = 0; j < 8; ++j) v[j] *= rs; }
                    const pg8::u32x4 pk = pg8::pack8((f32x4){v[0], v[1], v[2], v[3]}, (f32x4){v[4], v[5], v[6], v[7]});
                    if (which < 2) *(LAS pg8::u32x4*)(L + (which == 0 ? L_QS : L_KS) + (8 * ib + ii) * QS_LD + d8 * 2) = pk;
                    tr[i4][0] = pk.x; tr[i4][1] = pk.y; tr[i4][2] = pk.z; tr[i4][3] = pk.w;
                }
                if (which >= 1) { LAS unsigned char* T = L + (which == 1 ? L_KT : L_VT) + 8 * hb;
#pragma unroll
                    for (int dj = 0; dj < 8; ++dj) { u32x2_t o; const int q = dj >> 1;
                        if (dj & 1) { o.x = (tr[0][q] >> 16) | (tr[1][q] & 0xffff0000u); o.y = (tr[2][q] >> 16) | (tr[3][q] & 0xffff0000u); }
                        else { o.x = (tr[0][q] & 0xffffu) | (tr[1][q] << 16); o.y = (tr[2][q] & 0xffffu) | (tr[3][q] << 16); }
                        *(LAS u32x2_t*)(T + ktoff(d8 + dj, ib)) = o; } }
            }
        }
        if (w == 7) {
            const int p = p0 + lane; float be = 0.f, g = 0.f;
            if (p >= 0) { be = sigmoidf_(raw.pb); g = -__expf(A_log[h]) * softplusf_(raw.pa + dt_bias[h]); }
#pragma unroll
            for (int o = 1; o < 64; o <<= 1) { const float t = __shfl_up(g, o); if (lane >= o) g += t; }
            beta[lane] = be; gc[lane] = g;
        }
        __syncthreads();
        PREP_LOAD(raw, cu + 1 < u_hi ? cu + 1 : cu);
        const float gl = gc[63];
        if (!(SKIP & 2)) {
            const int kind = w >> 2, ti = w & 3;
            bf16x8_t af[4];
#pragma unroll
            for (int ks = 0; ks < 4; ++ks) af[ks] = *(const LAS bf16x8_t*)(L + L_KS + (16 * ti + fr) * QS_LD + (32 * ks + 8 * fq) * 2);
            bf16_t* oQK = QK + (size_t)cu * 4096;
#pragma unroll
            for (int tj = 0; tj < 4; ++tj) {
                if (kind == 0) {
                    if (tj > ti) continue;
                    f32x4 acc = (f32x4){0.f, 0.f, 0.f, 0.f};
#pragma unroll
                    for (int ks = 0; ks < 4; ++ks) acc = __builtin_amdgcn_mfma_f32_16x16x32_bf16(af[ks], *(const LAS bf16x8_t*)(L + L_KS + (16 * tj + fr) * QS_LD + (32 * ks + 8 * fq) * 2), acc, 0, 0, 0);
                    const int j = 16 * tj + fr; const float gj = gc[j]; const f32x4 gi4 = *(const LAS f32x4*)(gc + 16 * ti + 4 * fq), bi4 = *(const LAS f32x4*)(beta + 16 * ti + 4 * fq);
#pragma unroll
                    for (int r = 0; r < 4; ++r) { const int i = 16 * ti + 4 * fq + r; const float m = (tj < ti || fr < 4 * fq + r) ? 1.f : 0.f; Am[i * AM_LD + j] = acc[r] * bi4[r] * __expf(fminf(gi4[r] - gj, 0.f)) * m; }
                } else {
                    const int i = 16 * tj + fr; u32x2_t o = (u32x2_t){0u, 0u};
                    if (tj >= ti) {
                        f32x4 acc = (f32x4){0.f, 0.f, 0.f, 0.f};
#pragma unroll
                        for (int ks = 0; ks < 4; ++ks) acc = __builtin_amdgcn_mfma_f32_16x16x32_bf16(af[ks], *(const LAS bf16x8_t*)(L + L_QS + (16 * tj + fr) * QS_LD + (32 * ks + 8 * fq) * 2), acc, 0, 0, 0);
                        const float gi = gc[i]; const f32x4 gj4 = *(const LAS f32x4*)(gc + 16 * ti + 4 * fq);
#pragma unroll
                        for (int r = 0; r < 4; ++r) { const float m = (tj > ti || 4 * fq + r <= fr) ? 1.f : 0.f; acc[r] = acc[r] * __expf(fminf(gi - gj4[r], 0.f)) * m; }
                        o = pack4bf(acc);
                    }
                    *(u32x2_t*)(oQK + i * 64 + 16 * ti + 4 * fq) = o;
                }
            }
        }
        __syncthreads();
        if (SKIP & 4) {} else if (w == 0) {
            const int ab = fq, c = fr; float t[16];
#pragma unroll
            for (int r = 0; r < 16; ++r) { float s = (r == c) ? 1.f : 0.f;
#pragma unroll
                for (int m4 = 0; m4 < (r + 3) / 4; ++m4) { const f32x4 av = *(const LAS f32x4*)(Am + (16 * ab + r) * AM_LD + 16 * ab + 4 * m4);
#pragma unroll
                    for (int j = 0; j < 4; ++j) if (4 * m4 + j < r) s -= av[j] * t[4 * m4 + j]; }
                t[r] = s; Tm[(16 * ab + r) * AM_LD + 16 * ab + c] = s; }
        } else {
            bf16_t *oQD = QD + (size_t)cu * 8192, *oKDT = KDT + (size_t)cu * 8192;
            for (int idx = tid - 64; idx < 2048; idx += 448) {
                if (idx < 1024) { const int i = idx >> 4, d8 = (idx & 15) * 8; pg8::f32x4 x0, x1; pg8::unpack8(*(const LAS pg8::u32x4*)(L + L_QS + i * QS_LD + d8 * 2), x0, x1);
                    const float e = __expf(gc[i]); *(pg8::u32x4*)(oQD + i * 128 + d8) = pg8::pack8(x0 * e, x1 * e); }
                else { const int id = idx - 1024, d = id >> 3, i8 = (id & 7) * 8; pg8::f32x4 x0, x1; pg8::unpack8(*(const LAS pg8::u32x4*)(L + L_KT + ktoff(d, i8 >> 3)), x0, x1);
#pragma unroll
                    for (int j = 0; j < 4; ++j) { x0[j] *= __expf(gl - gc[i8 + j]); x1[j] *= __expf(gl - gc[i8 + 4 + j]); }
                    *(pg8::u32x4*)(oKDT + d * 64 + i8) = pg8::pack8(x0, x1); }
            }
            if (tid == 64) GL[cu] = __expf(gl);
        }
        __syncthreads();
#pragma unroll
        for (int dd = 1; dd < 4; ++dd) {
            if (w < 4 - dd && !(SKIP & 8)) {
                const int bb = w, ab = w + dd;
                f32x4 acc = (f32x4){0.f, 0.f, 0.f, 0.f};
                for (int c = bb; c < ab; ++c)
#pragma unroll
                    for (int ks = 0; ks < 4; ++ks) acc = __builtin_amdgcn_mfma_f32_16x16x4f32(Am[(16 * ab + fr) * AM_LD + 16 * c + 4 * ks + fq], Tm[(16 * c + 4 * ks + fq) * AM_LD + 16 * bb + fr], acc, 0, 0, 0);
                LAS float* Xs = (LAS float*)(L + L_XS + w * 1152);
#pragma unroll
                for (int r = 0; r < 4; ++r) Xs[(4 * fq + r) * 17 + fr] = acc[r];
                f32x4 acc2 = (f32x4){0.f, 0.f, 0.f, 0.f};
#pragma unroll
                for (int ks = 0; ks < 4; ++ks) acc2 = __builtin_amdgcn_mfma_f32_16x16x4f32(Tm[(16 * ab + fr) * AM_LD + 16 * ab + 4 * ks + fq], Xs[(4 * ks + fq) * 17 + fr], acc2, 0, 0, 0);
#pragma unroll
                for (int r = 0; r < 4; ++r) Tm[(16 * ab + 4 * fq + r) * AM_LD + 16 * bb + fr] = -acc2[r];
            }
            __syncthreads();
        }
        if (!(SKIP & 16)) { const int i = tid >> 3, j8 = (tid & 7) * 8; f32x4 t0 = *(const LAS f32x4*)(Tm + i * AM_LD + j8), t1 = *(const LAS f32x4*)(Tm + i * AM_LD + j8 + 4); f32x4 b0, b1, w0, w1;
#pragma unroll
            for (int j = 0; j < 4; ++j) { const int ja = j8 + j, jb = j8 + 4 + j; const float ba = beta[ja], bb = beta[jb];
                b0[j] = ja <= i ? t0[j] * ba : 0.f; b1[j] = jb <= i ? t1[j] * bb : 0.f; w0[j] = b0[j] * __expf(gc[ja]); w1[j] = b1[j] * __expf(gc[jb]); }
            *(LAS pg8::u32x4*)(L + L_TB + i * KT_LD + j8 * 2) = pg8::pack8(b0, b1); *(LAS pg8::u32x4*)(L + L_TW + i * KT_LD + j8 * 2) = pg8::pack8(w0, w1); }
        __syncthreads();
        if (!(SKIP & 16)) {
            bf16_t *oU = UT + (size_t)cu * 8192, *oNW = NW + (size_t)cu * 8192;
            bf16x8_t vf[2], kf[2];
#pragma unroll
            for (int ks = 0; ks < 2; ++ks) { vf[ks] = *(const LAS bf16x8_t*)(L + L_VT + ktoff(16 * w + fr, 4 * ks + fq)); kf[ks] = *(const LAS bf16x8_t*)(L + L_KT + ktoff(16 * w + fr, 4 * ks + fq)); }
#pragma unroll
            for (int mi = 0; mi < 4; ++mi) {
                f32x4 au = (f32x4){0.f, 0.f, 0.f, 0.f}, aw = (f32x4){0.f, 0.f, 0.f, 0.f};
#pragma unroll
                for (int ks = 0; ks < 2; ++ks) {
                    au = __builtin_amdgcn_mfma_f32_16x16x32_bf16(*(const LAS bf16x8_t*)(L + L_TB + (16 * mi + fr) * KT_LD + (32 * ks + 8 * fq) * 2), vf[ks], au, 0, 0, 0);
                    aw = __builtin_amdgcn_mfma_f32_16x16x32_bf16(kf[ks], *(const LAS bf16x8_t*)(L + L_TW + (16 * mi + fr) * KT_LD + (32 * ks + 8 * fq) * 2), aw, 0, 0, 0);
                }
                *(u32x2_t*)(oU + (16 * w + fr) * 64 + 16 * mi + 4 * fq) = pack4bf(au);
                *(u32x2_t*)(oNW + (16 * mi + fr) * 128 + 16 * w + 4 * fq) = pack4bf(-aw);
            }
        }
        __syncthreads();
    }
#undef PREP_LOAD
}

__device__ __forceinline__ void p3_scan_simple(Frame& F, const Args& a) {
    const bf16_t *NW = (const bf16_t*)(a.ws + WS_CH_NW), *UU = (const bf16_t*)(a.ws + WS_CH_U), *QD = (const bf16_t*)(a.ws + WS_CH_QD), *KDT = (const bf16_t*)(a.ws + WS_CH_KDT), *QK = (const bf16_t*)(a.ws + WS_CH_QK);
    const float* GL = (const float*)(a.ws + WS_CH_GL); bf16_t* O = (bf16_t*)(a.ws + WS_O);
    LAS float* sm = (LAS float*)(F.lds + RING_OFF);
    LAS float *nw = sm, *qd = sm + 8192, *kd = sm + 16384, *vn = sm + 24576;
    const int tid = F.tid, e = (tid >> 6) * 32 + (tid & 31), half = (tid >> 5) & 1, db = 64 * half; const bool act = tid < 256;
    for (int bh = F.vcu; bh < NB * NH; bh += F.G) {
        const int h = bh % NH, b = bh / NH;
        float S[64];
#pragma unroll
        for (int d = 0; d < 64; ++d) S[d] = 0.f;
        for (int n = 0; n < NCH; ++n) {
            const int cu = bh * NCH + n;
            for (int idx = tid; idx < 8192; idx += 512) { nw[idx] = bf2f(NW[(size_t)cu * 8192 + idx]); qd[idx] = bf2f(QD[(size_t)cu * 8192 + idx]);
                const int d = idx >> 6, i = idx & 63; kd[i * 128 + d] = bf2f(KDT[(size_t)cu * 8192 + idx]); }
            __syncthreads();
            const float gl = GL[cu];
            if (act) for (int i = 0; i < 64; ++i) { float s = 0.f;
#pragma unroll
                for (int d = 0; d < 64; ++d) s += nw[i * 128 + db + d] * S[d];
                s += __shfl_xor(s, 32); s += bf2f(UU[(size_t)cu * 8192 + e * 64 + i]);
                if (half == 0) vn[i * 128 + e] = s; }
            __syncthreads();
            if (act) {
                if (n > 0) for (int i = 0; i < 64; ++i) { float s = 0.f;
#pragma unroll
                    for (int d = 0; d < 64; ++d) s += qd[i * 128 + db + d] * S[d];
                    s += __shfl_xor(s, 32);
                    for (int j = 0; j <= i; ++j) s += bf2f(QK[(size_t)cu * 4096 + i * 64 + j]) * vn[j * 128 + e];
                    if (half == 0) O[(size_t)(b * SEQ + 64 * (n - 1) + i) * DNW + h * HD + e] = f2bf(s); }
#pragma unroll
                for (int d = 0; d < 64; ++d) S[d] *= gl;
                for (int i = 0; i < 64; ++i) { const float vi = vn[i * 128 + e];
#pragma unroll
                    for (int d = 0; d < 64; ++d) S[d] += kd[i * 128 + db + d] * vi; }
            }
            __syncthreads();
        }
    }
}


struct ScanOps { bf16x8_t a[4], x[2], kd[2]; float gl; };
constexpr int ST_LD = 272, VT_LD = 144;
template <int PROBE>
__device__ __forceinline__ void p3_scan_fast(Frame& F, const Args& a) {
    const bf16_t *NW = (const bf16_t*)(a.ws + WS_CH_NW), *UT = (const bf16_t*)(a.ws + WS_CH_U), *QD = (const bf16_t*)(a.ws + WS_CH_QD), *KDT = (const bf16_t*)(a.ws + WS_CH_KDT), *QK = (const bf16_t*)(a.ws + WS_CH_QK);
    const float* GL = (const float*)(a.ws + WS_CH_GL); bf16_t* O = (bf16_t*)(a.ws + (PROBE ? WS_Y : WS_O));
    LAS unsigned char* ST = F.lds + RING_OFF; LAS unsigned char* VT = ST + 32 * ST_LD;
    const int w = F.wave, lane = F.lane, fr = lane & 15, fq = lane >> 4, mt = w & 3; const bool vw = w < 4;
    for (int unit = F.vcu; unit < NB * NH * 4; unit += F.G) {
        const int bh = unit >> 2, s = unit & 3, h = bh % NH, b = bh / NH;
        f32x4 accS[2] = {(f32x4){0.f, 0.f, 0.f, 0.f}, (f32x4){0.f, 0.f, 0.f, 0.f}};
        for (int i = F.tid; i < 32 * ST_LD / 4; i += 512) ((LAS unsigned*)ST)[i] = 0u;
        __syncthreads();
        const bf16_t* Asrc = (vw ? NW : QD) + (16 * mt + fr) * 128 + 8 * fq;
        const bf16_t* Ksrc = KDT + (16 * w + fr) * 64 + 8 * fq;
        const bf16_t* Xsrc = vw ? UT + (32 * s + fr) * 64 + 16 * mt + 8 * (fq >> 1) : QK + (16 * mt + fr) * 64 + 8 * fq;
        const size_t xstride = vw ? 8192 : 4096; const int xstep = vw ? 16 * 64 : 32; const bool hiq = (fq & 1) != 0;
#define SCAN_LOAD(ops, n_) do { const size_t cu_ = (size_t)(bh * NCH + (PROBE != 0 ? 0 : (n_))); \
        _Pragma("unroll") for (int ks = 0; ks < 4; ++ks) (ops).a[ks] = *(const bf16x8_t*)(Asrc + cu_ * 8192 + 32 * ks); \
        _Pragma("unroll") for (int ks = 0; ks < 2; ++ks) (ops).kd[ks] = *(const bf16x8_t*)(Ksrc + cu_ * 8192 + 32 * ks); \
        (ops).x[0] = *(const bf16x8_t*)(Xsrc + cu_ * xstride); (ops).x[1] = *(const bf16x8_t*)(Xsrc + cu_ * xstride + xstep); \
        (ops).gl = GL[cu_]; } while (0)
#define SCAN_STEP(ops, n_) do { \
        f32x4 acc[2]; \
        _Pragma("unroll") for (int n2 = 0; n2 < 2; ++n2) { const unsigned u0_ = hiq ? (unsigned)__builtin_bit_cast(u32x4_t, (ops).x[n2]).z : (unsigned)__builtin_bit_cast(u32x4_t, (ops).x[n2]).x, u1_ = hiq ? (unsigned)__builtin_bit_cast(u32x4_t, (ops).x[n2]).w : (unsigned)__builtin_bit_cast(u32x4_t, (ops).x[n2]).y; \
            acc[n2] = vw ? (f32x4){__uint_as_float(u0_ << 16), __uint_as_float(u0_ & 0xffff0000u), __uint_as_float(u1_ << 16), __uint_as_float(u1_ & 0xffff0000u)} : (f32x4){0.f, 0.f, 0.f, 0.f}; } \
        _Pragma("unroll") for (int ks = 0; ks < 4; ++ks) _Pragma("unroll") for (int n2 = 0; n2 < 2; ++n2) \
            acc[n2] = __builtin_amdgcn_mfma_f32_16x16x32_bf16((ops).a[ks], *(const LAS bf16x8_t*)(ST + (16 * n2 + fr) * ST_LD + (32 * ks + 8 * fq) * 2), acc[n2], 0, 0, 0); \
        if (vw) { _Pragma("unroll") for (int n2 = 0; n2 < 2; ++n2) *(LAS u32x2_t*)(VT + (16 * n2 + fr) * VT_LD + (16 * mt + 4 * fq) * 2) = pack4bf(acc[n2]); } \
        __syncthreads(); \
        bf16x8_t bV[2][2]; \
        _Pragma("unroll") for (int n2 = 0; n2 < 2; ++n2) _Pragma("unroll") for (int ks = 0; ks < 2; ++ks) bV[n2][ks] = *(const LAS bf16x8_t*)(VT + (16 * n2 + fr) * VT_LD + (32 * ks + 8 * fq) * 2); \
        if (!vw) { _Pragma("unroll") for (int n2 = 0; n2 < 2; ++n2) _Pragma("unroll") for (int ks = 0; ks < 2; ++ks) acc[n2] = __builtin_amdgcn_mfma_f32_16x16x32_bf16((ops).x[ks], bV[n2][ks], acc[n2], 0, 0, 0); \
            if ((n_) > 0 && PROBE != 2) { bf16_t* op = O + (size_t)(b * SEQ + 64 * ((n_) - 1) + 16 * mt + 4 * fq) * DNW + h * HD + 32 * s + fr; \
                _Pragma("unroll") for (int n2 = 0; n2 < 2; ++n2) _Pragma("unroll") for (int r = 0; r < 4; ++r) op[(size_t)r * DNW + 16 * n2] = f2bf(acc[n2][r]); } } \
        _Pragma("unroll") for (int n2 = 0; n2 < 2; ++n2) { accS[n2] = accS[n2] * (ops).gl; \
            _Pragma("unroll") for (int ks = 0; ks < 2; ++ks) accS[n2] = __builtin_amdgcn_mfma_f32_16x16x32_bf16((ops).kd[ks], bV[n2][ks], accS[n2], 0, 0, 0); \
            *(LAS u32x2_t*)(ST + (16 * n2 + fr) * ST_LD + (16 * w + 4 * fq) * 2) = pack4bf(accS[n2]); } \
        __syncthreads(); } while (0)
        ScanOps opA, opB, opC;
        SCAN_LOAD(opA, 0); SCAN_LOAD(opB, 1);
        for (int n = 0; n < NCH; n += 3) {
            SCAN_LOAD(opC, n + 2); SCAN_STEP(opA, n);
            SCAN_LOAD(opA, n + 3 < NCH ? n + 3 : NCH - 1); SCAN_STEP(opB, n + 1);
            SCAN_LOAD(opB, n + 4 < NCH ? n + 4 : NCH - 1); SCAN_STEP(opC, n + 2);
        }
#undef SCAN_LOAD
#undef SCAN_STEP
    }
}

__device__ __forceinline__ void p3b_gnorm(Frame& F, const Args& a) {
    const bf16_t *O = (const bf16_t*)(a.ws + WS_O), *SZD = (const bf16_t*)(a.ws + WS_SZD); bf16_t* Y = (bf16_t*)(a.ws + WS_Y); const float* w = a.in[9];
    const int gw = F.vcu * NWAVES + F.wave, NGW = F.G * NWAVES, lane = F.lane;
    const f32x4 w0 = *(const f32x4*)(w + 8 * (lane & 15)), w1 = *(const f32x4*)(w + 8 * (lane & 15) + 4);
    for (int r = gw; r < MTOK; r += NGW) {
        pg8::u32x4 ov[4], zv[4];
#pragma unroll
        for (int j = 0; j < 4; ++j) { ov[j] = *(const pg8::u32x4*)(O + (size_t)r * DNW + 512 * j + 8 * lane); zv[j] = *(const pg8::u32x4*)(SZD + (size_t)r * DNW + 512 * j + 8 * lane); }
#pragma unroll
        for (int j = 0; j < 4; ++j) { f32x4 o0, o1, z0, z1; pg8::unpack8(ov[j], o0, o1); pg8::unpack8(zv[j], z0, z1);
            float ss = (o0[0] * o0[0] + o0[1] * o0[1]) + (o0[2] * o0[2] + o0[3] * o0[3]) + (o1[0] * o1[0] + o1[1] * o1[1]) + (o1[2] * o1[2] + o1[3] * o1[3]);
            ss += __shfl_xor(ss, 1); ss += __shfl_xor(ss, 2); ss += __shfl_xor(ss, 4); ss += __shfl_xor(ss, 8);
            const float rs = rsqrtf(ss * (1.f / HD) + EPS);
            *(pg8::u32x4*)(Y + (size_t)r * YLD + 1024 + 512 * j + 8 * lane) = pg8::pack8(o0 * rs * w0 * z0, o1 * rs * w1 * z1); }
    }
}

__device__ __forceinline__ void p6_final(Frame& F, const Args& a) {
    const float* w = a.in[13]; float* out = a.out;
    const int gw = F.vcu * NWAVES + F.wave, NGW = F.G * NWAVES;
    for (int r = gw; r < MTOK; r += NGW) {
        float* row = out + (size_t)r * DM;
        f32x4 v[8]; float s = 0.f;
#pragma unroll
        for (int j = 0; j < 8; ++j) { v[j] = *(const f32x4*)(row + 4 * F.lane + 256 * j); s += (v[j].x * v[j].x + v[j].y * v[j].y) + (v[j].z * v[j].z + v[j].w * v[j].w); }
        const float rs = rsqrtf(wave_sum(s) * (1.f / DM) + EPS);
#pragma unroll
        for (int j = 0; j < 8; ++j) { const f32x4 ww = *(const f32x4*)(w + 4 * F.lane + 256 * j); *(f32x4*)(row + 4 * F.lane + 256 * j) = v[j] * rs * ww; }
    }
}

struct PoolMixOrder {
    int G, c;
    __device__ bool next(int i, pg8::Unit& u) const { const int L = i * G + c; if (L >= 128) return false; u.pm = L >> 2; u.pn = L & 3; u.aoff = (L & 3) * 256; u.boff = 0; u.nt = 4; u.mode = 0; return true; }
};
struct MergeOrder {
    pg8::StaticOrder so;
    __device__ bool next(int i, pg8::Unit& u) const { if (!so.next(i >> 1, u)) return false; if ((i & 1) == 0) { u.nt = 16; u.mode = 0; } else { u.aoff = 1024; u.boff = 1024; u.nt = 32; u.mode = 1; } return true; }
};

constexpr int NPHASE = 8;
__global__ void __launch_bounds__(NWAVES * 64, 2) mega_fwd(Args args) {
    extern __shared__ __attribute__((aligned(16))) unsigned char lds[];
    Frame F;
    F.lds = (LAS unsigned char*)lds;
    F.tid = threadIdx.x; F.lane = F.tid & 63; F.wave = __builtin_amdgcn_readfirstlane(F.tid >> 6);
    F.G = gridDim.x; { const int bx = blockIdx.x; F.vcu = (F.G % 8 == 0) ? (bx % 8) * (F.G / 8) + bx / 8 : bx; }
    unsigned char* ws = args.ws;
    for (int u = F.tid; u < (LDS_BYTES - LDSCTL_OFF) / 4; u += NWAVES * 64) ((LAS unsigned*)(F.lds + LDSCTL_OFF))[u] = 0u;
    __syncthreads();
    const int lo = args.ph_lo, hi = args.ph_hi;
    XcdBarrier bar; bar.bar = (unsigned*)(ws + WS_CTL) + CW_BAR; bar.x = 0; bar.st = nullptr;
    if (hi - lo > 1 || DUP_MASK) bar = xcd_barrier_post((unsigned*)(ws + WS_CTL) + CW_BAR, (volatile LAS unsigned*)(F.lds + MISC_OFF) + 8);
#define DUP(k) ((DUP_MASK >> (k)) & 1)
#define PHASE(k, ...) do { if (lo <= (k) && (k) < hi) { __VA_ARGS__ if (DUP(k)) { xcd_barrier(bar); __VA_ARGS__ } if ((k) + 1 < hi) xcd_barrier(bar); } } while (0)
    PHASE(0, p0_prologue(F, args););
    PHASE(1, {
        pg8::Gemm g{(const bf16_t*)(ws + WS_XN), (const bf16_t*)(ws + WS_WINT), DM, DM}; pg8::StaticOrder S; S.init(MPAD / 256, NPAD1 / 256, DM / 64, F.G, (int)blockIdx.x);
        pg8::EpiProj E{(bf16_t*)(ws + WS_U), (bf16_t*)(ws + WS_SZP), (bf16_t*)(ws + WS_QKV), (bf16_t*)(ws + WS_SZD), (bf16_t*)(ws + WS_GATES), (float*)(ws + WS_BA)};
        pg8::gemm_phase<pg8::EpiProj, pg8::StaticOrder, true>(F.lds + RING_OFF, g, S, E); });
    PHASE(2, p2_pool(F, args); if (SIMPLE_PREP) p2_chunk_prep_simple(F, args); else { if (PREP_PROBE) p2_chunk_prep_fast<PREP_PROBE>(F, args); p2_chunk_prep_fast<0>(F, args); });
    #ifndef SCAN_PROBE
#define SCAN_PROBE 0
#endif
    PHASE(3, if (SIMPLE_SCAN) p3_scan_simple(F, args); else { if (SCAN_PROBE) p3_scan_fast<SCAN_PROBE>(F, args); p3_scan_fast<0>(F, args); });
    PHASE(4, {
        p3b_gnorm(F, args);
        pg8::Gemm g{(const bf16_t*)(ws + WS_POOLED), (const bf16_t*)(ws + WS_MIXT), PW, PGD}; PoolMixOrder S{F.G, F.vcu};
        pg8::EpiPoolMix E{(bf16_t*)(ws + WS_Y), (const bf16_t*)(ws + WS_SZP), args.in[8]};
        pg8::gemm_phase<pg8::EpiPoolMix, PoolMixOrder, false>(F.lds + RING_OFF, g, S, E); });
    PHASE(5, {
        pg8::Gemm g{(const bf16_t*)(ws + WS_Y), (const bf16_t*)(ws + WS_W2T), YLD, YLD}; MergeOrder S; S.so.init(MTOK / 256, DM / 256, 0, F.G, (int)blockIdx.x);
        pg8::EpiMerge E{(const bf16_t*)(ws + WS_GATES), (bf16_t*)(ws + WS_MERGED)};
        pg8::gemm_phase<pg8::EpiMerge, MergeOrder, false>(F.lds + RING_OFF, g, S, E); });
    PHASE(6, {
        pg8::Gemm g{(const bf16_t*)(ws + WS_MERGED), (const bf16_t*)(ws + WS_WOT), DM, DM}; pg8::StaticOrder S; S.init(MTOK / 256, DM / 256, DM / 64, F.G, (int)blockIdx.x);
        pg8::EpiResid E{args.in[0], args.out};
        pg8::gemm_phase<pg8::EpiResid, pg8::StaticOrder, false>(F.lds + RING_OFF, g, S, E); });
    PHASE(7, p6_final(F, args););
#undef PHASE
#undef DUP
}
#ifndef MIX
#define MIX 0
#endif
#ifndef NAIVE_MASK
#define NAIVE_MASK 0
#endif
#ifndef FUSE
#define FUSE 1
#endif
extern "C" void kernel_launch(void* const* d_in, const int* in_sizes, int n_in, void* d_out, int out_size, void* d_ws, size_t ws_size, hipStream_t stream) {
    static int grid = 0;
    if (grid == 0) {
        if (n_in != 14 || in_sizes[0] != MTOK * DM || out_size != MTOK * DM || ws_size < WS_END) { fprintf(stderr, "kernel_launch: unexpected shapes / workspace (%zu < %zu); nothing launched\n", ws_size, (size_t)WS_END); grid = -1; return; }
        int dev = 0, cus = 0;
        if (hipGetDevice(&dev) != hipSuccess || hipDeviceGetAttribute(&cus, hipDeviceAttributeMultiprocessorCount, dev) != hipSuccess) { grid = -1; return; }
        if (hipFuncSetAttribute((const void*)mega_fwd, hipFuncAttributeMaxDynamicSharedMemorySize, LDS_BYTES) != hipSuccess) { fprintf(stderr, "kernel_launch: hipFuncSetAttribute failed\n"); grid = -1; return; }
#if MIX
        if (hipFuncSetAttribute((const void*)nv_chunk_prep, hipFuncAttributeMaxDynamicSharedMemorySize, 140 * 1024) != hipSuccess) { grid = -1; return; }
#endif
        (void)hipGetLastError();
        grid = cus;
    }
    if (grid < 0) return;
    if (hipMemsetAsync((char*)d_ws + WS_CTL, 0, CTL_ZERO_BYTES, stream) != hipSuccess) return;
    Args a{};
    for (int i = 0; i < 14; ++i) a.in[i] = (const float*)d_in[i];
    a.out = (float*)d_out; a.ws = (unsigned char*)d_ws;
#if !MIX
    a.ph_lo = 0; a.ph_hi = NPHASE;
    hipLaunchKernelGGL(mega_fwd, dim3(grid), dim3(NWAVES * 64), LDS_BYTES, stream, a);
#else
    const float *x = a.in[0], *meta = a.in[1], *norm_w = a.in[2], *w_in = a.in[3], *conv_w = a.in[4], *A_log = a.in[5], *dt_bias = a.in[6], *pool_mix = a.in[7], *pool_scale = a.in[8],
                *dn_norm_w = a.in[9], *w_pool_out = a.in[10], *w_dn_out = a.in[11], *w_o = a.in[12], *final_norm_w = a.in[13];
    unsigned char* ws = (unsigned char*)d_ws; float* out = (float*)d_out;
    bf16_t *XN = (bf16_t*)(ws + WS_XN), *U = (bf16_t*)(ws + WS_U), *SZP = (bf16_t*)(ws + WS_SZP), *QKV = (bf16_t*)(ws + WS_QKV), *SZD = (bf16_t*)(ws + WS_SZD), *GATES = (bf16_t*)(ws + WS_GATES);
    float* BA = (float*)(ws + WS_BA);
    bf16_t *Y = (bf16_t*)(ws + WS_Y), *PO = (bf16_t*)(ws + WS_POOLED), *O = (bf16_t*)(ws + WS_O), *MG = (bf16_t*)(ws + WS_MERGED);
    bf16_t *cNW = (bf16_t*)(ws + WS_CH_NW), *cU = (bf16_t*)(ws + WS_CH_U), *cQD = (bf16_t*)(ws + WS_CH_QD), *cKDT = (bf16_t*)(ws + WS_CH_KDT), *cQK = (bf16_t*)(ws + WS_CH_QK);
    float* cGL = (float*)(ws + WS_CH_GL);
    int s = 0;
    while (s < NPHASE) {
        if (!((NAIVE_MASK >> s) & 1)) {
            int e = s + 1;
            if (FUSE) while (e < NPHASE && !((NAIVE_MASK >> e) & 1)) ++e;
            a.ph_lo = s; a.ph_hi = e;
            hipLaunchKernelGGL(mega_fwd, dim3(grid), dim3(NWAVES * 64), LDS_BYTES, stream, a);
            s = e; continue;
        }
        switch (s) {
        case 0: nv_prep<<<1024, 256, 0, stream>>>(x, meta, norm_w, XN); break;
        case 1: nv_gemm<EpiProj><<<dim3((INC + 127) / 128, (MROWS + 127) / 128), 256, 0, stream>>>(XN, DM, w_in, INC, MROWS, INC, DM, EpiProj{U, SZP, QKV, SZD, GATES, BA}); break;
        case 2: nv_pool<<<MTOK * PW / 256, 256, 0, stream>>>(U, PO);
                nv_chunk_prep<<<NUNITS, 256, 140 * 1024, stream>>>(QKV, BA, conv_w, A_log, dt_bias, cNW, cU, cQD, cKDT, cQK, cGL); break;
        case 3: nv_chunk_scan<<<NB * NH, 128, 0, stream>>>(cNW, cU, cQD, cKDT, cQK, cGL, O); break;
        case 4: nv_gnorm<<<MTOK * NH / 4, 256, 0, stream>>>(O, SZD, dn_norm_w, Y);
                for (int g = 0; g < 4; ++g)
                    nv_gemm<EpiPool><<<dim3(2, MTOK / 128), 256, 0, stream>>>(PO + g * PGD, PW, pool_mix + (size_t)g * PGD * PGD, PGD, MTOK, PGD, PGD, EpiPool{Y, SZP, pool_scale, g, 0});
                break;
        case 5: nv_gemm<EpiG2a><<<dim3(DM / 128, MTOK / 128), 256, 0, stream>>>(Y, YLD, w_pool_out, DM, MTOK, DM, PW, EpiG2a{out, GATES});
                nv_gemm<EpiG2b><<<dim3(DM / 128, MTOK / 128), 256, 0, stream>>>(Y + 1024, YLD, w_dn_out, DM, MTOK, DM, DNW, EpiG2b{out, GATES, MG}); break;
        case 6: nv_gemm<EpiG3><<<dim3(DM / 128, MTOK / 128), 256, 0, stream>>>(MG, DM, w_o, DM, MTOK, DM, DM, EpiG3{x, out}); break;
        case 7: nv_final<<<MTOK, 256, 0, stream>>>(out, final_norm_w); break;
        }
        ++s;
    }
#endif
}
```

```cpp
#define MIX 0
#include <hip/hip_runtime.h>
#include <cstdint>
#include <cstdio>

typedef unsigned short bf16_t;
__device__ __forceinline__ float bf2f(bf16_t v) { return __uint_as_float(((unsigned)v) << 16); }
__device__ __forceinline__ bf16_t f2bf(float f) { unsigned u = __float_as_uint(f); return (bf16_t)((u + 0x7fffu + ((u >> 16) & 1u)) >> 16); }
__device__ __forceinline__ float sigmoidf_(float x) { return 1.f / (1.f + __expf(-x)); }
__device__ __forceinline__ float siluf_(float x) { return x / (1.f + __expf(-x)); }
__device__ __forceinline__ float softplusf_(float x) { return x > 20.f ? x : log1pf(__expf(x)); }

constexpr int DM = 2048, NB = 4, SEQ = 2048, NMETA = 16, LEXT = SEQ + NMETA;
constexpr int PW = 1024, PGD = 256, NH = 16, HD = 128, DNW = 2048, CHUNK = 64, NCH = 33, PADF = 48;
constexpr int INC = 14368;
constexpr int C_U = 0, C_ZP = 1024, C_Q = 2048, C_ZD = 8192, C_B = 10240, C_GP = 10272;
constexpr int MTOK = NB * SEQ;
constexpr int MROWS = MTOK + NMETA;
constexpr int MPAD = 8448;
constexpr int NPAD1 = 14592;
constexpr int YLD = 3072;
constexpr float EPS = 1e-6f;
constexpr int NUNITS = NB * NH * NCH;

constexpr size_t MiB = 1u << 20;
constexpr size_t WS_CTL = 0, CTL_ZERO_BYTES = 1 * MiB;
constexpr size_t WS_CH = 1 * MiB;
constexpr size_t CH_ARR = (size_t)NUNITS * 8192 * 2;
constexpr size_t WS_CH_NW = WS_CH, WS_CH_U = WS_CH + CH_ARR, WS_CH_QD = WS_CH + 2 * CH_ARR, WS_CH_KDT = WS_CH + 3 * CH_ARR, WS_CH_QK = WS_CH + 4 * CH_ARR;
constexpr size_t WS_CH_GL = WS_CH_QK + (size_t)NUNITS * 4096 * 2;
constexpr size_t WS_WINT = WS_CH;
constexpr size_t WS_XN = WS_CH + 57 * MiB;
constexpr size_t WS_W2T = 150 * MiB;
constexpr size_t WS_WOT = 162 * MiB;
constexpr size_t WS_MIXT = 170 * MiB;
constexpr size_t WS_U = 171 * MiB;
constexpr size_t WS_SZP = WS_U + (size_t)MPAD * 1024 * 2;
constexpr size_t WS_QKV = WS_SZP + (size_t)MPAD * 1024 * 2;
constexpr size_t WS_BA = 303 * MiB;
constexpr size_t WS_O = 204 * MiB, WS_Y = 236 * MiB, WS_MERGED = 204 * MiB;
constexpr size_t WS_SZD = 304 * MiB + 512 * 1024;
constexpr size_t WS_GATES = WS_SZD + (size_t)MPAD * 2048 * 2;
constexpr size_t WS_POOLED = WS_GATES + (size_t)MPAD * 4096 * 2;
constexpr size_t WS_END = WS_POOLED + (size_t)MTOK * 1024 * 2;
static_assert(WS_CH_GL + NUNITS * 4 <= WS_W2T, "chunk arrays");
static_assert(WS_XN + (size_t)MPAD * 2048 * 2 <= WS_W2T, "xn");
static_assert(WS_QKV == 204 * MiB && WS_QKV + (size_t)MPAD * 6144 * 2 <= WS_BA, "qkv");
static_assert(WS_Y + (size_t)MTOK * YLD * 2 <= WS_BA, "y");
static_assert(WS_BA + (size_t)MPAD * 32 * 4 <= WS_SZD, "ba");
static_assert(WS_END <= 449 * MiB, "ws");

__device__ __forceinline__ int ext_row(int b, int p) { return p < NMETA ? MTOK + p : b * SEQ + (p - NMETA); }

__device__ __forceinline__ float wave_sum(float v) {
#pragma unroll
    for (int o = 1; o < 64; o <<= 1) v += __shfl_xor(v, o);
    return v;
}
#if MIX
__global__ void __launch_bounds__(256) nv_prep(const float* __restrict__ x, const float* __restrict__ meta, const float* __restrict__ nw, bf16_t* __restrict__ XN) {
    const int lane = threadIdx.x & 63, gw = (blockIdx.x * 256 + threadIdx.x) >> 6, ngw = gridDim.x * 4;
    for (int r = gw; r < MPAD; r += ngw) {
        bf16_t* o = XN + (size_t)r * DM;
        if (r >= MROWS) { for (int j = lane; j < DM; j += 64) o[j] = 0; continue; }
        const float* src = r < MTOK ? x + (size_t)r * DM : meta + (size_t)(r - MTOK) * DM;
        float v[32]; float s = 0.f;
#pragma unroll
        for (int j = 0; j < 32; ++j) { v[j] = src[lane + 64 * j]; s += v[j] * v[j]; }
        const float rs = rsqrtf(wave_sum(s) * (1.f / DM) + EPS);
#pragma unroll
        for (int j = 0; j < 32; ++j) o[lane + 64 * j] = f2bf(v[j] * rs * nw[lane + 64 * j]);
    }
}

template <class Epi>
__global__ void __launch_bounds__(256) nv_gemm(const bf16_t* __restrict__ A, int lda, const float* __restrict__ W, int ldw, int M, int N, int K, Epi epi) {
    __shared__ __attribute__((aligned(16))) float As[16][132];
    __shared__ __attribute__((aligned(16))) float Bs[16][132];
    const int tid = threadIdx.x, tx = tid & 15, ty = tid >> 4;
    const int m0 = blockIdx.y * 128, n0 = blockIdx.x * 128;
    float acc[8][8];
#pragma unroll
    for (int i = 0; i < 8; ++i)
#pragma unroll
        for (int j = 0; j < 8; ++j) acc[i][j] = 0.f;
    for (int k0 = 0; k0 < K; k0 += 16) {
        {
            const int r = tid >> 1, kc = (tid & 1) * 8, gm = m0 + r;
            uint4 v = make_uint4(0, 0, 0, 0);
            if (gm < M) v = *(const uint4*)(A + (size_t)gm * lda + k0 + kc);
            const unsigned w[4] = {v.x, v.y, v.z, v.w};
#pragma unroll
            for (int j = 0; j < 4; ++j) { As[kc + 2 * j][r] = __uint_as_float(w[j] << 16); As[kc + 2 * j + 1][r] = __uint_as_float(w[j] & 0xffff0000u); }
        }
        {
            const int kk = tid >> 4, nc = (tid & 15) * 8, gn = n0 + nc;
            float4 v0 = make_float4(0, 0, 0, 0), v1 = v0;
            if (gn < N) { const float* p = W + (size_t)(k0 + kk) * ldw + gn; v0 = *(const float4*)p; v1 = *(const float4*)(p + 4); }
            *(float4*)&Bs[kk][nc] = v0; *(float4*)&Bs[kk][nc + 4] = v1;
        }
        __syncthreads();
#pragma unroll
        for (int kk = 0; kk < 16; ++kk) {
            float a[8], b[8];
            *(float4*)&a[0] = *(const float4*)&As[kk][ty * 8]; *(float4*)&a[4] = *(const float4*)&As[kk][ty * 8 + 4];
            *(float4*)&b[0] = *(const float4*)&Bs[kk][tx * 8]; *(float4*)&b[4] = *(const float4*)&Bs[kk][tx * 8 + 4];
#pragma unroll
            for (int i = 0; i < 8; ++i)
#pragma unroll
                for (int j = 0; j < 8; ++j) acc[i][j] += a[i] * b[j];
        }
        __syncthreads();
    }
#pragma unroll
    for (int i = 0; i < 8; ++i)
#pragma unroll
        for (int j = 0; j < 8; ++j) { const int gm = m0 + ty * 8 + i, gn = n0 + tx * 8 + j; if (gm < M && gn < N) epi(gm, gn, acc[i][j]); }
}

struct EpiProj {
    bf16_t *U, *SZP, *QKV, *SZD, *GATES; float* BA;
    __device__ __forceinline__ void operator()(int m, int n, float v) const {
        if (n < C_ZP) U[(size_t)m * 1024 + n] = f2bf(v);
        else if (n < C_Q) SZP[(size_t)m * 1024 + (n - C_ZP)] = f2bf(siluf_(v));
        else if (n < C_ZD) QKV[(size_t)m * 6144 + (n - C_Q)] = f2bf(v);
        else if (n < C_B) SZD[(size_t)m * 2048 + (n - C_ZD)] = f2bf(siluf_(v));
        else if (n < C_GP) BA[(size_t)m * 32 + (n - C_B)] = v;
        else GATES[(size_t)m * 4096 + (n - C_GP)] = f2bf(sigmoidf_(v));
    }
};
struct EpiPool {
    bf16_t* Y; const bf16_t* SZP; const float* scale; int g, pad;
    __device__ __forceinline__ void operator()(int m, int n, float v) const {
        const int c = g * PGD + n; Y[(size_t)m * YLD + c] = f2bf(v * scale[c] * bf2f(SZP[(size_t)m * 1024 + c]));
    }
};
struct EpiG2a { float* T; const bf16_t* GATES; __device__ __forceinline__ void operator()(int m, int n, float v) const { T[(size_t)m * DM + n] = v * bf2f(GATES[(size_t)m * 4096 + n]); } };
struct EpiG2b { const float* T; const bf16_t* GATES; bf16_t* MG; __device__ __forceinline__ void operator()(int m, int n, float v) const { MG[(size_t)m * DM + n] = f2bf(T[(size_t)m * DM + n] + v * bf2f(GATES[(size_t)m * 4096 + 2048 + n])); } };
struct EpiG3 { const float* x; float* out; __device__ __forceinline__ void operator()(int m, int n, float v) const { out[(size_t)m * DM + n] = x[(size_t)m * DM + n] + v; } };

__global__ void __launch_bounds__(256) nv_pool(const bf16_t* __restrict__ U, bf16_t* __restrict__ PO) {
    const int idx = blockIdx.x * 256 + threadIdx.x; if (idx >= MTOK * PW) return;
    const int m = idx >> 10, c = idx & 1023, b = m >> 11, t = m & 2047, p = t + NMETA, win = 2 << (c >> 8);
    float s = 0.f;
    for (int j = 0; j < win; ++j) { const int pp = p - j; if (pp >= 0) s += bf2f(U[(size_t)ext_row(b, pp) * 1024 + c]); }
    const int cnt = (p + 1) < win ? (p + 1) : win;
    PO[idx] = f2bf(s / (float)cnt - bf2f(U[(size_t)m * 1024 + c]));
}

__global__ void __launch_bounds__(256) nv_chunk_prep(const bf16_t* __restrict__ QKV, const float* __restrict__ BA, const float* __restrict__ conv_w, const float* __restrict__ A_log,
                                                     const float* __restrict__ dt_bias, bf16_t* __restrict__ NW, bf16_t* __restrict__ UU, bf16_t* __restrict__ QD, bf16_t* __restrict__ KDT,
                                                     bf16_t* __restrict__ QK, float* __restrict__ GL) {
    extern __shared__ __attribute__((aligned(16))) float sm[];
    float *q = sm, *k = q + 8192, *v = k + 8192, *Am = v + 8192, *Tm = Am + 4096, *beta = Tm + 4096, *gc = beta + 64;
    const int cu = blockIdx.x, n = cu % NCH, bh = cu / NCH, h = bh % NH, b = bh / NH, tid = threadIdx.x, lane = tid & 63, wv = tid >> 6;
    const int p0 = CHUNK * n - PADF;
    for (int idx = tid; idx < 64 * 384; idx += 256) {
        const int i = idx / 384, c3 = idx % 384, which = c3 >> 7, d = c3 & 127, col = which * 2048 + h * HD + d, p = p0 + i;
        float val = 0.f;
        if (p >= 0) { float a = 0.f;
            for (int kk = 0; kk < 4; ++kk) { const int pp = p - 3 + kk; if (pp >= 0) a += conv_w[kk * 6144 + col] * bf2f(QKV[(size_t)ext_row(b, pp) * 6144 + col]); }
            val = siluf_(a); }
        (which == 0 ? q : which == 1 ? k : v)[i * 128 + d] = val;
    }
    if (tid < 64) { const int p = p0 + tid; float be = 0.f, g = 0.f;
        if (p >= 0) { const int r = ext_row(b, p); be = sigmoidf_(BA[(size_t)r * 32 + h]); g = -__expf(A_log[h]) * softplusf_(BA[(size_t)r * 32 + 16 + h] + dt_bias[h]); }
        beta[tid] = be; gc[tid] = g; }
    __syncthreads();
    if (tid == 0) { float s = 0.f; for (int i = 0; i < 64; ++i) { s += gc[i]; gc[i] = s; } }
    for (int r = wv; r < 128; r += 4) {
        float* row = (r < 64 ? q + r * 128 : k + (r - 64) * 128);
        const float a0 = row[lane], a1 = row[lane + 64];
        const float rs = rsqrtf(wave_sum(a0 * a0 + a1 * a1) + EPS) * (r < 64 ? 0.08838834764831845f : 1.f);
        row[lane] = a0 * rs; row[lane + 64] = a1 * rs;
    }
    __syncthreads();
    bf16_t* oQK = QK + (size_t)cu * 4096;
    for (int idx = tid; idx < 4096; idx += 256) {
        const int i = idx >> 6, j = idx & 63; float akk = 0.f, aqk = 0.f;
        if (j <= i) { for (int d = 0; d < 128; ++d) { const float kj = k[j * 128 + d]; akk += k[i * 128 + d] * kj; aqk += q[i * 128 + d] * kj; }
            const float dec = __expf(gc[i] - gc[j]); akk *= beta[i] * dec; aqk *= dec; }
        Am[idx] = j < i ? akk : 0.f; oQK[idx] = f2bf(j <= i ? aqk : 0.f);
    }
    __syncthreads();
    if (tid < 64) { const int c = tid;
        for (int i = 0; i < 64; ++i) { float s = (i == c) ? 1.f : 0.f; for (int j = c; j < i; ++j) s -= Am[i * 64 + j] * Tm[j * 64 + c]; Tm[i * 64 + c] = (i >= c) ? s : 0.f; } }
    __syncthreads();
    bf16_t *oNW = NW + (size_t)cu * 8192, *oU = UU + (size_t)cu * 8192, *oQD = QD + (size_t)cu * 8192, *oKDT = KDT + (size_t)cu * 8192;
    const float gl = gc[63];
    for (int idx = tid; idx < 8192; idx += 256) {
        const int i = idx >> 7, d = idx & 127; float su = 0.f, sw = 0.f;
        for (int j = 0; j <= i; ++j) { const float t = Tm[i * 64 + j] * beta[j]; su += t * v[j * 128 + d]; sw += t * __expf(gc[j]) * k[j * 128 + d]; }
        oU[idx] = f2bf(su); oNW[idx] = f2bf(-sw);
        oQD[idx] = f2bf(q[idx] * __expf(gc[i]));
        oKDT[d * 64 + i] = f2bf(k[idx] * __expf(gl - gc[i]));
    }
    if (tid == 0) GL[cu] = __expf(gl);
}

__global__ void __launch_bounds__(128) nv_chunk_scan(const bf16_t* __restrict__ NW, const bf16_t* __restrict__ UU, const bf16_t* __restrict__ QD, const bf16_t* __restrict__ KDT,
                                                     const bf16_t* __restrict__ QK, const float* __restrict__ GL, bf16_t* __restrict__ O) {
    __shared__ float vn[64][128];
    const int bh = blockIdx.x, h = bh % NH, b = bh / NH, e = threadIdx.x;
    float S[128];
#pragma unroll
    for (int d = 0; d < 128; ++d) S[d] = 0.f;
    for (int n = 0; n < NCH; ++n) {
        const int cu = bh * NCH + n;
        const bf16_t *nw = NW + (size_t)cu * 8192, *uu = UU + (size_t)cu * 8192, *qd = QD + (size_t)cu * 8192, *kdt = KDT + (size_t)cu * 8192, *qk = QK + (size_t)cu * 4096;
        const float gl = GL[cu];
        for (int i = 0; i < 64; ++i) { float a = bf2f(uu[i * 128 + e]);
#pragma unroll
            for (int d = 0; d < 128; ++d) a += bf2f(nw[i * 128 + d]) * S[d];
            vn[i][e] = a; }
        __syncthreads();
        if (n > 0) for (int i = 0; i < 64; ++i) { float a = 0.f;
#pragma unroll
            for (int d = 0; d < 128; ++d) a += bf2f(qd[i * 128 + d]) * S[d];
            for (int j = 0; j <= i; ++j) a += bf2f(qk[i * 64 + j]) * vn[j][e];
            O[(size_t)(b * SEQ + 64 * (n - 1) + i) * DNW + h * HD + e] = f2bf(a); }
#pragma unroll
        for (int d = 0; d < 128; ++d) { float s = S[d] * gl; for (int i = 0; i < 64; ++i) s += bf2f(kdt[d * 64 + i]) * vn[i][e]; S[d] = s; }
        __syncthreads();
    }
}

__global__ void __launch_bounds__(256) nv_gnorm(const bf16_t* __restrict__ O, const bf16_t* __restrict__ SZD, const float* __restrict__ w, bf16_t* __restrict__ Y) {
    const int lane = threadIdx.x & 63, gw = (blockIdx.x * 256 + threadIdx.x) >> 6; if (gw >= MTOK * NH) return;
    const size_t base = (size_t)(gw >> 4) * DNW + (gw & 15) * HD, yb = (size_t)(gw >> 4) * YLD + 1024 + (gw & 15) * HD;
    const float a0 = bf2f(O[base + lane]), a1 = bf2f(O[base + lane + 64]);
    const float rs = rsqrtf(wave_sum(a0 * a0 + a1 * a1) * (1.f / HD) + EPS);
    Y[yb + lane] = f2bf(a0 * rs * w[lane] * bf2f(SZD[base + lane]));
    Y[yb + lane + 64] = f2bf(a1 * rs * w[lane + 64] * bf2f(SZD[base + lane + 64]));
}

__global__ void __launch_bounds__(256) nv_final(float* __restrict__ out, const float* __restrict__ w) {
    __shared__ float red[4];
    float* row = out + (size_t)blockIdx.x * DM; const int tid = threadIdx.x;
    float v[8]; float s = 0.f;
#pragma unroll
    for (int j = 0; j < 8; ++j) { v[j] = row[tid + 256 * j]; s += v[j] * v[j]; }
    s = wave_sum(s); if ((tid & 63) == 0) red[tid >> 6] = s; __syncthreads();
    const float rs = rsqrtf((red[0] + red[1] + red[2] + red[3]) * (1.f / DM) + EPS);
#pragma unroll
    for (int j = 0; j < 8; ++j) row[tid + 256 * j] = v[j] * rs * w[tid + 256 * j];
}

#endif
namespace pg8 {
#define PG8_LAS __attribute__((address_space(3)))
typedef short bf16x8 __attribute__((ext_vector_type(8)));
typedef float f32x4 __attribute__((ext_vector_type(4)));
typedef unsigned u32x4 __attribute__((ext_vector_type(4)));
constexpr int BM = 256, BK = 64, HALF = 128, HTB = HALF * BK * 2  , STAGE_BYTES = 8 * HTB, NXCD = 8, WGM = 8;

__host__ __device__ __forceinline__ int lds_byte(int r, int c) { const int st = (r >> 4) * 2 + (c >> 5), rr = r & 15, cc = c & 31, ob = rr * 64 + cc * 2; return st * 1024 + (ob ^ (((ob >> 9) & 1) << 5)); }
__host__ __device__ __forceinline__ void stage_rc(int b, int& R, int& C) { const int st = b / 1024, sb = b % 1024, swz = sb ^ (((sb >> 9) & 1) << 5); R = (st >> 1) * 16 + swz / 64; C = (st & 1) * 32 + (swz % 64) / 2; }
__host__ __device__ __forceinline__ int perm32(int rho) { const int n = rho >> 4, i = rho & 15; return 8 * (i >> 2) + 4 * n + (i & 3); }

struct Unit { int pm, pn, aoff, boff, nt, mode; };
struct Gemm { const bf16_t* A; const bf16_t* Bt; int lda, ldb; };

struct StaticOrder {
    int nM, nN, nwg, G, c, nt;
    __device__ void init(int nM_, int nN_, int nt_, int G_, int c_) { nM = nM_; nN = nN_; nwg = nM * nN; G = G_; c = c_; nt = nt_; }
    __device__ bool next(int i, Unit& u) const {
        const long L = (long)i * G + c; if (L >= nwg) return false;
        int wgid = (int)L; { const int q = nwg / NXCD, r = nwg % NXCD, xcd = wgid % NXCD, off = wgid / NXCD; wgid = (xcd < r ? xcd * (q + 1) : r * (q + 1) + (xcd - r) * q) + off; }
        const int nig = WGM * nN, gid = wgid / nig, fm = gid * WGM, gsz = (nM - fm) < WGM ? (nM - fm) : WGM;
        u.pm = fm + ((wgid % nig) % gsz); u.pn = (wgid % nig) / gsz; u.aoff = 0; u.boff = 0; u.nt = nt; u.mode = 0; return true;
    }
};

typedef float f32x2_t __attribute__((ext_vector_type(2))); typedef __bf16 bf16x2_t __attribute__((ext_vector_type(2)));
__device__ __forceinline__ unsigned cvt_pk_bf16(float lo, float hi) { f32x2_t v = {lo, hi}; bf16x2_t b = __builtin_convertvector(v, bf16x2_t); return __builtin_bit_cast(unsigned, b); }
__device__ __forceinline__ u32x4 pack8(f32x4 v0, f32x4 v1) { u32x4 w; w.x = cvt_pk_bf16(v0[0], v0[1]); w.y = cvt_pk_bf16(v0[2], v0[3]); w.z = cvt_pk_bf16(v1[0], v1[1]); w.w = cvt_pk_bf16(v1[2], v1[3]); return w; }
__device__ __forceinline__ void unpack8(u32x4 w, f32x4& v0, f32x4& v1) {
    v0 = (f32x4){__uint_as_float(w.x << 16), __uint_as_float(w.x & 0xffff0000u), __uint_as_float(w.y << 16), __uint_as_float(w.y & 0xffff0000u)};
    v1 = (f32x4){__uint_as_float(w.z << 16), __uint_as_float(w.z & 0xffff0000u), __uint_as_float(w.w << 16), __uint_as_float(w.w & 0xffff0000u)};
}
__device__ __forceinline__ float fast_sigmoid(float x) { return __builtin_amdgcn_rcpf(1.f + __builtin_amdgcn_exp2f(-1.4426950408889634f * x)); }

struct EpiProj {
    static constexpr bool PERM = true;
    bf16_t *U, *SZP, *QKV, *SZD, *GATES; float* BA;
    __device__ __forceinline__ bool reset_after(const Unit&) const { return true; }
    __device__ __forceinline__ void operator()(f32x4 (&acc)[2][2][4][2], const Unit& u, int wr, int wc, int fr, int fq) const {
        const int row0 = u.pm * BM + wr * 64 + fr, pn = u.pn;
        if (pn == 56) {
            if (wc == 0) {
#pragma unroll
                for (int ai = 0; ai < 2; ++ai)
#pragma unroll
                    for (int m = 0; m < 4; ++m) { float* rowp = BA + (size_t)(row0 + ai * HALF + m * 16) * 32 + 8 * fq;
                        *(f32x4*)rowp = acc[ai][0][m][0]; *(f32x4*)(rowp + 4) = acc[ai][0][m][1]; }
            }
            return;
        }
        bf16_t* base; int ld, colt, act;
        if (pn < 4) { base = U; ld = 1024; colt = pn * 256; act = 0; }
        else if (pn < 8) { base = SZP; ld = 1024; colt = (pn - 4) * 256; act = 1; }
        else if (pn < 32) { base = QKV; ld = 6144; colt = (pn - 8) * 256; act = 0; }
        else if (pn < 40) { base = SZD; ld = 2048; colt = (pn - 32) * 256; act = 1; }
        else { base = GATES; ld = 4096; colt = (pn - 40) * 256; act = 2; }
        const int col0 = colt + wc * 32 + 8 * fq;
#pragma unroll
        for (int ai = 0; ai < 2; ++ai)
#pragma unroll
            for (int m = 0; m < 4; ++m) { bf16_t* rowp = base + (size_t)(row0 + ai * HALF + m * 16) * ld + col0;
#pragma unroll
                for (int bj = 0; bj < 2; ++bj) { f32x4 v0 = acc[ai][bj][m][0], v1 = acc[ai][bj][m][1];
                    if (act != 0) {
#pragma unroll
                        for (int j = 0; j < 4; ++j) { const float s0 = fast_sigmoid(v0[j]), s1 = fast_sigmoid(v1[j]); v0[j] = act == 1 ? v0[j] * s0 : s0; v1[j] = act == 1 ? v1[j] * s1 : s1; }
                    }
                    *(u32x4*)(rowp + bj * HALF) = pack8(v0, v1); } }
    }
};
struct EpiPoolMix {
    static constexpr bool PERM = true;
    bf16_t* Y; const bf16_t* SZP; const float* scale;
    __device__ __forceinline__ bool reset_after(const Unit&) const { return true; }
    __device__ __forceinline__ void operator()(f32x4 (&acc)[2][2][4][2], const Unit& u, int wr, int wc, int fr, int fq) const {
        const int row0 = u.pm * BM + wr * 64 + fr, col0 = u.pn * BM + wc * 32 + 8 * fq;
#pragma unroll
        for (int bj = 0; bj < 2; ++bj) { const f32x4 s0 = *(const f32x4*)(scale + col0 + bj * HALF), s1 = *(const f32x4*)(scale + col0 + bj * HALF + 4);
#pragma unroll
            for (int ai = 0; ai < 2; ++ai)
#pragma unroll
                for (int m = 0; m < 4; ++m) { const size_t r = (size_t)(row0 + ai * HALF + m * 16);
                    f32x4 z0, z1; unpack8(*(const u32x4*)(SZP + r * 1024 + col0 + bj * HALF), z0, z1);
                    *(u32x4*)(Y + r * YLD + col0 + bj * HALF) = pack8(acc[ai][bj][m][0] * s0 * z0, acc[ai][bj][m][1] * s1 * z1); } }
    }
};
struct EpiMerge {
    static constexpr bool PERM = true;
    const bf16_t* GATES; bf16_t* MG;
    __device__ __forceinline__ bool reset_after(const Unit& u) const { return u.mode != 0; }
    __device__ __forceinline__ void operator()(f32x4 (&acc)[2][2][4][2], const Unit& u, int wr, int wc, int fr, int fq) const {
        const int row0 = u.pm * BM + wr * 64 + fr, col0 = u.pn * BM + wc * 32 + 8 * fq;
#pragma unroll
        for (int ai = 0; ai < 2; ++ai)
#pragma unroll
            for (int m = 0; m < 4; ++m) { const size_t r = (size_t)(row0 + ai * HALF + m * 16);
#pragma unroll
                for (int bj = 0; bj < 2; ++bj) {
                    f32x4 d0, d1; unpack8(*(const u32x4*)(GATES + r * 4096 + 2048 + col0 + bj * HALF), d0, d1);
                    if (u.mode == 0) {
                        f32x4 p0, p1; unpack8(*(const u32x4*)(GATES + r * 4096 + col0 + bj * HALF), p0, p1);
#pragma unroll
                        for (int j = 0; j < 4; ++j) { acc[ai][bj][m][0][j] *= p0[j] / fmaxf(d0[j], 1e-30f); acc[ai][bj][m][1][j] *= p1[j] / fmaxf(d1[j], 1e-30f); }
                    } else {
                        *(u32x4*)(MG + r * DM + col0 + bj * HALF) = pack8(acc[ai][bj][m][0] * d0, acc[ai][bj][m][1] * d1);
                    } } }
    }
};
struct EpiResid {
    static constexpr bool PERM = false;
    const float* x; float* out;
    __device__ __forceinline__ bool reset_after(const Unit&) const { return true; }
    __device__ __forceinline__ void operator()(f32x4 (&acc)[2][2][4][2], const Unit& u, int wr, int wc, int fr, int fq) const {
        const int row0 = u.pm * BM + wr * 64 + fr, col0 = u.pn * BM + wc * 32 + 4 * fq;
#pragma unroll
        for (int ai = 0; ai < 2; ++ai)
#pragma unroll
            for (int m = 0; m < 4; ++m) { const size_t off = (size_t)(row0 + ai * HALF + m * 16) * DM + col0;
#pragma unroll
                for (int bj = 0; bj < 2; ++bj)
#pragma unroll
                    for (int n = 0; n < 2; ++n) *(f32x4*)(out + off + bj * HALF + n * 16) = *(const f32x4*)(x + off + bj * HALF + n * 16) + acc[ai][bj][m][n]; }
    }
};

template <class Epi, class Sched, bool ALIGN_EPI>
__device__ __forceinline__ void gemm_phase(PG8_LAS unsigned char* lds, const Gemm g, const Sched& S, const Epi& E) {
    const int tid = threadIdx.x, wid = __builtin_amdgcn_readfirstlane(tid >> 6), lane = tid & 63, wr = wid >> 2, wc = wid & 3, fr = lane & 15, fq = lane >> 4;
    const int lda = g.lda, ldb = g.ldb;
    unsigned voffA[2], voffB[2];
#pragma unroll
    for (int i = 0; i < 2; ++i) { int R, C; stage_rc(tid * 16 + i * 8192, R, C); const int Rb = Epi::PERM ? ((R & ~31) + perm32(R & 31)) : R;
        voffA[i] = (unsigned)(R * lda + C) * 2u; voffB[i] = (unsigned)(Rb * ldb + C) * 2u; }
    const size_t kstep = (size_t)(BK * 2);
    const size_t hstepA = (size_t)HALF * lda * 2, hstepB = (size_t)HALF * ldb * 2;
    const unsigned ldsw = (unsigned)wid * 1024u;
    const int aoff = lds_byte(wr * 64 + fr, fq * 8), boff = lds_byte(wc * 32 + fr, fq * 8);
#define PG8_SA(b, h) (((b) * 2 + (h)) * HTB)
#define PG8_SB(b, h) ((4 + (b) * 2 + (h)) * HTB)
#define PG8_STAGE(bufoff, gbase, voff) do { _Pragma("unroll") for (int _i = 0; _i < 2; ++_i) \
        __builtin_amdgcn_global_load_lds((const unsigned*)((const char*)(gbase) + (voff)[_i]), (PG8_LAS unsigned*)(lds + (bufoff) + ldsw + _i * 8192), 16, 0, 0); } while (0)
#define PG8_LDA(dst, b, h) do { _Pragma("unroll") for (int m = 0; m < 4; ++m) _Pragma("unroll") for (int k = 0; k < 2; ++k) dst[m][k] = *(const PG8_LAS bf16x8*)(lds + PG8_SA(b, h) + aoff + m * 2048 + k * 1024); } while (0)
#define PG8_LDB(dst, b, h) do { _Pragma("unroll") for (int n = 0; n < 2; ++n) _Pragma("unroll") for (int k = 0; k < 2; ++k) dst[n][k] = *(const PG8_LAS bf16x8*)(lds + PG8_SB(b, h) + boff + n * 2048 + k * 1024); } while (0)
#define PG8_MMA(ai, bj, At, Bt) do { __builtin_amdgcn_s_setprio(1); _Pragma("unroll") for (int m = 0; m < 4; ++m) _Pragma("unroll") for (int n = 0; n < 2; ++n) _Pragma("unroll") for (int k = 0; k < 2; ++k) \
        acc[ai][bj][m][n] = __builtin_amdgcn_mfma_f32_16x16x32_bf16(Bt[n][k], At[m][k], acc[ai][bj][m][n], 0, 0, 0); __builtin_amdgcn_s_setprio(0); } while (0)
#define PG8_WAIT_V(n) asm volatile("s_waitcnt vmcnt(" #n ")" ::: "memory")
#define PG8_WAIT_L(n) asm volatile("s_waitcnt lgkmcnt(" #n ")" ::: "memory")
#define PG8_BAR __builtin_amdgcn_s_barrier()
#define PG8_SCHED __builtin_amdgcn_sched_barrier(0)
#define PG8_UA(u) ((const char*)g.A + ((size_t)(u).pm * BM * lda + (u).aoff) * 2)
#define PG8_UB(u) ((const char*)g.Bt + ((size_t)(u).pn * BM * ldb + (u).boff) * 2)
    Unit cur, nxt; int ui = 0;
    if (!S.next(0, cur)) return;
    f32x4 acc[2][2][4][2];
#pragma unroll
    for (int a = 0; a < 2; ++a)
#pragma unroll
        for (int b = 0; b < 2; ++b)
#pragma unroll
            for (int m = 0; m < 4; ++m)
#pragma unroll
                for (int n = 0; n < 2; ++n) acc[a][b][m][n] = (f32x4){0.f, 0.f, 0.f, 0.f};
    bf16x8 At[4][2], B0[2][2], B1[2][2];
    const char* cA = PG8_UA(cur); const char* cB = PG8_UB(cur);
    PG8_STAGE(PG8_SB(0, 0), cB, voffB); PG8_STAGE(PG8_SB(0, 1), cB + hstepB, voffB); PG8_STAGE(PG8_SA(0, 0), cA, voffA); PG8_STAGE(PG8_SA(0, 1), cA + hstepA, voffA);
    if (wr == 1) PG8_BAR;
    PG8_WAIT_V(2); PG8_BAR;
    PG8_STAGE(PG8_SB(1, 0), cB + kstep, voffB); PG8_STAGE(PG8_SA(1, 0), cA + kstep, voffA); PG8_STAGE(PG8_SB(1, 1), cB + hstepB + kstep, voffB);
    PG8_WAIT_V(6); PG8_BAR;
    for (;;) {
        const bool has_next = S.next(ui + 1, nxt);
        const char* nA = has_next ? PG8_UA(nxt) : cA; const char* nB = has_next ? PG8_UB(nxt) : cB;
        const int nt = cur.nt;
        for (int t = 0; t < nt; t += 2) {
            const bool last = (t == nt - 2);
            const char* a1 = cA + (size_t)(t + 1) * kstep;
            const char* a2 = last ? nA : cA + (size_t)(t + 2) * kstep; const char* b2 = last ? nB : cB + (size_t)(t + 2) * kstep;
            const char* a3 = a2 + kstep; const char* b3 = b2 + kstep;
            PG8_LDB(B0, 0, 0); PG8_LDB(B1, 0, 1); PG8_SCHED; PG8_LDA(At, 0, 0); PG8_STAGE(PG8_SA(1, 1), a1 + hstepA, voffA);
            PG8_WAIT_V(8); PG8_WAIT_L(0); PG8_BAR; PG8_MMA(0, 0, At, B0); PG8_MMA(0, 1, At, B1); PG8_BAR; PG8_SCHED;
            PG8_LDA(At, 0, 1); PG8_STAGE(PG8_SB(0, 0), b2, voffB); PG8_STAGE(PG8_SB(0, 1), b2 + hstepB, voffB); PG8_STAGE(PG8_SA(0, 0), a2, voffA);
            PG8_WAIT_V(8); PG8_WAIT_L(0); PG8_BAR; PG8_MMA(1, 0, At, B0); PG8_MMA(1, 1, At, B1); PG8_BAR; PG8_SCHED;
            PG8_LDB(B0, 1, 0); PG8_LDB(B1, 1, 1); PG8_SCHED; PG8_LDA(At, 1, 0); PG8_STAGE(PG8_SA(0, 1), a2 + hstepA, voffA);
            PG8_WAIT_V(8); PG8_WAIT_L(0); PG8_BAR; PG8_MMA(0, 0, At, B0); PG8_MMA(0, 1, At, B1); PG8_BAR; PG8_SCHED;
            PG8_LDA(At, 1, 1); PG8_STAGE(PG8_SB(1, 0), b3, voffB); PG8_STAGE(PG8_SB(1, 1), b3 + hstepB, voffB); PG8_STAGE(PG8_SA(1, 0), a3, voffA);
            PG8_WAIT_V(8); PG8_WAIT_L(0); PG8_BAR; PG8_MMA(1, 0, At, B0); PG8_MMA(1, 1, At, B1); PG8_BAR; PG8_SCHED;
        }
        if constexpr (ALIGN_EPI) { if (wr == 0) PG8_BAR; }
        E(acc, cur, wr, wc, fr, fq);
        if (!has_next) break;
        if (E.reset_after(cur)) {
#pragma unroll
            for (int a = 0; a < 2; ++a)
#pragma unroll
                for (int b = 0; b < 2; ++b)
#pragma unroll
                    for (int m = 0; m < 4; ++m)
#pragma unroll
                        for (int n = 0; n < 2; ++n) acc[a][b][m][n] = (f32x4){0.f, 0.f, 0.f, 0.f};
        }
        cur = nxt; cA = nA; cB = nB; ++ui;
        if constexpr (ALIGN_EPI) { if (wr == 1) PG8_BAR; }
    }
    PG8_WAIT_V(0);
    if constexpr (!ALIGN_EPI) { if (wr == 0) PG8_BAR; }
    PG8_BAR;
#undef PG8_SA
#undef PG8_SB
#undef PG8_STAGE
#undef PG8_LDA
#undef PG8_LDB
#undef PG8_MMA
#undef PG8_WAIT_V
#undef PG8_WAIT_L
#undef PG8_BAR
#undef PG8_SCHED
#undef PG8_UA
#undef PG8_UB
}
}
#ifndef DUP_MASK
#define DUP_MASK 0
#endif
#ifndef SIMPLE_PREP
#define SIMPLE_PREP 0
#endif
#ifndef PREP_PROBE
#define PREP_PROBE 0
#endif
#ifndef SIMPLE_SCAN
#define SIMPLE_SCAN 0
#endif
constexpr int NWAVES = 8;
constexpr int RING_OFF = 0, RING_BYTES = 131072;
constexpr int LDSCTL_OFF = RING_BYTES, MISC_OFF = LDSCTL_OFF + 320;
constexpr int XTRA_OFF = RING_BYTES + 1024;
constexpr int LDS_BYTES = 147456;
constexpr int CW_BAR = 4096;

#define GAS __attribute__((address_space(1)))
#define LAS __attribute__((address_space(3)))
typedef unsigned v4u __attribute__((ext_vector_type(4)));
typedef float f32x4 __attribute__((ext_vector_type(4)));
typedef GAS unsigned gu32;
#define LDS_WAIT() asm volatile("s_waitcnt lgkmcnt(0)" ::: "memory")
#define VM_WAIT() asm volatile("s_waitcnt vmcnt(0)" ::: "memory")
__device__ __forceinline__ unsigned pk2(float lo, float hi) { return (unsigned)f2bf(lo) | ((unsigned)f2bf(hi) << 16); }
typedef short bf16x8_t __attribute__((ext_vector_type(8)));
typedef unsigned u32x2_t __attribute__((ext_vector_type(2)));
typedef unsigned u32x4_t __attribute__((ext_vector_type(4)));
__device__ __forceinline__ u32x2_t pack4bf(f32x4 v) { u32x2_t r; r.x = pg8::cvt_pk_bf16(v[0], v[1]); r.y = pg8::cvt_pk_bf16(v[2], v[3]); return r; }

#define XB_TMO      128
#define XB_XCNT(j)  (256  + 64 * (j))
#define XB_XSUB(j)  (1280 + 64 * (j))
#define XB_XGEN(j)  (2304 + 64 * (j))
#define XB_TOP      3328
#define XB_TOPGEN   3392
#define XCD_BAR_WORDS 3456
#define XB_SPIN_CAP (1u << 18)
__device__ __forceinline__ unsigned xb_ld(unsigned* p)              { return __hip_atomic_load(p, __ATOMIC_RELAXED, __HIP_MEMORY_SCOPE_AGENT); }
__device__ __forceinline__ unsigned xb_add(unsigned* p, unsigned v) { return __hip_atomic_fetch_add(p, v, __ATOMIC_RELAXED, __HIP_MEMORY_SCOPE_AGENT); }
__device__ __forceinline__ unsigned xb_xcc_id() { return (unsigned)__builtin_amdgcn_s_getreg((3 << 11) | 20) & 0xFu; }
#define XB_SPIN(cond, bar) do { unsigned _sp = 0; while (cond) { __builtin_amdgcn_s_sleep(1); \
    if ((++_sp & 255u) == 0u) { if (xb_ld(&(bar)[XB_TMO])) break; if (_sp > XB_SPIN_CAP) { atomicAdd(&(bar)[XB_TMO], 1u); break; } } } } while (0)
struct XcdBarrier { unsigned* bar; unsigned x; volatile LAS unsigned* st; };
__device__ __forceinline__ XcdBarrier xcd_barrier_post(unsigned* bar, volatile LAS unsigned* st) {
    XcdBarrier b; b.bar = bar; b.x = xb_xcc_id(); b.st = st;
    if (threadIdx.x == 0) (void)xb_add(&bar[XB_XCNT(b.x)], 1u);
    return b;
}
__device__ __forceinline__ void xcd_barrier_complete(unsigned* bar, unsigned x, unsigned& nloc, unsigned& nx) {
    const unsigned G = gridDim.x * gridDim.y * gridDim.z;
    unsigned sum, cnt, mine, sp = 0u;
    for (;;) {
        sum = 0u; cnt = 0u; mine = 0u;
#pragma unroll
        for (unsigned j = 0; j < 16; ++j) { const unsigned c = xb_ld(&bar[XB_XCNT(j)]); sum += c; cnt += (c > 0u) ? 1u : 0u; mine = (j == x) ? c : mine; }
        if (sum == G) break;
        __builtin_amdgcn_s_sleep(1);
        if ((++sp & 255u) == 0u) { if (xb_ld(&bar[XB_TMO])) break; if (sp > XB_SPIN_CAP) { atomicAdd(&bar[XB_TMO], 1u); break; } }
    }
    nloc = mine > 0u ? mine : 1u; nx = cnt > 0u ? cnt : 1u;
}
__device__ __forceinline__ void xcd_barrier(const XcdBarrier& b) {
    asm volatile("s_waitcnt vmcnt(0)" ::: "memory");
    __syncthreads();
    if (threadIdx.x == 0) {
        unsigned* bar = b.bar;
        __builtin_amdgcn_s_waitcnt(0);
        unsigned nloc = b.st[0], nx = b.st[1];
        if (nloc == 0u) { xcd_barrier_complete(bar, b.x, nloc, nx); b.st[0] = nloc; b.st[1] = nx; }
        const unsigned old = xb_add(&bar[XB_XSUB(b.x)], 1u);
        const unsigned gen = old / nloc;
        if (old + 1u == (gen + 1u) * nloc) {
            __builtin_amdgcn_fence(__ATOMIC_RELEASE, "agent");
            asm volatile("s_waitcnt vmcnt(0)" ::: "memory");
            const unsigned og = xb_add(&bar[XB_TOP], 1u);
            const unsigned tg = og / nx;
            if (og + 1u == (tg + 1u) * nx) xb_add(&bar[XB_TOPGEN], 1u);
            else XB_SPIN(xb_ld(&bar[XB_TOPGEN]) == tg, bar);
            __builtin_amdgcn_fence(__ATOMIC_ACQUIRE, "agent");
            xb_add(&bar[XB_XGEN(b.x)], 1u);
            asm volatile("s_waitcnt vmcnt(0)" ::: "memory");
        } else {
            XB_SPIN(xb_ld(&bar[XB_XGEN(b.x)]) == gen, bar);
            __builtin_amdgcn_fence(__ATOMIC_ACQUIRE, "agent");
            asm volatile("s_waitcnt vmcnt(0)" ::: "memory");
        }
    }
    __syncthreads();
}

struct Args { const float* in[14]; float* out; unsigned char* ws; int ph_lo, ph_hi; };

struct Frame {
    LAS unsigned char* lds; int tid, lane, wave, vcu, G;
};

__device__ __forceinline__ void p0_transpose_item(const float* __restrict__ W, int N, int k0, int n0, bf16_t* __restrict__ WT, int ldt, int dn0, int koff, LAS float* scr, int lane) {
#pragma unroll 8
    for (int i = 0; i < 32; ++i) { const int kk = 2 * i + (lane >> 5); scr[kk * 33 + (lane & 31)] = W[(size_t)(k0 + kk) * N + n0 + (lane & 31)]; }
    LDS_WAIT(); asm volatile("" ::: "memory");
    const int c = lane & 7;
#pragma unroll
    for (int j = 0; j < 4; ++j) { const int n = (lane >> 3) + 8 * j; const LAS float* s = scr + (8 * c) * 33 + n;
        v4u o; o.x = pk2(s[0 * 33], s[1 * 33]); o.y = pk2(s[2 * 33], s[3 * 33]); o.z = pk2(s[4 * 33], s[5 * 33]); o.w = pk2(s[6 * 33], s[7 * 33]);
        *(v4u*)(WT + (size_t)(dn0 + n) * ldt + koff + k0 + 8 * c) = o; }
    LDS_WAIT(); asm volatile("" ::: "memory");
}
__device__ __forceinline__ void p0_prologue(Frame& F, const Args& a) {
    unsigned char* ws = a.ws;
    bf16_t *WinT = (bf16_t*)(ws + WS_WINT), *W2T = (bf16_t*)(ws + WS_W2T), *WoT = (bf16_t*)(ws + WS_WOT), *MixT = (bf16_t*)(ws + WS_MIXT), *XN = (bf16_t*)(ws + WS_XN);
    LAS float* scr = (LAS float*)(F.lds + RING_OFF + F.wave * 16384);
    const int gw = F.vcu * NWAVES + F.wave, NGW = F.G * NWAVES;
    constexpr int I_IN = (DM / 64) * (INC / 32), I_PO = (PW / 64) * (DM / 32), I_DN = (DNW / 64) * (DM / 32), I_WO = (DM / 64) * (DM / 32), I_MX = 4 * (PGD / 64) * (PGD / 32);
    constexpr int NITEMS = I_IN + I_PO + I_DN + I_WO + I_MX;
    for (int it = gw; it < NITEMS; it += NGW) {
        int r = it;
        if (r < I_IN) { const int nblk = INC / 32, kb = r / nblk, nb = r % nblk, n0 = 32 * nb;
            const int dn0 = n0 < C_B ? n0 : (n0 < C_GP ? 14336 + (n0 - C_B) : n0 - 32);
            p0_transpose_item(a.in[3], INC, 64 * kb, n0, WinT, DM, dn0, 0, scr, F.lane); continue; } r -= I_IN;
        if (r < I_PO) { const int nblk = DM / 32, kb = r / nblk, nb = r % nblk; p0_transpose_item(a.in[10], DM, 64 * kb, 32 * nb, W2T, YLD, 32 * nb, 0, scr, F.lane); continue; } r -= I_PO;
        if (r < I_DN) { const int nblk = DM / 32, kb = r / nblk, nb = r % nblk; p0_transpose_item(a.in[11], DM, 64 * kb, 32 * nb, W2T, YLD, 32 * nb, 1024, scr, F.lane); continue; } r -= I_DN;
        if (r < I_WO) { const int nblk = DM / 32, kb = r / nblk, nb = r % nblk; p0_transpose_item(a.in[12], DM, 64 * kb, 32 * nb, WoT, DM, 32 * nb, 0, scr, F.lane); continue; } r -= I_WO;
        { const int g = r / 32, rr = r % 32, kb = rr / 8, nb = rr % 8;
          p0_transpose_item(a.in[7] + (size_t)g * PGD * PGD, PGD, 64 * kb, 32 * nb, MixT + (size_t)g * PGD * PGD, PGD, 32 * nb, 0, scr, F.lane); }
    }
    const float* nw = a.in[2];
    for (int r = gw; r < MPAD + (NPAD1 - INC); r += NGW) {
        if (r >= MROWS) { bf16_t* o = r < MPAD ? XN + (size_t)r * DM : WinT + (size_t)(INC + (r - MPAD)) * DM;
#pragma unroll
            for (int j = 0; j < 4; ++j) *(v4u*)(o + 8 * F.lane + 512 * j) = (v4u){0u, 0u, 0u, 0u};
            continue; }
        const float* src = r < MTOK ? a.in[0] + (size_t)r * DM : a.in[1] + (size_t)(r - MTOK) * DM;
        f32x4 v[8]; float s = 0.f;
#pragma unroll
        for (int j = 0; j < 8; ++j) { v[j] = *(const f32x4*)(src + 4 * F.lane + 256 * j); s += (v[j].x * v[j].x + v[j].y * v[j].y) + (v[j].z * v[j].z + v[j].w * v[j].w); }
        const float rs = rsqrtf(wave_sum(s) * (1.f / DM) + EPS);
        unsigned long long* o8 = (unsigned long long*)(XN + (size_t)r * DM) + F.lane;
#pragma unroll
        for (int j = 0; j < 8; ++j) { const f32x4 w = *(const f32x4*)(nw + 4 * F.lane + 256 * j);
            o8[64 * j] = (unsigned long long)pk2(v[j].x * rs * w.x, v[j].y * rs * w.y) | ((unsigned long long)pk2(v[j].z * rs * w.z, v[j].w * rs * w.w) << 32); }
    }
}


template <int NMT>
__device__ __forceinline__ void skinny_unit(Frame& F, const bf16_t* __restrict__ Arows, const bf16_t* __restrict__ Brows, f32x4 (&res)[2], int& orow, int& ocol) {
    const int w = F.wave, lane = F.lane, fr = lane & 15, fq = lane >> 4;
    f32x4 acc[NMT][2];
#pragma unroll
    for (int m = 0; m < NMT; ++m) { acc[m][0] = (f32x4){0.f, 0.f, 0.f, 0.f}; acc[m][1] = acc[m][0]; }
    const bf16_t* ap = Arows + (size_t)fr * DM + 256 * w + 8 * fq; const bf16_t* bp = Brows + (size_t)fr * DM + 256 * w + 8 * fq;
    bf16x8_t af[NMT][8], bfr[2][8];
#pragma unroll
    for (int ks = 0; ks < 8; ++ks) {
#pragma unroll
        for (int m = 0; m < NMT; ++m) af[m][ks] = *(const bf16x8_t*)(ap + (size_t)(16 * m) * DM + 32 * ks);
#pragma unroll
        for (int n2 = 0; n2 < 2; ++n2) bfr[n2][ks] = *(const bf16x8_t*)(bp + (size_t)(16 * n2) * DM + 32 * ks); }
#pragma unroll
    for (int ks = 0; ks < 8; ++ks)
#pragma unroll
        for (int m = 0; m < NMT; ++m)
#pragma unroll
            for (int n2 = 0; n2 < 2; ++n2) acc[m][n2] = __builtin_amdgcn_mfma_f32_16x16x32_bf16(af[m][ks], bfr[n2][ks], acc[m][n2], 0, 0, 0);
    LAS float* P = (LAS float*)(F.lds + RING_OFF);
#pragma unroll
    for (int m = 0; m < NMT; ++m)
#pragma unroll
        for (int n2 = 0; n2 < 2; ++n2)
#pragma unroll
            for (int r = 0; r < 4; ++r) P[(((w * NMT + m) * 2 + n2) * 4 + r) * 64 + lane] = acc[m][n2][r];
    __syncthreads();
    const int t = F.tid, m = NMT == 2 ? (t >> 8) & 1 : 0, n2 = (t >> 7) & 1, rp = (t >> 6) & 1, l2 = t & 63;
    float s0 = 0.f, s1 = 0.f;
    if (t < 256 * NMT) {
#pragma unroll
        for (int ww = 0; ww < 8; ++ww) { s0 += P[(((ww * NMT + m) * 2 + n2) * 4 + 2 * rp) * 64 + l2]; s1 += P[(((ww * NMT + m) * 2 + n2) * 4 + 2 * rp + 1) * 64 + l2]; } }
    res[0] = (f32x4){s0, s1, 0.f, 0.f}; orow = 16 * m + 4 * (l2 >> 4) + 2 * rp; ocol = 16 * n2 + (l2 & 15);
    __syncthreads();
}
__device__ __forceinline__ void p1_skinny(Frame& F, const Args& a) {
    unsigned char* ws = a.ws;
    const bf16_t *XN = (const bf16_t*)(ws + WS_XN), *WinT = (const bf16_t*)(ws + WS_WINT);
    bf16_t *U = (bf16_t*)(ws + WS_U), *QKV = (bf16_t*)(ws + WS_QKV); float* BA = (float*)(ws + WS_BA);
    constexpr int N_TOK = MTOK / 32, N_META = (1024 + 6144 + 32) / 32;
    for (int u = F.vcu; u < N_TOK + N_META; u += F.G) {
        f32x4 res[2]; int orow, ocol;
        if (u < N_TOK) {
            skinny_unit<2>(F, XN + (size_t)(32 * u) * DM, WinT + (size_t)14336 * DM, res, orow, ocol);
            if (F.tid < 512) { BA[(size_t)(32 * u + orow) * 32 + ocol] = res[0][0]; BA[(size_t)(32 * u + orow + 1) * 32 + ocol] = res[0][1]; }
        } else {
            const int j = u - N_TOK;
            const int wrow = j < 32 ? 32 * j : (j < 224 ? 2048 + 32 * (j - 32) : 14336);
            skinny_unit<1>(F, XN + (size_t)MTOK * DM, WinT + (size_t)wrow * DM, res, orow, ocol);
            if (F.tid < 256) {
#pragma unroll
                for (int q = 0; q < 2; ++q) { const size_t r = (size_t)(MTOK + orow + q); const float v = res[0][q];
                    if (j < 32) U[r * 1024 + 32 * j + ocol] = f2bf(v); else if (j < 224) QKV[r * 6144 + 32 * (j - 32) + ocol] = f2bf(v); else BA[r * 32 + ocol] = v; } }
        }
    }
}

template <int WIN>
__device__ __forceinline__ void p2_pool_item(const bf16_t* __restrict__ U, bf16_t* __restrict__ PO, int g, int rb, int c) {
    const int b = rb >> 8, t0 = (rb & 255) * 8, col = g * 256 + c * 8;
    pg8::u32x4 raw[WIN + 7];
#pragma unroll
    for (int j = 0; j < WIN + 7; ++j) { const int t = t0 - (WIN - 1) + j; const int row = t >= 0 ? b * SEQ + t : MTOK + NMETA + t; raw[j] = *(const pg8::u32x4*)(U + (size_t)row * 1024 + col); }
    f32x4 s0 = (f32x4){0.f, 0.f, 0.f, 0.f}, s1 = s0;
#pragma unroll
    for (int j = 0; j < WIN - 1; ++j) { f32x4 x0, x1; pg8::unpack8(raw[j], x0, x1); s0 += x0; s1 += x1; }
    constexpr float inv = 1.f / (float)WIN;
#pragma unroll
    for (int i = 0; i < 8; ++i) { f32x4 x0, x1; pg8::unpack8(raw[WIN - 1 + i], x0, x1); s0 += x0; s1 += x1;
        *(pg8::u32x4*)(PO + (size_t)(b * SEQ + t0 + i) * 1024 + col) = pg8::pack8(s0 * inv - x0, s1 * inv - x1);
        f32x4 y0, y1; pg8::unpack8(raw[i], y0, y1); s0 -= y0; s1 -= y1; }
}
__device__ __forceinline__ void p2_pool(Frame& F, const Args& a) {
    const bf16_t* U = (const bf16_t*)(a.ws + WS_U); bf16_t* PO = (bf16_t*)(a.ws + WS_POOLED);
    const int gw = F.vcu * NWAVES + F.wave, NGW = F.G * NWAVES;
    for (int wi = gw; wi < 4 * 512; wi += NGW) {
        const int g = wi >> 9, rb = (wi & 511) * 2 + (F.lane >> 5), c = F.lane & 31;
        if (g == 0) p2_pool_item<2>(U, PO, 0, rb, c); else if (g == 1) p2_pool_item<4>(U, PO, 1, rb, c); else if (g == 2) p2_pool_item<8>(U, PO, 2, rb, c); else p2_pool_item<16>(U, PO, 3, rb, c);
    }
}
__device__ __forceinline__ void p2_chunk_prep_simple(Frame& F, const Args& a) {
    const bf16_t* QKV = (const bf16_t*)(a.ws + WS_QKV); const float* BA = (const float*)(a.ws + WS_BA);
    const float *conv_w = a.in[4], *A_log = a.in[5], *dt_bias = a.in[6];
    bf16_t *NW = (bf16_t*)(a.ws + WS_CH_NW), *UU = (bf16_t*)(a.ws + WS_CH_U), *QD = (bf16_t*)(a.ws + WS_CH_QD), *KDT = (bf16_t*)(a.ws + WS_CH_KDT), *QK = (bf16_t*)(a.ws + WS_CH_QK);
    float* GL = (float*)(a.ws + WS_CH_GL);
    LAS float* sm = (LAS float*)(F.lds + RING_OFF);
    LAS float *q = sm, *k = q + 8192, *v = k + 8192, *Am = v + 8192, *Tm = Am + 4096;
    LAS float *beta = (LAS float*)(F.lds + XTRA_OFF), *gc = beta + 64;
    const int tid = F.tid, lane = F.lane, wv = F.wave;
    for (int cu = F.vcu; cu < NUNITS; cu += F.G) {
        const int n = cu % NCH, bh = cu / NCH, h = bh % NH, b = bh / NH, p0 = CHUNK * n - PADF;
        for (int idx = tid; idx < 64 * 384; idx += 512) {
            const int i = idx / 384, c3 = idx % 384, which = c3 >> 7, d = c3 & 127, col = which * 2048 + h * HD + d, p = p0 + i;
            float val = 0.f;
            if (p >= 0) { float s = 0.f;
                for (int kk = 0; kk < 4; ++kk) { const int pp = p - 3 + kk; if (pp >= 0) s += conv_w[kk * 6144 + col] * bf2f(QKV[(size_t)ext_row(b, pp) * 6144 + col]); }
                val = siluf_(s); }
            (which == 0 ? q : which == 1 ? k : v)[i * 128 + d] = val;
        }
        if (tid < 64) { const int p = p0 + tid; float be = 0.f, g = 0.f;
            if (p >= 0) { const int r = ext_row(b, p); be = sigmoidf_(BA[(size_t)r * 32 + h]); g = -__expf(A_log[h]) * softplusf_(BA[(size_t)r * 32 + 16 + h] + dt_bias[h]); }
            beta[tid] = be; gc[tid] = g; }
        __syncthreads();
        if (tid == 0) { float s = 0.f; for (int i = 0; i < 64; ++i) { s += gc[i]; gc[i] = s; } }
        for (int r = wv; r < 128; r += 8) {
            LAS float* row = (r < 64 ? q + r * 128 : k + (r - 64) * 128);
            const float a0 = row[lane], a1 = row[lane + 64];
            const float rs = rsqrtf(wave_sum(a0 * a0 + a1 * a1) + EPS) * (r < 64 ? 0.08838834764831845f : 1.f);
            row[lane] = a0 * rs; row[lane + 64] = a1 * rs;
        }
        __syncthreads();
        bf16_t* oQK = QK + (size_t)cu * 4096;
        for (int idx = tid; idx < 4096; idx += 512) {
            const int i = idx >> 6, j = idx & 63; float akk = 0.f, aqk = 0.f;
            if (j <= i) { for (int d = 0; d < 128; ++d) { const float kj = k[j * 128 + d]; akk += k[i * 128 + d] * kj; aqk += q[i * 128 + d] * kj; }
                const float dec = __expf(gc[i] - gc[j]); akk *= beta[i] * dec; aqk *= dec; }
            Am[idx] = j < i ? akk : 0.f; oQK[idx] = f2bf(j <= i ? aqk : 0.f);
        }
        __syncthreads();
        if (tid < 64) { const int c = tid;
            for (int i = 0; i < 64; ++i) { float s = (i == c) ? 1.f : 0.f; for (int j = c; j < i; ++j) s -= Am[i * 64 + j] * Tm[j * 64 + c]; Tm[i * 64 + c] = (i >= c) ? s : 0.f; } }
        __syncthreads();
        bf16_t *oNW = NW + (size_t)cu * 8192, *oU = UU + (size_t)cu * 8192, *oQD = QD + (size_t)cu * 8192, *oKDT = KDT + (size_t)cu * 8192;
        const float gl = gc[63];
        for (int idx = tid; idx < 8192; idx += 512) {
            const int i = idx >> 7, d = idx & 127; float su = 0.f, sw = 0.f;
            for (int j = 0; j <= i; ++j) { const float t = Tm[i * 64 + j] * beta[j]; su += t * v[j * 128 + d]; sw += t * __expf(gc[j]) * k[j * 128 + d]; }
            oU[d * 64 + i] = f2bf(su); oNW[idx] = f2bf(-sw);
            oQD[idx] = f2bf(q[idx] * __expf(gc[i]));
            oKDT[d * 64 + i] = f2bf(k[idx] * __expf(gl - gc[i]));
        }
        if (tid == 0) GL[cu] = __expf(gl);
        __syncthreads();
    }
}


constexpr int QS_LD = 272, KT_LD = 144, AM_LD = 68;
constexpr int L_QS = 0, L_KS = 17408, L_KT = 34816, L_VT = 53248, L_AM = 71680, L_TM = 89088, L_TB = 106496, L_TW = 115712, L_XS = 124928;
static_assert(L_XS + 3 * 1152 <= RING_BYTES, "chunk-prep LDS map");
__device__ __forceinline__ int ktoff(int d, int chunk) { return d * KT_LD + ((chunk ^ ((d >> 3) & 7)) << 4); }
struct PrepRaw { pg8::u32x4 x[11]; float pb, pa; };
template <int SKIP>
__device__ __forceinline__ void p2_chunk_prep_fast(Frame& F, const Args& a) {
    const bf16_t* QKV = (const bf16_t*)(a.ws + WS_QKV); const float* BA = (const float*)(a.ws + WS_BA);
    const float *conv_w = a.in[4], *A_log = a.in[5], *dt_bias = a.in[6];
    bf16_t *NW = (bf16_t*)(a.ws + WS_CH_NW), *UT = (bf16_t*)(a.ws + WS_CH_U), *QD = (bf16_t*)(a.ws + WS_CH_QD), *KDT = (bf16_t*)(a.ws + WS_CH_KDT), *QK = (bf16_t*)(a.ws + WS_CH_QK);
    float* GL = (float*)(a.ws + WS_CH_GL);
    LAS unsigned char* L = F.lds + RING_OFF;
    LAS float *Am = (LAS float*)(L + L_AM), *Tm = (LAS float*)(L + L_TM);
    LAS float *beta = (LAS float*)(F.lds + XTRA_OFF), *gc = beta + 64;
    const int w = F.wave;
    const int which = w >> 1; const bool cvt = w < 6;
    const int u_lo = (33 * F.vcu) / 4, u_hi = F.G == 256 ? (33 * (F.vcu + 1)) / 4 : 0;
#define PREP_LOAD(R, cu_) do { const int n_ = (cu_) % NCH, bh_ = (cu_) / NCH, h_ = bh_ % NH, b_ = bh_ / NH, colx = (which < 3 ? which : 2) * 2048 + h_ * HD + d8; \
        _Pragma("unroll") for (int j = 0; j < 11; ++j) { int pp = CHUNK * n_ - PADF + 8 * ib - 3 + j; pp = pp < 0 ? 0 : pp; (R).x[j] = *(const pg8::u32x4*)(QKV + (size_t)ext_row(b_, pp) * 6144 + colx); } \
        { int pl = CHUNK * n_ - PADF + lane; pl = pl < 0 ? 0 : pl; const float* bp = BA + (size_t)ext_row(b_, pl) * 32 + h_; (R).pb = bp[0]; (R).pa = bp[16]; } } while (0)
    LAS float* cw = (LAS float*)(F.lds + XTRA_OFF + 1024);
    PrepRaw raw; int hcur = -1;
    { const int lane = F.lane, fr = lane & 15, fq = lane >> 4, ib = (4 * w + fq) & 7, d8 = 8 * fr; if (u_lo < u_hi) PREP_LOAD(raw, u_lo); }
    for (int cu = u_lo; cu < u_hi; ++cu) {
        int lane = F.lane; asm volatile("" : "+v"(lane));
        const int fr = lane & 15, fq = lane >> 4, tid = w * 64 + lane, ib = (4 * w + fq) & 7, d8 = 8 * fr;
        const int n = cu % NCH, bh = cu / NCH, h = bh % NH, b = bh / NH, p0 = CHUNK * n - PADF;
        if (h != hcur) { hcur = h; for (int i = tid; i < 4 * 384; i += 512) { const int kk = i / 384, c = i % 384; cw[i] = conv_w[kk * 6144 + (c >> 7) * 2048 + h * HD + (c & 127)]; } __syncthreads(); }
        if (cvt && !(SKIP & 1)) {
            if (n == 0) {
#pragma unroll
                for (int j = 0; j < 11; ++j) { const bool ok = p0 + 8 * ib - 3 + j >= 0; raw.x[j].x = ok ? raw.x[j].x : 0u; raw.x[j].y = ok ? raw.x[j].y : 0u; raw.x[j].z = ok ? raw.x[j].z : 0u; raw.x[j].w = ok ? raw.x[j].w : 0u; } }
            f32x4 cwr[8];
#pragma unroll
            for (int kk = 0; kk < 4; ++kk) { cwr[2 * kk] = *(const LAS f32x4*)(cw + kk * 384 + which * 128 + d8); cwr[2 * kk + 1] = *(const LAS f32x4*)(cw + kk * 384 + which * 128 + d8 + 4); }
#pragma unroll
            for (int hb = 0; hb < 2; ++hb) {
                unsigned tr[4][4];
#pragma unroll
                for (int i4 = 0; i4 < 4; ++i4) { const int ii = 4 * hb + i4;
                    float v[8];
#pragma unroll
                    for (int j = 0; j < 8; ++j) v[j] = 0.f;
#pragma unroll
                    for (int kk = 0; kk < 4; ++kk) { f32x4 x0, x1; pg8::unpack8(raw.x[ii + kk], x0, x1);
#pragma unroll
                        for (int j = 0; j < 4; ++j) { v[j] += cwr[2 * kk][j] * x0[j]; v[4 + j] += cwr[2 * kk + 1][j] * x1[j]; } }
#pragma unroll
                    for (int j = 0; j < 8; ++j) v[j] = v[j] * pg8::fast_sigmoid(v[j]);
                    if (which < 2) { float ss = 0.f;
#pragma unroll
                        for (int j = 0; j < 8; ++j) ss += v[j] * v[j];
                        ss += __shfl_xor(ss, 1); ss += __shfl_xor(ss, 2); ss += __shfl_xor(ss, 4); ss += __shfl_xor(ss, 8);
                        const float rs = rsqrtf(ss + EPS) * (which == 0 ? 0.08838834764831845f : 1.f);
#pragma unroll
                        for (int j = 0; j < 8; ++j) v[j] *= rs; }
                    const pg8::u32x4 pk = pg8::pack8((f32x4){v[0], v[1], v[2], v[3]}, (f32x4){v[4], v[5], v[6], v[7]});
                    if (which < 2) *(LAS pg8::u32x4*)(L + (which == 0 ? L_QS : L_KS) + (8 * ib + ii) * QS_LD + d8 * 2) = pk;
                    tr[i4][0] = pk.x; tr[i4][1] = pk.y; tr[i4][2] = pk.z; tr[i4][3] = pk.w;
                }
                if (which >= 1) { LAS unsigned char* T = L + (which == 1 ? L_KT : L_VT) + 8 * hb;
#pragma unroll
                    for (int dj = 0; dj < 8; ++dj) { u32x2_t o; const int q = dj >> 1;
                        if (dj & 1) { o.x = (tr[0][q] >> 16) | (tr[1][q] & 0xffff0000u); o.y = (tr[2][q] >> 16) | (tr[3][q] & 0xffff0000u); }
                        else { o.x = (tr[0][q] & 0xffffu) | (tr[1][q] << 16); o.y = (tr[2][q] & 0xffffu) | (tr[3][q] << 16); }
                        *(LAS u32x2_t*)(T + ktoff(d8 + dj, ib)) = o; } }
            }
        }
        if (w == 7) {
            const int p = p0 + lane; float be = 0.f, g = 0.f;
            if (p >= 0) { be = sigmoidf_(raw.pb); g = -__expf(A_log[h]) * softplusf_(raw.pa + dt_bias[h]); }
#pragma unroll
            for (int o = 1; o < 64; o <<= 1) { const float t = __shfl_up(g, o); if (lane >= o) g += t; }
            beta[lane] = be; gc[lane] = g;
        }
        __syncthreads();
        PREP_LOAD(raw, cu + 1 < u_hi ? cu + 1 : cu);
        const float gl = gc[63];
        if (!(SKIP & 2)) {
            const int kind = w >> 2, ti = w & 3;
            bf16x8_t af[4];
#pragma unroll
            for (int ks = 0; ks < 4; ++ks) af[ks] = *(const LAS bf16x8_t*)(L + L_KS + (16 * ti + fr) * QS_LD + (32 * ks + 8 * fq) * 2);
            bf16_t* oQK = QK + (size_t)cu * 4096;
#pragma unroll
            for (int tj = 0; tj < 4; ++tj) {
                if (kind == 0) {
                    if (tj > ti) continue;
                    f32x4 acc = (f32x4){0.f, 0.f, 0.f, 0.f};
#pragma unroll
                    for (int ks = 0; ks < 4; ++ks) acc = __builtin_amdgcn_mfma_f32_16x16x32_bf16(af[ks], *(const LAS bf16x8_t*)(L + L_KS + (16 * tj + fr) * QS_LD + (32 * ks + 8 * fq) * 2), acc, 0, 0, 0);
                    const int j = 16 * tj + fr; const float gj = gc[j]; const f32x4 gi4 = *(const LAS f32x4*)(gc + 16 * ti + 4 * fq), bi4 = *(const LAS f32x4*)(beta + 16 * ti + 4 * fq);
#pragma unroll
                    for (int r = 0; r < 4; ++r) { const int i = 16 * ti + 4 * fq + r; const float m = (tj < ti || fr < 4 * fq + r) ? 1.f : 0.f; Am[i * AM_LD + j] = acc[r] * bi4[r] * __expf(fminf(gi4[r] - gj, 0.f)) * m; }
                } else {
                    const int i = 16 * tj + fr; u32x2_t o = (u32x2_t){0u, 0u};
                    if (tj >= ti) {
                        f32x4 acc = (f32x4){0.f, 0.f, 0.f, 0.f};
#pragma unroll
                        for (int ks = 0; ks < 4; ++ks) acc = __builtin_amdgcn_mfma_f32_16x16x32_bf16(af[ks], *(const LAS bf16x8_t*)(L + L_QS + (16 * tj + fr) * QS_LD + (32 * ks + 8 * fq) * 2), acc, 0, 0, 0);
                        const float gi = gc[i]; const f32x4 gj4 = *(const LAS f32x4*)(gc + 16 * ti + 4 * fq);
#pragma unroll
                        for (int r = 0; r < 4; ++r) { const float m = (tj > ti || 4 * fq + r <= fr) ? 1.f : 0.f; acc[r] = acc[r] * __expf(fminf(gi - gj4[r], 0.f)) * m; }
                        o = pack4bf(acc);
                    }
                    *(u32x2_t*)(oQK + i * 64 + 16 * ti + 4 * fq) = o;
                }
            }
        }
        __syncthreads();
        if (SKIP & 4) {} else if (w == 0) {
            const int ab = fq, c = fr; float t[16];
#pragma unroll
            for (int r = 0; r < 16; ++r) { float s = (r == c) ? 1.f : 0.f;
#pragma unroll
                for (int m4 = 0; m4 < (r + 3) / 4; ++m4) { const f32x4 av = *(const LAS f32x4*)(Am + (16 * ab + r) * AM_LD + 16 * ab + 4 * m4);
#pragma unroll
                    for (int j = 0; j < 4; ++j) if (4 * m4 + j < r) s -= av[j] * t[4 * m4 + j]; }
                t[r] = s; Tm[(16 * ab + r) * AM_LD + 16 * ab + c] = s; }
        } else {
            bf16_t *oQD = QD + (size_t)cu * 8192, *oKDT = KDT + (size_t)cu * 8192;
            for (int idx = tid - 64; idx < 2048; idx += 448) {
                if (idx < 1024) { const int i = idx >> 4, d8 = (idx & 15) * 8; pg8::f32x4 x0, x1; pg8::unpack8(*(const LAS pg8::u32x4*)(L + L_QS + i * QS_LD + d8 * 2), x0, x1);
                    const float e = __expf(gc[i]); *(pg8::u32x4*)(oQD + i * 128 + d8) = pg8::pack8(x0 * e, x1 * e); }
                else { const int id = idx - 1024, d = id >> 3, i8 = (id & 7) * 8; pg8::f32x4 x0, x1; pg8::unpack8(*(const LAS pg8::u32x4*)(L + L_KT + ktoff(d, i8 >> 3)), x0, x1);
#pragma unroll
                    for (int j = 0; j < 4; ++j) { x0[j] *= __expf(gl - gc[i8 + j]); x1[j] *= __expf(gl - gc[i8 + 4 + j]); }
                    *(pg8::u32x4*)(oKDT + d * 64 + i8) = pg8::pack8(x0, x1); }
            }
            if (tid == 64) GL[cu] = __expf(gl);
        }
        __syncthreads();
#pragma unroll
        for (int dd = 1; dd < 4; ++dd) {
            if (w < 4 - dd && !(SKIP & 8)) {
                const int bb = w, ab = w + dd;
                f32x4 acc = (f32x4){0.f, 0.f, 0.f, 0.f};
                for (int c = bb; c < ab; ++c)
#pragma unroll
                    for (int ks = 0; ks < 4; ++ks) acc = __builtin_amdgcn_mfma_f32_16x16x4f32(Am[(16 * ab + fr) * AM_LD + 16 * c + 4 * ks + fq], Tm[(16 * c + 4 * ks + fq) * AM_LD + 16 * bb + fr], acc, 0, 0, 0);
                LAS float* Xs = (LAS float*)(L + L_XS + w * 1152);
#pragma unroll
                for (int r = 0; r < 4; ++r) Xs[(4 * fq + r) * 17 + fr] = acc[r];
                f32x4 acc2 = (f32x4){0.f, 0.f, 0.f, 0.f};
#pragma unroll
                for (int ks = 0; ks < 4; ++ks) acc2 = __builtin_amdgcn_mfma_f32_16x16x4f32(Tm[(16 * ab + fr) * AM_LD + 16 * ab + 4 * ks + fq], Xs[(4 * ks + fq) * 17 + fr], acc2, 0, 0, 0);
#pragma unroll
                for (int r = 0; r < 4; ++r) Tm[(16 * ab + 4 * fq + r) * AM_LD + 16 * bb + fr] = -acc2[r];
            }
            __syncthreads();
        }
        if (!(SKIP & 16)) { const int i = tid >> 3, j8 = (tid & 7) * 8; f32x4 t0 = *(const LAS f32x4*)(Tm + i * AM_LD + j8), t1 = *(const LAS f32x4*)(Tm + i * AM_LD + j8 + 4); f32x4 b0, b1, w0, w1;
#pragma unroll
            for (int j = 0; j < 4; ++j) { const int ja = j8 + j, jb = j8 + 4 + j; const float ba = beta[ja], bb = beta[jb];
                b0[j] = ja <= i ? t0[j] * ba : 0.f; b1[j] = jb <= i ? t1[j] * bb : 0.f; w0[j] = b0[j] * __expf(gc[ja]); w1[j] = b1[j] * __expf(gc[jb]); }
            *(LAS pg8::u32x4*)(L + L_TB + i * KT_LD + j8 * 2) = pg8::pack8(b0, b1); *(LAS pg8::u32x4*)(L + L_TW + i * KT_LD + j8 * 2) = pg8::pack8(w0, w1); }
        __syncthreads();
        if (!(SKIP & 16)) {
            bf16_t *oU = UT + (size_t)cu * 8192, *oNW = NW + (size_t)cu * 8192;
            bf16x8_t vf[2], kf[2];
#pragma unroll
            for (int ks = 0; ks < 2; ++ks) { vf[ks] = *(const LAS bf16x8_t*)(L + L_VT + ktoff(16 * w + fr, 4 * ks + fq)); kf[ks] = *(const LAS bf16x8_t*)(L + L_KT + ktoff(16 * w + fr, 4 * ks + fq)); }
#pragma unroll
            for (int mi = 0; mi < 4; ++mi) {
                f32x4 au = (f32x4){0.f, 0.f, 0.f, 0.f}, aw = (f32x4){0.f, 0.f, 0.f, 0.f};
#pragma unroll
                for (int ks = 0; ks < 2; ++ks) {
                    au = __builtin_amdgcn_mfma_f32_16x16x32_bf16(*(const LAS bf16x8_t*)(L + L_TB + (16 * mi + fr) * KT_LD + (32 * ks + 8 * fq) * 2), vf[ks], au, 0, 0, 0);
                    aw = __builtin_amdgcn_mfma_f32_16x16x32_bf16(kf[ks], *(const LAS bf16x8_t*)(L + L_TW + (16 * mi + fr) * KT_LD + (32 * ks + 8 * fq) * 2), aw, 0, 0, 0);
                }
                *(u32x2_t*)(oU + (16 * w + fr) * 64 + 16 * mi + 4 * fq) = pack4bf(au);
                *(u32x2_t*)(oNW + (16 * mi + fr) * 128 + 16 * w + 4 * fq) = pack4bf(-aw);
            }
        }
        __syncthreads();
    }
#undef PREP_LOAD
}

__device__ __forceinline__ void p3_scan_simple(Frame& F, const Args& a) {
    const bf16_t *NW = (const bf16_t*)(a.ws + WS_CH_NW), *UU = (const bf16_t*)(a.ws + WS_CH_U), *QD = (const bf16_t*)(a.ws + WS_CH_QD), *KDT = (const bf16_t*)(a.ws + WS_CH_KDT), *QK = (const bf16_t*)(a.ws + WS_CH_QK);
    const float* GL = (const float*)(a.ws + WS_CH_GL); bf16_t* O = (bf16_t*)(a.ws + WS_O);
    LAS float* sm = (LAS float*)(F.lds + RING_OFF);
    LAS float *nw = sm, *qd = sm + 8192, *kd = sm + 16384, *vn = sm + 24576;
    const int tid = F.tid, e = (tid >> 6) * 32 + (tid & 31), half = (tid >> 5) & 1, db = 64 * half; const bool act = tid < 256;
    for (int bh = F.vcu; bh < NB * NH; bh += F.G) {
        const int h = bh % NH, b = bh / NH;
        float S[64];
#pragma unroll
        for (int d = 0; d < 64; ++d) S[d] = 0.f;
        for (int n = 0; n < NCH; ++n) {
            const int cu = bh * NCH + n;
            for (int idx = tid; idx < 8192; idx += 512) { nw[idx] = bf2f(NW[(size_t)cu * 8192 + idx]); qd[idx] = bf2f(QD[(size_t)cu * 8192 + idx]);
                const int d = idx >> 6, i = idx & 63; kd[i * 128 + d] = bf2f(KDT[(size_t)cu * 8192 + idx]); }
            __syncthreads();
            const float gl = GL[cu];
            if (act) for (int i = 0; i < 64; ++i) { float s = 0.f;
#pragma unroll
                for (int d = 0; d < 64; ++d) s += nw[i * 128 + db + d] * S[d];
                s += __shfl_xor(s, 32); s += bf2f(UU[(size_t)cu * 8192 + e * 64 + i]);
                if (half == 0) vn[i * 128 + e] = s; }
            __syncthreads();
            if (act) {
                if (n > 0) for (int i = 0; i < 64; ++i) { float s = 0.f;
#pragma unroll
                    for (int d = 0; d < 64; ++d) s += qd[i * 128 + db + d] * S[d];
                    s += __shfl_xor(s, 32);
                    for (int j = 0; j <= i; ++j) s += bf2f(QK[(size_t)cu * 4096 + i * 64 + j]) * vn[j * 128 + e];
                    if (half == 0) O[(size_t)(b * SEQ + 64 * (n - 1) + i) * DNW + h * HD + e] = f2bf(s); }
#pragma unroll
                for (int d = 0; d < 64; ++d) S[d] *= gl;
                for (int i = 0; i < 64; ++i) { const float vi = vn[i * 128 + e];
#pragma unroll
                    for (int d = 0; d < 64; ++d) S[d] += kd[i * 128 + db + d] * vi; }
            }
            __syncthreads();
        }
    }
}


struct ScanOps { bf16x8_t a[4], x[2], kd[2]; float gl; };
constexpr int ST_LD = 272, VT_LD = 144;
template <int PROBE>
__device__ __forceinline__ void p3_scan_fast(Frame& F, const Args& a) {
    const bf16_t *NW = (const bf16_t*)(a.ws + WS_CH_NW), *UT = (const bf16_t*)(a.ws + WS_CH_U), *QD = (const bf16_t*)(a.ws + WS_CH_QD), *KDT = (const bf16_t*)(a.ws + WS_CH_KDT), *QK = (const bf16_t*)(a.ws + WS_CH_QK);
    const float* GL = (const float*)(a.ws + WS_CH_GL); bf16_t* O = (bf16_t*)(a.ws + (PROBE ? WS_Y : WS_O));
    LAS unsigned char* ST = F.lds + RING_OFF; LAS unsigned char* VT = ST + 32 * ST_LD;
    const int w = F.wave, lane = F.lane, fr = lane & 15, fq = lane >> 4, mt = w & 3; const bool vw = w < 4;
    for (int unit = F.vcu; unit < NB * NH * 4; unit += F.G) {
        const int bh = unit >> 2, s = unit & 3, h = bh % NH, b = bh / NH;
        f32x4 accS[2] = {(f32x4){0.f, 0.f, 0.f, 0.f}, (f32x4){0.f, 0.f, 0.f, 0.f}};
        for (int i = F.tid; i < 32 * ST_LD / 4; i += 512) ((LAS unsigned*)ST)[i] = 0u;
        __syncthreads();
        const bf16_t* Asrc = (vw ? NW : QD) + (16 * mt + fr) * 128 + 8 * fq;
        const bf16_t* Ksrc = KDT + (16 * w + fr) * 64 + 8 * fq;
        const bf16_t* Xsrc = vw ? UT + (32 * s + fr) * 64 + 16 * mt + 8 * (fq >> 1) : QK + (16 * mt + fr) * 64 + 8 * fq;
        const size_t xstride = vw ? 8192 : 4096; const int xstep = vw ? 16 * 64 : 32; const bool hiq = (fq & 1) != 0;
#define SCAN_LOAD(ops, n_) do { const size_t cu_ = (size_t)(bh * NCH + (PROBE != 0 ? 0 : (n_))); \
        _Pragma("unroll") for (int ks = 0; ks < 4; ++ks) (ops).a[ks] = *(const bf16x8_t*)(Asrc + cu_ * 8192 + 32 * ks); \
        _Pragma("unroll") for (int ks = 0; ks < 2; ++ks) (ops).kd[ks] = *(const bf16x8_t*)(Ksrc + cu_ * 8192 + 32 * ks); \
        (ops).x[0] = *(const bf16x8_t*)(Xsrc + cu_ * xstride); (ops).x[1] = *(const bf16x8_t*)(Xsrc + cu_ * xstride + xstep); \
        (ops).gl = GL[cu_]; } while (0)
#define SCAN_STEP(ops, n_) do { \
        f32x4 acc[2]; \
        _Pragma("unroll") for (int n2 = 0; n2 < 2; ++n2) { const unsigned u0_ = hiq ? (unsigned)__builtin_bit_cast(u32x4_t, (ops).x[n2]).z : (unsigned)__builtin_bit_cast(u32x4_t, (ops).x[n2]).x, u1_ = hiq ? (unsigned)__builtin_bit_cast(u32x4_t, (ops).x[n2]).w : (unsigned)__builtin_bit_cast(u32x4_t, (ops).x[n2]).y; \
            acc[n2] = vw ? (f32x4){__uint_as_float(u0_ << 16), __uint_as_float(u0_ & 0xffff0000u), __uint_as_float(u1_ << 16), __uint_as_float(u1_ & 0xffff0000u)} : (f32x4){0.f, 0.f, 0.f, 0.f}; } \
        _Pragma("unroll") for (int ks = 0; ks < 4; ++ks) _Pragma("unroll") for (int n2 = 0; n2 < 2; ++n2) \
            acc[n2] = __builtin_amdgcn_mfma_f32_16x16x32_bf16((ops).a[ks], *(const LAS bf16x8_t*)(ST + (16 * n2 + fr) * ST_LD + (32 * ks + 8 * fq) * 2), acc[n2], 0, 0, 0); \
        if (vw) { _Pragma("unroll") for (int n2 = 0; n2 < 2; ++n2) *(LAS u32x2_t*)(VT + (16 * n2 + fr) * VT_LD + (16 * mt + 4 * fq) * 2) = pack4bf(acc[n2]); } \
        __syncthreads(); \
        bf16x8_t bV[2][2]; \
        _Pragma("unroll") for (int n2 = 0; n2 < 2; ++n2) _Pragma("unroll") for (int ks = 0; ks < 2; ++ks) bV[n2][ks] = *(const LAS bf16x8_t*)(VT + (16 * n2 + fr) * VT_LD + (32 * ks + 8 * fq) * 2); \
        if (!vw) { _Pragma("unroll") for (int n2 = 0; n2 < 2; ++n2) _Pragma("unroll") for (int ks = 0; ks < 2; ++ks) acc[n2] = __builtin_amdgcn_mfma_f32_16x16x32_bf16((ops).x[ks], bV[n2][ks], acc[n2], 0, 0, 0); \
            if ((n_) > 0 && PROBE != 2) { bf16_t* op = O + (size_t)(b * SEQ + 64 * ((n_) - 1) + 16 * mt + 4 * fq) * DNW + h * HD + 32 * s + fr; \
                _Pragma("unroll") for (int n2 = 0; n2 < 2; ++n2) _Pragma("unroll") for (int r = 0; r < 4; ++r) op[(size_t)r * DNW + 16 * n2] = f2bf(acc[n2][r]); } } \
        _Pragma("unroll") for (int n2 = 0; n2 < 2; ++n2) { accS[n2] = accS[n2] * (ops).gl; \
            _Pragma("unroll") for (int ks = 0; ks < 2; ++ks) accS[n2] = __builtin_amdgcn_mfma_f32_16x16x32_bf16((ops).kd[ks], bV[n2][ks], accS[n2], 0, 0, 0); \
            *(LAS u32x2_t*)(ST + (16 * n2 + fr) * ST_LD + (16 * w + 4 * fq) * 2) = pack4bf(accS[n2]); } \
        __syncthreads(); } while (0)
        ScanOps opA, opB, opC;
        SCAN_LOAD(opA, 0); SCAN_LOAD(opB, 1);
        for (int n = 0; n < NCH; n += 3) {
            SCAN_LOAD(opC, n + 2); SCAN_STEP(opA, n);
            SCAN_LOAD(opA, n + 3 < NCH ? n + 3 : NCH - 1); SCAN_STEP(opB, n + 1);
            SCAN_LOAD(opB, n + 4 < NCH ? n + 4 : NCH - 1); SCAN_STEP(opC, n + 2);
        }
#undef SCAN_LOAD
#undef SCAN_STEP
    }
}

__device__ __forceinline__ void p3b_gnorm(Frame& F, const Args& a) {
    const bf16_t *O = (const bf16_t*)(a.ws + WS_O), *SZD = (const bf16_t*)(a.ws + WS_SZD); bf16_t* Y = (bf16_t*)(a.ws + WS_Y); const float* w = a.in[9];
    const int gw = F.vcu * NWAVES + F.wave, NGW = F.G * NWAVES, lane = F.lane;
    const f32x4 w0 = *(const f32x4*)(w + 8 * (lane & 15)), w1 = *(const f32x4*)(w + 8 * (lane & 15) + 4);
    for (int r = gw; r < MTOK; r += NGW) {
        pg8::u32x4 ov[4], zv[4];
#pragma unroll
        for (int j = 0; j < 4; ++j) { ov[j] = *(const pg8::u32x4*)(O + (size_t)r * DNW + 512 * j + 8 * lane); zv[j] = *(const pg8::u32x4*)(SZD + (size_t)r * DNW + 512 * j + 8 * lane); }
#pragma unroll
        for (int j = 0; j < 4; ++j) { f32x4 o0, o1, z0, z1; pg8::unpack8(ov[j], o0, o1); pg8::unpack8(zv[j], z0, z1);
            float ss = (o0[0] * o0[0] + o0[1] * o0[1]) + (o0[2] * o0[2] + o0[3] * o0[3]) + (o1[0] * o1[0] + o1[1] * o1[1]) + (o1[2] * o1[2] + o1[3] * o1[3]);
            ss += __shfl_xor(ss, 1); ss += __shfl_xor(ss, 2); ss += __shfl_xor(ss, 4); ss += __shfl_xor(ss, 8);
            const float rs = rsqrtf(ss * (1.f / HD) + EPS);
            *(pg8::u32x4*)(Y + (size_t)r * YLD + 1024 + 512 * j + 8 * lane) = pg8::pack8(o0 * rs * w0 * z0, o1 * rs * w1 * z1); }
    }
}

__device__ __forceinline__ void p6_final(Frame& F, const Args& a) {
    const float* w = a.in[13]; float* out = a.out;
    const int gw = F.vcu * NWAVES + F.wave, NGW = F.G * NWAVES;
    for (int r = gw; r < MTOK; r += NGW) {
        float* row = out + (size_t)r * DM;
        f32x4 v[8]; float s = 0.f;
#pragma unroll
        for (int j = 0; j < 8; ++j) { v[j] = *(const f32x4*)(row + 4 * F.lane + 256 * j); s += (v[j].x * v[j].x + v[j].y * v[j].y) + (v[j].z * v[j].z + v[j].w * v[j].w); }
        const float rs = rsqrtf(wave_sum(s) * (1.f / DM) + EPS);
#pragma unroll
        for (int j = 0; j < 8; ++j) { const f32x4 ww = *(const f32x4*)(w + 4 * F.lane + 256 * j); *(f32x4*)(row + 4 * F.lane + 256 * j) = v[j] * rs * ww; }
    }
}

struct PoolMixOrder {
    int G, c;
    __device__ bool next(int i, pg8::Unit& u) const { const int L = i * G + c; if (L >= 128) return false; u.pm = L >> 2; u.pn = L & 3; u.aoff = (L & 3) * 256; u.boff = 0; u.nt = 4; u.mode = 0; return true; }
};
struct MergeOrder {
    pg8::StaticOrder so;
    __device__ bool next(int i, pg8::Unit& u) const { if (!so.next(i >> 1, u)) return false; if ((i & 1) == 0) { u.nt = 16; u.mode = 0; } else { u.aoff = 1024; u.boff = 1024; u.nt = 32; u.mode = 1; } return true; }
};

constexpr int NPHASE = 8;
__global__ void __launch_bounds__(NWAVES * 64, 2) mega_fwd(Args args) {
    extern __shared__ __attribute__((aligned(16))) unsigned char lds[];
    Frame F;
    F.lds = (LAS unsigned char*)lds;
    F.tid = threadIdx.x; F.lane = F.tid & 63; F.wave = __builtin_amdgcn_readfirstlane(F.tid >> 6);
    F.G = gridDim.x; { const int bx = blockIdx.x; F.vcu = (F.G % 8 == 0) ? (bx % 8) * (F.G / 8) + bx / 8 : bx; }
    unsigned char* ws = args.ws;
    for (int u = F.tid; u < (LDS_BYTES - LDSCTL_OFF) / 4; u += NWAVES * 64) ((LAS unsigned*)(F.lds + LDSCTL_OFF))[u] = 0u;
    __syncthreads();
    const int lo = args.ph_lo, hi = args.ph_hi;
    XcdBarrier bar; bar.bar = (unsigned*)(ws + WS_CTL) + CW_BAR; bar.x = 0; bar.st = nullptr;
    if (hi - lo > 1 || DUP_MASK) bar = xcd_barrier_post((unsigned*)(ws + WS_CTL) + CW_BAR, (volatile LAS unsigned*)(F.lds + MISC_OFF) + 8);
#define DUP(k) ((DUP_MASK >> (k)) & 1)
#define PHASE(k, ...) do { if (lo <= (k) && (k) < hi) { __VA_ARGS__ if (DUP(k)) { xcd_barrier(bar); __VA_ARGS__ } if ((k) + 1 < hi) xcd_barrier(bar); } } while (0)
    PHASE(0, p0_prologue(F, args););
    PHASE(1, {
        p1_skinny(F, args);
        pg8::Gemm g{(const bf16_t*)(ws + WS_XN), (const bf16_t*)(ws + WS_WINT), DM, DM}; pg8::StaticOrder S; S.init(MTOK / 256, 14336 / 256, DM / 64, F.G, (int)blockIdx.x);
        pg8::EpiProj E{(bf16_t*)(ws + WS_U), (bf16_t*)(ws + WS_SZP), (bf16_t*)(ws + WS_QKV), (bf16_t*)(ws + WS_SZD), (bf16_t*)(ws + WS_GATES), (float*)(ws + WS_BA)};
        pg8::gemm_phase<pg8::EpiProj, pg8::StaticOrder, true>(F.lds + RING_OFF, g, S, E); });
    PHASE(2, p2_pool(F, args); if (SIMPLE_PREP) p2_chunk_prep_simple(F, args); else { if (PREP_PROBE) p2_chunk_prep_fast<PREP_PROBE>(F, args); p2_chunk_prep_fast<0>(F, args); });
    #ifndef SCAN_PROBE
#define SCAN_PROBE 0
#endif
    PHASE(3, if (SIMPLE_SCAN) p3_scan_simple(F, args); else { if (SCAN_PROBE) p3_scan_fast<SCAN_PROBE>(F, args); p3_scan_fast<0>(F, args); });
    PHASE(4, {
        p3b_gnorm(F, args);
        pg8::Gemm g{(const bf16_t*)(ws + WS_POOLED), (const bf16_t*)(ws + WS_MIXT), PW, PGD}; PoolMixOrder S{F.G, F.vcu};
        pg8::EpiPoolMix E{(bf16_t*)(ws + WS_Y), (const bf16_t*)(ws + WS_SZP), args.in[8]};
        pg8::gemm_phase<pg8::EpiPoolMix, PoolMixOrder, false>(F.lds + RING_OFF, g, S, E); });
    PHASE(5, {
        pg8::Gemm g{(const bf16_t*)(ws + WS_Y), (const bf16_t*)(ws + WS_W2T), YLD, YLD}; MergeOrder S; S.so.init(MTOK / 256, DM / 256, 0, F.G, (int)blockIdx.x);
        pg8::EpiMerge E{(const bf16_t*)(ws + WS_GATES), (bf16_t*)(ws + WS_MERGED)};
        pg8::gemm_phase<pg8::EpiMerge, MergeOrder, false>(F.lds + RING_OFF, g, S, E); });
    PHASE(6, {
        pg8::Gemm g{(const bf16_t*)(ws + WS_MERGED), (const bf16_t*)(ws + WS_WOT), DM, DM}; pg8::StaticOrder S; S.init(MTOK / 256, DM / 256, DM / 64, F.G, (int)blockIdx.x);
        pg8::EpiResid E{args.in[0], args.out};
        pg8::gemm_phase<pg8::EpiResid, pg8::StaticOrder, false>(F.lds + RING_OFF, g, S, E); });
    PHASE(7, p6_final(F, args););
#undef PHASE
#undef DUP
}
#ifndef MIX
#define MIX 0
#endif
#ifndef NAIVE_MASK
#define NAIVE_MASK 0
#endif
#ifndef FUSE
#define FUSE 1
#endif
extern "C" void kernel_launch(void* const* d_in, const int* in_sizes, int n_in, void* d_out, int out_size, void* d_ws, size_t ws_size, hipStream_t stream) {
    static int grid = 0;
    if (grid == 0) {
        if (n_in != 14 || in_sizes[0] != MTOK * DM || out_size != MTOK * DM || ws_size < WS_END) { fprintf(stderr, "kernel_launch: unexpected shapes / workspace (%zu < %zu); nothing launched\n", ws_size, (size_t)WS_END); grid = -1; return; }
        int dev = 0, cus = 0;
        if (hipGetDevice(&dev) != hipSuccess || hipDeviceGetAttribute(&cus, hipDeviceAttributeMultiprocessorCount, dev) != hipSuccess) { grid = -1; return; }
        if (hipFuncSetAttribute((const void*)mega_fwd, hipFuncAttributeMaxDynamicSharedMemorySize, LDS_BYTES) != hipSuccess) { fprintf(stderr, "kernel_launch: hipFuncSetAttribute failed\n"); grid = -1; return; }
#if MIX
        if (hipFuncSetAttribute((const void*)nv_chunk_prep, hipFuncAttributeMaxDynamicSharedMemorySize, 140 * 1024) != hipSuccess) { grid = -1; return; }
#endif
        (void)hipGetLastError();
        grid = cus;
    }
    if (grid < 0) return;
    if (hipMemsetAsync((char*)d_ws + WS_CTL, 0, CTL_ZERO_BYTES, stream) != hipSuccess) return;
    Args a{};
    for (int i = 0; i < 14; ++i) a.in[i] = (const float*)d_in[i];
    a.out = (float*)d_out; a.ws = (unsigned char*)d_ws;
#if !MIX
    a.ph_lo = 0; a.ph_hi = NPHASE;
    hipLaunchKernelGGL(mega_fwd, dim3(grid), dim3(NWAVES * 64), LDS_BYTES, stream, a);
#else
    const float *x = a.in[0], *meta = a.in[1], *norm_w = a.in[2], *w_in = a.in[3], *conv_w = a.in[4], *A_log = a.in[5], *dt_bias = a.in[6], *pool_mix = a.in[7], *pool_scale = a.in[8],
                *dn_norm_w = a.in[9], *w_pool_out = a.in[10], *w_dn_out = a.in[11], *w_o = a.in[12], *final_norm_w = a.in[13];
    unsigned char* ws = (unsigned char*)d_ws; float* out = (float*)d_out;
    bf16_t *XN = (bf16_t*)(ws + WS_XN), *U = (bf16_t*)(ws + WS_U), *SZP = (bf16_t*)(ws + WS_SZP), *QKV = (bf16_t*)(ws + WS_QKV), *SZD = (bf16_t*)(ws + WS_SZD), *GATES = (bf16_t*)(ws + WS_GATES);
    float* BA = (float*)(ws + WS_BA);
    bf16_t *Y = (bf16_t*)(ws + WS_Y), *PO = (bf16_t*)(ws + WS_POOLED), *O = (bf16_t*)(ws + WS_O), *MG = (bf16_t*)(ws + WS_MERGED);
    bf16_t *cNW = (bf16_t*)(ws + WS_CH_NW), *cU = (bf16_t*)(ws + WS_CH_U), *cQD = (bf16_t*)(ws + WS_CH_QD), *cKDT = (bf16_t*)(ws + WS_CH_KDT), *cQK = (bf16_t*)(ws + WS_CH_QK);
    float* cGL = (float*)(ws + WS_CH_GL);
    int s = 0;
    while (s < NPHASE) {
        if (!((NAIVE_MASK >> s) & 1)) {
            int e = s + 1;
            if (FUSE) while (e < NPHASE && !((NAIVE_MASK >> e) & 1)) ++e;
            a.ph_lo = s; a.ph_hi = e;
            hipLaunchKernelGGL(mega_fwd, dim3(grid), dim3(NWAVES * 64), LDS_BYTES, stream, a);
            s = e; continue;
        }
        switch (s) {
        case 0: nv_prep<<<1024, 256, 0, stream>>>(x, meta, norm_w, XN); break;
        case 1: nv_gemm<EpiProj><<<dim3((INC + 127) / 128, (MROWS + 127) / 128), 256, 0, stream>>>(XN, DM, w_in, INC, MROWS, INC, DM, EpiProj{U, SZP, QKV, SZD, GATES, BA}); break;
        case 2: nv_pool<<<MTOK * PW / 256, 256, 0, stream>>>(U, PO);
                nv_chunk_prep<<<NUNITS, 256, 140 * 1024, stream>>>(QKV, BA, conv_w, A_log, dt_bias, cNW, cU, cQD, cKDT, cQK, cGL); break;
        case 3: nv_chunk_scan<<<NB * NH, 128, 0, stream>>>(cNW, cU, cQD, cKDT, cQK, cGL, O); break;
        case 4: nv_gnorm<<<MTOK * NH / 4, 256, 0, stream>>>(O, SZD, dn_norm_w, Y);
                for (int g = 0; g < 4; ++g)
                    nv_gemm<EpiPool><<<dim3(2, MTOK / 128), 256, 0, stream>>>(PO + g * PGD, PW, pool_mix + (size_t)g * PGD * PGD, PGD, MTOK, PGD, PGD, EpiPool{Y, SZP, pool_scale, g, 0});
                break;
        case 5: nv_gemm<EpiG2a><<<dim3(DM / 128, MTOK / 128), 256, 0, stream>>>(Y, YLD, w_pool_out, DM, MTOK, DM, PW, EpiG2a{out, GATES});
                nv_gemm<EpiG2b><<<dim3(DM / 128, MTOK / 128), 256, 0, stream>>>(Y + 1024, YLD, w_dn_out, DM, MTOK, DM, DNW, EpiG2b{out, GATES, MG}); break;
        case 6: nv_gemm<EpiG3><<<dim3(DM / 128, MTOK / 128), 256, 0, stream>>>(MG, DM, w_o, DM, MTOK, DM, DM, EpiG3{x, out}); break;
        case 7: nv_final<<<MTOK, 256, 0, stream>>>(out, final_norm_w); break;
        }
        ++s;
    }
#endif
}
```
